# Optimizing an MI355X kernel written in HIP

```python
import math
import jax
import jax.numpy as jnp
from jax import lax
import numpy as np

D_MODEL = 1024
BATCH = 4
SEQ = 4096
DEPTH = 4

GRID_W = 64
CTX_LEN = 256

HEAD_DIM = 64
GLA_WIDTH = D_MODEL // 4
RWKV_WIDTH = D_MODEL // 4
SSD_WIDTH = D_MODEL - GLA_WIDTH - RWKV_WIDTH

GLA_HEADS = GLA_WIDTH // HEAD_DIM
GLA_DV = HEAD_DIM
GLA_DK = HEAD_DIM // 2
GLA_KEY_WIDTH = GLA_HEADS * GLA_DK
GLA_GATE_RANK = 16
GLA_GATE_TAU = 16.0
GLA_CHUNK = 16

RWKV_HEADS = RWKV_WIDTH // HEAD_DIM
RWKV_N = HEAD_DIM
RWKV_DECAY_RANK = 32
RWKV_A_RANK = 32
RWKV_GATE_RANK = 64
RWKV_DECAY_SCALE = 0.606531
RWKV_LN_EPS = 64e-5

SSD_HEADS = SSD_WIDTH // HEAD_DIM
SSD_P = HEAD_DIM
SSD_N = 128
SSD_GROUPS = 2
SSD_CONV = 4
SSD_CHUNK = 64

N_EXPERTS = 32
TOP_K = 4
D_FF = D_MODEL
SWIGLU_LIMIT = 7.0
SWIGLU_ALPHA = 1.702

NORM_EPS = 1e-6

GLA_COLS = 2 * GLA_KEY_WIDTH + 2 * GLA_WIDTH + 2 * GLA_GATE_RANK
RWKV_COLS = 3 * RWKV_WIDTH + 2 * RWKV_DECAY_RANK + RWKV_A_RANK + RWKV_GATE_RANK
SSD_XBC = SSD_WIDTH + 2 * SSD_GROUPS * SSD_N
SSD_COLS = SSD_WIDTH + SSD_XBC + 2 * SSD_HEADS
IN_COLS = GLA_COLS + RWKV_COLS + SSD_COLS

kernel_name = "hybrid_gla_rwkv7_ssd_moe_prefix_dit"


def _split(u, sizes):
    offsets = [int(o) for o in np.cumsum(sizes)[:-1]]
    return jnp.split(u, offsets, axis=-1)


def rmsnorm(x, g, eps=NORM_EPS):
    xf = x.astype(jnp.float32)
    y = xf * lax.rsqrt(jnp.mean(xf * xf, axis=-1, keepdims=True) + eps)
    return (y * g.astype(jnp.float32)).astype(x.dtype)


def modulate(h, shift, scale):
    return h * (1.0 + scale) + shift


def split_heads(t, n_heads):
    b, l, _ = t.shape
    return t.reshape(b, l, n_heads, -1).transpose(0, 2, 1, 3)


def merge_heads(t):
    b, h, l, d = t.shape
    return t.transpose(0, 2, 1, 3).reshape(b, l, h * d)


def _rows_view(u, grid_rows):
    if grid_rows is None:
        return u
    b, l, ch = u.shape
    return u.reshape(b * grid_rows, l // grid_rows, ch)


def centred_dwconv(u, w, bias, grid_rows):
    b, l, ch = u.shape
    rows = _rows_view(u, grid_rows)
    k = w.shape[0]
    pad_l = k // 2
    out = lax.conv_general_dilated(rows, w[:, None, :].astype(rows.dtype), window_strides=(1,),
                                   padding=[(pad_l, k - 1 - pad_l)],
                                   dimension_numbers=('NWC', 'WIO', 'NWC'), feature_group_count=ch)
    return out.reshape(b, l, ch) + bias


def centred_token_shift(u, mu, grid_rows):
    b, l, ch = u.shape
    rows = _rows_view(u, grid_rows)
    prev = jnp.pad(rows, ((0, 0), (1, 0), (0, 0)))[:, :-1]
    nxt = jnp.pad(rows, ((0, 0), (0, 1), (0, 0)))[:, 1:]
    out = rows + mu[0] * (prev - rows) + mu[1] * (nxt - rows)
    return out.reshape(b, l, ch)


def chunk_state_scan(chunk_decay, chunk_update, s0):
    def step(s, inp):
        d, upd = inp
        return d[..., None] * s + upd, s
    s_fin, starts = lax.scan(step, s0, (jnp.moveaxis(chunk_decay, 2, 0), jnp.moveaxis(chunk_update, 2, 0)))
    return jnp.moveaxis(starts, 0, 2), s_fin


def gla_chunked(q, k, v, g, s0):
    b_, h, l, dk = q.shape
    dv = v.shape[-1]
    c = GLA_CHUNK
    nc = l // c
    q = q.reshape(b_, h, nc, c, dk)
    k = k.reshape(b_, h, nc, c, dk)
    v = v.reshape(b_, h, nc, c, dv)
    cum = jnp.cumsum(g.reshape(b_, h, nc, c, dk).astype(jnp.float32), axis=3)
    causal = jnp.tril(jnp.ones((c, c), dtype=bool))[:, :, None]
    rel = jnp.exp(jnp.where(causal, cum[:, :, :, :, None, :] - cum[:, :, :, None, :, :], -jnp.inf))
    att = jnp.einsum('bhntd,bhnsd,bhntsd->bhnts', q, k, rel)
    o = jnp.einsum('bhnts,bhnsv->bhntv', att, v)
    last = cum[:, :, :, -1:, :]
    upd = jnp.einsum('bhnsd,bhnsv->bhndv', k * jnp.exp(last - cum), v)
    s_start, s_fin = chunk_state_scan(jnp.exp(last[:, :, :, 0, :]), upd, s0)
    o = o + jnp.einsum('bhntd,bhndv->bhntv', q * jnp.exp(cum), s_start)
    return o.reshape(b_, h, l, dv), s_fin


def ssd_chunked(xdt, a, bm, cm, s0):
    b_, h, l, p = xdt.shape
    c = SSD_CHUNK
    nc = l // c
    xdt = xdt.reshape(b_, h, nc, c, p)
    bm = bm.reshape(b_, h, nc, c, -1)
    cm = cm.reshape(b_, h, nc, c, -1)
    cum = jnp.cumsum(a.reshape(b_, h, nc, c).astype(jnp.float32), axis=-1)
    causal = jnp.tril(jnp.ones((c, c), dtype=bool))
    decay = jnp.exp(jnp.where(causal, cum[..., :, None] - cum[..., None, :], -jnp.inf))
    scores = jnp.einsum('bhctn,bhcsn->bhcts', cm, bm) * decay
    y = jnp.einsum('bhcts,bhcsp->bhctp', scores, xdt)
    last = cum[..., -1:]
    upd = jnp.einsum('bhcsn,bhcsp->bhcnp', bm * jnp.exp(last - cum)[..., None], xdt)
    s_start, s_fin = chunk_state_scan(jnp.exp(last), upd, s0)
    y = y + jnp.einsum('bhctn,bhcnp->bhctp', cm * jnp.exp(cum)[..., None], s_start)
    return y.reshape(b_, h, l, p), s_fin


def rwkv7_scan(r, w, k, v, kk, a, s0):
    def step(s, inp):
        r_t, w_t, k_t, v_t, kk_t, a_t = inp
        s_kk = jnp.einsum('bhvk,bhk->bhv', s, kk_t)
        s = (s * w_t[:, :, None, :] - s_kk[..., None] * (kk_t * a_t)[:, :, None, :]
             + v_t[..., None] * k_t[:, :, None, :])
        return s, jnp.einsum('bhvk,bhk->bhv', s, r_t)
    xs = tuple(jnp.moveaxis(t, 2, 0) for t in (r, w, k, v, kk, a))
    s_fin, o = lax.scan(step, s0, xs)
    return jnp.moveaxis(o, 0, 2), s_fin


def _flip_time(ts):
    return tuple(jnp.flip(t, axis=2) for t in ts)


def bidir_prefix_scan(scan_fn, s0, ctx_f, ctx_b, lat_f, lat_b):
    o_cf, s_cf = scan_fn(*ctx_f, s0)
    o_cb, s_cb = scan_fn(*_flip_time(ctx_b), s0)
    o_lf, _ = scan_fn(*lat_f, s_cf)
    o_lb, _ = scan_fn(*_flip_time(lat_b), s_cb)
    return o_cf + jnp.flip(o_cb, axis=2), o_lf + jnp.flip(o_lb, axis=2)


def mixer_inputs(h, p, grid_rows):
    b, l, _ = h.shape
    u = h @ p['w_in']
    u_gla, u_rw, u_ssd = _split(u, [GLA_COLS, RWKV_COLS, SSD_COLS])

    q, k, v, og, lg_f, lg_b = _split(u_gla, [GLA_KEY_WIDTH, GLA_KEY_WIDTH, GLA_WIDTH, GLA_WIDTH,
                                             GLA_GATE_RANK, GLA_GATE_RANK])

    def gla_log_decay(low, d):
        z = (low @ p['gla_gate_w'][d] + p['gla_gate_b'][d]).astype(jnp.float32)
        return split_heads(jax.nn.log_sigmoid(z) / GLA_GATE_TAU, GLA_HEADS)

    gla = dict(q=split_heads(q, GLA_HEADS) * (GLA_DK ** -0.5), k=split_heads(k, GLA_HEADS),
               v=split_heads(v, GLA_HEADS), g_f=gla_log_decay(lg_f, 0), g_b=gla_log_decay(lg_b, 1),
               gate=jax.nn.silu(og))

    u_rw = centred_token_shift(u_rw, p['rw_mu'], grid_rows)
    r, k, v, lw_f, lw_b, la, lgt = _split(u_rw, [RWKV_WIDTH, RWKV_WIDTH, RWKV_WIDTH, RWKV_DECAY_RANK,
                                               RWKV_DECAY_RANK, RWKV_A_RANK, RWKV_GATE_RANK])

    def rw_decay(low, d):
        z = p['rw_w0'][d] + jnp.tanh(low) @ p['rw_w2'][d]
        return split_heads(jnp.exp(-RWKV_DECAY_SCALE * jax.nn.sigmoid(z)), RWKV_HEADS)

    a = jax.nn.sigmoid(p['rw_a0'] + la @ p['rw_a2'])
    kk = split_heads(k * p['rw_kk'], RWKV_HEADS).astype(jnp.float32)
    kk = (kk * lax.rsqrt(jnp.sum(kk * kk, axis=-1, keepdims=True) + 1e-12)).astype(k.dtype)
    k = k * (1.0 + (a - 1.0) * p['rw_ka'])
    rwkv = dict(r=split_heads(r, RWKV_HEADS), k=split_heads(k, RWKV_HEADS), v=split_heads(v, RWKV_HEADS),
                kk=kk, a=split_heads(a, RWKV_HEADS), w_f=rw_decay(lw_f, 0), w_b=rw_decay(lw_b, 1),
                gate=jax.nn.sigmoid(lgt) @ p['rw_g2'])

    z, xbc, dt = _split(u_ssd, [SSD_WIDTH, SSD_XBC, 2 * SSD_HEADS])
    xbc = jax.nn.silu(centred_dwconv(xbc, p['ssd_conv_w'], p['ssd_conv_b'], grid_rows))
    xs, bm, cm = _split(xbc, [SSD_WIDTH, SSD_GROUPS * SSD_N, SSD_GROUPS * SSD_N])
    rep = SSD_HEADS // SSD_GROUPS
    bm = jnp.repeat(split_heads(bm, SSD_GROUPS), rep, axis=1)
    cm = jnp.repeat(split_heads(cm, SSD_GROUPS), rep, axis=1)
    xs = split_heads(xs, SSD_HEADS)
    dt = jax.nn.softplus((dt.reshape(b, l, 2, SSD_HEADS) + p['ssd_dt_bias']).astype(jnp.float32))
    a_neg = -jnp.exp(p['ssd_a_log'])
    dt_f = dt[:, :, 0].transpose(0, 2, 1)
    dt_b = dt[:, :, 1].transpose(0, 2, 1)
    ssd = dict(x=xs, xdt_f=xs * dt_f[..., None], a_f=dt_f * a_neg[0][:, None],
               xdt_b=xs * dt_b[..., None], a_b=dt_b * a_neg[1][:, None], b=bm, c=cm, z=z)
    return dict(gla=gla, rwkv=rwkv, ssd=ssd)


def _pick(f, names):
    return tuple(f[n] for n in names)


def token_mixers(fc, fl):
    b = fl['gla']['v'].shape[0]
    gc, gl = fc['gla'], fl['gla']
    nf, nb = ('q', 'k', 'v', 'g_f'), ('q', 'k', 'v', 'g_b')
    gla = bidir_prefix_scan(gla_chunked, jnp.zeros((b, GLA_HEADS, GLA_DK, GLA_DV), jnp.float32),
                            _pick(gc, nf), _pick(gc, nb), _pick(gl, nf), _pick(gl, nb))
    rc, rl = fc['rwkv'], fl['rwkv']
    nf, nb = ('r', 'w_f', 'k', 'v', 'kk', 'a'), ('r', 'w_b', 'k', 'v', 'kk', 'a')
    rwkv = bidir_prefix_scan(rwkv7_scan, jnp.zeros((b, RWKV_HEADS, RWKV_N, RWKV_N), jnp.float32),
                             _pick(rc, nf), _pick(rc, nb), _pick(rl, nf), _pick(rl, nb))
    sc, sl = fc['ssd'], fl['ssd']
    nf, nb = ('xdt_f', 'a_f', 'b', 'c'), ('xdt_b', 'a_b', 'b', 'c')
    ssd = bidir_prefix_scan(ssd_chunked, jnp.zeros((b, SSD_HEADS, SSD_N, SSD_P), jnp.float32),
                            _pick(sc, nf), _pick(sc, nb), _pick(sl, nf), _pick(sl, nb))
    return gla, rwkv, ssd


def mixer_output(f, o_gla, o_rw, y_ssd, p):
    g, r, s = f['gla'], f['rwkv'], f['ssd']
    o1 = merge_heads(rmsnorm(o_gla, p['gla_norm_g'][:, None, :])) * g['gate']
    of = o_rw.astype(jnp.float32)
    mean = jnp.mean(of, axis=-1, keepdims=True)
    var = jnp.mean(jnp.square(of - mean), axis=-1, keepdims=True)
    on = (of - mean) * lax.rsqrt(var + RWKV_LN_EPS) * p['rw_lnx_g'][:, None, :] + p['rw_lnx_b'][:, None, :]
    bonus = jnp.sum(r['r'] * r['k'] * p['rw_rk'][:, None, :], axis=-1, keepdims=True) * r['v']
    o2 = merge_heads(on + bonus) * r['gate']
    y = merge_heads(y_ssd + p['ssd_d'][:, None, None] * s['x']) * jax.nn.silu(s['z'])
    bb, l, _ = y.shape
    y = rmsnorm(y.reshape(bb, l, SSD_GROUPS, -1), p['ssd_norm_g'].reshape(SSD_GROUPS, -1)).reshape(bb, l, SSD_WIDTH)
    return jnp.concatenate([o1, o2, y], axis=-1) @ p['w_out']


def moe(h, p):
    shp = h.shape
    t = h.reshape(-1, shp[-1])
    logits = (t @ p['router_w'] + p['router_b']).astype(jnp.float32)
    top_v, top_i = lax.top_k(logits, TOP_K)
    probs = jax.nn.softmax(top_v, axis=-1)
    gates = jnp.einsum('nk,nke->ne', probs, jax.nn.one_hot(top_i, N_EXPERTS, dtype=probs.dtype)).astype(t.dtype)
    y = jnp.zeros_like(t)
    for e in range(N_EXPERTS):
        gu = t @ p['moe_w_gu'][e] + p['moe_b_gu'][e]
        glu, lin = jnp.split(gu, 2, axis=-1)
        glu = jnp.minimum(glu, SWIGLU_LIMIT)
        lin = jnp.clip(lin, -SWIGLU_LIMIT, SWIGLU_LIMIT)
        act = glu * jax.nn.sigmoid(SWIGLU_ALPHA * glu) * (lin + 1.0)
        y = y + gates[:, e:e + 1] * (act @ p['moe_w_down'][e] + p['moe_b_down'][e])
    return y.reshape(shp)


def setup_inputs(seed: int = 0) -> dict:
    key = jax.random.key(seed)
    keys = jax.random.split(key, 64)
    counter = [0]

    def nk():
        counter[0] += 1
        return keys[counter[0] - 1]

    def nrm(shape, scale):
        return jax.random.normal(nk(), shape, jnp.float32) * scale

    def gain(shape):
        return 1.0 + nrm(shape, 0.05)

    L = DEPTH
    D = D_MODEL
    dt = jnp.exp(jax.random.uniform(nk(), (L, 2, SSD_HEADS), jnp.float32, math.log(1e-3), math.log(1e-1)))
    return {
        'x': nrm((BATCH, SEQ, D), 1.0),
        'c': nrm((BATCH, D), 1.0),
        'ctx': nrm((BATCH, CTX_LEN, D), 1.0),
        'c_ctx': nrm((D,), 1.0),
        'w_ada': nrm((L, D, 6 * D), 0.5 * D ** -0.5),
        'b_ada': nrm((L, 6 * D), 0.02),
        'norm1_g': gain((L, D)),
        'norm2_g': gain((L, D)),
        'w_in': nrm((L, D, IN_COLS), D ** -0.5),
        'gla_gate_w': nrm((L, 2, GLA_GATE_RANK, GLA_KEY_WIDTH), GLA_GATE_RANK ** -0.5),
        'gla_gate_b': nrm((L, 2, GLA_KEY_WIDTH), 0.1),
        'gla_norm_g': gain((L, GLA_HEADS, GLA_DV)),
        'rw_mu': jax.random.uniform(nk(), (L, 2, RWKV_COLS), jnp.float32, 0.0, 0.45),
        'rw_w0': nrm((L, 2, RWKV_WIDTH), 1.0),
        'rw_w2': nrm((L, 2, RWKV_DECAY_RANK, RWKV_WIDTH), 0.1),
        'rw_a0': nrm((L, RWKV_WIDTH), 0.5),
        'rw_a2': nrm((L, RWKV_A_RANK, RWKV_WIDTH), 0.1),
        'rw_g2': nrm((L, RWKV_GATE_RANK, RWKV_WIDTH), RWKV_GATE_RANK ** -0.5),
        'rw_kk': gain((L, RWKV_WIDTH)),
        'rw_ka': gain((L, RWKV_WIDTH)),
        'rw_rk': nrm((L, RWKV_HEADS, RWKV_N), 0.5),
        'rw_lnx_g': gain((L, RWKV_HEADS, RWKV_N)),
        'rw_lnx_b': nrm((L, RWKV_HEADS, RWKV_N), 0.02),
        'ssd_conv_w': nrm((L, SSD_CONV, SSD_XBC), SSD_CONV ** -0.5),
        'ssd_conv_b': nrm((L, SSD_XBC), 0.02),
        'ssd_dt_bias': dt + jnp.log(-jnp.expm1(-dt)),
        'ssd_a_log': jnp.log(jax.random.uniform(nk(), (L, 2, SSD_HEADS), jnp.float32, 1.0, 16.0)),
        'ssd_d': gain((L, SSD_HEADS)),
        'ssd_norm_g': gain((L, SSD_WIDTH)),
        'w_out': nrm((L, D, D), D ** -0.5),
        'router_w': nrm((L, D, N_EXPERTS), D ** -0.5),
        'router_b': nrm((L, N_EXPERTS), 0.01),
        'moe_w_gu': nrm((L, N_EXPERTS, D, 2 * D_FF), D ** -0.5),
        'moe_b_gu': nrm((L, N_EXPERTS, 2 * D_FF), 0.01),
        'moe_w_down': nrm((L, N_EXPERTS, D_FF, D), D_FF ** -0.5),
        'moe_b_down': nrm((L, N_EXPERTS, D), 0.01),
        'final_norm_g': gain((D,)),
    }


def reference(x, c, ctx, c_ctx, w_ada, b_ada, norm1_g, norm2_g, w_in, gla_gate_w, gla_gate_b, gla_norm_g,
              rw_mu, rw_w0, rw_w2, rw_a0, rw_a2, rw_g2, rw_kk, rw_ka, rw_rk, rw_lnx_g, rw_lnx_b,
              ssd_conv_w, ssd_conv_b, ssd_dt_bias, ssd_a_log, ssd_d, ssd_norm_g, w_out,
              router_w, router_b, moe_w_gu, moe_b_gu, moe_w_down, moe_b_down, final_norm_g):
    grid_rows = x.shape[1] // GRID_W
    xl, xc = x, ctx
    for i in range(DEPTH):
        p = dict(w_in=w_in[i], gla_gate_w=gla_gate_w[i], gla_gate_b=gla_gate_b[i], gla_norm_g=gla_norm_g[i],
                 rw_mu=rw_mu[i], rw_w0=rw_w0[i], rw_w2=rw_w2[i], rw_a0=rw_a0[i], rw_a2=rw_a2[i],
                 rw_g2=rw_g2[i], rw_kk=rw_kk[i], rw_ka=rw_ka[i], rw_rk=rw_rk[i], rw_lnx_g=rw_lnx_g[i],
                 rw_lnx_b=rw_lnx_b[i], ssd_conv_w=ssd_conv_w[i], ssd_conv_b=ssd_conv_b[i],
                 ssd_dt_bias=ssd_dt_bias[i], ssd_a_log=ssd_a_log[i], ssd_d=ssd_d[i], ssd_norm_g=ssd_norm_g[i],
                 w_out=w_out[i], router_w=router_w[i], router_b=router_b[i], moe_w_gu=moe_w_gu[i],
                 moe_b_gu=moe_b_gu[i], moe_w_down=moe_w_down[i], moe_b_down=moe_b_down[i])
        mod_l = jnp.split((jax.nn.silu(c) @ w_ada[i] + b_ada[i])[:, None, :], 6, axis=-1)
        mod_c = jnp.split((jax.nn.silu(c_ctx) @ w_ada[i] + b_ada[i])[None, None, :], 6, axis=-1)

        hl = modulate(rmsnorm(xl, norm1_g[i]), mod_l[0], mod_l[1])
        hc = modulate(rmsnorm(xc, norm1_g[i]), mod_c[0], mod_c[1])
        fl = mixer_inputs(hl, p, grid_rows)
        fc = mixer_inputs(hc, p, None)
        (gla_c, gla_l), (rw_c, rw_l), (ssd_c, ssd_l) = token_mixers(fc, fl)
        xl = xl + mod_l[2] * mixer_output(fl, gla_l, rw_l, ssd_l, p)
        hl = modulate(rmsnorm(xl, norm2_g[i]), mod_l[3], mod_l[4])
        if i == DEPTH - 1:
            xl = xl + mod_l[5] * moe(hl, p)
        else:
            xc = xc + mod_c[2] * mixer_output(fc, gla_c, rw_c, ssd_c, p)
            hc = modulate(rmsnorm(xc, norm2_g[i]), mod_c[3], mod_c[4])
            y = moe(jnp.concatenate([hc, hl], axis=1), p)
            n_ctx = xc.shape[1]
            xc = xc + mod_c[5] * y[:, :n_ctx]
            xl = xl + mod_l[5] * y[:, n_ctx:]
    return rmsnorm(xl, final_norm_g)
```

```cpp
#ifndef EMU
#include <hip/hip_runtime.h>
#endif
#include <cstdio>
#include <cstdint>
#include <cmath>

#ifndef CFG_BATCH
#define CFG_BATCH 4
#define CFG_SEQ 4096
#define CFG_CTX 256
#define CFG_DEPTH 4
#define CFG_NEXP 32
#endif
#ifndef N_LAUNCH_MODE
#define N_LAUNCH_MODE 0
#endif

namespace mk {
constexpr int BATCH = CFG_BATCH, SEQ = CFG_SEQ, CTX = CFG_CTX, DEPTH = CFG_DEPTH, NEXP = CFG_NEXP;
constexpr int D = 1024, ML = BATCH * SEQ, MC = BATCH * CTX, M = ML + MC, NR = BATCH + 1;
constexpr int IN_COLS = 3280, NU = 3328;
constexpr int TOPK = 4, DFF = 1024;
constexpr int MAXROWS = M * TOPK + NEXP * 256;
constexpr int NTHREADS = 512, NWAVES = 8;
constexpr int U_GQ = 0, U_GK = 128, U_GV = 256, U_GOG = 512, U_GLF = 768, U_GLB = 784;
constexpr int U_RW = 800, U_RR = 800, U_RK = 1056, U_RV = 1312, U_RLWF = 1568, U_RLWB = 1600, U_RLA = 1632, U_RLGT = 1664;
constexpr int U_SZ = 1728, U_SXBC = 2240, U_SDT = 3264;
static_assert(SEQ % 256 == 0 && CTX % 256 == 0 && M % 256 == 0, "row tiles");

constexpr size_t al256(size_t x) { return (x + 255) & ~(size_t)255; }
constexpr size_t WS_CTL = 0, CTL_BYTES = 1u << 20;
constexpr size_t WS_MODS = WS_CTL + CTL_BYTES;
constexpr size_t WS_X = WS_MODS + al256((size_t)DEPTH * NR * 6144 * 4);
constexpr size_t WS_H = WS_X + al256((size_t)M * D * 4);
constexpr size_t WS_U = WS_H + al256((size_t)M * D * 2);
constexpr size_t WS_GG = WS_U + al256((size_t)M * NU * 4);
constexpr size_t WS_RW7 = WS_GG + al256((size_t)2 * M * 128 * 4);
constexpr size_t WS_SXBC = WS_RW7 + al256((size_t)7 * M * 256 * 4);
constexpr size_t WS_SDT = WS_SXBC + al256((size_t)M * 1024 * 4);
constexpr size_t WS_OG = WS_SDT + al256((size_t)M * 16 * 4);
constexpr size_t WS_OR = WS_OG + al256((size_t)2 * M * 256 * 4);
constexpr size_t WS_OS = WS_OR + al256((size_t)2 * M * 256 * 4);
constexpr size_t WS_MIX = WS_OS + al256((size_t)2 * M * 512 * 4);
constexpr size_t WS_TOPI = WS_MIX + al256((size_t)M * D * 2);
constexpr size_t WS_TOPP = WS_TOPI + al256((size_t)M * 4 * 4);
constexpr size_t WS_POS = WS_TOPP + al256((size_t)M * 4 * 4);
constexpr size_t WS_ROWIDX = WS_POS + al256((size_t)M * 4 * 4);
constexpr size_t WS_ROWGATE = WS_ROWIDX + al256((size_t)MAXROWS * 4);
constexpr size_t WS_ACT = WS_ROWGATE + al256((size_t)MAXROWS * 4);
constexpr size_t WS_Y = WS_ACT + al256((size_t)MAXROWS * DFF * 2);
constexpr size_t WS_WIN = WS_Y + al256((size_t)MAXROWS * D * 2);
constexpr size_t WS_WOUT = WS_WIN + al256((size_t)DEPTH * NU * D * 2);
constexpr size_t WS_WGU = WS_WOUT + al256((size_t)DEPTH * D * D * 2);
constexpr size_t WS_WD = WS_WGU + al256((size_t)DEPTH * NEXP * 2048 * D * 2);
constexpr size_t WS_END = WS_WD + al256((size_t)DEPTH * NEXP * D * DFF * 2);
constexpr int CW_BAR = 4096;
constexpr int CW_CNT = 16384;
constexpr int CW_CUR = 16384 + 64 * 8;
constexpr int LDS_STAGE = 131072;
constexpr int LDS_TILE_E = LDS_STAGE;
constexpr int LDS_MISC = LDS_STAGE + 2048;
constexpr int LDS_BYTES = 147456;

#ifdef EMU
#define LAS
#define ASM_VM0() ((void)0)
#define ASM_LGKM0() ((void)0)
#define ASM_MEMFENCE() ((void)0)
#define WAIT_V(n) ((void)0)
#define WAIT_L(n) ((void)0)
#define WAVE_LDS_FENCE() emu_wave_sync()
#else
#define LAS __attribute__((address_space(3)))
#define ASM_VM0() asm volatile("s_waitcnt vmcnt(0)" ::: "memory")
#define ASM_LGKM0() asm volatile("s_waitcnt lgkmcnt(0)" ::: "memory")
#define ASM_MEMFENCE() asm volatile("" ::: "memory")
#define WAIT_V(n) asm volatile("s_waitcnt vmcnt(" #n ")" ::: "memory")
#define WAIT_L(n) asm volatile("s_waitcnt lgkmcnt(" #n ")" ::: "memory")
#define WAVE_LDS_FENCE() do { asm volatile("s_waitcnt lgkmcnt(0)" ::: "memory"); } while (0)
#endif

typedef unsigned short bf16_t;
typedef short bf16x8 __attribute__((ext_vector_type(8)));
typedef float f32x4 __attribute__((ext_vector_type(4)));
typedef float f32x2 __attribute__((ext_vector_type(2)));
typedef unsigned u32x4 __attribute__((ext_vector_type(4)));
typedef unsigned u32x2 __attribute__((ext_vector_type(2)));

__device__ __forceinline__ unsigned f2bf(float f) { unsigned u = __float_as_uint(f); return (u + 0x7fffu + ((u >> 16) & 1u)) >> 16; }
__device__ __forceinline__ unsigned pk2(float lo, float hi) { return f2bf(lo) | (f2bf(hi) << 16); }
__device__ __forceinline__ float bf_lo(unsigned w) { return __uint_as_float(w << 16); }
__device__ __forceinline__ float bf_hi(unsigned w) { return __uint_as_float(w & 0xffff0000u); }
__device__ __forceinline__ float wave_sum(float v) {
#pragma unroll
    for (int o = 1; o < 64; o <<= 1) v += __shfl_xor(v, o);
    return v;
}
__device__ __forceinline__ float sum8(float v) { v += __shfl_xor(v, 1); v += __shfl_xor(v, 2); v += __shfl_xor(v, 4); return v; }
__device__ __forceinline__ float sigmoidf_(float x) { return 1.0f / (1.0f + expf(-x)); }
__device__ __forceinline__ float siluf_(float x) { return x / (1.0f + expf(-x)); }
__device__ __forceinline__ float softplusf_(float x) { return fmaxf(x, 0.f) + log1pf(expf(-fabsf(x))); }
__device__ __forceinline__ float logsigmoidf_(float x) { return -softplusf_(-x); }

#define XB_TMO      128
#define XB_XCNT(j)  (256  + 64 * (j))
#define XB_XSUB(j)  (1280 + 64 * (j))
#define XB_XGEN(j)  (2304 + 64 * (j))
#define XB_TOP      3328
#define XB_TOPGEN   3392
#define XCD_BAR_WORDS 3456
#ifdef EMU
#define XB_SPIN_CAP (0xffffffffu)
#else
#define XB_SPIN_CAP (1u << 22)
#endif
__device__ __forceinline__ unsigned xb_ld(unsigned* p)              { return __hip_atomic_load(p, __ATOMIC_RELAXED, __HIP_MEMORY_SCOPE_AGENT); }
__device__ __forceinline__ unsigned xb_add(unsigned* p, unsigned v) { return __hip_atomic_fetch_add(p, v, __ATOMIC_RELAXED, __HIP_MEMORY_SCOPE_AGENT); }
__device__ __forceinline__ unsigned xb_xcc_id() { return (unsigned)__builtin_amdgcn_s_getreg((3 << 11) | 20) & 0xFu; }
#define XB_SPIN(cond, bar) do { unsigned _sp = 0; while (cond) { __builtin_amdgcn_s_sleep(1); \
    if ((++_sp & 255u) == 0u) { if (xb_ld(&(bar)[XB_TMO])) break; if (_sp > XB_SPIN_CAP) { atomicAdd(&(bar)[XB_TMO], 1u); break; } } } } while (0)
struct XcdBarrier { unsigned* bar; unsigned x; volatile LAS unsigned* st; };
__device__ __forceinline__ XcdBarrier xcd_barrier_post(unsigned* bar, volatile LAS unsigned* st) {
    XcdBarrier b; b.bar = bar; b.x = xb_xcc_id(); b.st = st;
    if (threadIdx.x == 0) (void)xb_add(&bar[XB_XCNT(b.x)], 1u);
    return b;
}
__device__ __forceinline__ void xcd_barrier_complete(unsigned* bar, unsigned x, unsigned& nloc, unsigned& nx) {
    const unsigned G = gridDim.x * gridDim.y * gridDim.z;
    unsigned sum, cnt, mine, sp = 0u;
    for (;;) {
        sum = 0u; cnt = 0u; mine = 0u;
#pragma unroll
        for (unsigned j = 0; j < 16; ++j) { const unsigned c = xb_ld(&bar[XB_XCNT(j)]); sum += c; cnt += (c > 0u) ? 1u : 0u; mine = (j == x) ? c : mine; }
        if (sum == G) break;
        __builtin_amdgcn_s_sleep(1);
        if ((++sp & 255u) == 0u) { if (xb_ld(&bar[XB_TMO])) break; if (sp > XB_SPIN_CAP) { atomicAdd(&bar[XB_TMO], 1u); break; } }
    }
    nloc = mine > 0u ? mine : 1u; nx = cnt > 0u ? cnt : 1u;
}
__device__ __forceinline__ void xcd_barrier(const XcdBarrier& b) {
    ASM_VM0();
    __syncthreads();
    if (threadIdx.x == 0) {
        unsigned* bar = b.bar;
        __builtin_amdgcn_s_waitcnt(0);
        unsigned nloc = b.st[0], nx = b.st[1];
        if (nloc == 0u) { xcd_barrier_complete(bar, b.x, nloc, nx); b.st[0] = nloc; b.st[1] = nx; }
        const unsigned old = xb_add(&bar[XB_XSUB(b.x)], 1u);
        const unsigned gen = old / nloc;
        if (old + 1u == (gen + 1u) * nloc) {
            __builtin_amdgcn_fence(__ATOMIC_RELEASE, "agent");
            ASM_VM0();
            const unsigned og = xb_add(&bar[XB_TOP], 1u);
            const unsigned tg = og / nx;
            if (og + 1u == (tg + 1u) * nx) xb_add(&bar[XB_TOPGEN], 1u);
            else XB_SPIN(xb_ld(&bar[XB_TOPGEN]) == tg, bar);
            __builtin_amdgcn_fence(__ATOMIC_ACQUIRE, "agent");
            xb_add(&bar[XB_XGEN(b.x)], 1u);
            ASM_VM0();
        } else {
            XB_SPIN(xb_ld(&bar[XB_XGEN(b.x)]) == gen, bar);
            __builtin_amdgcn_fence(__ATOMIC_ACQUIRE, "agent");
            ASM_VM0();
        }
    }
    __syncthreads();
}

namespace pg8 {
constexpr int BM = 256, BK = 64, HALF = 128, HTB = HALF * BK * 2, STAGE_BYTES = 8 * HTB, NXCD = 8, WGM = 8;
__host__ __device__ __forceinline__ int lds_byte(int r, int c) { const int st = (r >> 4) * 2 + (c >> 5), rr = r & 15, cc = c & 31, ob = rr * 64 + cc * 2; return st * 1024 + (ob ^ (((ob >> 9) & 1) << 5)); }
__host__ __device__ __forceinline__ void stage_rc(int b, int& R, int& C) { const int st = b / 1024, sb = b % 1024, swz = sb ^ (((sb >> 9) & 1) << 5); R = (st >> 1) * 16 + swz / 64; C = (st & 1) * 32 + (swz % 64) / 2; }
__host__ __device__ __forceinline__ int perm32(int rho) { const int n = rho >> 4, i = rho & 15; return 8 * (i >> 2) + 4 * n + (i & 3); }
struct Unit { int pm, pn, pb; };
struct Gemm { const bf16_t* A; const bf16_t* Bt; int K; const int* rowidx; };
struct Order {
    int nM, nN, nwg, G, c;
    __device__ __forceinline__ void init(int nM_, int nN_, int G_, int c_) { nM = nM_; nN = nN_; nwg = nM * nN; G = G_; c = c_; }
    __device__ __forceinline__ bool tile(int i, int& pm, int& pn) const {
        const long L = (long)i * G + c; if (L >= nwg) return false;
        int wgid = (int)L; { const int q = nwg / NXCD, r = nwg % NXCD, xcd = wgid % NXCD, off = wgid / NXCD; wgid = (xcd < r ? xcd * (q + 1) : r * (q + 1) + (xcd - r) * q) + off; }
        const int nig = WGM * nN, gid = wgid / nig, fm = gid * WGM, gsz = (nM - fm) < WGM ? (nM - fm) : WGM;
        pm = fm + ((wgid % nig) % gsz); pn = (wgid % nig) / gsz; return true;
    }
};
struct DenseSched { Order o; __device__ __forceinline__ bool next(int i, Unit& u) const { if (!o.tile(i, u.pm, u.pn)) return false; u.pb = u.pn; return true; } };
struct MoeSched { Order o; const LAS int* tile_e; int nct;
    __device__ __forceinline__ bool next(int i, Unit& u) const { if (!o.tile(i, u.pm, u.pn)) return false; u.pb = tile_e[u.pm] * nct + u.pn; return true; } };

__device__ __forceinline__ unsigned cvt_pk_bf16(float lo, float hi) {
#ifdef EMU
    return pk2(lo, hi);
#else
    unsigned r; asm volatile("v_cvt_pk_bf16_f32 %0, %1, %2" : "=v"(r) : "v"(lo), "v"(hi)); return r;
#endif
}
struct EpiF32 {
    static constexpr bool PERM = false;
    float* C; int ldc;
    __device__ __forceinline__ void operator()(const f32x4 (&acc)[2][2][4][2], const Unit& u, int wr, int wc, int fr, int fq) const {
        const int row0 = u.pm * BM + wr * 64 + fr, col0 = u.pn * BM + wc * 32 + 4 * fq;
#pragma unroll
        for (int ai = 0; ai < 2; ++ai)
#pragma unroll
            for (int m = 0; m < 4; ++m) { float* rowp = C + (size_t)(row0 + ai * HALF + m * 16) * ldc + col0;
#pragma unroll
                for (int bj = 0; bj < 2; ++bj)
#pragma unroll
                    for (int n = 0; n < 2; ++n) *(f32x4*)(rowp + bj * HALF + n * 16) = acc[ai][bj][m][n]; }
    }
};
struct EpiResid {
    static constexpr bool PERM = false;
    float* X; const float* mods;
    __device__ __forceinline__ void operator()(const f32x4 (&acc)[2][2][4][2], const Unit& u, int wr, int wc, int fr, int fq) const {
        const int row0 = u.pm * BM + wr * 64 + fr, col0 = u.pn * BM + wc * 32 + 4 * fq;
        const int rbase = u.pm * BM; const int mrow = rbase < ML ? rbase / SEQ : BATCH;
        const float* g = mods + (size_t)mrow * 6144 + 2 * 1024 + col0;
        f32x4 gv[2][2];
#pragma unroll
        for (int bj = 0; bj < 2; ++bj)
#pragma unroll
            for (int n = 0; n < 2; ++n) gv[bj][n] = *(const f32x4*)(g + bj * HALF + n * 16);
#pragma unroll
        for (int ai = 0; ai < 2; ++ai)
#pragma unroll
            for (int m = 0; m < 4; ++m) { float* rowp = X + (size_t)(row0 + ai * HALF + m * 16) * D + col0;
#pragma unroll
                for (int bj = 0; bj < 2; ++bj)
#pragma unroll
                    for (int n = 0; n < 2; ++n) { f32x4* p = (f32x4*)(rowp + bj * HALF + n * 16); *p = *p + gv[bj][n] * acc[ai][bj][m][n]; } }
    }
};
struct EpiSwiglu {
    static constexpr bool PERM = true;
    bf16_t* ACT; const float* bgu;
    __device__ __forceinline__ void operator()(const f32x4 (&acc)[2][2][4][2], const Unit& u, int wr, int wc, int fr, int fq) const {
        const int e = u.pb >> 3;
        const int row0 = u.pm * BM + wr * 64 + fr, j0 = u.pn * 128 + wc * 32 + 8 * fq;
        const float* bg = bgu + (size_t)e * 2048 + j0;
        f32x4 bgl[2], bln[2];
#pragma unroll
        for (int n = 0; n < 2; ++n) { bgl[n] = *(const f32x4*)(bg + 4 * n); bln[n] = *(const f32x4*)(bg + 1024 + 4 * n); }
#pragma unroll
        for (int ai = 0; ai < 2; ++ai)
#pragma unroll
            for (int m = 0; m < 4; ++m) { bf16_t* rowp = ACT + (size_t)(row0 + ai * HALF + m * 16) * DFF + j0;
                float o[8];
#pragma unroll
                for (int n = 0; n < 2; ++n)
#pragma unroll
                    for (int j = 0; j < 4; ++j) { float gl = acc[ai][0][m][n][j] + bgl[n][j], ln = acc[ai][1][m][n][j] + bln[n][j];
                        gl = fminf(gl, 7.0f); ln = fminf(fmaxf(ln, -7.0f), 7.0f);
                        o[n * 4 + j] = gl / (1.0f + __expf(-1.702f * gl)) * (ln + 1.0f); }
                u32x4 w; w.x = cvt_pk_bf16(o[0], o[1]); w.y = cvt_pk_bf16(o[2], o[3]); w.z = cvt_pk_bf16(o[4], o[5]); w.w = cvt_pk_bf16(o[6], o[7]);
                *(u32x4*)rowp = w; }
    }
};
struct EpiDown {
    static constexpr bool PERM = true;
    bf16_t* Y; const float* bd; const float* rowgate;
    __device__ __forceinline__ void operator()(const f32x4 (&acc)[2][2][4][2], const Unit& u, int wr, int wc, int fr, int fq) const {
        const int e = u.pb >> 2;
        const int row0 = u.pm * BM + wr * 64 + fr, col0 = u.pn * BM + wc * 32 + 8 * fq;
        const float* b = bd + (size_t)e * 1024 + col0;
        f32x4 bv[2][2];
#pragma unroll
        for (int bj = 0; bj < 2; ++bj)
#pragma unroll
            for (int n = 0; n < 2; ++n) bv[bj][n] = *(const f32x4*)(b + bj * HALF + 4 * n);
#pragma unroll
        for (int ai = 0; ai < 2; ++ai)
#pragma unroll
            for (int m = 0; m < 4; ++m) { const int row = row0 + ai * HALF + m * 16; const float gt = rowgate[row]; bf16_t* rowp = Y + (size_t)row * D + col0;
#pragma unroll
                for (int bj = 0; bj < 2; ++bj) { const f32x4 v0 = (acc[ai][bj][m][0] + bv[bj][0]) * gt, v1 = (acc[ai][bj][m][1] + bv[bj][1]) * gt;
                    u32x4 w; w.x = cvt_pk_bf16(v0[0], v0[1]); w.y = cvt_pk_bf16(v0[2], v0[3]); w.z = cvt_pk_bf16(v1[0], v1[1]); w.w = cvt_pk_bf16(v1[2], v1[3]);
                    *(u32x4*)(rowp + bj * HALF) = w; } }
    }
};

template <class Epi, class Sched, bool GATHER>
__device__ __forceinline__ void gemm_phase(LAS unsigned char* lds, const int tid, const Gemm g, const Sched& S, const Epi& E) {
    const int wid = __builtin_amdgcn_readfirstlane(tid >> 6), lane = tid & 63, wr = wid >> 2, wc = wid & 3, fr = lane & 15, fq = lane >> 4;
    const int K = g.K, nt = K / BK;
    unsigned voffB[2]; int RA[2], CA[2];
#pragma unroll
    for (int i = 0; i < 2; ++i) { int R, C; stage_rc(tid * 16 + i * 8192, R, C); const int Rb = Epi::PERM ? ((R & ~31) + perm32(R & 31)) : R;
        RA[i] = R; CA[i] = C; voffB[i] = (unsigned)(Rb * K + C) * 2u; }
    const size_t kstep = (size_t)(BK * 2);
    const size_t hstep = (size_t)HALF * K * 2;
    const size_t tstep = 2 * hstep;
    const unsigned ldsw = (unsigned)wid * 1024u;
    const int aoff = lds_byte(wr * 64 + fr, fq * 8), boff = lds_byte(wc * 32 + fr, fq * 8);
#define PG8_SA(b, h) (((b) * 2 + (h)) * HTB)
#define PG8_SB(b, h) ((4 + (b) * 2 + (h)) * HTB)
#define PG8_STAGE(bufoff, gbase, voff) do { _Pragma("unroll") for (int _i = 0; _i < 2; ++_i) \
        __builtin_amdgcn_global_load_lds((const unsigned*)((const char*)(gbase) + (voff)[_i]), (LAS unsigned*)(lds + (bufoff) + ldsw + _i * 8192), 16, 0, 0); } while (0)
#define PG8_LDA(dst, b, h) do { _Pragma("unroll") for (int m = 0; m < 4; ++m) _Pragma("unroll") for (int k = 0; k < 2; ++k) dst[m][k] = *(const LAS bf16x8*)(lds + PG8_SA(b, h) + aoff + m * 2048 + k * 1024); } while (0)
#define PG8_LDB(dst, b, h) do { _Pragma("unroll") for (int n = 0; n < 2; ++n) _Pragma("unroll") for (int k = 0; k < 2; ++k) dst[n][k] = *(const LAS bf16x8*)(lds + PG8_SB(b, h) + boff + n * 2048 + k * 1024); } while (0)
#define PG8_MMA(ai, bj, At, Bt) do { __builtin_amdgcn_s_setprio(1); _Pragma("unroll") for (int m = 0; m < 4; ++m) _Pragma("unroll") for (int n = 0; n < 2; ++n) _Pragma("unroll") for (int k = 0; k < 2; ++k) \
        acc[ai][bj][m][n] = __builtin_amdgcn_mfma_f32_16x16x32_bf16(Bt[n][k], At[m][k], acc[ai][bj][m][n], 0, 0, 0); __builtin_amdgcn_s_setprio(0); } while (0)
#define PG8_BAR __builtin_amdgcn_s_barrier()
#define PG8_SCHED __builtin_amdgcn_sched_barrier(0)
#define PG8_AOFF(dst, unit) do { _Pragma("unroll") for (int _h = 0; _h < 2; ++_h) _Pragma("unroll") for (int _i = 0; _i < 2; ++_i) { \
        const int _r = (unit).pm * BM + _h * HALF + RA[_i]; const int _src = GATHER ? g.rowidx[_r] : _r; dst[_h][_i] = (unsigned)(_src * K + CA[_i]) * 2u; } } while (0)
    Unit cur, nxt; int ui = 0;
    if (!S.next(0, cur)) return;
    f32x4 acc[2][2][4][2];
#pragma unroll
    for (int a = 0; a < 2; ++a)
#pragma unroll
        for (int b = 0; b < 2; ++b)
#pragma unroll
            for (int m = 0; m < 4; ++m)
#pragma unroll
                for (int n = 0; n < 2; ++n) acc[a][b][m][n] = (f32x4){0.f, 0.f, 0.f, 0.f};
    bf16x8 At[4][2], B0[2][2], B1[2][2];
    unsigned cvA[2][2], nvA[2][2];
    PG8_AOFF(cvA, cur);
    const char* const gA = (const char*)g.A;
    const char* cB = (const char*)g.Bt + (size_t)cur.pb * tstep;
    PG8_STAGE(PG8_SB(0, 0), cB, voffB); PG8_STAGE(PG8_SA(0, 0), gA, cvA[0]); PG8_STAGE(PG8_SB(0, 1), cB + hstep, voffB); PG8_STAGE(PG8_SA(0, 1), gA, cvA[1]);
    if (wr == 1) PG8_BAR;
    WAIT_V(4); PG8_BAR;
    PG8_STAGE(PG8_SB(1, 0), cB + kstep, voffB); PG8_STAGE(PG8_SA(1, 0), gA + kstep, cvA[0]); PG8_STAGE(PG8_SB(1, 1), cB + hstep + kstep, voffB);
    WAIT_V(6); PG8_BAR;
    for (;;) {
        const bool has_next = S.next(ui + 1, nxt);
        if (has_next) { PG8_AOFF(nvA, nxt); } else {
#pragma unroll
            for (int h = 0; h < 2; ++h)
#pragma unroll
                for (int i = 0; i < 2; ++i) nvA[h][i] = cvA[h][i]; }
        const char* nB = has_next ? (const char*)g.Bt + (size_t)nxt.pb * tstep : cB;
        for (int t = 0; t < nt; t += 2) {
            const bool last = (t == nt - 2);
            const char* a1 = gA + (size_t)(t + 1) * kstep;
            const char* a2 = last ? gA : gA + (size_t)(t + 2) * kstep; const char* b2 = last ? nB : cB + (size_t)(t + 2) * kstep;
            const char* a3 = a2 + kstep; const char* b3 = b2 + kstep;
            unsigned xA0[2], xA1[2];
#pragma unroll
            for (int i = 0; i < 2; ++i) { xA0[i] = last ? nvA[0][i] : cvA[0][i]; xA1[i] = last ? nvA[1][i] : cvA[1][i]; }
            PG8_LDB(B0, 0, 0); PG8_SCHED; PG8_LDA(At, 0, 0); PG8_STAGE(PG8_SA(1, 1), a1, cvA[1]);
            WAIT_L(8); PG8_BAR; WAIT_L(0); PG8_MMA(0, 0, At, B0); PG8_BAR; PG8_SCHED;
            PG8_LDB(B1, 0, 1); PG8_STAGE(PG8_SB(0, 0), b2, voffB);
            PG8_BAR; WAIT_L(0); PG8_MMA(0, 1, At, B1); PG8_BAR;
            PG8_LDA(At, 0, 1); PG8_STAGE(PG8_SA(0, 0), a2, xA0);
            PG8_BAR; WAIT_L(0); PG8_MMA(1, 0, At, B0); PG8_BAR; PG8_SCHED;
            PG8_STAGE(PG8_SB(0, 1), b2 + hstep, voffB);
            WAIT_V(6); PG8_BAR; PG8_MMA(1, 1, At, B1); PG8_BAR;
            PG8_LDB(B0, 1, 0); PG8_SCHED; PG8_LDA(At, 1, 0); PG8_STAGE(PG8_SA(0, 1), a2, xA1);
            WAIT_L(8); PG8_BAR; WAIT_L(0); PG8_MMA(0, 0, At, B0); PG8_BAR; PG8_SCHED;
            PG8_LDB(B1, 1, 1); PG8_STAGE(PG8_SB(1, 0), b3, voffB);
            PG8_BAR; WAIT_L(0); PG8_MMA(0, 1, At, B1); PG8_BAR;
            PG8_LDA(At, 1, 1); PG8_STAGE(PG8_SA(1, 0), a3, xA0);
            PG8_BAR; WAIT_L(0); PG8_MMA(1, 0, At, B0); PG8_BAR; PG8_SCHED;
            PG8_STAGE(PG8_SB(1, 1), b3 + hstep, voffB);
            WAIT_V(6); PG8_BAR; PG8_MMA(1, 1, At, B1); PG8_BAR;
        }
        E(acc, cur, wr, wc, fr, fq);
        if (!has_next) break;
#pragma unroll
        for (int a = 0; a < 2; ++a)
#pragma unroll
            for (int b = 0; b < 2; ++b)
#pragma unroll
                for (int m = 0; m < 4; ++m)
#pragma unroll
                    for (int n = 0; n < 2; ++n) acc[a][b][m][n] = (f32x4){0.f, 0.f, 0.f, 0.f};
        cur = nxt; cB = nB; ++ui;
#pragma unroll
        for (int h = 0; h < 2; ++h)
#pragma unroll
            for (int i = 0; i < 2; ++i) cvA[h][i] = nvA[h][i];
    }
    WAIT_V(0);
    if (wr == 0) PG8_BAR;
    PG8_BAR;
#undef PG8_SA
#undef PG8_SB
#undef PG8_STAGE
#undef PG8_LDA
#undef PG8_LDB
#undef PG8_MMA
#undef PG8_BAR
#undef PG8_SCHED
#undef PG8_AOFF
}
}

struct Args { const float* in[37]; float* out; unsigned char* ws; int ph_lo, ph_hi; };
enum { I_X = 0, I_C, I_CTX, I_CCTX, I_WADA, I_BADA, I_N1G, I_N2G, I_WIN, I_GGW, I_GGB, I_GNG, I_RMU, I_RW0, I_RW2, I_RA0, I_RA2, I_RG2, I_RKK, I_RKA, I_RRK,
       I_RLG, I_RLB, I_SCW, I_SCB, I_SDTB, I_SALOG, I_SD, I_SNG, I_WOUT, I_ROUTW, I_ROUTB, I_WGU, I_BGU, I_WDN, I_BDN, I_FNG };

struct Tc { LAS unsigned char* lds; int tid, lane, wave, G, bid; };

__device__ __forceinline__ void transpose_item(const float* W, int ldw, int k0, int n0, int nv, bf16_t* dst, int K, LAS float* scr, int lane) {
#pragma unroll 8
    for (int i = 0; i < 32; ++i) { const int kk = 2 * i + (lane >> 5), c = lane & 31; scr[kk * 33 + c] = (c < nv) ? W[(size_t)(k0 + kk) * ldw + n0 + c] : 0.f; }
    WAVE_LDS_FENCE();
    const int c = lane & 7;
#pragma unroll
    for (int j = 0; j < 4; ++j) { const int n = (lane >> 3) + 8 * j; const LAS float* s = scr + (8 * c) * 33 + n;
        u32x4 o; o.x = pk2(s[0 * 33], s[1 * 33]); o.y = pk2(s[2 * 33], s[3 * 33]); o.z = pk2(s[4 * 33], s[5 * 33]); o.w = pk2(s[6 * 33], s[7 * 33]);
        *(u32x4*)(dst + (size_t)n * K + k0 + 8 * c) = o; }
    WAVE_LDS_FENCE();
}
__device__ __forceinline__ void phase_pro0(const Args& a, const Tc& t) {
    LAS float* scr = (LAS float*)(t.lds + t.wave * 16384);
    const int gw = t.bid * NWAVES + t.wave, NGW = t.G * NWAVES;
    constexpr int KB = D / 64;
    constexpr int I_IN = KB * (NU / 32), I_OUT = KB * (D / 32), I_GU = KB * (2048 / 32), I_DN = KB * (D / 32);
    constexpr int IPL = I_IN + I_OUT + NEXP * (I_GU + I_DN);
    bf16_t* WIN = (bf16_t*)(a.ws + WS_WIN); bf16_t* WOUT = (bf16_t*)(a.ws + WS_WOUT); bf16_t* WGU = (bf16_t*)(a.ws + WS_WGU); bf16_t* WDN = (bf16_t*)(a.ws + WS_WD);
    for (int it = gw; it < DEPTH * IPL; it += NGW) {
        const int l = it / IPL; int r = it % IPL;
        if (r < I_IN) { const int kb = r / (NU / 32), nb = r % (NU / 32), n0 = nb * 32; int nv = IN_COLS - n0; nv = nv < 0 ? 0 : (nv > 32 ? 32 : nv);
            transpose_item(a.in[I_WIN] + (size_t)l * D * IN_COLS, IN_COLS, kb * 64, n0, nv, WIN + ((size_t)l * NU + n0) * D, D, scr, t.lane); continue; }
        r -= I_IN;
        if (r < I_OUT) { const int kb = r / (D / 32), nb = r % (D / 32);
            transpose_item(a.in[I_WOUT] + (size_t)l * D * D, D, kb * 64, nb * 32, 32, WOUT + ((size_t)l * D + nb * 32) * D, D, scr, t.lane); continue; }
        r -= I_OUT;
        const int e = r / (I_GU + I_DN); r = r % (I_GU + I_DN);
        if (r < I_GU) { const int kb = r / 64, nb = r % 64, n0 = nb * 32; const int half = n0 >> 10, rem = n0 & 1023, pn = rem >> 7, jj = rem & 127;
            transpose_item(a.in[I_WGU] + ((size_t)l * NEXP + e) * D * 2048, 2048, kb * 64, n0, 32, WGU + (((size_t)l * NEXP + e) * 2048 + pn * 256 + half * 128 + jj) * D, D, scr, t.lane); continue; }
        r -= I_GU;
        { const int kb = r / (D / 32), nb = r % (D / 32);
            transpose_item(a.in[I_WDN] + ((size_t)l * NEXP + e) * DFF * D, D, kb * 64, nb * 32, 32, WDN + (((size_t)l * NEXP + e) * D + nb * 32) * DFF, DFF, scr, t.lane); }
    }
    __syncthreads();
    LAS float* sc = (LAS float*)t.lds;
    LAS float* red = (LAS float*)(t.lds + 32768);
    for (int i = t.tid; i < NR * D; i += NTHREADS) { const int r = i / D, k = i % D; const float v = r < BATCH ? a.in[I_C][r * D + k] : a.in[I_CCTX][k]; sc[i] = siluf_(v); }
    __syncthreads();
    float* MODS = (float*)(a.ws + WS_MODS);
    const int jl = t.tid & 127, kq = t.tid >> 7;
    for (int cb = t.bid; cb < DEPTH * 48; cb += t.G) {
        const int l = cb / 48, j = (cb % 48) * 128 + jl;
        const float* w = a.in[I_WADA] + (size_t)l * D * 6144 + j;
        float acc[NR];
#pragma unroll
        for (int r = 0; r < NR; ++r) acc[r] = 0.f;
        for (int k = kq * 256; k < kq * 256 + 256; ++k) { const float wv = w[(size_t)k * 6144];
#pragma unroll
            for (int r = 0; r < NR; ++r) acc[r] += sc[r * D + k] * wv; }
#pragma unroll
        for (int r = 0; r < NR; ++r) red[(kq * NR + r) * 128 + jl] = acc[r];
        __syncthreads();
        if (kq == 0) {
            const float bb = a.in[I_BADA][(size_t)l * 6144 + j];
#pragma unroll
            for (int r = 0; r < NR; ++r) MODS[((size_t)l * NR + r) * 6144 + j] = red[(0 * NR + r) * 128 + jl] + red[(1 * NR + r) * 128 + jl] + red[(2 * NR + r) * 128 + jl] + red[(3 * NR + r) * 128 + jl] + bb;
        }
        __syncthreads();
    }
}

__device__ __forceinline__ int mod_row(int row) { return row < ML ? row / SEQ : BATCH; }
__device__ __forceinline__ void norm_mod_store(const f32x4 (&v)[4], const float* g, const float* shift, const float* scale, bf16_t* hrow, int lane, f32x4 (&hout)[4]) {
    float ss = 0.f;
#pragma unroll
    for (int j = 0; j < 4; ++j) ss += (v[j][0] * v[j][0] + v[j][1] * v[j][1]) + (v[j][2] * v[j][2] + v[j][3] * v[j][3]);
    const float rstd = 1.0f / sqrtf(wave_sum(ss) * (1.0f / D) + 1e-6f);
#pragma unroll
    for (int j = 0; j < 4; ++j) { const int c = 4 * lane + 256 * j;
        const f32x4 gg = *(const f32x4*)(g + c), sh = *(const f32x4*)(shift + c), sc = *(const f32x4*)(scale + c);
        const f32x4 h = (v[j] * rstd * gg) * (sc + 1.0f) + sh; hout[j] = h;
        u32x2 w; w.x = pk2(h[0], h[1]); w.y = pk2(h[2], h[3]); *(u32x2*)(hrow + c) = w; }
}
__device__ __forceinline__ void phase_pro1(const Args& a, const Tc& t) {
    const int gw = t.bid * NWAVES + t.wave, NGW = t.G * NWAVES;
    float* X = (float*)(a.ws + WS_X); bf16_t* H = (bf16_t*)(a.ws + WS_H); const float* MODS = (const float*)(a.ws + WS_MODS);
    for (int row = gw; row < M; row += NGW) {
        const float* src = row < ML ? a.in[I_X] + (size_t)row * D : a.in[I_CTX] + (size_t)(row - ML) * D;
        f32x4 v[4], h[4];
#pragma unroll
        for (int j = 0; j < 4; ++j) { v[j] = *(const f32x4*)(src + 4 * t.lane + 256 * j); *(f32x4*)(X + (size_t)row * D + 4 * t.lane + 256 * j) = v[j]; }
        const float* md = MODS + (size_t)mod_row(row) * 6144;
        norm_mod_store(v, a.in[I_N1G], md, md + 1024, H + (size_t)row * D, t.lane, h);
    }
}

__device__ __forceinline__ void seg_bounds(int row, int& lo, int& hi) {
    if (row < ML) { lo = row & ~63; hi = lo + 64; } else { lo = ML + ((row - ML) / CTX) * CTX; hi = lo + CTX; }
}
__device__ __forceinline__ void phase_prep(const Args& a, const Tc& t, int l) {
    const float* U = (const float*)(a.ws + WS_U);
    float* GG = (float*)(a.ws + WS_GG); float* RW7 = (float*)(a.ws + WS_RW7); float* SXBC = (float*)(a.ws + WS_SXBC); float* SDT = (float*)(a.ws + WS_SDT);
    const float* mu = a.in[I_RMU] + (size_t)l * 2 * 928;
    const float* w0 = a.in[I_RW0] + (size_t)l * 2 * 256; const float* w2 = a.in[I_RW2] + (size_t)l * 2 * 32 * 256;
    const float* a0 = a.in[I_RA0] + (size_t)l * 256; const float* a2 = a.in[I_RA2] + (size_t)l * 32 * 256;
    const float* rkk = a.in[I_RKK] + (size_t)l * 256; const float* rka = a.in[I_RKA] + (size_t)l * 256;
    const float* ggw = a.in[I_GGW] + (size_t)l * 2 * 16 * 128; const float* ggb = a.in[I_GGB] + (size_t)l * 2 * 128;
    const float* cw = a.in[I_SCW] + (size_t)l * 4 * 1024; const float* cb = a.in[I_SCB] + (size_t)l * 1024;
    const float* dtb = a.in[I_SDTB] + (size_t)l * 16;
    LAS float* LOW = (LAS float*)t.lds;
    for (int tile = t.bid; tile < M / 16; tile += t.G) {
        const int r0 = tile * 16; int slo, shi; seg_bounds(r0, slo, shi);
        {
            const int tt = t.tid >> 5, r = t.tid & 31, row = r0 + tt;
            const float* up = U + (size_t)row * NU; const bool hp = row - 1 >= slo, hn = row + 1 < shi;
#pragma unroll
            for (int q = 0; q < 3; ++q) { const int col = U_RLWF + q * 32 + r, mi = col - U_RW;
                const float u = up[col], pv = hp ? up[col - NU] : 0.f, nv = hn ? up[col + NU] : 0.f;
                const float s = u + mu[mi] * (pv - u) + mu[928 + mi] * (nv - u);
                LOW[tt * 128 + q * 32 + r] = q < 2 ? tanhf(s) : s; }
            LOW[tt * 128 + 96 + r] = up[U_GLF + r];
        }
        __syncthreads();
        {
            const int c = t.tid & 255, tt0 = (t.tid >> 8) * 8;
            float aa[8], af[8], ab[8];
#pragma unroll
            for (int j = 0; j < 8; ++j) { aa[j] = a0[c]; af[j] = w0[c]; ab[j] = w0[256 + c]; }
            for (int r = 0; r < 32; ++r) { const float wa = a2[r * 256 + c], wf = w2[r * 256 + c], wb = w2[(32 + r) * 256 + c];
#pragma unroll
                for (int j = 0; j < 8; ++j) { const LAS float* lw = LOW + (tt0 + j) * 128; aa[j] += lw[64 + r] * wa; af[j] += lw[r] * wf; ab[j] += lw[32 + r] * wb; } }
            const float m0r = mu[c], m1r = mu[928 + c], m0k = mu[256 + c], m1k = mu[928 + 256 + c], m0v = mu[512 + c], m1v = mu[928 + 512 + c];
            const float kkg = rkk[c], kag = rka[c];
#pragma unroll
            for (int j = 0; j < 8; ++j) { const int row = r0 + tt0 + j; const float* up = U + (size_t)row * NU; const bool hp = row - 1 >= slo, hn = row + 1 < shi;
                float u, pv, nv;
                u = up[U_RR + c]; pv = hp ? up[U_RR + c - NU] : 0.f; nv = hn ? up[U_RR + c + NU] : 0.f; const float rs = u + m0r * (pv - u) + m1r * (nv - u);
                u = up[U_RK + c]; pv = hp ? up[U_RK + c - NU] : 0.f; nv = hn ? up[U_RK + c + NU] : 0.f; const float ks = u + m0k * (pv - u) + m1k * (nv - u);
                u = up[U_RV + c]; pv = hp ? up[U_RV + c - NU] : 0.f; nv = hn ? up[U_RV + c + NU] : 0.f; const float vs = u + m0v * (pv - u) + m1v * (nv - u);
                const float av = sigmoidf_(aa[j]);
                const float wfv = expf(-0.606531f * sigmoidf_(af[j])), wbv = expf(-0.606531f * sigmoidf_(ab[j]));
                const float kr = ks * kkg; const float ssq = wave_sum(kr * kr); const float kk = kr * (1.0f / sqrtf(ssq + 1e-12f));
                const float kf = ks * (1.0f + (av - 1.0f) * kag);
                const size_t o = (size_t)row * 256 + c, P = (size_t)M * 256;
                RW7[o] = rs; RW7[P + o] = kf; RW7[2 * P + o] = vs; RW7[3 * P + o] = kk; RW7[4 * P + o] = kk * av; RW7[5 * P + o] = wfv; RW7[6 * P + o] = wbv; }
        }
        {
            const int j = t.tid & 127, dq = t.tid >> 7, dir = dq & 1, tt0 = (dq >> 1) * 8;
            float acc[8];
#pragma unroll
            for (int q = 0; q < 8; ++q) acc[q] = ggb[dir * 128 + j];
#pragma unroll
            for (int r = 0; r < 16; ++r) { const float w = ggw[(dir * 16 + r) * 128 + j];
#pragma unroll
                for (int q = 0; q < 8; ++q) acc[q] += LOW[(tt0 + q) * 128 + 96 + dir * 16 + r] * w; }
#pragma unroll
            for (int q = 0; q < 8; ++q) GG[((size_t)dir * M + r0 + tt0 + q) * 128 + j] = logsigmoidf_(acc[q]) * (1.0f / 16.0f);
        }
        {
#pragma unroll
            for (int cc = 0; cc < 2; ++cc) { const int col = t.tid + cc * 512; const float* up = U + U_SXBC + col;
                const float c0 = cw[col], c1 = cw[1024 + col], c2 = cw[2048 + col], c3 = cw[3072 + col], bb = cb[col];
                float um2 = (r0 - 2 >= slo) ? up[(size_t)(r0 - 2) * NU] : 0.f, um1 = (r0 - 1 >= slo) ? up[(size_t)(r0 - 1) * NU] : 0.f, u0 = up[(size_t)r0 * NU];
#pragma unroll
                for (int q = 0; q < 16; ++q) { const int row = r0 + q; const float up1 = (row + 1 < shi) ? up[(size_t)(row + 1) * NU] : 0.f;
                    const float y = c0 * um2 + c1 * um1 + c2 * u0 + c3 * up1 + bb;
                    SXBC[(size_t)row * 1024 + col] = siluf_(y); um2 = um1; um1 = u0; u0 = up1; } }
        }
        if (t.tid < 256) { const int tt = t.tid >> 4, j = t.tid & 15, row = r0 + tt; SDT[(size_t)row * 16 + j] = softplusf_(U[(size_t)row * NU + U_SDT + j] + dtb[j]); }
        __syncthreads();
    }
}

__device__ __forceinline__ int chain_row(int b, int dir, int s) {
    if (s < CTX) return ML + b * CTX + (dir ? CTX - 1 - s : s);
    const int tt = s - CTX; return b * SEQ + (dir ? SEQ - 1 - tt : tt);
}
constexpr int CH = 32, NSTEP = CTX + SEQ, NCHUNK = NSTEP / CH;
__device__ __forceinline__ void phase_scan(const Args& a, const Tc& t, int l) {
    const float* U = (const float*)(a.ws + WS_U); const float* GG = (const float*)(a.ws + WS_GG); const float* RW7 = (const float*)(a.ws + WS_RW7);
    const float* SXBC = (const float*)(a.ws + WS_SXBC); const float* SDT = (const float*)(a.ws + WS_SDT);
    float* OG = (float*)(a.ws + WS_OG); float* OR = (float*)(a.ws + WS_OR); float* OS = (float*)(a.ws + WS_OS);
    LAS float* IN = (LAS float*)t.lds;
    LAS float* OUT = (LAS float*)(t.lds + 65536);
    constexpr int NC_R = BATCH * 8, NC_S = BATCH * 16, NC_G = BATCH * 8;
    const int i8 = t.tid >> 3, j8 = t.tid & 7;
    for (int ci = t.bid; ci < NC_R + NC_S + NC_G; ci += t.G) {
        if (ci < NC_R) {
            const int dir = ci & 1, h = (ci >> 1) & 3, b = ci >> 3;
            const size_t P = (size_t)M * 256;
            float S[8];
#pragma unroll
            for (int e = 0; e < 8; ++e) S[e] = 0.f;
            f32x4 pf[6];
#define RW_LOAD(chunk) do { _Pragma("unroll") for (int q = 0; q < 6; ++q) { const int e4 = t.tid + 512 * q, st = e4 / 96, rem = e4 % 96, vec = rem >> 4, c4 = rem & 15; \
                const int row = chain_row(b, dir, (chunk) * CH + st); const int vs = vec < 5 ? vec : 5 + dir; \
                pf[q] = *(const f32x4*)(RW7 + (size_t)vs * P + (size_t)row * 256 + h * 64 + c4 * 4); } } while (0)
            RW_LOAD(0);
            for (int ch = 0; ch < NCHUNK; ++ch) {
#pragma unroll
                for (int q = 0; q < 6; ++q) *(LAS f32x4*)(IN + (size_t)(t.tid + 512 * q) * 4) = pf[q];
                __syncthreads();
                if (ch + 1 < NCHUNK) RW_LOAD(ch + 1);
#pragma unroll 2
                for (int st = 0; st < CH; ++st) {
                    const LAS float* p = IN + st * 384;
                    const f32x4 r0 = *(const LAS f32x4*)(p + 8 * j8), r1 = *(const LAS f32x4*)(p + 8 * j8 + 4);
                    const f32x4 k0 = *(const LAS f32x4*)(p + 64 + 8 * j8), k1 = *(const LAS f32x4*)(p + 64 + 8 * j8 + 4);
                    const float vi = p[128 + i8];
                    const f32x4 q0 = *(const LAS f32x4*)(p + 192 + 8 * j8), q1 = *(const LAS f32x4*)(p + 192 + 8 * j8 + 4);
                    const f32x4 b0 = *(const LAS f32x4*)(p + 256 + 8 * j8), b1 = *(const LAS f32x4*)(p + 256 + 8 * j8 + 4);
                    const f32x4 w0 = *(const LAS f32x4*)(p + 320 + 8 * j8), w1 = *(const LAS f32x4*)(p + 320 + 8 * j8 + 4);
                    float d = (S[0] * q0[0] + S[1] * q0[1]) + (S[2] * q0[2] + S[3] * q0[3]) + (S[4] * q1[0] + S[5] * q1[1]) + (S[6] * q1[2] + S[7] * q1[3]);
                    d = sum8(d);
#pragma unroll
                    for (int e = 0; e < 4; ++e) { S[e] = S[e] * w0[e] - d * b0[e] + vi * k0[e]; S[4 + e] = S[4 + e] * w1[e] - d * b1[e] + vi * k1[e]; }
                    float o = (S[0] * r0[0] + S[1] * r0[1]) + (S[2] * r0[2] + S[3] * r0[3]) + (S[4] * r1[0] + S[5] * r1[1]) + (S[6] * r1[2] + S[7] * r1[3]);
                    o = sum8(o);
                    if (j8 == 0) OUT[st * 64 + i8] = o;
                }
                __syncthreads();
#pragma unroll
                for (int q = 0; q < 4; ++q) { const int e = t.tid + 512 * q, st = e >> 6, i = e & 63; const int row = chain_row(b, dir, ch * CH + st);
                    OR[((size_t)dir * M + row) * 256 + h * 64 + i] = OUT[e]; }
            }
#undef RW_LOAD
        } else if (ci < NC_R + NC_S) {
            const int cj = ci - NC_R; const int dir = cj & 1, h = (cj >> 1) & 7, b = cj >> 4, grp = h >> 2;
            const float a_neg = -expf(a.in[I_SALOG][(size_t)l * 16 + dir * 8 + h]);
            float S[16];
#pragma unroll
            for (int e = 0; e < 16; ++e) S[e] = 0.f;
            f32x4 pf[6];
#define SS_LOAD(chunk) do { _Pragma("unroll") for (int q = 0; q < 6; ++q) { const int e4 = t.tid + 512 * q; if (e4 < CH * 84) { const int st = e4 / 84, rem = e4 % 84; \
                const int row = chain_row(b, dir, (chunk) * CH + st); const float* src; \
                if (rem < 32) src = SXBC + (size_t)row * 1024 + 512 + grp * 128 + rem * 4; else if (rem < 64) src = SXBC + (size_t)row * 1024 + 768 + grp * 128 + (rem - 32) * 4; \
                else if (rem < 80) src = SXBC + (size_t)row * 1024 + h * 64 + (rem - 64) * 4; else src = SDT + (size_t)row * 16 + (rem - 80) * 4; \
                pf[q] = *(const f32x4*)src; } } } while (0)
            SS_LOAD(0);
            for (int ch = 0; ch < NCHUNK; ++ch) {
#pragma unroll
                for (int q = 0; q < 6; ++q) { const int e4 = t.tid + 512 * q; if (e4 < CH * 84) *(LAS f32x4*)(IN + (size_t)e4 * 4) = pf[q]; }
                __syncthreads();
                if (ch + 1 < NCHUNK) SS_LOAD(ch + 1);
#pragma unroll 2
                for (int st = 0; st < CH; ++st) {
                    const LAS float* p = IN + st * 336;
                    const float dtv = p[320 + dir * 8 + h], xdt = p[256 + i8] * dtv, ea = expf(dtv * a_neg);
                    float y = 0.f;
#pragma unroll
                    for (int q = 0; q < 4; ++q) { const f32x4 Bv = *(const LAS f32x4*)(p + 16 * j8 + 4 * q), Cv = *(const LAS f32x4*)(p + 128 + 16 * j8 + 4 * q);
#pragma unroll
                        for (int e = 0; e < 4; ++e) { S[4 * q + e] = ea * S[4 * q + e] + Bv[e] * xdt; y += S[4 * q + e] * Cv[e]; } }
                    y = sum8(y);
                    if (j8 == 0) OUT[st * 64 + i8] = y;
                }
                __syncthreads();
#pragma unroll
                for (int q = 0; q < 4; ++q) { const int e = t.tid + 512 * q, st = e >> 6, i = e & 63; const int row = chain_row(b, dir, ch * CH + st);
                    OS[((size_t)dir * M + row) * 512 + h * 64 + i] = OUT[e]; }
            }
#undef SS_LOAD
        } else {
            const int cj = ci - NC_R - NC_S; const int dir = cj & 1, h = (cj >> 1) & 3, b = cj >> 3;
            float S[4];
#pragma unroll
            for (int e = 0; e < 4; ++e) S[e] = 0.f;
            f32x4 pf[3];
#define GL_LOAD(chunk) do { _Pragma("unroll") for (int q = 0; q < 3; ++q) { const int e4 = t.tid + 512 * q; if (e4 < CH * 40) { const int st = e4 / 40, rem = e4 % 40; \
                const int row = chain_row(b, dir, (chunk) * CH + st); const float* src; \
                if (rem < 8) src = U + (size_t)row * NU + U_GQ + h * 32 + rem * 4; else if (rem < 16) src = U + (size_t)row * NU + U_GK + h * 32 + (rem - 8) * 4; \
                else if (rem < 32) src = U + (size_t)row * NU + U_GV + h * 64 + (rem - 16) * 4; else src = GG + ((size_t)dir * M + row) * 128 + h * 32 + (rem - 32) * 4; \
                pf[q] = *(const f32x4*)src; } } } while (0)
            GL_LOAD(0);
            for (int ch = 0; ch < NCHUNK; ++ch) {
#pragma unroll
                for (int q = 0; q < 3; ++q) { const int e4 = t.tid + 512 * q; if (e4 < CH * 40) *(LAS f32x4*)(IN + (size_t)e4 * 4) = pf[q]; }
                __syncthreads();
                if (ch + 1 < NCHUNK) GL_LOAD(ch + 1);
#pragma unroll 2
                for (int st = 0; st < CH; ++st) {
                    const LAS float* p = IN + st * 160;
                    const f32x4 qv = *(const LAS f32x4*)(p + 4 * j8), kv = *(const LAS f32x4*)(p + 32 + 4 * j8), gv = *(const LAS f32x4*)(p + 128 + 4 * j8);
                    const float vv = p[64 + i8];
                    float o = 0.f;
#pragma unroll
                    for (int e = 0; e < 4; ++e) { S[e] = expf(gv[e]) * S[e] + kv[e] * vv; o += S[e] * qv[e]; }
                    o = sum8(o) * 0.17677669529663687f;
                    if (j8 == 0) OUT[st * 64 + i8] = o;
                }
                __syncthreads();
#pragma unroll
                for (int q = 0; q < 4; ++q) { const int e = t.tid + 512 * q, st = e >> 6, i = e & 63; const int row = chain_row(b, dir, ch * CH + st);
                    OG[((size_t)dir * M + row) * 256 + h * 64 + i] = OUT[e]; }
            }
#undef GL_LOAD
        }
        __syncthreads();
    }
}

__device__ __forceinline__ void phase_mixout(const Args& a, const Tc& t, int l, int Mtok) {
    const float* U = (const float*)(a.ws + WS_U); const float* RW7 = (const float*)(a.ws + WS_RW7); const float* SXBC = (const float*)(a.ws + WS_SXBC);
    const float* OG = (const float*)(a.ws + WS_OG); const float* OR = (const float*)(a.ws + WS_OR); const float* OS = (const float*)(a.ws + WS_OS);
    bf16_t* MIX = (bf16_t*)(a.ws + WS_MIX);
    const float* mu = a.in[I_RMU] + (size_t)l * 2 * 928; const float* g2 = a.in[I_RG2] + (size_t)l * 64 * 256;
    const float* gng = a.in[I_GNG] + (size_t)l * 256; const float* lng = a.in[I_RLG] + (size_t)l * 256; const float* lnb = a.in[I_RLB] + (size_t)l * 256;
    const float* rrk = a.in[I_RRK] + (size_t)l * 256; const float* sd = a.in[I_SD] + (size_t)l * 8; const float* sng = a.in[I_SNG] + (size_t)l * 512;
    LAS float* SG = (LAS float*)t.lds;
    LAS float* RED = (LAS float*)(t.lds + 4096);
    const size_t P = (size_t)M * 256;
    for (int tile = t.bid; tile < Mtok / 16; tile += t.G) {
        const int r0 = tile * 16; int slo, shi; seg_bounds(r0, slo, shi);
        {   const int tt = t.tid >> 5, r = t.tid & 31, row = r0 + tt; const float* up = U + (size_t)row * NU; const bool hp = row - 1 >= slo, hn = row + 1 < shi;
#pragma unroll
            for (int q = 0; q < 2; ++q) { const int col = U_RLGT + q * 32 + r, mi = col - U_RW; const float u = up[col], pv = hp ? up[col - NU] : 0.f, nv = hn ? up[col + NU] : 0.f;
                SG[tt * 64 + q * 32 + r] = sigmoidf_(u + mu[mi] * (pv - u) + mu[928 + mi] * (nv - u)); } }
        __syncthreads();
        {
            const int c = t.tid & 255, tt0 = (t.tid >> 8) * 8;
            float ag[8];
#pragma unroll
            for (int j = 0; j < 8; ++j) ag[j] = 0.f;
            for (int r = 0; r < 64; ++r) { const float w = g2[r * 256 + c];
#pragma unroll
                for (int j = 0; j < 8; ++j) ag[j] += SG[(tt0 + j) * 64 + r] * w; }
            const float gn = gng[c], lg = lng[c], lb = lnb[c], rk = rrk[c];
#pragma unroll
            for (int j = 0; j < 8; ++j) { const int row = r0 + tt0 + j;
                const float og_ = OG[(size_t)row * 256 + c] + OG[P + (size_t)row * 256 + c];
                const float ms = wave_sum(og_ * og_) * (1.0f / 64.0f);
                const float o1 = og_ * (1.0f / sqrtf(ms + 1e-6f)) * gn * siluf_(U[(size_t)row * NU + U_GOG + c]);
                const float orr = OR[(size_t)row * 256 + c] + OR[P + (size_t)row * 256 + c];
                const float mean = wave_sum(orr) * (1.0f / 64.0f); const float dd = orr - mean; const float var = wave_sum(dd * dd) * (1.0f / 64.0f);
                const float on = dd * (1.0f / sqrtf(var + 64e-5f)) * lg + lb;
                const float rr = RW7[(size_t)row * 256 + c], kk = RW7[P + (size_t)row * 256 + c], vv = RW7[2 * P + (size_t)row * 256 + c];
                const float bon = wave_sum(rr * kk * rk) * vv;
                const float o2 = (on + bon) * ag[j];
                MIX[(size_t)row * D + c] = (bf16_t)f2bf(o1); MIX[(size_t)row * D + 256 + c] = (bf16_t)f2bf(o2); }
        }
        {
            const int c = t.tid; const float dh = sd[c >> 6], ng = sng[c];
            float y[16];
#pragma unroll
            for (int q = 0; q < 16; ++q) { const int row = r0 + q;
                float v = OS[(size_t)row * 512 + c] + OS[(size_t)M * 512 + (size_t)row * 512 + c] + dh * SXBC[(size_t)row * 1024 + c];
                v *= siluf_(U[(size_t)row * NU + U_SZ + c]); y[q] = v;
                const float ss = wave_sum(v * v); if (t.lane == 0) RED[q * 8 + t.wave] = ss; }
            __syncthreads();
            const int gb = (t.wave >> 2) * 4;
#pragma unroll
            for (int q = 0; q < 16; ++q) { const float ms = (RED[q * 8 + gb] + RED[q * 8 + gb + 1] + RED[q * 8 + gb + 2] + RED[q * 8 + gb + 3]) * (1.0f / 256.0f);
                MIX[(size_t)(r0 + q) * D + 512 + c] = (bf16_t)f2bf(y[q] * (1.0f / sqrtf(ms + 1e-6f)) * ng); }
        }
        __syncthreads();
    }
}

__device__ __forceinline__ void phase_router(const Args& a, const Tc& t, int l, int Mtok) {
    const int gw = t.bid * NWAVES + t.wave, NGW = t.G * NWAVES;
    const float* X = (const float*)(a.ws + WS_X); bf16_t* H = (bf16_t*)(a.ws + WS_H); const float* MODS = (const float*)(a.ws + WS_MODS) + (size_t)l * NR * 6144;
    const float* rw = a.in[I_ROUTW] + (size_t)l * D * NEXP; const float* rb = a.in[I_ROUTB] + (size_t)l * NEXP;
    int* TOPI = (int*)(a.ws + WS_TOPI); float* TOPP = (float*)(a.ws + WS_TOPP);
    unsigned* CNT = (unsigned*)(a.ws + WS_CTL) + CW_CNT + l * 64;
    LAS int* hist = (LAS int*)(t.lds + LDS_MISC + 64);
    if (t.tid < NEXP) hist[t.tid] = 0;
    __syncthreads();
    for (int row = gw; row < Mtok; row += NGW) {
        f32x4 v[4], h[4];
#pragma unroll
        for (int j = 0; j < 4; ++j) v[j] = *(const f32x4*)(X + (size_t)row * D + 4 * t.lane + 256 * j);
        const float* md = MODS + (size_t)mod_row(row) * 6144;
        norm_mod_store(v, a.in[I_N2G] + (size_t)l * D, md + 3 * 1024, md + 4 * 1024, H + (size_t)row * D, t.lane, h);
        float lg[NEXP];
#pragma unroll
        for (int e = 0; e < NEXP; ++e) lg[e] = 0.f;
#pragma unroll
        for (int j = 0; j < 4; ++j)
#pragma unroll
            for (int q = 0; q < 4; ++q) { const float hv = h[j][q]; const float* wr_ = rw + (size_t)(4 * t.lane + 256 * j + q) * NEXP;
#pragma unroll
                for (int e4 = 0; e4 < NEXP / 4; ++e4) { const f32x4 w = *(const f32x4*)(wr_ + 4 * e4);
                    lg[4 * e4] += hv * w[0]; lg[4 * e4 + 1] += hv * w[1]; lg[4 * e4 + 2] += hv * w[2]; lg[4 * e4 + 3] += hv * w[3]; } }
#pragma unroll
        for (int e = 0; e < NEXP; ++e) lg[e] = wave_sum(lg[e]) + rb[e];
        int ti[4]; float tv[4];
#pragma unroll
        for (int k = 0; k < 4; ++k) { float best = -3.0e38f; int bi = 0;
#pragma unroll
            for (int e = 0; e < NEXP; ++e) { bool taken = false;
#pragma unroll
                for (int k2 = 0; k2 < k; ++k2) taken = taken || (ti[k2] == e);
                if (!taken && lg[e] > best) { best = lg[e]; bi = e; } }
            ti[k] = bi; tv[k] = best; }
        const float e0 = 1.0f, e1 = expf(tv[1] - tv[0]), e2 = expf(tv[2] - tv[0]), e3 = expf(tv[3] - tv[0]); const float inv = 1.0f / (e0 + e1 + e2 + e3);
        if (t.lane == 0) {
            TOPI[row * 4 + 0] = ti[0]; TOPI[row * 4 + 1] = ti[1]; TOPI[row * 4 + 2] = ti[2]; TOPI[row * 4 + 3] = ti[3];
            TOPP[row * 4 + 0] = e0 * inv; TOPP[row * 4 + 1] = e1 * inv; TOPP[row * 4 + 2] = e2 * inv; TOPP[row * 4 + 3] = e3 * inv;
#pragma unroll
            for (int k = 0; k < 4; ++k) atomicAdd((int*)&hist[ti[k]], 1);
        }
    }
    __syncthreads();
    if (t.tid < NEXP && hist[t.tid] != 0) atomicAdd(&CNT[t.tid], (unsigned)hist[t.tid]);
}

__device__ __forceinline__ int moe_offsets(const unsigned* CNT, LAS int* off, LAS int* cnt, int tid) {
    if (tid < NEXP) { int o = 0; for (int e = 0; e < tid; ++e) o += ((int)CNT[e] + 255) & ~255; off[tid] = o; cnt[tid] = (int)CNT[tid]; }
    __syncthreads();
    return (off[NEXP - 1] + ((cnt[NEXP - 1] + 255) & ~255)) >> 8;
}
__device__ __forceinline__ void phase_lists(const Args& a, const Tc& t, int l, int Mtok) {
    const int* TOPI = (const int*)(a.ws + WS_TOPI); const float* TOPP = (const float*)(a.ws + WS_TOPP);
    int* POS = (int*)(a.ws + WS_POS); int* ROWIDX = (int*)(a.ws + WS_ROWIDX); float* ROWGATE = (float*)(a.ws + WS_ROWGATE);
    unsigned* CNT = (unsigned*)(a.ws + WS_CTL) + CW_CNT + l * 64; unsigned* CUR = (unsigned*)(a.ws + WS_CTL) + CW_CUR + l * 64;
    LAS int* off = (LAS int*)(t.lds + LDS_MISC + 64); LAS int* cnt = off + 64; LAS int* hist = off + 128; LAS int* base = off + 192; LAS int* cur = off + 256;
    if (t.tid < NEXP) { hist[t.tid] = 0; cur[t.tid] = 0; }
    moe_offsets(CNT, off, cnt, t.tid);
    const int rpb = (Mtok + t.G - 1) / t.G, s0 = t.bid * rpb * 4; int s1 = (t.bid + 1) * rpb * 4; if (s1 > Mtok * 4) s1 = Mtok * 4;
    for (int s = s0 + t.tid; s < s1; s += NTHREADS) atomicAdd((int*)&hist[TOPI[s]], 1);
    __syncthreads();
    if (t.tid < NEXP) base[t.tid] = hist[t.tid] ? (int)atomicAdd(&CUR[t.tid], (unsigned)hist[t.tid]) : 0;
    __syncthreads();
    for (int s = s0 + t.tid; s < s1; s += NTHREADS) { const int e = TOPI[s]; const int p = off[e] + base[e] + atomicAdd((int*)&cur[e], 1);
        POS[s] = p; ROWIDX[p] = s >> 2; ROWGATE[p] = TOPP[s]; }
    for (int e = t.bid; e < NEXP; e += t.G) { const int lo = off[e] + cnt[e], hi = off[e] + ((cnt[e] + 255) & ~255);
        for (int p = lo + t.tid; p < hi; p += NTHREADS) { ROWIDX[p] = 0; ROWGATE[p] = 0.f; } }
    __syncthreads();
}
__device__ __forceinline__ int moe_tile_table(const Args& a, const Tc& t, int l) {
    unsigned* CNT = (unsigned*)(a.ws + WS_CTL) + CW_CNT + l * 64;
    LAS int* off = (LAS int*)(t.lds + LDS_MISC + 64); LAS int* cnt = off + 64; LAS int* tile_e = (LAS int*)(t.lds + LDS_TILE_E);
    const int ntiles = moe_offsets(CNT, off, cnt, t.tid);
    for (int tt = t.tid; tt < ntiles; tt += NTHREADS) { int e = 0;
        for (int q = 1; q < NEXP; ++q) if ((off[q] >> 8) <= tt) e = q;
        tile_e[tt] = e; }
    __syncthreads();
    return ntiles;
}

__device__ __forceinline__ void phase_combine(const Args& a, const Tc& t, int l, int Mtok) {
    const int gw = t.bid * NWAVES + t.wave, NGW = t.G * NWAVES;
    float* X = (float*)(a.ws + WS_X); bf16_t* H = (bf16_t*)(a.ws + WS_H); const bf16_t* Y = (const bf16_t*)(a.ws + WS_Y); const int* POS = (const int*)(a.ws + WS_POS);
    const float* MODS = (const float*)(a.ws + WS_MODS) + (size_t)l * NR * 6144;
    for (int row = gw; row < Mtok; row += NGW) {
        const float* md = MODS + (size_t)mod_row(row) * 6144 + 5 * 1024;
        const int p0 = POS[row * 4], p1 = POS[row * 4 + 1], p2 = POS[row * 4 + 2], p3 = POS[row * 4 + 3];
        f32x4 v[4], h[4];
#pragma unroll
        for (int j = 0; j < 4; ++j) { const int c = 4 * t.lane + 256 * j;
            const u32x2 y0 = *(const u32x2*)(Y + (size_t)p0 * D + c), y1 = *(const u32x2*)(Y + (size_t)p1 * D + c), y2 = *(const u32x2*)(Y + (size_t)p2 * D + c), y3 = *(const u32x2*)(Y + (size_t)p3 * D + c);
            f32x4 s; s[0] = (bf_lo(y0.x) + bf_lo(y1.x)) + (bf_lo(y2.x) + bf_lo(y3.x)); s[1] = (bf_hi(y0.x) + bf_hi(y1.x)) + (bf_hi(y2.x) + bf_hi(y3.x));
            s[2] = (bf_lo(y0.y) + bf_lo(y1.y)) + (bf_lo(y2.y) + bf_lo(y3.y)); s[3] = (bf_hi(y0.y) + bf_hi(y1.y)) + (bf_hi(y2.y) + bf_hi(y3.y));
            const f32x4 g = *(const f32x4*)(md + c);
            v[j] = *(const f32x4*)(X + (size_t)row * D + c) + g * s; }
        if (l + 1 < DEPTH) {
#pragma unroll
            for (int j = 0; j < 4; ++j) *(f32x4*)(X + (size_t)row * D + 4 * t.lane + 256 * j) = v[j];
            const float* md2 = MODS + (size_t)NR * 6144 + (size_t)mod_row(row) * 6144;
            norm_mod_store(v, a.in[I_N1G] + (size_t)(l + 1) * D, md2, md2 + 1024, H + (size_t)row * D, t.lane, h);
        } else {
            float ss = 0.f;
#pragma unroll
            for (int j = 0; j < 4; ++j) ss += (v[j][0] * v[j][0] + v[j][1] * v[j][1]) + (v[j][2] * v[j][2] + v[j][3] * v[j][3]);
            const float rstd = 1.0f / sqrtf(wave_sum(ss) * (1.0f / D) + 1e-6f);
#pragma unroll
            for (int j = 0; j < 4; ++j) { const int c = 4 * t.lane + 256 * j; const f32x4 g = *(const f32x4*)(a.in[I_FNG] + c); *(f32x4*)(a.out + (size_t)row * D + c) = v[j] * rstd * g; }
        }
    }
}

#ifndef EMU
__device__ __forceinline__ void launder_tid(Tc& t) { int x = threadIdx.x; asm volatile("" : "+v"(x)); t.tid = x; t.lane = x & 63; t.wave = __builtin_amdgcn_readfirstlane(x >> 6); }
#endif
constexpr int PH_PER_LAYER = 10, N_PHASES = 2 + DEPTH * PH_PER_LAYER;
#if N_LAUNCH_MODE == 1 || defined(EMU)
__global__ void __launch_bounds__(NTHREADS, 2) fwd(Args a) {
#ifdef EMU
    unsigned char* lds_raw = EMU_DYN_LDS();
#else
    extern __shared__ __attribute__((aligned(16))) unsigned char lds_raw[];
#endif
    Tc t; t.lds = (LAS unsigned char*)lds_raw; t.tid = threadIdx.x; t.lane = t.tid & 63; t.wave = __builtin_amdgcn_readfirstlane(t.tid >> 6); t.G = gridDim.x; t.bid = blockIdx.x;
    const int lo = a.ph_lo, hi = a.ph_hi;
    volatile LAS unsigned* misc = (volatile LAS unsigned*)(t.lds + LDS_MISC);
    if (t.tid < 16) misc[t.tid] = 0u;
    __syncthreads();
    XcdBarrier bar; bar.bar = (unsigned*)(a.ws + WS_CTL) + CW_BAR; bar.x = 0; bar.st = misc;
    if (hi - lo > 1) bar = xcd_barrier_post((unsigned*)(a.ws + WS_CTL) + CW_BAR, misc);
#ifdef EMU
#define LAUNDER_TID() ((void)0)
#else
#define LAUNDER_TID() launder_tid(t)
#endif
#define IN_PH(k) (lo <= (k) && (k) < hi && (LAUNDER_TID(), true))
#define SEAM(k) do { if ((k) + 1 < hi) xcd_barrier(bar); } while (0)
    if (IN_PH(0)) { phase_pro0(a, t); SEAM(0); }
    if (IN_PH(1)) { phase_pro1(a, t); SEAM(1); }
    for (int l = 0; l < DEPTH; ++l) {
        const int pb = 2 + l * PH_PER_LAYER;
        const bool lastl = (l == DEPTH - 1);
        const int Mtok = lastl ? ML : M;
        const float* MODSL = (const float*)(a.ws + WS_MODS) + (size_t)l * NR * 6144;
        if (IN_PH(pb + 0)) {
            pg8::Gemm g{(const bf16_t*)(a.ws + WS_H), (const bf16_t*)(a.ws + WS_WIN) + (size_t)l * NU * D, D, nullptr};
            pg8::DenseSched S; S.o.init(M / 256, NU / 256, t.G, t.bid);
            pg8::EpiF32 E{(float*)(a.ws + WS_U), NU};
            pg8::gemm_phase<pg8::EpiF32, pg8::DenseSched, false>(t.lds, t.tid, g, S, E);
            SEAM(pb + 0);
        }
        if (IN_PH(pb + 1)) { phase_prep(a, t, l); SEAM(pb + 1); }
        if (IN_PH(pb + 2)) { phase_scan(a, t, l); SEAM(pb + 2); }
        if (IN_PH(pb + 3)) { phase_mixout(a, t, l, Mtok); SEAM(pb + 3); }
        if (IN_PH(pb + 4)) {
            pg8::Gemm g{(const bf16_t*)(a.ws + WS_MIX), (const bf16_t*)(a.ws + WS_WOUT) + (size_t)l * D * D, D, nullptr};
            pg8::DenseSched S; S.o.init(Mtok / 256, D / 256, t.G, t.bid);
            pg8::EpiResid E{(float*)(a.ws + WS_X), MODSL};
            pg8::gemm_phase<pg8::EpiResid, pg8::DenseSched, false>(t.lds, t.tid, g, S, E);
            SEAM(pb + 4);
        }
        if (IN_PH(pb + 5)) { phase_router(a, t, l, Mtok); SEAM(pb + 5); }
        if (IN_PH(pb + 6)) { phase_lists(a, t, l, Mtok); SEAM(pb + 6); }
        if (IN_PH(pb + 7)) {
            const int ntiles = moe_tile_table(a, t, l);
            pg8::Gemm g{(const bf16_t*)(a.ws + WS_H), (const bf16_t*)(a.ws + WS_WGU) + (size_t)l * NEXP * 2048 * D, D, (const int*)(a.ws + WS_ROWIDX)};
            pg8::MoeSched S; S.o.init(ntiles, 8, t.G, t.bid); S.tile_e = (const LAS int*)(t.lds + LDS_TILE_E); S.nct = 8;
            pg8::EpiSwiglu E{(bf16_t*)(a.ws + WS_ACT), a.in[I_BGU] + (size_t)l * NEXP * 2048};
            pg8::gemm_phase<pg8::EpiSwiglu, pg8::MoeSched, true>(t.lds, t.tid, g, S, E);
            SEAM(pb + 7);
        }
        if (IN_PH(pb + 8)) {
            const int ntiles = moe_tile_table(a, t, l);
            pg8::Gemm g{(const bf16_t*)(a.ws + WS_ACT), (const bf16_t*)(a.ws + WS_WD) + (size_t)l * NEXP * D * DFF, DFF, nullptr};
            pg8::MoeSched S; S.o.init(ntiles, 4, t.G, t.bid); S.tile_e = (const LAS int*)(t.lds + LDS_TILE_E); S.nct = 4;
            pg8::EpiDown E{(bf16_t*)(a.ws + WS_Y), a.in[I_BDN] + (size_t)l * NEXP * D, (const float*)(a.ws + WS_ROWGATE)};
            pg8::gemm_phase<pg8::EpiDown, pg8::MoeSched, false>(t.lds, t.tid, g, S, E);
            SEAM(pb + 8);
        }
        if (IN_PH(pb + 9)) { phase_combine(a, t, l, Mtok); SEAM(pb + 9); }
    }
#undef IN_PH
#undef SEAM
}
#endif

#if N_LAUNCH_MODE == 0
template <int KIND>
__global__ void __launch_bounds__(NTHREADS, 2) fwd_ph(Args a, int l) {
    extern __shared__ __attribute__((aligned(16))) unsigned char lds_raw[];
    Tc t; t.lds = (LAS unsigned char*)lds_raw; t.tid = threadIdx.x; t.lane = t.tid & 63; t.wave = __builtin_amdgcn_readfirstlane(t.tid >> 6); t.G = gridDim.x; t.bid = blockIdx.x;
    const bool lastl = (l == DEPTH - 1);
    const int Mtok = lastl ? ML : M;
    const float* MODSL = (const float*)(a.ws + WS_MODS) + (size_t)l * NR * 6144;
    if constexpr (KIND == 0) phase_pro0(a, t);
    if constexpr (KIND == 1) phase_pro1(a, t);
    if constexpr (KIND == 2) {
        pg8::Gemm g{(const bf16_t*)(a.ws + WS_H), (const bf16_t*)(a.ws + WS_WIN) + (size_t)l * NU * D, D, nullptr};
        pg8::DenseSched S; S.o.init(M / 256, NU / 256, t.G, t.bid);
        pg8::EpiF32 E{(float*)(a.ws + WS_U), NU};
        pg8::gemm_phase<pg8::EpiF32, pg8::DenseSched, false>(t.lds, t.tid, g, S, E);
    }
    if constexpr (KIND == 3) phase_prep(a, t, l);
    if constexpr (KIND == 4) phase_scan(a, t, l);
    if constexpr (KIND == 5) phase_mixout(a, t, l, Mtok);
    if constexpr (KIND == 6) {
        pg8::Gemm g{(const bf16_t*)(a.ws + WS_MIX), (const bf16_t*)(a.ws + WS_WOUT) + (size_t)l * D * D, D, nullptr};
        pg8::DenseSched S; S.o.init(Mtok / 256, D / 256, t.G, t.bid);
        pg8::EpiResid E{(float*)(a.ws + WS_X), MODSL};
        pg8::gemm_phase<pg8::EpiResid, pg8::DenseSched, false>(t.lds, t.tid, g, S, E);
    }
    if constexpr (KIND == 7) phase_router(a, t, l, Mtok);
    if constexpr (KIND == 8) phase_lists(a, t, l, Mtok);
    if constexpr (KIND == 9) {
        const int ntiles = moe_tile_table(a, t, l);
        pg8::Gemm g{(const bf16_t*)(a.ws + WS_H), (const bf16_t*)(a.ws + WS_WGU) + (size_t)l * NEXP * 2048 * D, D, (const int*)(a.ws + WS_ROWIDX)};
        pg8::MoeSched S; S.o.init(ntiles, 8, t.G, t.bid); S.tile_e = (const LAS int*)(t.lds + LDS_TILE_E); S.nct = 8;
        pg8::EpiSwiglu E{(bf16_t*)(a.ws + WS_ACT), a.in[I_BGU] + (size_t)l * NEXP * 2048};
        pg8::gemm_phase<pg8::EpiSwiglu, pg8::MoeSched, true>(t.lds, t.tid, g, S, E);
    }
    if constexpr (KIND == 10) {
        const int ntiles = moe_tile_table(a, t, l);
        pg8::Gemm g{(const bf16_t*)(a.ws + WS_ACT), (const bf16_t*)(a.ws + WS_WD) + (size_t)l * NEXP * D * DFF, DFF, nullptr};
        pg8::MoeSched S; S.o.init(ntiles, 4, t.G, t.bid); S.tile_e = (const LAS int*)(t.lds + LDS_TILE_E); S.nct = 4;
        pg8::EpiDown E{(bf16_t*)(a.ws + WS_Y), a.in[I_BDN] + (size_t)l * NEXP * D, (const float*)(a.ws + WS_ROWGATE)};
        pg8::gemm_phase<pg8::EpiDown, pg8::MoeSched, false>(t.lds, t.tid, g, S, E);
    }
    if constexpr (KIND == 11) phase_combine(a, t, l, Mtok);
}
#endif
}

extern "C" void kernel_launch(void* const* d_in, const int* in_sizes, int n_in, void* d_out, int out_size, void* d_ws, size_t ws_size, hipStream_t stream) {
    using namespace mk;
    static int grid = 0;
    if (grid == 0) {
        if (n_in != 37 || out_size != ML * D || ws_size < WS_END) { fprintf(stderr, "kernel_launch: unexpected shapes (n_in %d out %d ws %zu need %zu)\n", n_in, out_size, ws_size, (size_t)WS_END); grid = -1; return; }
#ifdef EMU
        { const char* e = getenv("EMU_GRID"); grid = e ? atoi(e) : 8; }
#else
        int dev = 0, cus = 0, per_cu = 0;
        if (hipGetDevice(&dev) != hipSuccess || hipDeviceGetAttribute(&cus, hipDeviceAttributeMultiprocessorCount, dev) != hipSuccess) { grid = -1; return; }
#if N_LAUNCH_MODE == 1
        if (hipFuncSetAttribute((const void*)fwd, hipFuncAttributeMaxDynamicSharedMemorySize, LDS_BYTES) != hipSuccess) { fprintf(stderr, "kernel_launch: hipFuncSetAttribute failed\n"); grid = -1; return; }
        if (hipOccupancyMaxActiveBlocksPerMultiprocessor(&per_cu, (const void*)fwd, NTHREADS, LDS_BYTES) != hipSuccess || per_cu < 1) fprintf(stderr, "kernel_launch: occupancy query reports %d\n", per_cu);
#else
#define SETA(K) (void)hipFuncSetAttribute((const void*)fwd_ph<K>, hipFuncAttributeMaxDynamicSharedMemorySize, LDS_BYTES)
        SETA(0); SETA(1); SETA(2); SETA(3); SETA(4); SETA(5); SETA(6); SETA(7); SETA(8); SETA(9); SETA(10); SETA(11);
#undef SETA
        (void)per_cu;
#endif
        (void)hipGetLastError();
        grid = cus;
#endif
    }
    if (grid < 0) return;
    (void)hipMemsetAsync((char*)d_ws + WS_CTL, 0, CTL_BYTES, stream);
    Args a{};
    for (int i = 0; i < 37; ++i) a.in[i] = (const float*)d_in[i];
    a.out = (float*)d_out; a.ws = (unsigned char*)d_ws;
#if N_LAUNCH_MODE == 1
    a.ph_lo = 0; a.ph_hi = N_PHASES;
    hipLaunchKernelGGL(fwd, dim3(grid), dim3(NTHREADS), LDS_BYTES, stream, a);
#else
    a.ph_lo = 0; a.ph_hi = 1;
#define LPH(K, l) hipLaunchKernelGGL(fwd_ph<K>, dim3(grid), dim3(NTHREADS), LDS_BYTES, stream, a, l)
    LPH(0, 0); LPH(1, 0);
    for (int l = 0; l < DEPTH; ++l) { LPH(2, l); LPH(3, l); LPH(4, l); LPH(5, l); LPH(6, l); LPH(7, l); LPH(8, l); LPH(9, l); LPH(10, l); LPH(11, l); }
#undef LPH
#endif
}
```

```cpp
#ifndef EMU
#include <hip/hip_runtime.h>
#endif
#include <cstdio>
#include <cstdint>
#include <cmath>

#ifndef CFG_BATCH
#define CFG_BATCH 4
#define CFG_SEQ 4096
#define CFG_CTX 256
#define CFG_DEPTH 4
#define CFG_NEXP 32
#endif
#ifndef N_LAUNCH_MODE
#define N_LAUNCH_MODE 1
#endif

namespace mk {
constexpr int BATCH = CFG_BATCH, SEQ = CFG_SEQ, CTX = CFG_CTX, DEPTH = CFG_DEPTH, NEXP = CFG_NEXP;
constexpr int D = 1024, ML = BATCH * SEQ, MC = BATCH * CTX, M = ML + MC, NR = BATCH + 1;
constexpr int IN_COLS = 3280, NU = 3328;
constexpr int TOPK = 4, DFF = 1024;
constexpr int MAXROWS = M * TOPK + NEXP * 256;
constexpr int NTHREADS = 512, NWAVES = 8;
constexpr int U_GQ = 0, U_GK = 128, U_GV = 256, U_GOG = 512, U_GLF = 768, U_GLB = 784;
constexpr int U_RW = 800, U_RR = 800, U_RK = 1056, U_RV = 1312, U_RLWF = 1568, U_RLWB = 1600, U_RLA = 1632, U_RLGT = 1664;
constexpr int U_SZ = 1728, U_SXBC = 2240, U_SDT = 3264;
static_assert(SEQ % 256 == 0 && CTX % 256 == 0 && M % 256 == 0, "row tiles");

constexpr size_t al256(size_t x) { return (x + 255) & ~(size_t)255; }
constexpr size_t WS_CTL = 0, CTL_BYTES = 1u << 20;
constexpr size_t WS_MODS = WS_CTL + CTL_BYTES;
constexpr size_t WS_X = WS_MODS + al256((size_t)DEPTH * NR * 6144 * 4);
constexpr size_t WS_H = WS_X + al256((size_t)M * D * 4);
constexpr size_t WS_U = WS_H + al256((size_t)M * D * 2);
constexpr size_t WS_GG = WS_U + al256((size_t)M * NU * 4);
constexpr size_t WS_RW7 = WS_GG + al256((size_t)2 * M * 128 * 4);
constexpr size_t WS_SXBC = WS_RW7 + al256((size_t)7 * M * 256 * 4);
constexpr size_t WS_SDT = WS_SXBC + al256((size_t)M * 1024 * 4);
constexpr size_t WS_OG = WS_SDT + al256((size_t)M * 16 * 4);
constexpr size_t WS_OR = WS_OG + al256((size_t)2 * M * 256 * 4);
constexpr size_t WS_OS = WS_OR + al256((size_t)2 * M * 256 * 4);
constexpr size_t WS_MIX = WS_OS + al256((size_t)2 * M * 512 * 4);
constexpr size_t WS_TOPI = WS_MIX + al256((size_t)M * D * 2);
constexpr size_t WS_TOPP = WS_TOPI + al256((size_t)M * 4 * 4);
constexpr size_t WS_POS = WS_TOPP + al256((size_t)M * 4 * 4);
constexpr size_t WS_ROWIDX = WS_POS + al256((size_t)M * 4 * 4);
constexpr size_t WS_ROWGATE = WS_ROWIDX + al256((size_t)MAXROWS * 4);
constexpr size_t WS_ACT = WS_ROWGATE + al256((size_t)MAXROWS * 4);
constexpr size_t WS_Y = WS_ACT + al256((size_t)MAXROWS * DFF * 2);
constexpr size_t WS_WIN = WS_Y + al256((size_t)MAXROWS * D * 2);
constexpr size_t WS_WOUT = WS_WIN + al256((size_t)DEPTH * NU * D * 2);
constexpr size_t WS_WGU = WS_WOUT + al256((size_t)DEPTH * D * D * 2);
constexpr size_t WS_WD = WS_WGU + al256((size_t)DEPTH * NEXP * 2048 * D * 2);
constexpr size_t WS_END = WS_WD + al256((size_t)DEPTH * NEXP * D * DFF * 2);
constexpr int CW_BAR = 4096;
constexpr int CW_CNT = 16384;
constexpr int CW_CUR = 16384 + 64 * 8;
constexpr int LDS_STAGE = 131072;
constexpr int LDS_TILE_E = LDS_STAGE;
constexpr int LDS_MISC = LDS_STAGE + 2048;
constexpr int LDS_BYTES = 147456;

#ifdef EMU
#define LAS
#define ASM_VM0() ((void)0)
#define ASM_LGKM0() ((void)0)
#define ASM_MEMFENCE() ((void)0)
#define WAIT_V(n) ((void)0)
#define WAIT_L(n) ((void)0)
#define WAVE_LDS_FENCE() emu_wave_sync()
#define LAUNDER_V(x) ((void)0)
#else
#define LAS __attribute__((address_space(3)))
#define ASM_VM0() asm volatile("s_waitcnt vmcnt(0)" ::: "memory")
#define ASM_LGKM0() asm volatile("s_waitcnt lgkmcnt(0)" ::: "memory")
#define ASM_MEMFENCE() asm volatile("" ::: "memory")
#define WAIT_V(n) asm volatile("s_waitcnt vmcnt(" #n ")" ::: "memory")
#define WAIT_L(n) asm volatile("s_waitcnt lgkmcnt(" #n ")" ::: "memory")
#define LAUNDER_V(x) asm volatile("" : "+v"(x))
#define WAVE_LDS_FENCE() do { asm volatile("s_waitcnt lgkmcnt(0)" ::: "memory"); } while (0)
#endif

typedef unsigned short bf16_t;
typedef short bf16x8 __attribute__((ext_vector_type(8)));
typedef float f32x4 __attribute__((ext_vector_type(4)));
typedef float f32x2 __attribute__((ext_vector_type(2)));
typedef unsigned u32x4 __attribute__((ext_vector_type(4)));
typedef unsigned u32x2 __attribute__((ext_vector_type(2)));

__device__ __forceinline__ unsigned f2bf(float f) { unsigned u = __float_as_uint(f); return (u + 0x7fffu + ((u >> 16) & 1u)) >> 16; }
__device__ __forceinline__ unsigned pk2(float lo, float hi) { return f2bf(lo) | (f2bf(hi) << 16); }
__device__ __forceinline__ float bf_lo(unsigned w) { return __uint_as_float(w << 16); }
__device__ __forceinline__ float bf_hi(unsigned w) { return __uint_as_float(w & 0xffff0000u); }
__device__ __forceinline__ float wave_sum(float v) {
#pragma unroll
    for (int o = 1; o < 64; o <<= 1) v += __shfl_xor(v, o);
    return v;
}
__device__ __forceinline__ float sum8(float v) { v += __shfl_xor(v, 1); v += __shfl_xor(v, 2); v += __shfl_xor(v, 4); return v; }
__device__ __forceinline__ float sigmoidf_(float x) { return 1.0f / (1.0f + expf(-x)); }
__device__ __forceinline__ float siluf_(float x) { return x / (1.0f + expf(-x)); }
__device__ __forceinline__ float softplusf_(float x) { return fmaxf(x, 0.f) + log1pf(expf(-fabsf(x))); }
__device__ __forceinline__ float logsigmoidf_(float x) { return -softplusf_(-x); }

#define XB_TMO      128
#define XB_XCNT(j)  (256  + 64 * (j))
#define XB_XSUB(j)  (1280 + 64 * (j))
#define XB_XGEN(j)  (2304 + 64 * (j))
#define XB_TOP      3328
#define XB_TOPGEN   3392
#define XCD_BAR_WORDS 3456
#ifdef EMU
#define XB_SPIN_CAP (0xffffffffu)
#else
#define XB_SPIN_CAP (1u << 22)
#endif
__device__ __forceinline__ unsigned xb_ld(unsigned* p)              { return __hip_atomic_load(p, __ATOMIC_RELAXED, __HIP_MEMORY_SCOPE_AGENT); }
__device__ __forceinline__ unsigned xb_add(unsigned* p, unsigned v) { return __hip_atomic_fetch_add(p, v, __ATOMIC_RELAXED, __HIP_MEMORY_SCOPE_AGENT); }
__device__ __forceinline__ unsigned xb_xcc_id() { return (unsigned)__builtin_amdgcn_s_getreg((3 << 11) | 20) & 0xFu; }
#define XB_SPIN(cond, bar) do { unsigned _sp = 0; while (cond) { __builtin_amdgcn_s_sleep(1); \
    if ((++_sp & 255u) == 0u) { if (xb_ld(&(bar)[XB_TMO])) break; if (_sp > XB_SPIN_CAP) { atomicAdd(&(bar)[XB_TMO], 1u); break; } } } } while (0)
struct XcdBarrier { unsigned* bar; unsigned x; volatile LAS unsigned* st; };
__device__ __forceinline__ XcdBarrier xcd_barrier_post(unsigned* bar, volatile LAS unsigned* st) {
    XcdBarrier b; b.bar = bar; b.x = xb_xcc_id(); b.st = st;
    if (threadIdx.x == 0) (void)xb_add(&bar[XB_XCNT(b.x)], 1u);
    return b;
}
__device__ __forceinline__ void xcd_barrier_complete(unsigned* bar, unsigned x, unsigned& nloc, unsigned& nx) {
    const unsigned G = gridDim.x * gridDim.y * gridDim.z;
    unsigned sum, cnt, mine, sp = 0u;
    for (;;) {
        sum = 0u; cnt = 0u; mine = 0u;
#pragma unroll
        for (unsigned j = 0; j < 16; ++j) { const unsigned c = xb_ld(&bar[XB_XCNT(j)]); sum += c; cnt += (c > 0u) ? 1u : 0u; mine = (j == x) ? c : mine; }
        if (sum == G) break;
        __builtin_amdgcn_s_sleep(1);
        if ((++sp & 255u) == 0u) { if (xb_ld(&bar[XB_TMO])) break; if (sp > XB_SPIN_CAP) { atomicAdd(&bar[XB_TMO], 1u); break; } }
    }
    nloc = mine > 0u ? mine : 1u; nx = cnt > 0u ? cnt : 1u;
}
__device__ __forceinline__ void xcd_barrier(const XcdBarrier& b) {
    ASM_VM0();
    __syncthreads();
    if (threadIdx.x == 0) {
        unsigned* bar = b.bar;
        __builtin_amdgcn_s_waitcnt(0);
        unsigned nloc = b.st[0], nx = b.st[1];
        if (nloc == 0u) { xcd_barrier_complete(bar, b.x, nloc, nx); b.st[0] = nloc; b.st[1] = nx; }
        const unsigned old = xb_add(&bar[XB_XSUB(b.x)], 1u);
        const unsigned gen = old / nloc;
        if (old + 1u == (gen + 1u) * nloc) {
            __builtin_amdgcn_fence(__ATOMIC_RELEASE, "agent");
            ASM_VM0();
            const unsigned og = xb_add(&bar[XB_TOP], 1u);
            const unsigned tg = og / nx;
            if (og + 1u == (tg + 1u) * nx) xb_add(&bar[XB_TOPGEN], 1u);
            else XB_SPIN(xb_ld(&bar[XB_TOPGEN]) == tg, bar);
            __builtin_amdgcn_fence(__ATOMIC_ACQUIRE, "agent");
            xb_add(&bar[XB_XGEN(b.x)], 1u);
            ASM_VM0();
        } else {
            XB_SPIN(xb_ld(&bar[XB_XGEN(b.x)]) == gen, bar);
            __builtin_amdgcn_fence(__ATOMIC_ACQUIRE, "agent");
            ASM_VM0();
        }
    }
    __syncthreads();
}

namespace pg8 {
constexpr int BM = 256, BK = 64, HALF = 128, HTB = HALF * BK * 2, STAGE_BYTES = 8 * HTB, NXCD = 8, WGM = 8;
__host__ __device__ __forceinline__ int lds_byte(int r, int c) { const int st = (r >> 4) * 2 + (c >> 5), rr = r & 15, cc = c & 31, ob = rr * 64 + cc * 2; return st * 1024 + (ob ^ (((ob >> 9) & 1) << 5)); }
__host__ __device__ __forceinline__ void stage_rc(int b, int& R, int& C) { const int st = b / 1024, sb = b % 1024, swz = sb ^ (((sb >> 9) & 1) << 5); R = (st >> 1) * 16 + swz / 64; C = (st & 1) * 32 + (swz % 64) / 2; }
__host__ __device__ __forceinline__ int perm32(int rho) { const int n = rho >> 4, i = rho & 15; return 8 * (i >> 2) + 4 * n + (i & 3); }
struct Unit { int pm, pn, pb; };
struct Gemm { const bf16_t* A; const bf16_t* Bt; int K; const int* rowidx; };
struct Order {
    int nM, nN, nwg, G, c;
    __device__ __forceinline__ void init(int nM_, int nN_, int G_, int c_) { nM = nM_; nN = nN_; nwg = nM * nN; G = G_; c = c_; }
    __device__ __forceinline__ bool tile(int i, int& pm, int& pn) const {
        const long L = (long)i * G + c; if (L >= nwg) return false;
        int wgid = (int)L; { const int q = nwg / NXCD, r = nwg % NXCD, xcd = wgid % NXCD, off = wgid / NXCD; wgid = (xcd < r ? xcd * (q + 1) : r * (q + 1) + (xcd - r) * q) + off; }
        const int nig = WGM * nN, gid = wgid / nig, fm = gid * WGM, gsz = (nM - fm) < WGM ? (nM - fm) : WGM;
        pm = fm + ((wgid % nig) % gsz); pn = (wgid % nig) / gsz; return true;
    }
};
struct DenseSched { Order o; __device__ __forceinline__ bool next(int i, Unit& u) const { if (!o.tile(i, u.pm, u.pn)) return false; u.pb = u.pn; return true; } };
struct MoeSched { Order o; const LAS int* tile_e; int nct;
    __device__ __forceinline__ bool next(int i, Unit& u) const { if (!o.tile(i, u.pm, u.pn)) return false; u.pb = tile_e[u.pm] * nct + u.pn; return true; } };

__device__ __forceinline__ unsigned cvt_pk_bf16(float lo, float hi) {
#ifdef EMU
    return pk2(lo, hi);
#else
    unsigned r; asm volatile("v_cvt_pk_bf16_f32 %0, %1, %2" : "=v"(r) : "v"(lo), "v"(hi)); return r;
#endif
}
struct EpiF32 {
    static constexpr bool PERM = false;
    float* C; int ldc;
    __device__ __forceinline__ void operator()(const f32x4 (&acc)[2][2][4][2], const Unit& u, int wr, int wc, int fr, int fq) const {
        const int row0 = u.pm * BM + wr * 64 + fr, col0 = u.pn * BM + wc * 32 + 4 * fq;
#pragma unroll
        for (int ai = 0; ai < 2; ++ai)
#pragma unroll
            for (int m = 0; m < 4; ++m) { float* rowp = C + (size_t)(row0 + ai * HALF + m * 16) * ldc + col0;
#pragma unroll
                for (int bj = 0; bj < 2; ++bj)
#pragma unroll
                    for (int n = 0; n < 2; ++n) *(f32x4*)(rowp + bj * HALF + n * 16) = acc[ai][bj][m][n]; }
    }
};
struct EpiResid {
    static constexpr bool PERM = false;
    float* X; const float* mods;
    __device__ __forceinline__ void operator()(const f32x4 (&acc)[2][2][4][2], const Unit& u, int wr, int wc, int fr, int fq) const {
        const int row0 = u.pm * BM + wr * 64 + fr, col0 = u.pn * BM + wc * 32 + 4 * fq;
        const int rbase = u.pm * BM; const int mrow = rbase < ML ? rbase / SEQ : BATCH;
        const float* g = mods + (size_t)mrow * 6144 + 2 * 1024 + col0;
        f32x4 gv[2][2];
#pragma unroll
        for (int bj = 0; bj < 2; ++bj)
#pragma unroll
            for (int n = 0; n < 2; ++n) gv[bj][n] = *(const f32x4*)(g + bj * HALF + n * 16);
#pragma unroll
        for (int ai = 0; ai < 2; ++ai)
#pragma unroll
            for (int m = 0; m < 4; ++m) { float* rowp = X + (size_t)(row0 + ai * HALF + m * 16) * D + col0;
#pragma unroll
                for (int bj = 0; bj < 2; ++bj)
#pragma unroll
                    for (int n = 0; n < 2; ++n) { f32x4* p = (f32x4*)(rowp + bj * HALF + n * 16); *p = *p + gv[bj][n] * acc[ai][bj][m][n]; } }
    }
};
struct EpiSwiglu {
    static constexpr bool PERM = true;
    bf16_t* ACT; const float* bgu;
    __device__ __forceinline__ void operator()(const f32x4 (&acc)[2][2][4][2], const Unit& u, int wr, int wc, int fr, int fq) const {
        const int e = u.pb >> 3;
        const int row0 = u.pm * BM + wr * 64 + fr, j0 = u.pn * 128 + wc * 32 + 8 * fq;
        const float* bg = bgu + (size_t)e * 2048 + j0;
        f32x4 bgl[2], bln[2];
#pragma unroll
        for (int n = 0; n < 2; ++n) { bgl[n] = *(const f32x4*)(bg + 4 * n); bln[n] = *(const f32x4*)(bg + 1024 + 4 * n); }
#pragma unroll
        for (int ai = 0; ai < 2; ++ai)
#pragma unroll
            for (int m = 0; m < 4; ++m) { bf16_t* rowp = ACT + (size_t)(row0 + ai * HALF + m * 16) * DFF + j0;
                float o[8];
#pragma unroll
                for (int n = 0; n < 2; ++n)
#pragma unroll
                    for (int j = 0; j < 4; ++j) { float gl = acc[ai][0][m][n][j] + bgl[n][j], ln = acc[ai][1][m][n][j] + bln[n][j];
                        gl = fminf(gl, 7.0f); ln = fminf(fmaxf(ln, -7.0f), 7.0f);
                        o[n * 4 + j] = gl / (1.0f + __expf(-1.702f * gl)) * (ln + 1.0f); }
                u32x4 w; w.x = cvt_pk_bf16(o[0], o[1]); w.y = cvt_pk_bf16(o[2], o[3]); w.z = cvt_pk_bf16(o[4], o[5]); w.w = cvt_pk_bf16(o[6], o[7]);
                *(u32x4*)rowp = w; }
    }
};
struct EpiDown {
    static constexpr bool PERM = true;
    bf16_t* Y; const float* bd; const float* rowgate;
    __device__ __forceinline__ void operator()(const f32x4 (&acc)[2][2][4][2], const Unit& u, int wr, int wc, int fr, int fq) const {
        const int e = u.pb >> 2;
        const int row0 = u.pm * BM + wr * 64 + fr, col0 = u.pn * BM + wc * 32 + 8 * fq;
        const float* b = bd + (size_t)e * 1024 + col0;
        f32x4 bv[2][2];
#pragma unroll
        for (int bj = 0; bj < 2; ++bj)
#pragma unroll
            for (int n = 0; n < 2; ++n) bv[bj][n] = *(const f32x4*)(b + bj * HALF + 4 * n);
#pragma unroll
        for (int ai = 0; ai < 2; ++ai)
#pragma unroll
            for (int m = 0; m < 4; ++m) { const int row = row0 + ai * HALF + m * 16; const float gt = rowgate[row]; bf16_t* rowp = Y + (size_t)row * D + col0;
#pragma unroll
                for (int bj = 0; bj < 2; ++bj) { const f32x4 v0 = (acc[ai][bj][m][0] + bv[bj][0]) * gt, v1 = (acc[ai][bj][m][1] + bv[bj][1]) * gt;
                    u32x4 w; w.x = cvt_pk_bf16(v0[0], v0[1]); w.y = cvt_pk_bf16(v0[2], v0[3]); w.z = cvt_pk_bf16(v1[0], v1[1]); w.w = cvt_pk_bf16(v1[2], v1[3]);
                    *(u32x4*)(rowp + bj * HALF) = w; } }
    }
};

template <class Epi, class Sched, bool GATHER>
__device__ __forceinline__ void gemm_phase(LAS unsigned char* lds, const int tid, const Gemm g, const Sched& S, const Epi& E) {
    const int wid = __builtin_amdgcn_readfirstlane(tid >> 6), lane = tid & 63, wr = wid >> 2, wc = wid & 3, fr = lane & 15, fq = lane >> 4;
    const int K = g.K, nt = K / BK;
    unsigned voffB[2]; int RA[2], CA[2];
#pragma unroll
    for (int i = 0; i < 2; ++i) { int R, C; stage_rc(tid * 16 + i * 8192, R, C); const int Rb = Epi::PERM ? ((R & ~31) + perm32(R & 31)) : R;
        RA[i] = R; CA[i] = C; voffB[i] = (unsigned)(Rb * K + C) * 2u; }
    const size_t kstep = (size_t)(BK * 2);
    const size_t hstep = (size_t)HALF * K * 2;
    const size_t tstep = 2 * hstep;
    const unsigned ldsw = (unsigned)wid * 1024u;
    const int aoff = lds_byte(wr * 64 + fr, fq * 8), boff = lds_byte(wc * 32 + fr, fq * 8);
#define PG8_SA(b, h) (((b) * 2 + (h)) * HTB)
#define PG8_SB(b, h) ((4 + (b) * 2 + (h)) * HTB)
#define PG8_STAGE(bufoff, gbase, voff) do { _Pragma("unroll") for (int _i = 0; _i < 2; ++_i) \
        __builtin_amdgcn_global_load_lds((const unsigned*)((const char*)(gbase) + (voff)[_i]), (LAS unsigned*)(lds + (bufoff) + ldsw + _i * 8192), 16, 0, 0); } while (0)
#define PG8_LDA(dst, b, h) do { _Pragma("unroll") for (int m = 0; m < 4; ++m) _Pragma("unroll") for (int k = 0; k < 2; ++k) dst[m][k] = *(const LAS bf16x8*)(lds + PG8_SA(b, h) + aoff + m * 2048 + k * 1024); } while (0)
#define PG8_LDB(dst, b, h) do { _Pragma("unroll") for (int n = 0; n < 2; ++n) _Pragma("unroll") for (int k = 0; k < 2; ++k) dst[n][k] = *(const LAS bf16x8*)(lds + PG8_SB(b, h) + boff + n * 2048 + k * 1024); } while (0)
#define PG8_MMA(ai, bj, At, Bt) do { __builtin_amdgcn_s_setprio(1); _Pragma("unroll") for (int m = 0; m < 4; ++m) _Pragma("unroll") for (int n = 0; n < 2; ++n) _Pragma("unroll") for (int k = 0; k < 2; ++k) \
        acc[ai][bj][m][n] = __builtin_amdgcn_mfma_f32_16x16x32_bf16(Bt[n][k], At[m][k], acc[ai][bj][m][n], 0, 0, 0); __builtin_amdgcn_s_setprio(0); } while (0)
#define PG8_BAR __builtin_amdgcn_s_barrier()
#define PG8_SCHED __builtin_amdgcn_sched_barrier(0)
#define PG8_AOFF(dst, unit) do { _Pragma("unroll") for (int _h = 0; _h < 2; ++_h) _Pragma("unroll") for (int _i = 0; _i < 2; ++_i) { \
        const int _r = (unit).pm * BM + _h * HALF + RA[_i]; const int _src = GATHER ? g.rowidx[_r] : _r; dst[_h][_i] = (unsigned)(_src * K + CA[_i]) * 2u; } } while (0)
    Unit cur, nxt; int ui = 0;
    if (!S.next(0, cur)) return;
    f32x4 acc[2][2][4][2];
#pragma unroll
    for (int a = 0; a < 2; ++a)
#pragma unroll
        for (int b = 0; b < 2; ++b)
#pragma unroll
            for (int m = 0; m < 4; ++m)
#pragma unroll
                for (int n = 0; n < 2; ++n) acc[a][b][m][n] = (f32x4){0.f, 0.f, 0.f, 0.f};
    bf16x8 At[4][2], B0[2][2], B1[2][2];
    unsigned cvA[2][2], nvA[2][2];
    PG8_AOFF(cvA, cur);
    const char* const gA = (const char*)g.A;
    const char* cB = (const char*)g.Bt + (size_t)cur.pb * tstep;
    PG8_STAGE(PG8_SB(0, 0), cB, voffB); PG8_STAGE(PG8_SA(0, 0), gA, cvA[0]); PG8_STAGE(PG8_SB(0, 1), cB + hstep, voffB); PG8_STAGE(PG8_SA(0, 1), gA, cvA[1]);
    if (wr == 1) PG8_BAR;
    WAIT_V(4); PG8_BAR;
    PG8_STAGE(PG8_SB(1, 0), cB + kstep, voffB); PG8_STAGE(PG8_SA(1, 0), gA + kstep, cvA[0]); PG8_STAGE(PG8_SB(1, 1), cB + hstep + kstep, voffB);
    WAIT_V(6); PG8_BAR;
    for (;;) {
        const bool has_next = S.next(ui + 1, nxt);
        if (has_next) { PG8_AOFF(nvA, nxt); } else {
#pragma unroll
            for (int h = 0; h < 2; ++h)
#pragma unroll
                for (int i = 0; i < 2; ++i) nvA[h][i] = cvA[h][i]; }
        const char* nB = has_next ? (const char*)g.Bt + (size_t)nxt.pb * tstep : cB;
        for (int t = 0; t < nt; t += 2) {
            const bool last = (t == nt - 2);
            const char* a1 = gA + (size_t)(t + 1) * kstep;
            const char* a2 = last ? gA : gA + (size_t)(t + 2) * kstep; const char* b2 = last ? nB : cB + (size_t)(t + 2) * kstep;
            const char* a3 = a2 + kstep; const char* b3 = b2 + kstep;
            unsigned xA0[2], xA1[2];
#pragma unroll
            for (int i = 0; i < 2; ++i) { xA0[i] = last ? nvA[0][i] : cvA[0][i]; xA1[i] = last ? nvA[1][i] : cvA[1][i]; }
            PG8_LDB(B0, 0, 0); PG8_SCHED; PG8_LDA(At, 0, 0); PG8_STAGE(PG8_SA(1, 1), a1, cvA[1]);
            WAIT_L(8); PG8_BAR; WAIT_L(0); PG8_MMA(0, 0, At, B0); PG8_BAR; PG8_SCHED;
            PG8_LDB(B1, 0, 1); PG8_STAGE(PG8_SB(0, 0), b2, voffB);
            PG8_BAR; WAIT_L(0); PG8_MMA(0, 1, At, B1); PG8_BAR;
            PG8_LDA(At, 0, 1); PG8_STAGE(PG8_SA(0, 0), a2, xA0);
            PG8_BAR; WAIT_L(0); PG8_MMA(1, 0, At, B0); PG8_BAR; PG8_SCHED;
            PG8_STAGE(PG8_SB(0, 1), b2 + hstep, voffB);
            WAIT_V(6); PG8_BAR; PG8_MMA(1, 1, At, B1); PG8_BAR;
            PG8_LDB(B0, 1, 0); PG8_SCHED; PG8_LDA(At, 1, 0); PG8_STAGE(PG8_SA(0, 1), a2, xA1);
            WAIT_L(8); PG8_BAR; WAIT_L(0); PG8_MMA(0, 0, At, B0); PG8_BAR; PG8_SCHED;
            PG8_LDB(B1, 1, 1); PG8_STAGE(PG8_SB(1, 0), b3, voffB);
            PG8_BAR; WAIT_L(0); PG8_MMA(0, 1, At, B1); PG8_BAR;
            PG8_LDA(At, 1, 1); PG8_STAGE(PG8_SA(1, 0), a3, xA0);
            PG8_BAR; WAIT_L(0); PG8_MMA(1, 0, At, B0); PG8_BAR; PG8_SCHED;
            PG8_STAGE(PG8_SB(1, 1), b3 + hstep, voffB);
            WAIT_V(6); PG8_BAR; PG8_MMA(1, 1, At, B1); PG8_BAR;
        }
        E(acc, cur, wr, wc, fr, fq);
        if (!has_next) break;
#pragma unroll
        for (int a = 0; a < 2; ++a)
#pragma unroll
            for (int b = 0; b < 2; ++b)
#pragma unroll
                for (int m = 0; m < 4; ++m)
#pragma unroll
                    for (int n = 0; n < 2; ++n) acc[a][b][m][n] = (f32x4){0.f, 0.f, 0.f, 0.f};
        cur = nxt; cB = nB; ++ui;
#pragma unroll
        for (int h = 0; h < 2; ++h)
#pragma unroll
            for (int i = 0; i < 2; ++i) cvA[h][i] = nvA[h][i];
    }
    WAIT_V(0);
    if (wr == 0) PG8_BAR;
    PG8_BAR;
#undef PG8_SA
#undef PG8_SB
#undef PG8_STAGE
#undef PG8_LDA
#undef PG8_LDB
#undef PG8_MMA
#undef PG8_BAR
#undef PG8_SCHED
#undef PG8_AOFF
}
}

struct Args { const float* in[37]; float* out; unsigned char* ws; int ph_lo, ph_hi; };
enum { I_X = 0, I_C, I_CTX, I_CCTX, I_WADA, I_BADA, I_N1G, I_N2G, I_WIN, I_GGW, I_GGB, I_GNG, I_RMU, I_RW0, I_RW2, I_RA0, I_RA2, I_RG2, I_RKK, I_RKA, I_RRK,
       I_RLG, I_RLB, I_SCW, I_SCB, I_SDTB, I_SALOG, I_SD, I_SNG, I_WOUT, I_ROUTW, I_ROUTB, I_WGU, I_BGU, I_WDN, I_BDN, I_FNG };

struct Tc { LAS unsigned char* lds; int tid, lane, wave, G, bid; };

__device__ __forceinline__ void transpose_item(const float* W, int ldw, int k0, int n0, int nv, bf16_t* dst, int K, LAS float* scr, int lane) {
#pragma unroll 8
    for (int i = 0; i < 32; ++i) { const int kk = 2 * i + (lane >> 5), c = lane & 31; scr[kk * 33 + c] = (c < nv) ? W[(size_t)(k0 + kk) * ldw + n0 + c] : 0.f; }
    WAVE_LDS_FENCE();
    const int c = lane & 7;
#pragma unroll
    for (int j = 0; j < 4; ++j) { const int n = (lane >> 3) + 8 * j; const LAS float* s = scr + (8 * c) * 33 + n;
        u32x4 o; o.x = pk2(s[0 * 33], s[1 * 33]); o.y = pk2(s[2 * 33], s[3 * 33]); o.z = pk2(s[4 * 33], s[5 * 33]); o.w = pk2(s[6 * 33], s[7 * 33]);
        *(u32x4*)(dst + (size_t)n * K + k0 + 8 * c) = o; }
    WAVE_LDS_FENCE();
}
__device__ __forceinline__ void phase_pro0(const Args& a, const Tc& t) {
    LAS float* scr = (LAS float*)(t.lds + t.wave * 16384);
    const int gw = t.bid * NWAVES + t.wave, NGW = t.G * NWAVES;
    constexpr int KB = D / 64;
    constexpr int I_IN = KB * (NU / 32), I_OUT = KB * (D / 32), I_GU = KB * (2048 / 32), I_DN = KB * (D / 32);
    constexpr int IPL = I_IN + I_OUT + NEXP * (I_GU + I_DN);
    bf16_t* WIN = (bf16_t*)(a.ws + WS_WIN); bf16_t* WOUT = (bf16_t*)(a.ws + WS_WOUT); bf16_t* WGU = (bf16_t*)(a.ws + WS_WGU); bf16_t* WDN = (bf16_t*)(a.ws + WS_WD);
    for (int it = gw; it < DEPTH * IPL; it += NGW) {
        const int l = it / IPL; int r = it % IPL;
        if (r < I_IN) { const int kb = r / (NU / 32), nb = r % (NU / 32), n0 = nb * 32; int nv = IN_COLS - n0; nv = nv < 0 ? 0 : (nv > 32 ? 32 : nv);
            transpose_item(a.in[I_WIN] + (size_t)l * D * IN_COLS, IN_COLS, kb * 64, n0, nv, WIN + ((size_t)l * NU + n0) * D, D, scr, t.lane); continue; }
        r -= I_IN;
        if (r < I_OUT) { const int kb = r / (D / 32), nb = r % (D / 32);
            transpose_item(a.in[I_WOUT] + (size_t)l * D * D, D, kb * 64, nb * 32, 32, WOUT + ((size_t)l * D + nb * 32) * D, D, scr, t.lane); continue; }
        r -= I_OUT;
        const int e = r / (I_GU + I_DN); r = r % (I_GU + I_DN);
        if (r < I_GU) { const int kb = r / 64, nb = r % 64, n0 = nb * 32; const int half = n0 >> 10, rem = n0 & 1023, pn = rem >> 7, jj = rem & 127;
            transpose_item(a.in[I_WGU] + ((size_t)l * NEXP + e) * D * 2048, 2048, kb * 64, n0, 32, WGU + (((size_t)l * NEXP + e) * 2048 + pn * 256 + half * 128 + jj) * D, D, scr, t.lane); continue; }
        r -= I_GU;
        { const int kb = r / (D / 32), nb = r % (D / 32);
            transpose_item(a.in[I_WDN] + ((size_t)l * NEXP + e) * DFF * D, D, kb * 64, nb * 32, 32, WDN + (((size_t)l * NEXP + e) * D + nb * 32) * DFF, DFF, scr, t.lane); }
    }
    __syncthreads();
    LAS float* sc = (LAS float*)t.lds;
    LAS float* red = (LAS float*)(t.lds + 32768);
    for (int i = t.tid; i < NR * D; i += NTHREADS) { const int r = i / D, k = i % D; const float v = r < BATCH ? a.in[I_C][r * D + k] : a.in[I_CCTX][k]; sc[i] = siluf_(v); }
    __syncthreads();
    float* MODS = (float*)(a.ws + WS_MODS);
    const int jl = t.tid & 127, kq = t.tid >> 7;
    for (int cb = t.bid; cb < DEPTH * 48; cb += t.G) {
        const int l = cb / 48, j = (cb % 48) * 128 + jl;
        const float* w = a.in[I_WADA] + (size_t)l * D * 6144 + j;
        float acc[NR];
#pragma unroll
        for (int r = 0; r < NR; ++r) acc[r] = 0.f;
        for (int k = kq * 256; k < kq * 256 + 256; ++k) { const float wv = w[(size_t)k * 6144];
#pragma unroll
            for (int r = 0; r < NR; ++r) acc[r] += sc[r * D + k] * wv; }
#pragma unroll
        for (int r = 0; r < NR; ++r) red[(kq * NR + r) * 128 + jl] = acc[r];
        __syncthreads();
        if (kq == 0) {
            const float bb = a.in[I_BADA][(size_t)l * 6144 + j];
#pragma unroll
            for (int r = 0; r < NR; ++r) MODS[((size_t)l * NR + r) * 6144 + j] = red[(0 * NR + r) * 128 + jl] + red[(1 * NR + r) * 128 + jl] + red[(2 * NR + r) * 128 + jl] + red[(3 * NR + r) * 128 + jl] + bb;
        }
        __syncthreads();
    }
}

__device__ __forceinline__ int mod_row(int row) { return row < ML ? row / SEQ : BATCH; }
__device__ __forceinline__ void norm_mod_store(const f32x4 (&v)[4], const float* g, const float* shift, const float* scale, bf16_t* hrow, int lane, f32x4 (&hout)[4]) {
    float ss = 0.f;
#pragma unroll
    for (int j = 0; j < 4; ++j) ss += (v[j][0] * v[j][0] + v[j][1] * v[j][1]) + (v[j][2] * v[j][2] + v[j][3] * v[j][3]);
    const float rstd = 1.0f / sqrtf(wave_sum(ss) * (1.0f / D) + 1e-6f);
#pragma unroll
    for (int j = 0; j < 4; ++j) { const int c = 4 * lane + 256 * j;
        const f32x4 gg = *(const f32x4*)(g + c), sh = *(const f32x4*)(shift + c), sc = *(const f32x4*)(scale + c);
        const f32x4 h = (v[j] * rstd * gg) * (sc + 1.0f) + sh; hout[j] = h;
        u32x2 w; w.x = pk2(h[0], h[1]); w.y = pk2(h[2], h[3]); *(u32x2*)(hrow + c) = w; }
}
__device__ __forceinline__ void phase_pro1(const Args& a, const Tc& t) {
    const int gw = t.bid * NWAVES + t.wave, NGW = t.G * NWAVES;
    float* X = (float*)(a.ws + WS_X); bf16_t* H = (bf16_t*)(a.ws + WS_H); const float* MODS = (const float*)(a.ws + WS_MODS);
    for (int row = gw; row < M; row += NGW) {
        const float* src = row < ML ? a.in[I_X] + (size_t)row * D : a.in[I_CTX] + (size_t)(row - ML) * D;
        f32x4 v[4], h[4];
#pragma unroll
        for (int j = 0; j < 4; ++j) { v[j] = *(const f32x4*)(src + 4 * t.lane + 256 * j); *(f32x4*)(X + (size_t)row * D + 4 * t.lane + 256 * j) = v[j]; }
        const float* md = MODS + (size_t)mod_row(row) * 6144;
        norm_mod_store(v, a.in[I_N1G], md, md + 1024, H + (size_t)row * D, t.lane, h);
    }
}

__device__ __forceinline__ void seg_bounds(int row, int& lo, int& hi) {
    if (row < ML) { lo = row & ~63; hi = lo + 64; } else { lo = ML + ((row - ML) / CTX) * CTX; hi = lo + CTX; }
}
__device__ __forceinline__ void phase_prep(const Args& a, const Tc& t, int l) {
    const float* U = (const float*)(a.ws + WS_U);
    float* GG = (float*)(a.ws + WS_GG); float* RW7 = (float*)(a.ws + WS_RW7); float* SXBC = (float*)(a.ws + WS_SXBC); float* SDT = (float*)(a.ws + WS_SDT);
    const float* mu = a.in[I_RMU] + (size_t)l * 2 * 928;
    const float* w0 = a.in[I_RW0] + (size_t)l * 2 * 256; const float* w2 = a.in[I_RW2] + (size_t)l * 2 * 32 * 256;
    const float* a0 = a.in[I_RA0] + (size_t)l * 256; const float* a2 = a.in[I_RA2] + (size_t)l * 32 * 256;
    const float* rkk = a.in[I_RKK] + (size_t)l * 256; const float* rka = a.in[I_RKA] + (size_t)l * 256;
    const float* ggw = a.in[I_GGW] + (size_t)l * 2 * 16 * 128; const float* ggb = a.in[I_GGB] + (size_t)l * 2 * 128;
    const float* cw = a.in[I_SCW] + (size_t)l * 4 * 1024; const float* cb = a.in[I_SCB] + (size_t)l * 1024;
    const float* dtb = a.in[I_SDTB] + (size_t)l * 16;
    LAS float* LOW = (LAS float*)t.lds;
    for (int tile = t.bid; tile < M / 16; tile += t.G) {
        const int r0 = tile * 16; int slo, shi; seg_bounds(r0, slo, shi);
        {
            const int tt = t.tid >> 5, r = t.tid & 31, row = r0 + tt;
            const float* up = U + (size_t)row * NU; const bool hp = row - 1 >= slo, hn = row + 1 < shi;
#pragma unroll
            for (int q = 0; q < 3; ++q) { const int col = U_RLWF + q * 32 + r, mi = col - U_RW;
                const float u = up[col], pv = hp ? up[col - NU] : 0.f, nv = hn ? up[col + NU] : 0.f;
                const float s = u + mu[mi] * (pv - u) + mu[928 + mi] * (nv - u);
                LOW[tt * 128 + q * 32 + r] = q < 2 ? tanhf(s) : s; }
            LOW[tt * 128 + 96 + r] = up[U_GLF + r];
        }
        __syncthreads();
        {
            const int c = t.tid & 255, tt0 = (t.tid >> 8) * 8;
            float aa[8], af[8], ab[8];
#pragma unroll
            for (int j = 0; j < 8; ++j) { aa[j] = a0[c]; af[j] = w0[c]; ab[j] = w0[256 + c]; }
            for (int r = 0; r < 32; ++r) { const float wa = a2[r * 256 + c], wf = w2[r * 256 + c], wb = w2[(32 + r) * 256 + c];
#pragma unroll
                for (int j = 0; j < 8; ++j) { const LAS float* lw = LOW + (tt0 + j) * 128; aa[j] += lw[64 + r] * wa; af[j] += lw[r] * wf; ab[j] += lw[32 + r] * wb; } }
            const float m0r = mu[c], m1r = mu[928 + c], m0k = mu[256 + c], m1k = mu[928 + 256 + c], m0v = mu[512 + c], m1v = mu[928 + 512 + c];
            const float kkg = rkk[c], kag = rka[c];
#pragma unroll
            for (int j = 0; j < 8; ++j) { const int row = r0 + tt0 + j; const float* up = U + (size_t)row * NU; const bool hp = row - 1 >= slo, hn = row + 1 < shi;
                float u, pv, nv;
                u = up[U_RR + c]; pv = hp ? up[U_RR + c - NU] : 0.f; nv = hn ? up[U_RR + c + NU] : 0.f; const float rs = u + m0r * (pv - u) + m1r * (nv - u);
                u = up[U_RK + c]; pv = hp ? up[U_RK + c - NU] : 0.f; nv = hn ? up[U_RK + c + NU] : 0.f; const float ks = u + m0k * (pv - u) + m1k * (nv - u);
                u = up[U_RV + c]; pv = hp ? up[U_RV + c - NU] : 0.f; nv = hn ? up[U_RV + c + NU] : 0.f; const float vs = u + m0v * (pv - u) + m1v * (nv - u);
                const float av = sigmoidf_(aa[j]);
                const float wfv = expf(-0.606531f * sigmoidf_(af[j])), wbv = expf(-0.606531f * sigmoidf_(ab[j]));
                const float kr = ks * kkg; const float ssq = wave_sum(kr * kr); const float kk = kr * (1.0f / sqrtf(ssq + 1e-12f));
                const float kf = ks * (1.0f + (av - 1.0f) * kag);
                const size_t o = (size_t)row * 256 + c, P = (size_t)M * 256;
                RW7[o] = rs; RW7[P + o] = kf; RW7[2 * P + o] = vs; RW7[3 * P + o] = kk; RW7[4 * P + o] = kk * av; RW7[5 * P + o] = wfv; RW7[6 * P + o] = wbv; }
        }
        {
            const int j = t.tid & 127, dq = t.tid >> 7, dir = dq & 1, tt0 = (dq >> 1) * 8;
            float acc[8];
#pragma unroll
            for (int q = 0; q < 8; ++q) acc[q] = ggb[dir * 128 + j];
#pragma unroll
            for (int r = 0; r < 16; ++r) { const float w = ggw[(dir * 16 + r) * 128 + j];
#pragma unroll
                for (int q = 0; q < 8; ++q) acc[q] += LOW[(tt0 + q) * 128 + 96 + dir * 16 + r] * w; }
#pragma unroll
            for (int q = 0; q < 8; ++q) GG[((size_t)dir * M + r0 + tt0 + q) * 128 + j] = logsigmoidf_(acc[q]) * (1.0f / 16.0f);
        }
        {
#pragma unroll
            for (int cc = 0; cc < 2; ++cc) { const int col = t.tid + cc * 512; const float* up = U + U_SXBC + col;
                const float c0 = cw[col], c1 = cw[1024 + col], c2 = cw[2048 + col], c3 = cw[3072 + col], bb = cb[col];
                float um2 = (r0 - 2 >= slo) ? up[(size_t)(r0 - 2) * NU] : 0.f, um1 = (r0 - 1 >= slo) ? up[(size_t)(r0 - 1) * NU] : 0.f, u0 = up[(size_t)r0 * NU];
#pragma unroll
                for (int q = 0; q < 16; ++q) { const int row = r0 + q; const float up1 = (row + 1 < shi) ? up[(size_t)(row + 1) * NU] : 0.f;
                    const float y = c0 * um2 + c1 * um1 + c2 * u0 + c3 * up1 + bb;
                    SXBC[(size_t)row * 1024 + col] = siluf_(y); um2 = um1; um1 = u0; u0 = up1; } }
        }
        if (t.tid < 256) { const int tt = t.tid >> 4, j = t.tid & 15, row = r0 + tt; SDT[(size_t)row * 16 + j] = softplusf_(U[(size_t)row * NU + U_SDT + j] + dtb[j]); }
        __syncthreads();
    }
}

__device__ __forceinline__ int chain_row(int b, int dir, int s) {
    if (s < CTX) return ML + b * CTX + (dir ? CTX - 1 - s : s);
    const int tt = s - CTX; return b * SEQ + (dir ? SEQ - 1 - tt : tt);
}
constexpr int CH = 32, NSTEP = CTX + SEQ, NCHUNK = NSTEP / CH;
__device__ __forceinline__ void phase_scan(const Args& a, const Tc& t, int l) {
    const float* U = (const float*)(a.ws + WS_U); const float* GG = (const float*)(a.ws + WS_GG); const float* RW7 = (const float*)(a.ws + WS_RW7);
    const float* SXBC = (const float*)(a.ws + WS_SXBC); const float* SDT = (const float*)(a.ws + WS_SDT);
    float* OG = (float*)(a.ws + WS_OG); float* OR = (float*)(a.ws + WS_OR); float* OS = (float*)(a.ws + WS_OS);
    LAS float* IN = (LAS float*)t.lds;
    LAS float* OUT = (LAS float*)(t.lds + 65536);
    constexpr int NC_R = BATCH * 8, NC_S = BATCH * 16, NC_G = BATCH * 8;
    for (int ci = t.bid; ci < NC_R + NC_S + NC_G; ci += t.G) {
        int tidl = t.tid; LAUNDER_V(tidl);
        const int i8 = tidl >> 3, j8 = tidl & 7;
        if (ci < NC_R) {
            const int dir = ci & 1, h = (ci >> 1) & 3, b = ci >> 3;
            const size_t P = (size_t)M * 256;
            float S[8];
#pragma unroll
            for (int e = 0; e < 8; ++e) S[e] = 0.f;
            f32x4 pf[6];
#define RW_LOAD(chunk) do { _Pragma("unroll") for (int q = 0; q < 6; ++q) { const int e4 = tidl + 512 * q, st = e4 / 96, rem = e4 % 96, vec = rem >> 4, c4 = rem & 15; \
                const int row = chain_row(b, dir, (chunk) * CH + st); const int vs = vec < 5 ? vec : 5 + dir; \
                pf[q] = *(const f32x4*)(RW7 + (size_t)vs * P + (size_t)row * 256 + h * 64 + c4 * 4); } } while (0)
            RW_LOAD(0);
            for (int ch = 0; ch < NCHUNK; ++ch) {
#pragma unroll
                for (int q = 0; q < 6; ++q) *(LAS f32x4*)(IN + (size_t)(tidl + 512 * q) * 4) = pf[q];
                __syncthreads();
                if (ch + 1 < NCHUNK) RW_LOAD(ch + 1);
#pragma unroll 2
                for (int st = 0; st < CH; ++st) {
                    const LAS float* p = IN + st * 384;
                    const f32x4 r0 = *(const LAS f32x4*)(p + 8 * j8), r1 = *(const LAS f32x4*)(p + 8 * j8 + 4);
                    const f32x4 k0 = *(const LAS f32x4*)(p + 64 + 8 * j8), k1 = *(const LAS f32x4*)(p + 64 + 8 * j8 + 4);
                    const float vi = p[128 + i8];
                    const f32x4 q0 = *(const LAS f32x4*)(p + 192 + 8 * j8), q1 = *(const LAS f32x4*)(p + 192 + 8 * j8 + 4);
                    const f32x4 b0 = *(const LAS f32x4*)(p + 256 + 8 * j8), b1 = *(const LAS f32x4*)(p + 256 + 8 * j8 + 4);
                    const f32x4 w0 = *(const LAS f32x4*)(p + 320 + 8 * j8), w1 = *(const LAS f32x4*)(p + 320 + 8 * j8 + 4);
                    float d = (S[0] * q0[0] + S[1] * q0[1]) + (S[2] * q0[2] + S[3] * q0[3]) + (S[4] * q1[0] + S[5] * q1[1]) + (S[6] * q1[2] + S[7] * q1[3]);
                    d = sum8(d);
#pragma unroll
                    for (int e = 0; e < 4; ++e) { S[e] = S[e] * w0[e] - d * b0[e] + vi * k0[e]; S[4 + e] = S[4 + e] * w1[e] - d * b1[e] + vi * k1[e]; }
                    float o = (S[0] * r0[0] + S[1] * r0[1]) + (S[2] * r0[2] + S[3] * r0[3]) + (S[4] * r1[0] + S[5] * r1[1]) + (S[6] * r1[2] + S[7] * r1[3]);
                    o = sum8(o);
                    if (j8 == 0) OUT[st * 64 + i8] = o;
                }
                __syncthreads();
#pragma unroll
                for (int q = 0; q < 4; ++q) { const int e = tidl + 512 * q, st = e >> 6, i = e & 63; const int row = chain_row(b, dir, ch * CH + st);
                    OR[((size_t)dir * M + row) * 256 + h * 64 + i] = OUT[e]; }
            }
#undef RW_LOAD
        } else if (ci < NC_R + NC_S) {
            const int cj = ci - NC_R; const int dir = cj & 1, h = (cj >> 1) & 7, b = cj >> 4, grp = h >> 2;
            const float a_neg = -expf(a.in[I_SALOG][(size_t)l * 16 + dir * 8 + h]);
            float S[16];
#pragma unroll
            for (int e = 0; e < 16; ++e) S[e] = 0.f;
            f32x4 pf[6];
#define SS_LOAD(chunk) do { _Pragma("unroll") for (int q = 0; q < 6; ++q) { const int e4 = tidl + 512 * q; if (e4 < CH * 84) { const int st = e4 / 84, rem = e4 % 84; \
                const int row = chain_row(b, dir, (chunk) * CH + st); const float* src; \
                if (rem < 32) src = SXBC + (size_t)row * 1024 + 512 + grp * 128 + rem * 4; else if (rem < 64) src = SXBC + (size_t)row * 1024 + 768 + grp * 128 + (rem - 32) * 4; \
                else if (rem < 80) src = SXBC + (size_t)row * 1024 + h * 64 + (rem - 64) * 4; else src = SDT + (size_t)row * 16 + (rem - 80) * 4; \
                pf[q] = *(const f32x4*)src; } } } while (0)
            SS_LOAD(0);
            for (int ch = 0; ch < NCHUNK; ++ch) {
#pragma unroll
                for (int q = 0; q < 6; ++q) { const int e4 = tidl + 512 * q; if (e4 < CH * 84) *(LAS f32x4*)(IN + (size_t)e4 * 4) = pf[q]; }
                __syncthreads();
                if (ch + 1 < NCHUNK) SS_LOAD(ch + 1);
#pragma unroll 2
                for (int st = 0; st < CH; ++st) {
                    const LAS float* p = IN + st * 336;
                    const float dtv = p[320 + dir * 8 + h], xdt = p[256 + i8] * dtv, ea = expf(dtv * a_neg);
                    float y = 0.f;
#pragma unroll
                    for (int q = 0; q < 4; ++q) { const f32x4 Bv = *(const LAS f32x4*)(p + 16 * j8 + 4 * q), Cv = *(const LAS f32x4*)(p + 128 + 16 * j8 + 4 * q);
#pragma unroll
                        for (int e = 0; e < 4; ++e) { S[4 * q + e] = ea * S[4 * q + e] + Bv[e] * xdt; y += S[4 * q + e] * Cv[e]; } }
                    y = sum8(y);
                    if (j8 == 0) OUT[st * 64 + i8] = y;
                }
                __syncthreads();
#pragma unroll
                for (int q = 0; q < 4; ++q) { const int e = tidl + 512 * q, st = e >> 6, i = e & 63; const int row = chain_row(b, dir, ch * CH + st);
                    OS[((size_t)dir * M + row) * 512 + h * 64 + i] = OUT[e]; }
            }
#undef SS_LOAD
        } else {
            const int cj = ci - NC_R - NC_S; const int dir = cj & 1, h = (cj >> 1) & 3, b = cj >> 3;
            float S[4];
#pragma unroll
            for (int e = 0; e < 4; ++e) S[e] = 0.f;
            f32x4 pf[3];
#define GL_LOAD(chunk) do { _Pragma("unroll") for (int q = 0; q < 3; ++q) { const int e4 = tidl + 512 * q; if (e4 < CH * 40) { const int st = e4 / 40, rem = e4 % 40; \
                const int row = chain_row(b, dir, (chunk) * CH + st); const float* src; \
                if (rem < 8) src = U + (size_t)row * NU + U_GQ + h * 32 + rem * 4; else if (rem < 16) src = U + (size_t)row * NU + U_GK + h * 32 + (rem - 8) * 4; \
                else if (rem < 32) src = U + (size_t)row * NU + U_GV + h * 64 + (rem - 16) * 4; else src = GG + ((size_t)dir * M + row) * 128 + h * 32 + (rem - 32) * 4; \
                pf[q] = *(const f32x4*)src; } } } while (0)
            GL_LOAD(0);
            for (int ch = 0; ch < NCHUNK; ++ch) {
#pragma unroll
                for (int q = 0; q < 3; ++q) { const int e4 = tidl + 512 * q; if (e4 < CH * 40) *(LAS f32x4*)(IN + (size_t)e4 * 4) = pf[q]; }
                __syncthreads();
                if (ch + 1 < NCHUNK) GL_LOAD(ch + 1);
#pragma unroll 2
                for (int st = 0; st < CH; ++st) {
                    const LAS float* p = IN + st * 160;
                    const f32x4 qv = *(const LAS f32x4*)(p + 4 * j8), kv = *(const LAS f32x4*)(p + 32 + 4 * j8), gv = *(const LAS f32x4*)(p + 128 + 4 * j8);
                    const float vv = p[64 + i8];
                    float o = 0.f;
#pragma unroll
                    for (int e = 0; e < 4; ++e) { S[e] = expf(gv[e]) * S[e] + kv[e] * vv; o += S[e] * qv[e]; }
                    o = sum8(o) * 0.17677669529663687f;
                    if (j8 == 0) OUT[st * 64 + i8] = o;
                }
                __syncthreads();
#pragma unroll
                for (int q = 0; q < 4; ++q) { const int e = tidl + 512 * q, st = e >> 6, i = e & 63; const int row = chain_row(b, dir, ch * CH + st);
                    OG[((size_t)dir * M + row) * 256 + h * 64 + i] = OUT[e]; }
            }
#undef GL_LOAD
        }
        __syncthreads();
    }
}

__device__ __forceinline__ void phase_mixout(const Args& a, const Tc& t, int l, int Mtok) {
    const float* U = (const float*)(a.ws + WS_U); const float* RW7 = (const float*)(a.ws + WS_RW7); const float* SXBC = (const float*)(a.ws + WS_SXBC);
    const float* OG = (const float*)(a.ws + WS_OG); const float* OR = (const float*)(a.ws + WS_OR); const float* OS = (const float*)(a.ws + WS_OS);
    bf16_t* MIX = (bf16_t*)(a.ws + WS_MIX);
    const float* mu = a.in[I_RMU] + (size_t)l * 2 * 928; const float* g2 = a.in[I_RG2] + (size_t)l * 64 * 256;
    const float* gng = a.in[I_GNG] + (size_t)l * 256; const float* lng = a.in[I_RLG] + (size_t)l * 256; const float* lnb = a.in[I_RLB] + (size_t)l * 256;
    const float* rrk = a.in[I_RRK] + (size_t)l * 256; const float* sd = a.in[I_SD] + (size_t)l * 8; const float* sng = a.in[I_SNG] + (size_t)l * 512;
    LAS float* SG = (LAS float*)t.lds;
    LAS float* RED = (LAS float*)(t.lds + 4096);
    const size_t P = (size_t)M * 256;
    for (int tile = t.bid; tile < Mtok / 16; tile += t.G) {
        const int r0 = tile * 16; int slo, shi; seg_bounds(r0, slo, shi);
        {   const int tt = t.tid >> 5, r = t.tid & 31, row = r0 + tt; const float* up = U + (size_t)row * NU; const bool hp = row - 1 >= slo, hn = row + 1 < shi;
#pragma unroll
            for (int q = 0; q < 2; ++q) { const int col = U_RLGT + q * 32 + r, mi = col - U_RW; const float u = up[col], pv = hp ? up[col - NU] : 0.f, nv = hn ? up[col + NU] : 0.f;
                SG[tt * 64 + q * 32 + r] = sigmoidf_(u + mu[mi] * (pv - u) + mu[928 + mi] * (nv - u)); } }
        __syncthreads();
        {
            const int c = t.tid & 255, tt0 = (t.tid >> 8) * 8;
            float ag[8];
#pragma unroll
            for (int j = 0; j < 8; ++j) ag[j] = 0.f;
            for (int r = 0; r < 64; ++r) { const float w = g2[r * 256 + c];
#pragma unroll
                for (int j = 0; j < 8; ++j) ag[j] += SG[(tt0 + j) * 64 + r] * w; }
            const float gn = gng[c], lg = lng[c], lb = lnb[c], rk = rrk[c];
#pragma unroll
            for (int j = 0; j < 8; ++j) { const int row = r0 + tt0 + j;
                const float og_ = OG[(size_t)row * 256 + c] + OG[P + (size_t)row * 256 + c];
                const float ms = wave_sum(og_ * og_) * (1.0f / 64.0f);
                const float o1 = og_ * (1.0f / sqrtf(ms + 1e-6f)) * gn * siluf_(U[(size_t)row * NU + U_GOG + c]);
                const float orr = OR[(size_t)row * 256 + c] + OR[P + (size_t)row * 256 + c];
                const float mean = wave_sum(orr) * (1.0f / 64.0f); const float dd = orr - mean; const float var = wave_sum(dd * dd) * (1.0f / 64.0f);
                const float on = dd * (1.0f / sqrtf(var + 64e-5f)) * lg + lb;
                const float rr = RW7[(size_t)row * 256 + c], kk = RW7[P + (size_t)row * 256 + c], vv = RW7[2 * P + (size_t)row * 256 + c];
                const float bon = wave_sum(rr * kk * rk) * vv;
                const float o2 = (on + bon) * ag[j];
                MIX[(size_t)row * D + c] = (bf16_t)f2bf(o1); MIX[(size_t)row * D + 256 + c] = (bf16_t)f2bf(o2); }
        }
        {
            const int c = t.tid; const float dh = sd[c >> 6], ng = sng[c];
            float y[16];
#pragma unroll
            for (int q = 0; q < 16; ++q) { const int row = r0 + q;
                float v = OS[(size_t)row * 512 + c] + OS[(size_t)M * 512 + (size_t)row * 512 + c] + dh * SXBC[(size_t)row * 1024 + c];
                v *= siluf_(U[(size_t)row * NU + U_SZ + c]); y[q] = v;
                const float ss = wave_sum(v * v); if (t.lane == 0) RED[q * 8 + t.wave] = ss; }
            __syncthreads();
            const int gb = (t.wave >> 2) * 4;
#pragma unroll
            for (int q = 0; q < 16; ++q) { const float ms = (RED[q * 8 + gb] + RED[q * 8 + gb + 1] + RED[q * 8 + gb + 2] + RED[q * 8 + gb + 3]) * (1.0f / 256.0f);
                MIX[(size_t)(r0 + q) * D + 512 + c] = (bf16_t)f2bf(y[q] * (1.0f / sqrtf(ms + 1e-6f)) * ng); }
        }
        __syncthreads();
    }
}

__device__ __forceinline__ void phase_router(const Args& a, const Tc& t, int l, int Mtok) {
    const int gw = t.bid * NWAVES + t.wave, NGW = t.G * NWAVES;
    const float* X = (const float*)(a.ws + WS_X); bf16_t* H = (bf16_t*)(a.ws + WS_H); const float* MODS = (const float*)(a.ws + WS_MODS) + (size_t)l * NR * 6144;
    const float* rw = a.in[I_ROUTW] + (size_t)l * D * NEXP; const float* rb = a.in[I_ROUTB] + (size_t)l * NEXP;
    int* TOPI = (int*)(a.ws + WS_TOPI); float* TOPP = (float*)(a.ws + WS_TOPP);
    unsigned* CNT = (unsigned*)(a.ws + WS_CTL) + CW_CNT + l * 64;
    LAS int* hist = (LAS int*)(t.lds + LDS_MISC + 64);
    if (t.tid < NEXP) hist[t.tid] = 0;
    __syncthreads();
    for (int row = gw; row < Mtok; row += NGW) {
        f32x4 v[4], h[4];
#pragma unroll
        for (int j = 0; j < 4; ++j) v[j] = *(const f32x4*)(X + (size_t)row * D + 4 * t.lane + 256 * j);
        const float* md = MODS + (size_t)mod_row(row) * 6144;
        norm_mod_store(v, a.in[I_N2G] + (size_t)l * D, md + 3 * 1024, md + 4 * 1024, H + (size_t)row * D, t.lane, h);
        float lg[NEXP];
#pragma unroll
        for (int e = 0; e < NEXP; ++e) lg[e] = 0.f;
#pragma unroll
        for (int j = 0; j < 4; ++j)
#pragma unroll
            for (int q = 0; q < 4; ++q) { const float hv = h[j][q]; const float* wr_ = rw + (size_t)(4 * t.lane + 256 * j + q) * NEXP;
#pragma unroll
                for (int e4 = 0; e4 < NEXP / 4; ++e4) { const f32x4 w = *(const f32x4*)(wr_ + 4 * e4);
                    lg[4 * e4] += hv * w[0]; lg[4 * e4 + 1] += hv * w[1]; lg[4 * e4 + 2] += hv * w[2]; lg[4 * e4 + 3] += hv * w[3]; } }
#pragma unroll
        for (int e = 0; e < NEXP; ++e) lg[e] = wave_sum(lg[e]) + rb[e];
        int ti[4]; float tv[4];
#pragma unroll
        for (int k = 0; k < 4; ++k) { float best = -3.0e38f; int bi = 0;
#pragma unroll
            for (int e = 0; e < NEXP; ++e) { bool taken = false;
#pragma unroll
                for (int k2 = 0; k2 < k; ++k2) taken = taken || (ti[k2] == e);
                if (!taken && lg[e] > best) { best = lg[e]; bi = e; } }
            ti[k] = bi; tv[k] = best; }
        const float e0 = 1.0f, e1 = expf(tv[1] - tv[0]), e2 = expf(tv[2] - tv[0]), e3 = expf(tv[3] - tv[0]); const float inv = 1.0f / (e0 + e1 + e2 + e3);
        if (t.lane == 0) {
            TOPI[row * 4 + 0] = ti[0]; TOPI[row * 4 + 1] = ti[1]; TOPI[row * 4 + 2] = ti[2]; TOPI[row * 4 + 3] = ti[3];
            TOPP[row * 4 + 0] = e0 * inv; TOPP[row * 4 + 1] = e1 * inv; TOPP[row * 4 + 2] = e2 * inv; TOPP[row * 4 + 3] = e3 * inv;
#pragma unroll
            for (int k = 0; k < 4; ++k) atomicAdd((int*)&hist[ti[k]], 1);
        }
    }
    __syncthreads();
    if (t.tid < NEXP && hist[t.tid] != 0) atomicAdd(&CNT[t.tid], (unsigned)hist[t.tid]);
}

__device__ __forceinline__ int moe_offsets(const unsigned* CNT, LAS int* off, LAS int* cnt, int tid) {
    if (tid < NEXP) { int o = 0; for (int e = 0; e < tid; ++e) o += ((int)CNT[e] + 255) & ~255; off[tid] = o; cnt[tid] = (int)CNT[tid]; }
    __syncthreads();
    return (off[NEXP - 1] + ((cnt[NEXP - 1] + 255) & ~255)) >> 8;
}
__device__ __forceinline__ void phase_lists(const Args& a, const Tc& t, int l, int Mtok) {
    const int* TOPI = (const int*)(a.ws + WS_TOPI); const float* TOPP = (const float*)(a.ws + WS_TOPP);
    int* POS = (int*)(a.ws + WS_POS); int* ROWIDX = (int*)(a.ws + WS_ROWIDX); float* ROWGATE = (float*)(a.ws + WS_ROWGATE);
    unsigned* CNT = (unsigned*)(a.ws + WS_CTL) + CW_CNT + l * 64; unsigned* CUR = (unsigned*)(a.ws + WS_CTL) + CW_CUR + l * 64;
    LAS int* off = (LAS int*)(t.lds + LDS_MISC + 64); LAS int* cnt = off + 64; LAS int* hist = off + 128; LAS int* base = off + 192; LAS int* cur = off + 256;
    if (t.tid < NEXP) { hist[t.tid] = 0; cur[t.tid] = 0; }
    moe_offsets(CNT, off, cnt, t.tid);
    const int rpb = (Mtok + t.G - 1) / t.G, s0 = t.bid * rpb * 4; int s1 = (t.bid + 1) * rpb * 4; if (s1 > Mtok * 4) s1 = Mtok * 4;
    for (int s = s0 + t.tid; s < s1; s += NTHREADS) atomicAdd((int*)&hist[TOPI[s]], 1);
    __syncthreads();
    if (t.tid < NEXP) base[t.tid] = hist[t.tid] ? (int)atomicAdd(&CUR[t.tid], (unsigned)hist[t.tid]) : 0;
    __syncthreads();
    for (int s = s0 + t.tid; s < s1; s += NTHREADS) { const int e = TOPI[s]; const int p = off[e] + base[e] + atomicAdd((int*)&cur[e], 1);
        POS[s] = p; ROWIDX[p] = s >> 2; ROWGATE[p] = TOPP[s]; }
    for (int e = t.bid; e < NEXP; e += t.G) { const int lo = off[e] + cnt[e], hi = off[e] + ((cnt[e] + 255) & ~255);
        for (int p = lo + t.tid; p < hi; p += NTHREADS) { ROWIDX[p] = 0; ROWGATE[p] = 0.f; } }
    __syncthreads();
}
__device__ __forceinline__ int moe_tile_table(const Args& a, const Tc& t, int l) {
    unsigned* CNT = (unsigned*)(a.ws + WS_CTL) + CW_CNT + l * 64;
    LAS int* off = (LAS int*)(t.lds + LDS_MISC + 64); LAS int* cnt = off + 64; LAS int* tile_e = (LAS int*)(t.lds + LDS_TILE_E);
    const int ntiles = moe_offsets(CNT, off, cnt, t.tid);
    for (int tt = t.tid; tt < ntiles; tt += NTHREADS) { int e = 0;
        for (int q = 1; q < NEXP; ++q) if ((off[q] >> 8) <= tt) e = q;
        tile_e[tt] = e; }
    __syncthreads();
    return ntiles;
}

__device__ __forceinline__ void phase_combine(const Args& a, const Tc& t, int l, int Mtok) {
    const int gw = t.bid * NWAVES + t.wave, NGW = t.G * NWAVES;
    float* X = (float*)(a.ws + WS_X); bf16_t* H = (bf16_t*)(a.ws + WS_H); const bf16_t* Y = (const bf16_t*)(a.ws + WS_Y); const int* POS = (const int*)(a.ws + WS_POS);
    const float* MODS = (const float*)(a.ws + WS_MODS) + (size_t)l * NR * 6144;
    for (int row = gw; row < Mtok; row += NGW) {
        const float* md = MODS + (size_t)mod_row(row) * 6144 + 5 * 1024;
        const int p0 = POS[row * 4], p1 = POS[row * 4 + 1], p2 = POS[row * 4 + 2], p3 = POS[row * 4 + 3];
        f32x4 v[4], h[4];
#pragma unroll
        for (int j = 0; j < 4; ++j) { const int c = 4 * t.lane + 256 * j;
            const u32x2 y0 = *(const u32x2*)(Y + (size_t)p0 * D + c), y1 = *(const u32x2*)(Y + (size_t)p1 * D + c), y2 = *(const u32x2*)(Y + (size_t)p2 * D + c), y3 = *(const u32x2*)(Y + (size_t)p3 * D + c);
            f32x4 s; s[0] = (bf_lo(y0.x) + bf_lo(y1.x)) + (bf_lo(y2.x) + bf_lo(y3.x)); s[1] = (bf_hi(y0.x) + bf_hi(y1.x)) + (bf_hi(y2.x) + bf_hi(y3.x));
            s[2] = (bf_lo(y0.y) + bf_lo(y1.y)) + (bf_lo(y2.y) + bf_lo(y3.y)); s[3] = (bf_hi(y0.y) + bf_hi(y1.y)) + (bf_hi(y2.y) + bf_hi(y3.y));
            const f32x4 g = *(const f32x4*)(md + c);
            v[j] = *(const f32x4*)(X + (size_t)row * D + c) + g * s; }
        if (l + 1 < DEPTH) {
#pragma unroll
            for (int j = 0; j < 4; ++j) *(f32x4*)(X + (size_t)row * D + 4 * t.lane + 256 * j) = v[j];
            const float* md2 = MODS + (size_t)NR * 6144 + (size_t)mod_row(row) * 6144;
            norm_mod_store(v, a.in[I_N1G] + (size_t)(l + 1) * D, md2, md2 + 1024, H + (size_t)row * D, t.lane, h);
        } else {
            float ss = 0.f;
#pragma unroll
            for (int j = 0; j < 4; ++j) ss += (v[j][0] * v[j][0] + v[j][1] * v[j][1]) + (v[j][2] * v[j][2] + v[j][3] * v[j][3]);
            const float rstd = 1.0f / sqrtf(wave_sum(ss) * (1.0f / D) + 1e-6f);
#pragma unroll
            for (int j = 0; j < 4; ++j) { const int c = 4 * t.lane + 256 * j; const f32x4 g = *(const f32x4*)(a.in[I_FNG] + c); *(f32x4*)(a.out + (size_t)row * D + c) = v[j] * rstd * g; }
        }
    }
}

#ifndef EMU
__device__ __forceinline__ void launder_tid(Tc& t) { int x = threadIdx.x; asm volatile("" : "+v"(x)); t.tid = x; t.lane = x & 63; t.wave = __builtin_amdgcn_readfirstlane(x >> 6); }
#endif
constexpr int PH_PER_LAYER = 10, N_PHASES = 2 + DEPTH * PH_PER_LAYER;
#if N_LAUNCH_MODE == 1 || defined(EMU)
__global__ void __launch_bounds__(NTHREADS, 2) fwd(Args a) {
#ifdef EMU
    unsigned char* lds_raw = EMU_DYN_LDS();
#else
    extern __shared__ __attribute__((aligned(16))) unsigned char lds_raw[];
#endif
    Tc t; t.lds = (LAS unsigned char*)lds_raw; t.tid = threadIdx.x; t.lane = t.tid & 63; t.wave = __builtin_amdgcn_readfirstlane(t.tid >> 6); t.G = gridDim.x; t.bid = blockIdx.x;
    const int lo = a.ph_lo, hi = a.ph_hi;
    volatile LAS unsigned* misc = (volatile LAS unsigned*)(t.lds + LDS_MISC);
    if (t.tid < 16) misc[t.tid] = 0u;
    __syncthreads();
    XcdBarrier bar; bar.bar = (unsigned*)(a.ws + WS_CTL) + CW_BAR; bar.x = 0; bar.st = misc;
    if (hi - lo > 1) bar = xcd_barrier_post((unsigned*)(a.ws + WS_CTL) + CW_BAR, misc);
#ifdef EMU
#define LAUNDER_TID() ((void)0)
#else
#define LAUNDER_TID() launder_tid(t)
#endif
#define IN_PH(k) (lo <= (k) && (k) < hi && (LAUNDER_TID(), true))
#define SEAM(k) do { if ((k) + 1 < hi) xcd_barrier(bar); } while (0)
    if (IN_PH(0)) { phase_pro0(a, t); SEAM(0); }
    if (IN_PH(1)) { phase_pro1(a, t); SEAM(1); }
    for (int l = 0; l < DEPTH; ++l) {
        const int pb = 2 + l * PH_PER_LAYER;
        const bool lastl = (l == DEPTH - 1);
        const int Mtok = lastl ? ML : M;
        const float* MODSL = (const float*)(a.ws + WS_MODS) + (size_t)l * NR * 6144;
        if (IN_PH(pb + 0)) {
            pg8::Gemm g{(const bf16_t*)(a.ws + WS_H), (const bf16_t*)(a.ws + WS_WIN) + (size_t)l * NU * D, D, nullptr};
            pg8::DenseSched S; S.o.init(M / 256, NU / 256, t.G, t.bid);
            pg8::EpiF32 E{(float*)(a.ws + WS_U), NU};
            pg8::gemm_phase<pg8::EpiF32, pg8::DenseSched, false>(t.lds, t.tid, g, S, E);
            SEAM(pb + 0);
        }
        if (IN_PH(pb + 1)) { phase_prep(a, t, l); SEAM(pb + 1); }
        if (IN_PH(pb + 2)) { phase_scan(a, t, l); SEAM(pb + 2); }
        if (IN_PH(pb + 3)) { phase_mixout(a, t, l, Mtok); SEAM(pb + 3); }
        if (IN_PH(pb + 4)) {
            pg8::Gemm g{(const bf16_t*)(a.ws + WS_MIX), (const bf16_t*)(a.ws + WS_WOUT) + (size_t)l * D * D, D, nullptr};
            pg8::DenseSched S; S.o.init(Mtok / 256, D / 256, t.G, t.bid);
            pg8::EpiResid E{(float*)(a.ws + WS_X), MODSL};
            pg8::gemm_phase<pg8::EpiResid, pg8::DenseSched, false>(t.lds, t.tid, g, S, E);
            SEAM(pb + 4);
        }
        if (IN_PH(pb + 5)) { phase_router(a, t, l, Mtok); SEAM(pb + 5); }
        if (IN_PH(pb + 6)) { phase_lists(a, t, l, Mtok); SEAM(pb + 6); }
        if (IN_PH(pb + 7)) {
            const int ntiles = moe_tile_table(a, t, l);
            pg8::Gemm g{(const bf16_t*)(a.ws + WS_H), (const bf16_t*)(a.ws + WS_WGU) + (size_t)l * NEXP * 2048 * D, D, (const int*)(a.ws + WS_ROWIDX)};
            pg8::MoeSched S; S.o.init(ntiles, 8, t.G, t.bid); S.tile_e = (const LAS int*)(t.lds + LDS_TILE_E); S.nct = 8;
            pg8::EpiSwiglu E{(bf16_t*)(a.ws + WS_ACT), a.in[I_BGU] + (size_t)l * NEXP * 2048};
            pg8::gemm_phase<pg8::EpiSwiglu, pg8::MoeSched, true>(t.lds, t.tid, g, S, E);
            SEAM(pb + 7);
        }
        if (IN_PH(pb + 8)) {
            const int ntiles = moe_tile_table(a, t, l);
            pg8::Gemm g{(const bf16_t*)(a.ws + WS_ACT), (const bf16_t*)(a.ws + WS_WD) + (size_t)l * NEXP * D * DFF, DFF, nullptr};
            pg8::MoeSched S; S.o.init(ntiles, 4, t.G, t.bid); S.tile_e = (const LAS int*)(t.lds + LDS_TILE_E); S.nct = 4;
            pg8::EpiDown E{(bf16_t*)(a.ws + WS_Y), a.in[I_BDN] + (size_t)l * NEXP * D, (const float*)(a.ws + WS_ROWGATE)};
            pg8::gemm_phase<pg8::EpiDown, pg8::MoeSched, false>(t.lds, t.tid, g, S, E);
            SEAM(pb + 8);
        }
        if (IN_PH(pb + 9)) { phase_combine(a, t, l, Mtok); SEAM(pb + 9); }
    }
#undef IN_PH
#undef SEAM
}
#endif

#if N_LAUNCH_MODE == 0 && !defined(EMU)
template <int KIND>
__global__ void __launch_bounds__(NTHREADS, 2) fwd_ph(Args a, int l) {
    extern __shared__ __attribute__((aligned(16))) unsigned char lds_raw[];
    Tc t; t.lds = (LAS unsigned char*)lds_raw; t.tid = threadIdx.x; t.lane = t.tid & 63; t.wave = __builtin_amdgcn_readfirstlane(t.tid >> 6); t.G = gridDim.x; t.bid = blockIdx.x;
    const bool lastl = (l == DEPTH - 1);
    const int Mtok = lastl ? ML : M;
    const float* MODSL = (const float*)(a.ws + WS_MODS) + (size_t)l * NR * 6144;
    if constexpr (KIND == 0) phase_pro0(a, t);
    if constexpr (KIND == 1) phase_pro1(a, t);
    if constexpr (KIND == 2) {
        pg8::Gemm g{(const bf16_t*)(a.ws + WS_H), (const bf16_t*)(a.ws + WS_WIN) + (size_t)l * NU * D, D, nullptr};
        pg8::DenseSched S; S.o.init(M / 256, NU / 256, t.G, t.bid);
        pg8::EpiF32 E{(float*)(a.ws + WS_U), NU};
        pg8::gemm_phase<pg8::EpiF32, pg8::DenseSched, false>(t.lds, t.tid, g, S, E);
    }
    if constexpr (KIND == 3) phase_prep(a, t, l);
    if constexpr (KIND == 4) phase_scan(a, t, l);
    if constexpr (KIND == 5) phase_mixout(a, t, l, Mtok);
    if constexpr (KIND == 6) {
        pg8::Gemm g{(const bf16_t*)(a.ws + WS_MIX), (const bf16_t*)(a.ws + WS_WOUT) + (size_t)l * D * D, D, nullptr};
        pg8::DenseSched S; S.o.init(Mtok / 256, D / 256, t.G, t.bid);
        pg8::EpiResid E{(float*)(a.ws + WS_X), MODSL};
        pg8::gemm_phase<pg8::EpiResid, pg8::DenseSched, false>(t.lds, t.tid, g, S, E);
    }
    if constexpr (KIND == 7) phase_router(a, t, l, Mtok);
    if constexpr (KIND == 8) phase_lists(a, t, l, Mtok);
    if constexpr (KIND == 9) {
        const int ntiles = moe_tile_table(a, t, l);
        pg8::Gemm g{(const bf16_t*)(a.ws + WS_H), (const bf16_t*)(a.ws + WS_WGU) + (size_t)l * NEXP * 2048 * D, D, (const int*)(a.ws + WS_ROWIDX)};
        pg8::MoeSched S; S.o.init(ntiles, 8, t.G, t.bid); S.tile_e = (const LAS int*)(t.lds + LDS_TILE_E); S.nct = 8;
        pg8::EpiSwiglu E{(bf16_t*)(a.ws + WS_ACT), a.in[I_BGU] + (size_t)l * NEXP * 2048};
        pg8::gemm_phase<pg8::EpiSwiglu, pg8::MoeSched, true>(t.lds, t.tid, g, S, E);
    }
    if constexpr (KIND == 10) {
        const int ntiles = moe_tile_table(a, t, l);
        pg8::Gemm g{(const bf16_t*)(a.ws + WS_ACT), (const bf16_t*)(a.ws + WS_WD) + (size_t)l * NEXP * D * DFF, DFF, nullptr};
        pg8::MoeSched S; S.o.init(ntiles, 4, t.G, t.bid); S.tile_e = (const LAS int*)(t.lds + LDS_TILE_E); S.nct = 4;
        pg8::EpiDown E{(bf16_t*)(a.ws + WS_Y), a.in[I_BDN] + (size_t)l * NEXP * D, (const float*)(a.ws + WS_ROWGATE)};
        pg8::gemm_phase<pg8::EpiDown, pg8::MoeSched, false>(t.lds, t.tid, g, S, E);
    }
    if constexpr (KIND == 11) phase_combine(a, t, l, Mtok);
}
#endif
}

extern "C" void kernel_launch(void* const* d_in, const int* in_sizes, int n_in, void* d_out, int out_size, void* d_ws, size_t ws_size, hipStream_t stream) {
    using namespace mk;
    static int grid = 0;
    if (grid == 0) {
        if (n_in != 37 || out_size != ML * D || ws_size < WS_END) { fprintf(stderr, "kernel_launch: unexpected shapes (n_in %d out %d ws %zu need %zu)\n", n_in, out_size, ws_size, (size_t)WS_END); grid = -1; return; }
#ifdef EMU
        { const char* e = getenv("EMU_GRID"); grid = e ? atoi(e) : 8; }
#else
        int dev = 0, cus = 0, per_cu = 0;
        if (hipGetDevice(&dev) != hipSuccess || hipDeviceGetAttribute(&cus, hipDeviceAttributeMultiprocessorCount, dev) != hipSuccess) { grid = -1; return; }
#if N_LAUNCH_MODE == 1
        if (hipFuncSetAttribute((const void*)fwd, hipFuncAttributeMaxDynamicSharedMemorySize, LDS_BYTES) != hipSuccess) { fprintf(stderr, "kernel_launch: hipFuncSetAttribute failed\n"); grid = -1; return; }
        if (hipOccupancyMaxActiveBlocksPerMultiprocessor(&per_cu, (const void*)fwd, NTHREADS, LDS_BYTES) != hipSuccess || per_cu < 1) fprintf(stderr, "kernel_launch: occupancy query reports %d\n", per_cu);
#else
#define SETA(K) (void)hipFuncSetAttribute((const void*)fwd_ph<K>, hipFuncAttributeMaxDynamicSharedMemorySize, LDS_BYTES)
        SETA(0); SETA(1); SETA(2); SETA(3); SETA(4); SETA(5); SETA(6); SETA(7); SETA(8); SETA(9); SETA(10); SETA(11);
#undef SETA
        (void)per_cu;
#endif
        (void)hipGetLastError();
        grid = cus;
#endif
    }
    if (grid < 0) return;
    (void)hipMemsetAsync((char*)d_ws + WS_CTL, 0, CTL_BYTES, stream);
    Args a{};
    for (int i = 0; i < 37; ++i) a.in[i] = (const float*)d_in[i];
    a.out = (float*)d_out; a.ws = (unsigned char*)d_ws;
#if N_LAUNCH_MODE == 1
    a.ph_lo = 0; a.ph_hi = N_PHASES;
    hipLaunchKernelGGL(fwd, dim3(grid), dim3(NTHREADS), LDS_BYTES, stream, a);
#else
    a.ph_lo = 0; a.ph_hi = 1;
#define LPH(K, l) hipLaunchKernelGGL(fwd_ph<K>, dim3(grid), dim3(NTHREADS), LDS_BYTES, stream, a, l)
    LPH(0, 0); LPH(1, 0);
    for (int l = 0; l < DEPTH; ++l) { LPH(2, l); LPH(3, l); LPH(4, l); LPH(5, l); LPH(6, l); LPH(7, l); LPH(8, l); LPH(9, l); LPH(10, l); LPH(11, l); }
#undef LPH
#endif
}
```

```cpp
#ifndef EMU
#include <hip/hip_runtime.h>
#endif
#include <cstdio>
#include <cstdint>
#include <cmath>

#ifndef CFG_BATCH
#define CFG_BATCH 4
#define CFG_SEQ 4096
#define CFG_CTX 256
#define CFG_DEPTH 4
#define CFG_NEXP 32
#endif
#ifndef PROBE_DOUBLE
#define PROBE_DOUBLE 0
#endif
#ifndef N_LAUNCH_MODE
#define N_LAUNCH_MODE 1
#endif

namespace mk {
constexpr int BATCH = CFG_BATCH, SEQ = CFG_SEQ, CTX = CFG_CTX, DEPTH = CFG_DEPTH, NEXP = CFG_NEXP;
constexpr int D = 1024, ML = BATCH * SEQ, MC = BATCH * CTX, M = ML + MC, NR = BATCH + 1;
constexpr int IN_COLS = 3280, NU = 3328;
constexpr int TOPK = 4, DFF = 1024;
constexpr int MAXROWS = M * TOPK + NEXP * 256;
constexpr int NTHREADS = 512, NWAVES = 8;
constexpr int U_GQ = 0, U_GK = 128, U_GV = 256, U_GOG = 512, U_GLF = 768, U_GLB = 784;
constexpr int U_RW = 800, U_RR = 800, U_RK = 1056, U_RV = 1312, U_RLWF = 1568, U_RLWB = 1600, U_RLA = 1632, U_RLGT = 1664;
constexpr int U_SZ = 1728, U_SXBC = 2240, U_SDT = 3264;
static_assert(SEQ % 256 == 0 && CTX % 256 == 0 && M % 256 == 0, "row tiles");

constexpr size_t al256(size_t x) { return (x + 255) & ~(size_t)255; }
constexpr size_t WS_CTL = 0, CTL_BYTES = 1u << 20;
constexpr size_t WS_MODS = WS_CTL + CTL_BYTES;
constexpr size_t WS_X = WS_MODS + al256((size_t)DEPTH * NR * 6144 * 4);
constexpr size_t WS_H = WS_X + al256((size_t)M * D * 4);
constexpr size_t WS_U = WS_H + al256((size_t)M * D * 2);
constexpr size_t WS_GG = WS_U + al256((size_t)M * NU * 4);
constexpr size_t WS_RW7 = WS_GG + al256((size_t)2 * M * 128 * 4);
constexpr size_t WS_SXBC = WS_RW7 + al256((size_t)7 * M * 256 * 4);
constexpr size_t WS_SDT = WS_SXBC + al256((size_t)M * 1024 * 4);
constexpr size_t WS_OG = WS_SDT + al256((size_t)M * 16 * 4);
constexpr size_t WS_OR = WS_OG + al256((size_t)2 * M * 256 * 4);
constexpr size_t WS_OS = WS_OR + al256((size_t)2 * M * 256 * 4);
constexpr size_t WS_MIX = WS_OS + al256((size_t)2 * M * 512 * 4);
constexpr size_t WS_TOPI = WS_MIX + al256((size_t)M * D * 2);
constexpr size_t WS_TOPP = WS_TOPI + al256((size_t)M * 4 * 4);
constexpr size_t WS_POS = WS_TOPP + al256((size_t)M * 4 * 4);
constexpr size_t WS_ROWIDX = WS_POS + al256((size_t)M * 4 * 4);
constexpr size_t WS_ROWGATE = WS_ROWIDX + al256((size_t)MAXROWS * 4);
constexpr size_t WS_ACT = WS_ROWGATE + al256((size_t)MAXROWS * 4);
constexpr size_t WS_Y = WS_ACT + al256((size_t)MAXROWS * DFF * 2);
constexpr size_t WS_WIN = WS_Y + al256((size_t)MAXROWS * D * 2);
constexpr size_t WS_WOUT = WS_WIN + al256((size_t)DEPTH * NU * D * 2);
constexpr size_t WS_WGU = WS_WOUT + al256((size_t)DEPTH * D * D * 2);
constexpr size_t WS_WD = WS_WGU + al256((size_t)DEPTH * NEXP * 2048 * D * 2);
constexpr int CTXC = CTX / 64, LATC = SEQ / 64, NRC = CTXC + LATC;
constexpr size_t WS_SZ = WS_WD + al256((size_t)DEPTH * NEXP * D * DFF * 2);
constexpr size_t WS_SDEC = WS_SZ + al256((size_t)BATCH * 16 * NRC * 64 * 128 * 4);
constexpr size_t WS_SST = WS_SDEC + al256((size_t)BATCH * 16 * NRC * 4);
constexpr int RKT = 16, NCK = (CTX + SEQ) / RKT;
constexpr int RK_PA = 0, RK_RA = 8192, RK_QA = 10240, RK_VB = 11264, RK_ZC = 15360, RK_BYTES = 31744;
constexpr size_t WS_RK = WS_SST + al256((size_t)BATCH * 16 * NRC * 64 * 128 * 2);
constexpr int GC_CTX = CTX / 32, GC_LAT = SEQ / 32, GNC = GC_CTX + GC_LAT;
constexpr size_t WS_GZ = WS_RK + al256((size_t)BATCH * 8 * NCK * RK_BYTES);
constexpr size_t WS_GDEC = WS_GZ + al256((size_t)BATCH * 8 * GNC * 2048 * 4);
constexpr size_t WS_GST = WS_GDEC + al256((size_t)BATCH * 8 * GNC * 32 * 4);
constexpr size_t WS_END = WS_GST + al256((size_t)BATCH * 8 * GNC * 2048 * 2);
constexpr int CW_BAR = 4096;
constexpr int CW_CNT = 16384;
constexpr int CW_CUR = 16384 + 64 * 8;
constexpr int LDS_STAGE = 131072;
constexpr int LDS_TILE_E = LDS_STAGE;
constexpr int LDS_MISC = LDS_STAGE + 2048;
constexpr int LDS_BYTES = 147456;

#ifdef EMU
#define LAS
#define ASM_VM0() ((void)0)
#define ASM_LGKM0() ((void)0)
#define ASM_MEMFENCE() ((void)0)
#define WAIT_V(n) ((void)0)
#define WAIT_L(n) ((void)0)
#define WAVE_LDS_FENCE() emu_wave_sync()
#define LAUNDER_V(x) ((void)0)
#else
#define LAS __attribute__((address_space(3)))
#define ASM_VM0() asm volatile("s_waitcnt vmcnt(0)" ::: "memory")
#define ASM_LGKM0() asm volatile("s_waitcnt lgkmcnt(0)" ::: "memory")
#define ASM_MEMFENCE() asm volatile("" ::: "memory")
#define WAIT_V(n) asm volatile("s_waitcnt vmcnt(" #n ")" ::: "memory")
#define WAIT_L(n) asm volatile("s_waitcnt lgkmcnt(" #n ")" ::: "memory")
#define LAUNDER_V(x) asm volatile("" : "+v"(x))
#define WAVE_LDS_FENCE() do { asm volatile("s_waitcnt lgkmcnt(0)" ::: "memory"); } while (0)
#endif

typedef unsigned short bf16_t;
typedef short bf16x8 __attribute__((ext_vector_type(8)));
typedef float f32x4 __attribute__((ext_vector_type(4)));
typedef float f32x2 __attribute__((ext_vector_type(2)));
typedef unsigned u32x4 __attribute__((ext_vector_type(4)));
typedef unsigned u32x2 __attribute__((ext_vector_type(2)));

__device__ __forceinline__ unsigned f2bf(float f) { unsigned u = __float_as_uint(f); return (u + 0x7fffu + ((u >> 16) & 1u)) >> 16; }
__device__ __forceinline__ unsigned pk2(float lo, float hi) { return f2bf(lo) | (f2bf(hi) << 16); }
__device__ __forceinline__ float bf_lo(unsigned w) { return __uint_as_float(w << 16); }
__device__ __forceinline__ float bf_hi(unsigned w) { return __uint_as_float(w & 0xffff0000u); }
__device__ __forceinline__ float wave_sum(float v) {
#pragma unroll
    for (int o = 1; o < 64; o <<= 1) v += __shfl_xor(v, o);
    return v;
}
__device__ __forceinline__ float sum8(float v) { v += __shfl_xor(v, 1); v += __shfl_xor(v, 2); v += __shfl_xor(v, 4); return v; }
__device__ __forceinline__ float sigmoidf_(float x) { return 1.0f / (1.0f + expf(-x)); }
__device__ __forceinline__ float siluf_(float x) { return x / (1.0f + expf(-x)); }
__device__ __forceinline__ float softplusf_(float x) { return fmaxf(x, 0.f) + log1pf(expf(-fabsf(x))); }
__device__ __forceinline__ float logsigmoidf_(float x) { return -softplusf_(-x); }

#define XB_TMO      128
#define XB_XCNT(j)  (256  + 64 * (j))
#define XB_XSUB(j)  (1280 + 64 * (j))
#define XB_XGEN(j)  (2304 + 64 * (j))
#define XB_TOP      3328
#define XB_TOPGEN   3392
#define XCD_BAR_WORDS 3456
#ifdef EMU
#define XB_SPIN_CAP (0xffffffffu)
#else
#define XB_SPIN_CAP (1u << 22)
#endif
__device__ __forceinline__ unsigned xb_ld(unsigned* p)              { return __hip_atomic_load(p, __ATOMIC_RELAXED, __HIP_MEMORY_SCOPE_AGENT); }
__device__ __forceinline__ unsigned xb_add(unsigned* p, unsigned v) { return __hip_atomic_fetch_add(p, v, __ATOMIC_RELAXED, __HIP_MEMORY_SCOPE_AGENT); }
__device__ __forceinline__ unsigned xb_xcc_id() { return (unsigned)__builtin_amdgcn_s_getreg((3 << 11) | 20) & 0xFu; }
#define XB_SPIN(cond, bar) do { unsigned _sp = 0; while (cond) { __builtin_amdgcn_s_sleep(1); \
    if ((++_sp & 255u) == 0u) { if (xb_ld(&(bar)[XB_TMO])) break; if (_sp > XB_SPIN_CAP) { atomicAdd(&(bar)[XB_TMO], 1u); break; } } } } while (0)
struct XcdBarrier { unsigned* bar; unsigned x; volatile LAS unsigned* st; };
__device__ __forceinline__ XcdBarrier xcd_barrier_post(unsigned* bar, volatile LAS unsigned* st) {
    XcdBarrier b; b.bar = bar; b.x = xb_xcc_id(); b.st = st;
    if (threadIdx.x == 0) (void)xb_add(&bar[XB_XCNT(b.x)], 1u);
    return b;
}
__device__ __forceinline__ void xcd_barrier_complete(unsigned* bar, unsigned x, unsigned& nloc, unsigned& nx) {
    const unsigned G = gridDim.x * gridDim.y * gridDim.z;
    unsigned sum, cnt, mine, sp = 0u;
    for (;;) {
        sum = 0u; cnt = 0u; mine = 0u;
#pragma unroll
        for (unsigned j = 0; j < 16; ++j) { const unsigned c = xb_ld(&bar[XB_XCNT(j)]); sum += c; cnt += (c > 0u) ? 1u : 0u; mine = (j == x) ? c : mine; }
        if (sum == G) break;
        __builtin_amdgcn_s_sleep(1);
        if ((++sp & 255u) == 0u) { if (xb_ld(&bar[XB_TMO])) break; if (sp > XB_SPIN_CAP) { atomicAdd(&bar[XB_TMO], 1u); break; } }
    }
    nloc = mine > 0u ? mine : 1u; nx = cnt > 0u ? cnt : 1u;
}
__device__ __forceinline__ void xcd_barrier(const XcdBarrier& b) {
    ASM_VM0();
    __syncthreads();
    if (threadIdx.x == 0) {
        unsigned* bar = b.bar;
        __builtin_amdgcn_s_waitcnt(0);
        unsigned nloc = b.st[0], nx = b.st[1];
        if (nloc == 0u) { xcd_barrier_complete(bar, b.x, nloc, nx); b.st[0] = nloc; b.st[1] = nx; }
        const unsigned old = xb_add(&bar[XB_XSUB(b.x)], 1u);
        const unsigned gen = old / nloc;
        if (old + 1u == (gen + 1u) * nloc) {
            __builtin_amdgcn_fence(__ATOMIC_RELEASE, "agent");
            ASM_VM0();
            const unsigned og = xb_add(&bar[XB_TOP], 1u);
            const unsigned tg = og / nx;
            if (og + 1u == (tg + 1u) * nx) xb_add(&bar[XB_TOPGEN], 1u);
            else XB_SPIN(xb_ld(&bar[XB_TOPGEN]) == tg, bar);
            __builtin_amdgcn_fence(__ATOMIC_ACQUIRE, "agent");
            xb_add(&bar[XB_XGEN(b.x)], 1u);
            ASM_VM0();
        } else {
            XB_SPIN(xb_ld(&bar[XB_XGEN(b.x)]) == gen, bar);
            __builtin_amdgcn_fence(__ATOMIC_ACQUIRE, "agent");
            ASM_VM0();
        }
    }
    __syncthreads();
}

namespace pg8 {
constexpr int BM = 256, BK = 64, HALF = 128, HTB = HALF * BK * 2, STAGE_BYTES = 8 * HTB, NXCD = 8, WGM = 8;
__host__ __device__ __forceinline__ int lds_byte(int r, int c) { const int st = (r >> 4) * 2 + (c >> 5), rr = r & 15, cc = c & 31, ob = rr * 64 + cc * 2; return st * 1024 + (ob ^ (((ob >> 9) & 1) << 5)); }
__host__ __device__ __forceinline__ void stage_rc(int b, int& R, int& C) { const int st = b / 1024, sb = b % 1024, swz = sb ^ (((sb >> 9) & 1) << 5); R = (st >> 1) * 16 + swz / 64; C = (st & 1) * 32 + (swz % 64) / 2; }
__host__ __device__ __forceinline__ int perm32(int rho) { const int n = rho >> 4, i = rho & 15; return 8 * (i >> 2) + 4 * n + (i & 3); }
struct Unit { int pm, pn, pb; };
struct Gemm { const bf16_t* A; const bf16_t* Bt; int K; const int* rowidx; };
struct Order {
    int nM, nN, nwg, G, c;
    __device__ __forceinline__ void init(int nM_, int nN_, int G_, int c_) { nM = nM_; nN = nN_; nwg = nM * nN; G = G_; c = c_; }
    __device__ __forceinline__ bool tile(int i, int& pm, int& pn) const {
        const long L = (long)i * G + c; if (L >= nwg) return false;
        int wgid = (int)L; { const int q = nwg / NXCD, r = nwg % NXCD, xcd = wgid % NXCD, off = wgid / NXCD; wgid = (xcd < r ? xcd * (q + 1) : r * (q + 1) + (xcd - r) * q) + off; }
        const int nig = WGM * nN, gid = wgid / nig, fm = gid * WGM, gsz = (nM - fm) < WGM ? (nM - fm) : WGM;
        pm = fm + ((wgid % nig) % gsz); pn = (wgid % nig) / gsz; return true;
    }
};
struct DenseSched { Order o; __device__ __forceinline__ bool next(int i, Unit& u) const { if (!o.tile(i, u.pm, u.pn)) return false; u.pb = u.pn; return true; } };
struct MoeSched { Order o; const LAS int* tile_e; int nct;
    __device__ __forceinline__ bool next(int i, Unit& u) const { if (!o.tile(i, u.pm, u.pn)) return false; u.pb = tile_e[u.pm] * nct + u.pn; return true; } };

__device__ __forceinline__ unsigned cvt_pk_bf16(float lo, float hi) {
#ifdef EMU
    return pk2(lo, hi);
#else
    unsigned r; asm volatile("v_cvt_pk_bf16_f32 %0, %1, %2" : "=v"(r) : "v"(lo), "v"(hi)); return r;
#endif
}
struct EpiF32 {
    static constexpr bool PERM = false;
    float* C; int ldc;
    __device__ __forceinline__ void operator()(const f32x4 (&acc)[2][2][4][2], const Unit& u, int wr, int wc, int fr, int fq) const {
        const int row0 = u.pm * BM + wr * 64 + fr, col0 = u.pn * BM + wc * 32 + 4 * fq;
#pragma unroll
        for (int ai = 0; ai < 2; ++ai)
#pragma unroll
            for (int m = 0; m < 4; ++m) { float* rowp = C + (size_t)(row0 + ai * HALF + m * 16) * ldc + col0;
#pragma unroll
                for (int bj = 0; bj < 2; ++bj)
#pragma unroll
                    for (int n = 0; n < 2; ++n) *(f32x4*)(rowp + bj * HALF + n * 16) = acc[ai][bj][m][n]; }
    }
};
struct EpiResid {
    static constexpr bool PERM = false;
    float* X; const float* mods;
    __device__ __forceinline__ void operator()(const f32x4 (&acc)[2][2][4][2], const Unit& u, int wr, int wc, int fr, int fq) const {
        const int row0 = u.pm * BM + wr * 64 + fr, col0 = u.pn * BM + wc * 32 + 4 * fq;
        const int rbase = u.pm * BM; const int mrow = rbase < ML ? rbase / SEQ : BATCH;
        const float* g = mods + (size_t)mrow * 6144 + 2 * 1024 + col0;
        f32x4 gv[2][2];
#pragma unroll
        for (int bj = 0; bj < 2; ++bj)
#pragma unroll
            for (int n = 0; n < 2; ++n) gv[bj][n] = *(const f32x4*)(g + bj * HALF + n * 16);
#pragma unroll
        for (int ai = 0; ai < 2; ++ai)
#pragma unroll
            for (int m = 0; m < 4; ++m) { float* rowp = X + (size_t)(row0 + ai * HALF + m * 16) * D + col0;
#pragma unroll
                for (int bj = 0; bj < 2; ++bj)
#pragma unroll
                    for (int n = 0; n < 2; ++n) { f32x4* p = (f32x4*)(rowp + bj * HALF + n * 16); *p = *p + gv[bj][n] * acc[ai][bj][m][n]; } }
    }
};
struct EpiSwiglu {
    static constexpr bool PERM = true;
    bf16_t* ACT; const float* bgu;
    __device__ __forceinline__ void operator()(const f32x4 (&acc)[2][2][4][2], const Unit& u, int wr, int wc, int fr, int fq) const {
        const int e = u.pb >> 3;
        const int row0 = u.pm * BM + wr * 64 + fr, j0 = u.pn * 128 + wc * 32 + 8 * fq;
        const float* bg = bgu + (size_t)e * 2048 + j0;
        f32x4 bgl[2], bln[2];
#pragma unroll
        for (int n = 0; n < 2; ++n) { bgl[n] = *(const f32x4*)(bg + 4 * n); bln[n] = *(const f32x4*)(bg + 1024 + 4 * n); }
#pragma unroll
        for (int ai = 0; ai < 2; ++ai)
#pragma unroll
            for (int m = 0; m < 4; ++m) { bf16_t* rowp = ACT + (size_t)(row0 + ai * HALF + m * 16) * DFF + j0;
                float o[8];
#pragma unroll
                for (int n = 0; n < 2; ++n)
#pragma unroll
                    for (int j = 0; j < 4; ++j) { float gl = acc[ai][0][m][n][j] + bgl[n][j], ln = acc[ai][1][m][n][j] + bln[n][j];
                        gl = fminf(gl, 7.0f); ln = fminf(fmaxf(ln, -7.0f), 7.0f);
                        o[n * 4 + j] = gl / (1.0f + __expf(-1.702f * gl)) * (ln + 1.0f); }
                u32x4 w; w.x = cvt_pk_bf16(o[0], o[1]); w.y = cvt_pk_bf16(o[2], o[3]); w.z = cvt_pk_bf16(o[4], o[5]); w.w = cvt_pk_bf16(o[6], o[7]);
                *(u32x4*)rowp = w; }
    }
};
struct EpiDown {
    static constexpr bool PERM = true;
    bf16_t* Y; const float* bd; const float* rowgate;
    __device__ __forceinline__ void operator()(const f32x4 (&acc)[2][2][4][2], const Unit& u, int wr, int wc, int fr, int fq) const {
        const int e = u.pb >> 2;
        const int row0 = u.pm * BM + wr * 64 + fr, col0 = u.pn * BM + wc * 32 + 8 * fq;
        const float* b = bd + (size_t)e * 1024 + col0;
        f32x4 bv[2][2];
#pragma unroll
        for (int bj = 0; bj < 2; ++bj)
#pragma unroll
            for (int n = 0; n < 2; ++n) bv[bj][n] = *(const f32x4*)(b + bj * HALF + 4 * n);
#pragma unroll
        for (int ai = 0; ai < 2; ++ai)
#pragma unroll
            for (int m = 0; m < 4; ++m) { const int row = row0 + ai * HALF + m * 16; const float gt = rowgate[row]; bf16_t* rowp = Y + (size_t)row * D + col0;
#pragma unroll
                for (int bj = 0; bj < 2; ++bj) { const f32x4 v0 = (acc[ai][bj][m][0] + bv[bj][0]) * gt, v1 = (acc[ai][bj][m][1] + bv[bj][1]) * gt;
                    u32x4 w; w.x = cvt_pk_bf16(v0[0], v0[1]); w.y = cvt_pk_bf16(v0[2], v0[3]); w.z = cvt_pk_bf16(v1[0], v1[1]); w.w = cvt_pk_bf16(v1[2], v1[3]);
                    *(u32x4*)(rowp + bj * HALF) = w; } }
    }
};

template <class Epi, class Sched, bool GATHER>
__device__ __forceinline__ void gemm_phase(LAS unsigned char* lds, const int tid, const Gemm g, const Sched& S, const Epi& E) {
    const int wid = __builtin_amdgcn_readfirstlane(tid >> 6), lane = tid & 63, wr = wid >> 2, wc = wid & 3, fr = lane & 15, fq = lane >> 4;
    const int K = g.K, nt = K / BK;
    unsigned voffB[2]; int RA[2], CA[2];
#pragma unroll
    for (int i = 0; i < 2; ++i) { int R, C; stage_rc(tid * 16 + i * 8192, R, C); const int Rb = Epi::PERM ? ((R & ~31) + perm32(R & 31)) : R;
        RA[i] = R; CA[i] = C; voffB[i] = (unsigned)(Rb * K + C) * 2u; }
    const size_t kstep = (size_t)(BK * 2);
    const size_t hstep = (size_t)HALF * K * 2;
    const size_t tstep = 2 * hstep;
    const unsigned ldsw = (unsigned)wid * 1024u;
    const int aoff = lds_byte(wr * 64 + fr, fq * 8), boff = lds_byte(wc * 32 + fr, fq * 8);
#define PG8_SA(b, h) (((b) * 2 + (h)) * HTB)
#define PG8_SB(b, h) ((4 + (b) * 2 + (h)) * HTB)
#define PG8_STAGE(bufoff, gbase, voff) do { _Pragma("unroll") for (int _i = 0; _i < 2; ++_i) \
        __builtin_amdgcn_global_load_lds((const unsigned*)((const char*)(gbase) + (voff)[_i]), (LAS unsigned*)(lds + (bufoff) + ldsw + _i * 8192), 16, 0, 0); } while (0)
#define PG8_LDA(dst, b, h) do { _Pragma("unroll") for (int m = 0; m < 4; ++m) _Pragma("unroll") for (int k = 0; k < 2; ++k) dst[m][k] = *(const LAS bf16x8*)(lds + PG8_SA(b, h) + aoff + m * 2048 + k * 1024); } while (0)
#define PG8_LDB(dst, b, h) do { _Pragma("unroll") for (int n = 0; n < 2; ++n) _Pragma("unroll") for (int k = 0; k < 2; ++k) dst[n][k] = *(const LAS bf16x8*)(lds + PG8_SB(b, h) + boff + n * 2048 + k * 1024); } while (0)
#define PG8_MMA(ai, bj, At, Bt) do { __builtin_amdgcn_s_setprio(1); _Pragma("unroll") for (int m = 0; m < 4; ++m) _Pragma("unroll") for (int n = 0; n < 2; ++n) _Pragma("unroll") for (int k = 0; k < 2; ++k) \
        acc[ai][bj][m][n] = __builtin_amdgcn_mfma_f32_16x16x32_bf16(Bt[n][k], At[m][k], acc[ai][bj][m][n], 0, 0, 0); __builtin_amdgcn_s_setprio(0); } while (0)
#define PG8_BAR __builtin_amdgcn_s_barrier()
#define PG8_SCHED __builtin_amdgcn_sched_barrier(0)
#define PG8_AOFF(dst, unit) do { _Pragma("unroll") for (int _h = 0; _h < 2; ++_h) _Pragma("unroll") for (int _i = 0; _i < 2; ++_i) { \
        const int _r = (unit).pm * BM + _h * HALF + RA[_i]; const int _src = GATHER ? g.rowidx[_r] : _r; dst[_h][_i] = (unsigned)(_src * K + CA[_i]) * 2u; } } while (0)
    Unit cur, nxt; int ui = 0;
    if (!S.next(0, cur)) return;
    f32x4 acc[2][2][4][2];
#pragma unroll
    for (int a = 0; a < 2; ++a)
#pragma unroll
        for (int b = 0; b < 2; ++b)
#pragma unroll
            for (int m = 0; m < 4; ++m)
#pragma unroll
                for (int n = 0; n < 2; ++n) acc[a][b][m][n] = (f32x4){0.f, 0.f, 0.f, 0.f};
    bf16x8 At[4][2], B0[2][2], B1[2][2];
    unsigned cvA[2][2], nvA[2][2];
    PG8_AOFF(cvA, cur);
    const char* const gA = (const char*)g.A;
    const char* cB = (const char*)g.Bt + (size_t)cur.pb * tstep;
    PG8_STAGE(PG8_SB(0, 0), cB, voffB); PG8_STAGE(PG8_SA(0, 0), gA, cvA[0]); PG8_STAGE(PG8_SB(0, 1), cB + hstep, voffB); PG8_STAGE(PG8_SA(0, 1), gA, cvA[1]);
    if (wr == 1) PG8_BAR;
    WAIT_V(4); PG8_BAR;
    PG8_STAGE(PG8_SB(1, 0), cB + kstep, voffB); PG8_STAGE(PG8_SA(1, 0), gA + kstep, cvA[0]); PG8_STAGE(PG8_SB(1, 1), cB + hstep + kstep, voffB);
    WAIT_V(6); PG8_BAR;
    for (;;) {
        const bool has_next = S.next(ui + 1, nxt);
        if (has_next) { PG8_AOFF(nvA, nxt); } else {
#pragma unroll
            for (int h = 0; h < 2; ++h)
#pragma unroll
                for (int i = 0; i < 2; ++i) nvA[h][i] = cvA[h][i]; }
        const char* nB = has_next ? (const char*)g.Bt + (size_t)nxt.pb * tstep : cB;
        for (int t = 0; t < nt; t += 2) {
            const bool last = (t == nt - 2);
            const char* a1 = gA + (size_t)(t + 1) * kstep;
            const char* a2 = last ? gA : gA + (size_t)(t + 2) * kstep; const char* b2 = last ? nB : cB + (size_t)(t + 2) * kstep;
            const char* a3 = a2 + kstep; const char* b3 = b2 + kstep;
            unsigned xA0[2], xA1[2];
#pragma unroll
            for (int i = 0; i < 2; ++i) { xA0[i] = last ? nvA[0][i] : cvA[0][i]; xA1[i] = last ? nvA[1][i] : cvA[1][i]; }
            PG8_LDB(B0, 0, 0); PG8_SCHED; PG8_LDA(At, 0, 0); PG8_STAGE(PG8_SA(1, 1), a1, cvA[1]);
            WAIT_L(8); PG8_BAR; WAIT_L(0); PG8_MMA(0, 0, At, B0); PG8_BAR; PG8_SCHED;
            PG8_LDB(B1, 0, 1); PG8_STAGE(PG8_SB(0, 0), b2, voffB);
            PG8_BAR; WAIT_L(0); PG8_MMA(0, 1, At, B1); PG8_BAR;
            PG8_LDA(At, 0, 1); PG8_STAGE(PG8_SA(0, 0), a2, xA0);
            PG8_BAR; WAIT_L(0); PG8_MMA(1, 0, At, B0); PG8_BAR; PG8_SCHED;
            PG8_STAGE(PG8_SB(0, 1), b2 + hstep, voffB);
            WAIT_V(6); PG8_BAR; PG8_MMA(1, 1, At, B1); PG8_BAR;
            PG8_LDB(B0, 1, 0); PG8_SCHED; PG8_LDA(At, 1, 0); PG8_STAGE(PG8_SA(0, 1), a2, xA1);
            WAIT_L(8); PG8_BAR; WAIT_L(0); PG8_MMA(0, 0, At, B0); PG8_BAR; PG8_SCHED;
            PG8_LDB(B1, 1, 1); PG8_STAGE(PG8_SB(1, 0), b3, voffB);
            PG8_BAR; WAIT_L(0); PG8_MMA(0, 1, At, B1); PG8_BAR;
            PG8_LDA(At, 1, 1); PG8_STAGE(PG8_SA(1, 0), a3, xA0);
            PG8_BAR; WAIT_L(0); PG8_MMA(1, 0, At, B0); PG8_BAR; PG8_SCHED;
            PG8_STAGE(PG8_SB(1, 1), b3 + hstep, voffB);
            WAIT_V(6); PG8_BAR; PG8_MMA(1, 1, At, B1); PG8_BAR;
        }
        E(acc, cur, wr, wc, fr, fq);
        if (!has_next) break;
#pragma unroll
        for (int a = 0; a < 2; ++a)
#pragma unroll
            for (int b = 0; b < 2; ++b)
#pragma unroll
                for (int m = 0; m < 4; ++m)
#pragma unroll
                    for (int n = 0; n < 2; ++n) acc[a][b][m][n] = (f32x4){0.f, 0.f, 0.f, 0.f};
        cur = nxt; cB = nB; ++ui;
#pragma unroll
        for (int h = 0; h < 2; ++h)
#pragma unroll
            for (int i = 0; i < 2; ++i) cvA[h][i] = nvA[h][i];
    }
    WAIT_V(0);
    if (wr == 0) PG8_BAR;
    PG8_BAR;
#undef PG8_SA
#undef PG8_SB
#undef PG8_STAGE
#undef PG8_LDA
#undef PG8_LDB
#undef PG8_MMA
#undef PG8_BAR
#undef PG8_SCHED
#undef PG8_AOFF
}
}

struct Args { const float* in[37]; float* out; unsigned char* ws; int ph_lo, ph_hi; };
enum { I_X = 0, I_C, I_CTX, I_CCTX, I_WADA, I_BADA, I_N1G, I_N2G, I_WIN, I_GGW, I_GGB, I_GNG, I_RMU, I_RW0, I_RW2, I_RA0, I_RA2, I_RG2, I_RKK, I_RKA, I_RRK,
       I_RLG, I_RLB, I_SCW, I_SCB, I_SDTB, I_SALOG, I_SD, I_SNG, I_WOUT, I_ROUTW, I_ROUTB, I_WGU, I_BGU, I_WDN, I_BDN, I_FNG };

struct Tc { LAS unsigned char* lds; int tid, lane, wave, G, bid; };

__device__ __forceinline__ void transpose_item(const float* W, int ldw, int k0, int n0, int nv, bf16_t* dst, int K, LAS float* scr, int lane) {
#pragma unroll 8
    for (int i = 0; i < 32; ++i) { const int kk = 2 * i + (lane >> 5), c = lane & 31; scr[kk * 33 + c] = (c < nv) ? W[(size_t)(k0 + kk) * ldw + n0 + c] : 0.f; }
    WAVE_LDS_FENCE();
    const int c = lane & 7;
#pragma unroll
    for (int j = 0; j < 4; ++j) { const int n = (lane >> 3) + 8 * j; const LAS float* s = scr + (8 * c) * 33 + n;
        u32x4 o; o.x = pk2(s[0 * 33], s[1 * 33]); o.y = pk2(s[2 * 33], s[3 * 33]); o.z = pk2(s[4 * 33], s[5 * 33]); o.w = pk2(s[6 * 33], s[7 * 33]);
        *(u32x4*)(dst + (size_t)n * K + k0 + 8 * c) = o; }
    WAVE_LDS_FENCE();
}
__device__ __forceinline__ void phase_pro0(const Args& a, const Tc& t) {
    LAS float* scr = (LAS float*)(t.lds + t.wave * 16384);
    const int gw = t.bid * NWAVES + t.wave, NGW = t.G * NWAVES;
    constexpr int KB = D / 64;
    constexpr int I_IN = KB * (NU / 32), I_OUT = KB * (D / 32), I_GU = KB * (2048 / 32), I_DN = KB * (D / 32);
    constexpr int IPL = I_IN + I_OUT + NEXP * (I_GU + I_DN);
    bf16_t* WIN = (bf16_t*)(a.ws + WS_WIN); bf16_t* WOUT = (bf16_t*)(a.ws + WS_WOUT); bf16_t* WGU = (bf16_t*)(a.ws + WS_WGU); bf16_t* WDN = (bf16_t*)(a.ws + WS_WD);
    for (int it = gw; it < DEPTH * IPL; it += NGW) {
        const int l = it / IPL; int r = it % IPL;
        if (r < I_IN) { const int kb = r / (NU / 32), nb = r % (NU / 32), n0 = nb * 32; int nv = IN_COLS - n0; nv = nv < 0 ? 0 : (nv > 32 ? 32 : nv);
            transpose_item(a.in[I_WIN] + (size_t)l * D * IN_COLS, IN_COLS, kb * 64, n0, nv, WIN + ((size_t)l * NU + n0) * D, D, scr, t.lane); continue; }
        r -= I_IN;
        if (r < I_OUT) { const int kb = r / (D / 32), nb = r % (D / 32);
            transpose_item(a.in[I_WOUT] + (size_t)l * D * D, D, kb * 64, nb * 32, 32, WOUT + ((size_t)l * D + nb * 32) * D, D, scr, t.lane); continue; }
        r -= I_OUT;
        const int e = r / (I_GU + I_DN); r = r % (I_GU + I_DN);
        if (r < I_GU) { const int kb = r / 64, nb = r % 64, n0 = nb * 32; const int half = n0 >> 10, rem = n0 & 1023, pn = rem >> 7, jj = rem & 127;
            transpose_item(a.in[I_WGU] + ((size_t)l * NEXP + e) * D * 2048, 2048, kb * 64, n0, 32, WGU + (((size_t)l * NEXP + e) * 2048 + pn * 256 + half * 128 + jj) * D, D, scr, t.lane); continue; }
        r -= I_GU;
        { const int kb = r / (D / 32), nb = r % (D / 32);
            transpose_item(a.in[I_WDN] + ((size_t)l * NEXP + e) * DFF * D, D, kb * 64, nb * 32, 32, WDN + (((size_t)l * NEXP + e) * D + nb * 32) * DFF, DFF, scr, t.lane); }
    }
    __syncthreads();
    LAS float* sc = (LAS float*)t.lds;
    LAS float* red = (LAS float*)(t.lds + 32768);
    for (int i = t.tid; i < NR * D; i += NTHREADS) { const int r = i / D, k = i % D; const float v = r < BATCH ? a.in[I_C][r * D + k] : a.in[I_CCTX][k]; sc[i] = siluf_(v); }
    __syncthreads();
    float* MODS = (float*)(a.ws + WS_MODS);
    const int jl = t.tid & 127, kq = t.tid >> 7;
    for (int cb = t.bid; cb < DEPTH * 48; cb += t.G) {
        const int l = cb / 48, j = (cb % 48) * 128 + jl;
        const float* w = a.in[I_WADA] + (size_t)l * D * 6144 + j;
        float acc[NR];
#pragma unroll
        for (int r = 0; r < NR; ++r) acc[r] = 0.f;
        for (int k = kq * 256; k < kq * 256 + 256; ++k) { const float wv = w[(size_t)k * 6144];
#pragma unroll
            for (int r = 0; r < NR; ++r) acc[r] += sc[r * D + k] * wv; }
#pragma unroll
        for (int r = 0; r < NR; ++r) red[(kq * NR + r) * 128 + jl] = acc[r];
        __syncthreads();
        if (kq == 0) {
            const float bb = a.in[I_BADA][(size_t)l * 6144 + j];
#pragma unroll
            for (int r = 0; r < NR; ++r) MODS[((size_t)l * NR + r) * 6144 + j] = red[(0 * NR + r) * 128 + jl] + red[(1 * NR + r) * 128 + jl] + red[(2 * NR + r) * 128 + jl] + red[(3 * NR + r) * 128 + jl] + bb;
        }
        __syncthreads();
    }
}

__device__ __forceinline__ int mod_row(int row) { return row < ML ? row / SEQ : BATCH; }
__device__ __forceinline__ void norm_mod_store(const f32x4 (&v)[4], const float* g, const float* shift, const float* scale, bf16_t* hrow, int lane, f32x4 (&hout)[4]) {
    float ss = 0.f;
#pragma unroll
    for (int j = 0; j < 4; ++j) ss += (v[j][0] * v[j][0] + v[j][1] * v[j][1]) + (v[j][2] * v[j][2] + v[j][3] * v[j][3]);
    const float rstd = 1.0f / sqrtf(wave_sum(ss) * (1.0f / D) + 1e-6f);
#pragma unroll
    for (int j = 0; j < 4; ++j) { const int c = 4 * lane + 256 * j;
        const f32x4 gg = *(const f32x4*)(g + c), sh = *(const f32x4*)(shift + c), sc = *(const f32x4*)(scale + c);
        const f32x4 h = (v[j] * rstd * gg) * (sc + 1.0f) + sh; hout[j] = h;
        u32x2 w; w.x = pk2(h[0], h[1]); w.y = pk2(h[2], h[3]); *(u32x2*)(hrow + c) = w; }
}
__device__ __forceinline__ void phase_pro1(const Args& a, const Tc& t) {
    const int gw = t.bid * NWAVES + t.wave, NGW = t.G * NWAVES;
    float* X = (float*)(a.ws + WS_X); bf16_t* H = (bf16_t*)(a.ws + WS_H); const float* MODS = (const float*)(a.ws + WS_MODS);
    for (int row = gw; row < M; row += NGW) {
        const float* src = row < ML ? a.in[I_X] + (size_t)row * D : a.in[I_CTX] + (size_t)(row - ML) * D;
        f32x4 v[4], h[4];
#pragma unroll
        for (int j = 0; j < 4; ++j) { v[j] = *(const f32x4*)(src + 4 * t.lane + 256 * j); *(f32x4*)(X + (size_t)row * D + 4 * t.lane + 256 * j) = v[j]; }
        const float* md = MODS + (size_t)mod_row(row) * 6144;
        norm_mod_store(v, a.in[I_N1G], md, md + 1024, H + (size_t)row * D, t.lane, h);
    }
}

__device__ __forceinline__ void seg_bounds(int row, int& lo, int& hi) {
    if (row < ML) { lo = row & ~63; hi = lo + 64; } else { lo = ML + ((row - ML) / CTX) * CTX; hi = lo + CTX; }
}
__device__ __forceinline__ void phase_prep(const Args& a, const Tc& t, int l) {
    const float* U = (const float*)(a.ws + WS_U);
    float* GG = (float*)(a.ws + WS_GG); float* RW7 = (float*)(a.ws + WS_RW7); float* SXBC = (float*)(a.ws + WS_SXBC); float* SDT = (float*)(a.ws + WS_SDT);
    const float* mu = a.in[I_RMU] + (size_t)l * 2 * 928;
    const float* w0 = a.in[I_RW0] + (size_t)l * 2 * 256; const float* w2 = a.in[I_RW2] + (size_t)l * 2 * 32 * 256;
    const float* a0 = a.in[I_RA0] + (size_t)l * 256; const float* a2 = a.in[I_RA2] + (size_t)l * 32 * 256;
    const float* rkk = a.in[I_RKK] + (size_t)l * 256; const float* rka = a.in[I_RKA] + (size_t)l * 256;
    const float* ggw = a.in[I_GGW] + (size_t)l * 2 * 16 * 128; const float* ggb = a.in[I_GGB] + (size_t)l * 2 * 128;
    const float* cw = a.in[I_SCW] + (size_t)l * 4 * 1024; const float* cb = a.in[I_SCB] + (size_t)l * 1024;
    const float* dtb = a.in[I_SDTB] + (size_t)l * 16;
    LAS float* LOW = (LAS float*)t.lds;
    for (int tile = t.bid; tile < M / 16; tile += t.G) {
        const int r0 = tile * 16; int slo, shi; seg_bounds(r0, slo, shi);
        {
            const int tt = t.tid >> 5, r = t.tid & 31, row = r0 + tt;
            const float* up = U + (size_t)row * NU; const bool hp = row - 1 >= slo, hn = row + 1 < shi;
#pragma unroll
            for (int q = 0; q < 3; ++q) { const int col = U_RLWF + q * 32 + r, mi = col - U_RW;
                const float u = up[col], pv = hp ? up[col - NU] : 0.f, nv = hn ? up[col + NU] : 0.f;
                const float s = u + mu[mi] * (pv - u) + mu[928 + mi] * (nv - u);
                LOW[tt * 128 + q * 32 + r] = q < 2 ? tanhf(s) : s; }
            LOW[tt * 128 + 96 + r] = up[U_GLF + r];
        }
        __syncthreads();
        {
            const int c = t.tid & 255, tt0 = (t.tid >> 8) * 8;
            float aa[8], af[8], ab[8];
#pragma unroll
            for (int j = 0; j < 8; ++j) { aa[j] = a0[c]; af[j] = w0[c]; ab[j] = w0[256 + c]; }
            for (int r = 0; r < 32; ++r) { const float wa = a2[r * 256 + c], wf = w2[r * 256 + c], wb = w2[(32 + r) * 256 + c];
#pragma unroll
                for (int j = 0; j < 8; ++j) { const LAS float* lw = LOW + (tt0 + j) * 128; aa[j] += lw[64 + r] * wa; af[j] += lw[r] * wf; ab[j] += lw[32 + r] * wb; } }
            const float m0r = mu[c], m1r = mu[928 + c], m0k = mu[256 + c], m1k = mu[928 + 256 + c], m0v = mu[512 + c], m1v = mu[928 + 512 + c];
            const float kkg = rkk[c], kag = rka[c];
#pragma unroll
            for (int j = 0; j < 8; ++j) { const int row = r0 + tt0 + j; const float* up = U + (size_t)row * NU; const bool hp = row - 1 >= slo, hn = row + 1 < shi;
                float u, pv, nv;
                u = up[U_RR + c]; pv = hp ? up[U_RR + c - NU] : 0.f; nv = hn ? up[U_RR + c + NU] : 0.f; const float rs = u + m0r * (pv - u) + m1r * (nv - u);
                u = up[U_RK + c]; pv = hp ? up[U_RK + c - NU] : 0.f; nv = hn ? up[U_RK + c + NU] : 0.f; const float ks = u + m0k * (pv - u) + m1k * (nv - u);
                u = up[U_RV + c]; pv = hp ? up[U_RV + c - NU] : 0.f; nv = hn ? up[U_RV + c + NU] : 0.f; const float vs = u + m0v * (pv - u) + m1v * (nv - u);
                const float av = sigmoidf_(aa[j]);
                const float wfv = expf(-0.606531f * sigmoidf_(af[j])), wbv = expf(-0.606531f * sigmoidf_(ab[j]));
                const float kr = ks * kkg; const float ssq = wave_sum(kr * kr); const float kk = kr * (1.0f / sqrtf(ssq + 1e-12f));
                const float kf = ks * (1.0f + (av - 1.0f) * kag);
                const size_t o = (size_t)row * 256 + c, P = (size_t)M * 256;
                RW7[o] = rs; RW7[P + o] = kf; RW7[2 * P + o] = vs; RW7[3 * P + o] = kk; RW7[4 * P + o] = kk * av; RW7[5 * P + o] = wfv; RW7[6 * P + o] = wbv; }
        }
        {
            const int j = t.tid & 127, dq = t.tid >> 7, dir = dq & 1, tt0 = (dq >> 1) * 8;
            float acc[8];
#pragma unroll
            for (int q = 0; q < 8; ++q) acc[q] = ggb[dir * 128 + j];
#pragma unroll
            for (int r = 0; r < 16; ++r) { const float w = ggw[(dir * 16 + r) * 128 + j];
#pragma unroll
                for (int q = 0; q < 8; ++q) acc[q] += LOW[(tt0 + q) * 128 + 96 + dir * 16 + r] * w; }
#pragma unroll
            for (int q = 0; q < 8; ++q) GG[((size_t)dir * M + r0 + tt0 + q) * 128 + j] = logsigmoidf_(acc[q]) * (1.0f / 16.0f);
        }
        {
#pragma unroll
            for (int cc = 0; cc < 2; ++cc) { const int col = t.tid + cc * 512; const float* up = U + U_SXBC + col;
                const float c0 = cw[col], c1 = cw[1024 + col], c2 = cw[2048 + col], c3 = cw[3072 + col], bb = cb[col];
                float um2 = (r0 - 2 >= slo) ? up[(size_t)(r0 - 2) * NU] : 0.f, um1 = (r0 - 1 >= slo) ? up[(size_t)(r0 - 1) * NU] : 0.f, u0 = up[(size_t)r0 * NU];
#pragma unroll
                for (int q = 0; q < 16; ++q) { const int row = r0 + q; const float up1 = (row + 1 < shi) ? up[(size_t)(row + 1) * NU] : 0.f;
                    const float y = c0 * um2 + c1 * um1 + c2 * u0 + c3 * up1 + bb;
                    SXBC[(size_t)row * 1024 + col] = siluf_(y); um2 = um1; um1 = u0; u0 = up1; } }
        }
        if (t.tid < 256) { const int tt = t.tid >> 4, j = t.tid & 15, row = r0 + tt; SDT[(size_t)row * 16 + j] = softplusf_(U[(size_t)row * NU + U_SDT + j] + dtb[j]); }
        __syncthreads();
    }
}

__device__ __forceinline__ int chain_row(int b, int dir, int s) {
    if (s < CTX) return ML + b * CTX + (dir ? CTX - 1 - s : s);
    const int tt = s - CTX; return b * SEQ + (dir ? SEQ - 1 - tt : tt);
}

__device__ __forceinline__ f32x4 mma16(f32x4 acc, const LAS bf16_t* A, int lda, const LAS bf16_t* Bt, int ldb, int K, int lane) {
    const int r = lane & 15, kq = (lane >> 4) * 8;
    for (int k0 = 0; k0 < K; k0 += 32) {
        const bf16x8 av = *(const LAS bf16x8*)(A + r * lda + k0 + kq), bv = *(const LAS bf16x8*)(Bt + r * ldb + k0 + kq);
        acc = __builtin_amdgcn_mfma_f32_16x16x32_bf16(av, bv, acc, 0, 0, 0);
    }
    return acc;
}
__device__ __forceinline__ float wave_incl_scan(float v, int lane) {
#pragma unroll
    for (int o = 1; o < 64; o <<= 1) { const float u = __shfl_up(v, o); if (lane >= o) v += u; }
    return v;
}
__device__ __forceinline__ int rc_row0(int b, int c) { return c < CTXC ? ML + b * CTX + 64 * c : b * SEQ + 64 * (c - CTXC); }
__device__ __forceinline__ int rc_chain_pos(int c, int dir) { return dir == 0 ? c : (c < CTXC ? CTXC - 1 - c : CTXC + (LATC - 1 - (c - CTXC))); }

constexpr int SSD_UNITS = BATCH * 2 * NRC;
__device__ __forceinline__ void ssd_a1_unit(const Args& a, const Tc& t, int l, int u) {
    const float* SXBC = (const float*)(a.ws + WS_SXBC); const float* SDT = (const float*)(a.ws + WS_SDT);
    float* SZ = (float*)(a.ws + WS_SZ); float* SDEC = (float*)(a.ws + WS_SDEC);
    const int c = u % NRC, g = (u / NRC) & 1, b = u / (2 * NRC), row0 = rc_row0(b, c);
    LAS bf16_t* BT = (LAS bf16_t*)t.lds;
    LAS bf16_t* XT = BT + 128 * 72 + t.wave * 64 * 72;
    for (int e = t.tid; e < 64 * 32; e += NTHREADS) { const int rho = e >> 5, n4 = (e & 31) * 4;
        const f32x4 v = *(const f32x4*)(SXBC + (size_t)(row0 + rho) * 1024 + 512 + g * 128 + n4);
#pragma unroll
        for (int q = 0; q < 4; ++q) BT[(n4 + q) * 72 + rho] = (bf16_t)f2bf(v[q]); }
    const int hh = t.wave & 3, dir = t.wave >> 2, h = 4 * g + hh, chain = (b * 8 + h) * 2 + dir, cc = rc_chain_pos(c, dir);
    const float a_neg = -expf(a.in[I_SALOG][(size_t)l * 16 + dir * 8 + h]);
    const float dtv = SDT[(size_t)(row0 + t.lane) * 16 + dir * 8 + h], av = dtv * a_neg;
    const float pre = wave_incl_scan(av, t.lane), tot = __shfl(pre, 63);
    const float wgt = dir == 0 ? expf(tot - pre) : expf(pre - av);
    const float sc = dtv * wgt;
#pragma unroll
    for (int p4 = 0; p4 < 16; ++p4) { const f32x4 x = *(const f32x4*)(SXBC + (size_t)(row0 + t.lane) * 1024 + h * 64 + p4 * 4);
#pragma unroll
        for (int q = 0; q < 4; ++q) XT[(p4 * 4 + q) * 72 + t.lane] = (bf16_t)f2bf(x[q] * sc); }
    if (t.lane == 0) SDEC[(size_t)chain * NRC + cc] = expf(tot);
    __syncthreads();
    float* zb = SZ + ((size_t)chain * NRC + cc) * 64 * 128;
#pragma unroll 1
    for (int pt = 0; pt < 4; ++pt)
#pragma unroll 2
        for (int nt = 0; nt < 8; ++nt) { f32x4 acc = {0.f, 0.f, 0.f, 0.f};
            acc = mma16(acc, XT + pt * 16 * 72, 72, BT + nt * 16 * 72, 72, 64, t.lane);
#pragma unroll
            for (int r = 0; r < 4; ++r) zb[(size_t)(16 * pt + 4 * (t.lane >> 4) + r) * 128 + 16 * nt + (t.lane & 15)] = acc[r]; }
    __syncthreads();
}
__device__ __forceinline__ void ssd_b_carry(const Args& a, const Tc& t, int wg, int nwg) {
    const float* SZ = (const float*)(a.ws + WS_SZ); const float* SDEC = (const float*)(a.ws + WS_SDEC); bf16_t* SST = (bf16_t*)(a.ws + WS_SST);
    for (int idx = wg * NTHREADS + t.tid; idx < BATCH * 16 * 2048; idx += nwg * NTHREADS) {
        const int chain = idx >> 11, e4 = (idx & 2047) * 4;
        const float* zc = SZ + (size_t)chain * NRC * 8192 + e4; bf16_t* sc = SST + (size_t)chain * NRC * 8192 + e4; const float* dc = SDEC + (size_t)chain * NRC;
        f32x4 s = {0.f, 0.f, 0.f, 0.f};
        static_assert(NRC % 4 == 0, "carry unroll");
        for (int cc = 0; cc < NRC; cc += 4) {
            f32x4 z[4]; float d[4];
#pragma unroll
            for (int q = 0; q < 4; ++q) { z[q] = *(const f32x4*)(zc + (size_t)(cc + q) * 8192); d[q] = dc[cc + q]; }
#pragma unroll
            for (int q = 0; q < 4; ++q) { u32x2 w; w.x = pk2(s[0], s[1]); w.y = pk2(s[2], s[3]); *(u32x2*)(sc + (size_t)(cc + q) * 8192) = w; s = s * d[q] + z[q]; }
        }
    }
}
__device__ __forceinline__ void ssd_c_unit(const Args& a, const Tc& t, int l, int u) {
    const float* SXBC = (const float*)(a.ws + WS_SXBC); const float* SDT = (const float*)(a.ws + WS_SDT);
    const bf16_t* SST = (const bf16_t*)(a.ws + WS_SST); float* OS = (float*)(a.ws + WS_OS);
    const int c = u % NRC, g = (u / NRC) & 1, b = u / (2 * NRC), row0 = rc_row0(b, c);
    LAS bf16_t* CM = (LAS bf16_t*)t.lds;
    LAS bf16_t* BM = CM + 64 * 136;
    LAS bf16_t* GS = BM + 64 * 136;
    LAS bf16_t* XT = GS + 64 * 72 + t.wave * 64 * 72;
    LAS float* PRE = (LAS float*)(GS + 64 * 72 + 8 * 64 * 72) + t.wave * 128;
    for (int e = t.tid; e < 64 * 32; e += NTHREADS) { const int rho = e >> 5, n4 = (e & 31) * 4;
        const f32x4 bv = *(const f32x4*)(SXBC + (size_t)(row0 + rho) * 1024 + 512 + g * 128 + n4), cv = *(const f32x4*)(SXBC + (size_t)(row0 + rho) * 1024 + 768 + g * 128 + n4);
        u32x2 wb, wc; wb.x = pk2(bv[0], bv[1]); wb.y = pk2(bv[2], bv[3]); wc.x = pk2(cv[0], cv[1]); wc.y = pk2(cv[2], cv[3]);
        *(LAS u32x2*)(BM + rho * 136 + n4) = wb; *(LAS u32x2*)(CM + rho * 136 + n4) = wc; }
    const int hh = t.wave & 3, dir = t.wave >> 2, h = 4 * g + hh, chain = (b * 8 + h) * 2 + dir, cc = rc_chain_pos(c, dir);
    const float a_neg = -expf(a.in[I_SALOG][(size_t)l * 16 + dir * 8 + h]);
    const float dtv = SDT[(size_t)(row0 + t.lane) * 16 + dir * 8 + h], av = dtv * a_neg;
    const float pre = wave_incl_scan(av, t.lane), tot = __shfl(pre, 63);
    PRE[t.lane] = pre; PRE[64 + t.lane] = pre - av;
#pragma unroll
    for (int p4 = 0; p4 < 16; ++p4) { const f32x4 x = *(const f32x4*)(SXBC + (size_t)(row0 + t.lane) * 1024 + h * 64 + p4 * 4);
#pragma unroll
        for (int q = 0; q < 4; ++q) XT[(p4 * 4 + q) * 72 + t.lane] = (bf16_t)f2bf(x[q] * dtv); }
    __syncthreads();
#pragma unroll
    for (int q = 0; q < 2; ++q) { const int ti = t.wave * 2 + q, it = ti >> 2, jt = ti & 3; f32x4 acc = {0.f, 0.f, 0.f, 0.f};
        acc = mma16(acc, CM + it * 16 * 136, 136, BM + jt * 16 * 136, 136, 128, t.lane);
#pragma unroll
        for (int r = 0; r < 4; ++r) GS[(16 * it + 4 * (t.lane >> 4) + r) * 72 + 16 * jt + (t.lane & 15)] = (bf16_t)f2bf(acc[r]); }
    __syncthreads();
    const bf16_t* sb = SST + ((size_t)chain * NRC + cc) * 8192;
    bf16x8 sf[4][4];
#pragma unroll
    for (int pt = 0; pt < 4; ++pt)
#pragma unroll
        for (int ks = 0; ks < 4; ++ks) sf[pt][ks] = *(const bf16x8*)(sb + (size_t)(16 * pt + (t.lane & 15)) * 128 + 32 * ks + 8 * (t.lane >> 4));
#pragma unroll 1
    for (int it = 0; it < 4; ++it) {
        f32x4 acc[4], acc2[4];
#pragma unroll
        for (int pt = 0; pt < 4; ++pt) { acc[pt] = (f32x4){0.f, 0.f, 0.f, 0.f}; acc2[pt] = (f32x4){0.f, 0.f, 0.f, 0.f}; }
        const int rho = 16 * it + (t.lane & 15);
        const float prer = PRE[rho], exr = PRE[64 + rho];
#pragma unroll
        for (int ks = 0; ks < 2; ++ks) {
            const int rp0 = 32 * ks + 8 * (t.lane >> 4);
            const bf16x8 g8 = *(const LAS bf16x8*)(GS + rho * 72 + rp0);
            bf16x8 af;
#pragma unroll
            for (int e = 0; e < 8; ++e) { const int rp = rp0 + e; const float gv = __uint_as_float(((unsigned)(unsigned short)g8[e]) << 16);
                float f;
                if (dir == 0) f = rp <= rho ? expf(prer - PRE[rp]) : 0.f; else f = rp >= rho ? expf(PRE[64 + rp] - exr) : 0.f;
                af[e] = (short)f2bf(gv * f); }
#pragma unroll
            for (int pt = 0; pt < 4; ++pt) { const bf16x8 bfr = *(const LAS bf16x8*)(XT + (16 * pt + (t.lane & 15)) * 72 + rp0); acc[pt] = __builtin_amdgcn_mfma_f32_16x16x32_bf16(af, bfr, acc[pt], 0, 0, 0); }
        }
#pragma unroll
        for (int ks = 0; ks < 4; ++ks) {
            const bf16x8 cf = *(const LAS bf16x8*)(CM + rho * 136 + 32 * ks + 8 * (t.lane >> 4));
#pragma unroll
            for (int pt = 0; pt < 4; ++pt) acc2[pt] = __builtin_amdgcn_mfma_f32_16x16x32_bf16(cf, sf[pt][ks], acc2[pt], 0, 0, 0);
        }
#pragma unroll
        for (int r = 0; r < 4; ++r) { const int ro = 16 * it + 4 * (t.lane >> 4) + r; const float f = dir == 0 ? expf(PRE[ro]) : expf(tot - PRE[64 + ro]);
#pragma unroll
            for (int pt = 0; pt < 4; ++pt) OS[((size_t)dir * M + row0 + ro) * 512 + h * 64 + 16 * pt + (t.lane & 15)] = acc[pt][r] + f * acc2[pt][r]; }
    }
    __syncthreads();
}


constexpr int RW_UNITS = BATCH * 8 * NCK;
__device__ __forceinline__ void rwkv_a_unit(const Args& a, const Tc& t, int u) {
    const float* RW7 = (const float*)(a.ws + WS_RW7);
    const int ck = u % NCK, chain = u / NCK, dir = chain & 1, h = (chain >> 1) & 3, b = chain >> 3;
    unsigned char* rec = a.ws + WS_RK + ((size_t)chain * NCK + ck) * RK_BYTES;
    const size_t P7 = (size_t)M * 256;
    LAS float* RAW = (LAS float*)t.lds;
    LAS float* KhF = RAW + 6 * 1024;
    LAS float* RtF = KhF + 1024;
    LAS float* Uf = RtF + 1024;
    LAS float* Qkf = Uf + 256;
    LAS bf16_t* BtN = (LAS bf16_t*)(Qkf + 256);
    LAS bf16_t* KtN = BtN + 16 * 72; LAS bf16_t* AtN = KtN + 16 * 72; LAS bf16_t* RtN = AtN + 16 * 72;
    LAS bf16_t* AtT = RtN + 16 * 72;
    LAS bf16_t* BhT = AtT + 64 * 40; LAS bf16_t* VT = BhT + 64 * 40; LAS bf16_t* ApS = VT + 64 * 40; LAS bf16_t* KpT = ApS + 64 * 40;
    LAS bf16_t* GT = KpT + 64 * 40;
    LAS bf16_t* NuS = GT + 16 * 40; LAS bf16_t* NpS = NuS + 16 * 40; LAS bf16_t* QbT = NpS + 16 * 40;
#pragma unroll
    for (int q = 0; q < 3; ++q) { const int e = t.tid + NTHREADS * q, vec = e >> 8, rem = e & 255, i = rem >> 4, c4 = rem & 15;
        const int row = chain_row(b, dir, ck * RKT + i); const int vs = vec < 5 ? vec : 5 + dir;
        *(LAS f32x4*)(RAW + vec * 1024 + i * 64 + c4 * 4) = *(const f32x4*)(RW7 + (size_t)vs * P7 + (size_t)row * 256 + h * 64 + c4 * 4); }
    for (int e = t.tid; e < 5 * 64 * 8; e += NTHREADS) { const int arr = e / 512, rem = e % 512, r = rem >> 3, c2 = rem & 7; *(LAS unsigned*)(AtT + arr * 64 * 40 + r * 40 + 16 + 2 * c2) = 0u; }
    if (t.tid < 4 * 16 * 8) { const int arr = t.tid >> 7, rem = t.tid & 127, r = rem >> 3, c2 = rem & 7; *(LAS unsigned*)(GT + arr * 16 * 40 + r * 40 + 16 + 2 * c2) = 0u; }
    __syncthreads();
    if (t.tid < 64) { float wc = 1.f;
#pragma unroll
        for (int i = 0; i < 16; ++i) { wc *= RAW[5 * 1024 + i * 64 + t.tid]; RAW[5 * 1024 + i * 64 + t.tid] = wc; } }
    __syncthreads();
#pragma unroll
    for (int q = 0; q < 2; ++q) { const int e = t.tid + NTHREADS * q, i = e >> 6, j = e & 63;
        const float wc = RAW[5 * 1024 + i * 64 + j], wp = i > 0 ? RAW[5 * 1024 + (i - 1) * 64 + j] : 1.f, wT = RAW[5 * 1024 + 15 * 64 + j], iw = 1.0f / wc;
        const float at = RAW[3 * 1024 + i * 64 + j] * wp, rt = RAW[i * 64 + j] * wc, bt = RAW[4 * 1024 + i * 64 + j] * iw, kt = RAW[1024 + i * 64 + j] * iw;
        AtN[i * 72 + j] = (bf16_t)f2bf(at); RtN[i * 72 + j] = (bf16_t)f2bf(rt); BtN[i * 72 + j] = (bf16_t)f2bf(bt); KtN[i * 72 + j] = (bf16_t)f2bf(kt);
        AtT[j * 40 + i] = (bf16_t)f2bf(at); BhT[j * 40 + i] = (bf16_t)f2bf(bt * wT); VT[j * 40 + i] = (bf16_t)f2bf(RAW[2 * 1024 + i * 64 + j]);
        KhF[i * 64 + j] = kt * wT; RtF[i * 64 + j] = rt; }
    __syncthreads();
    const int hq = t.lane >> 4, lc = t.lane & 15;
    if (t.wave < 4) { f32x4 acc = {0.f, 0.f, 0.f, 0.f};
        acc = mma16(acc, (t.wave == 0 || t.wave == 3) ? BtN : KtN, 72, t.wave < 2 ? AtN : RtN, 72, 64, t.lane);
#pragma unroll
        for (int r = 0; r < 4; ++r) { const int s_ = 4 * hq + r, t_ = lc; const bool keep = t.wave < 2 ? (s_ < t_) : (s_ <= t_); const float v = keep ? acc[r] : 0.f;
            if (t.wave == 0) Uf[s_ * 16 + t_] = v; else if (t.wave == 1) NuS[s_ * 40 + t_] = (bf16_t)f2bf(v); else if (t.wave == 2) Qkf[s_ * 16 + t_] = v; else QbT[t_ * 40 + s_] = (bf16_t)f2bf(v); } }
    __syncthreads();
    if (t.tid < 16) { float g[16];
#pragma unroll
        for (int tt = 0; tt < 16; ++tt) { float acc = (t.tid == tt) ? 1.f : 0.f;
#pragma unroll
            for (int s_ = 0; s_ < 16; ++s_) if (s_ < tt) acc -= g[s_] * Uf[s_ * 16 + tt];
            g[tt] = acc; GT[tt * 40 + t.tid] = (bf16_t)f2bf(acc); } }
    __syncthreads();
    if (t.wave < 5) { f32x4 acc = {0.f, 0.f, 0.f, 0.f};
        if (t.wave < 4) { acc = mma16(acc, AtT + t.wave * 16 * 40, 40, GT, 40, 32, t.lane);
#pragma unroll
            for (int r = 0; r < 4; ++r) ApS[(16 * t.wave + 4 * hq + r) * 40 + lc] = (bf16_t)f2bf(acc[r]); }
        else { acc = mma16(acc, NuS, 40, GT, 40, 32, t.lane);
#pragma unroll
            for (int r = 0; r < 4; ++r) NpS[(4 * hq + r) * 40 + lc] = (bf16_t)f2bf(acc[r]); } }
    __syncthreads();
    for (int ti = t.wave; ti < 25; ti += NWAVES) {
        f32x4 acc = {0.f, 0.f, 0.f, 0.f};
        if (ti < 16) { const int jt = ti >> 2, jt2 = ti & 3;
            acc = mma16(acc, ApS + jt * 16 * 40, 40, BhT + jt2 * 16 * 40, 40, 32, t.lane);
            unsigned short o[4];
#pragma unroll
            for (int r = 0; r < 4; ++r) { const int j = 16 * jt + 4 * hq + r, j2 = 16 * jt2 + lc; const float dg = (j == j2) ? RAW[5 * 1024 + 15 * 64 + j] : 0.f; o[r] = (unsigned short)f2bf(dg - acc[r]); }
            u32x2 w; w.x = o[0] | ((unsigned)o[1] << 16); w.y = o[2] | ((unsigned)o[3] << 16);
            *(u32x2*)(rec + RK_PA + ((size_t)((jt2 * 2 + (jt >> 1)) * 64 + t.lane) * 8 + 4 * (jt & 1)) * 2) = w;
        } else if (ti < 20) { const int jt = ti - 16;
            acc = mma16(acc, ApS + jt * 16 * 40, 40, QbT, 40, 32, t.lane);
            unsigned short o[4];
#pragma unroll
            for (int r = 0; r < 4; ++r) { const int j = 16 * jt + 4 * hq + r; o[r] = (unsigned short)f2bf(RtF[lc * 64 + j] - acc[r]); }
            u32x2 w; w.x = o[0] | ((unsigned)o[1] << 16); w.y = o[2] | ((unsigned)o[3] << 16);
            *(u32x2*)(rec + RK_RA + ((size_t)(((jt >> 1) * 64 + t.lane) * 8 + 4 * (jt & 1))) * 2) = w;
        } else if (ti == 20) {
            acc = mma16(acc, NpS, 40, QbT, 40, 32, t.lane);
            unsigned short o[4];
#pragma unroll
            for (int r = 0; r < 4; ++r) o[r] = (unsigned short)f2bf(Qkf[(4 * hq + r) * 16 + lc] - acc[r]);
            u32x2 w; w.x = o[0] | ((unsigned)o[1] << 16); w.y = o[2] | ((unsigned)o[3] << 16);
            *(u32x2*)(rec + RK_QA + ((size_t)((lc + 16 * (hq >> 1)) * 8 + 4 * (hq & 1))) * 2) = w;
            u32x2 z; z.x = 0u; z.y = 0u; *(u32x2*)(rec + RK_QA + ((size_t)((32 + lc + 16 * (hq >> 1)) * 8 + 4 * (hq & 1))) * 2) = z;
        } else { const int jt2 = ti - 21;
            acc = mma16(acc, NpS, 40, BhT + jt2 * 16 * 40, 40, 32, t.lane);
#pragma unroll
            for (int r = 0; r < 4; ++r) { const int s_ = 4 * hq + r, j2 = 16 * jt2 + lc; KpT[j2 * 40 + s_] = (bf16_t)f2bf(KhF[s_ * 64 + j2] - acc[r]); }
        }
    }
    for (int e = t.tid; e < 4 * 64 * 4; e += NTHREADS) { const int it = e >> 8, rem = e & 255, ln = rem >> 2, e2 = (rem & 3) * 2, hp = ln >> 4, i2 = 16 * it + (ln & 15);
        unsigned w = 0u; if (hp < 2) { const int s0 = 8 * hp + e2; w = f2bf(RAW[2 * 1024 + s0 * 64 + i2]) | (f2bf(RAW[2 * 1024 + (s0 + 1) * 64 + i2]) << 16); }
        *(unsigned*)(rec + RK_VB + ((size_t)((it * 64 + ln) * 8 + e2)) * 2) = w; }
    __syncthreads();
#pragma unroll
    for (int q = 0; q < 2; ++q) { const int ti = t.wave * 2 + q, rt = ti >> 2, it = ti & 3; f32x4 acc = {0.f, 0.f, 0.f, 0.f};
        acc = mma16(acc, KpT + rt * 16 * 40, 40, VT + it * 16 * 40, 40, 32, t.lane);
        *(f32x4*)(rec + RK_ZC + ((size_t)((rt * 4 + it) * 64 + t.lane)) * 16) = acc; }
    __syncthreads();
}
__device__ __forceinline__ void rwkv_b_chain(const Args& a, const Tc& t, int chain) {
    if (t.wave >= 4) return;
    float* OR = (float*)(a.ws + WS_OR);
    const int dir = chain & 1, h = (chain >> 1) & 3, b = chain >> 3, w = t.wave, hq = t.lane >> 4, lc = t.lane & 15;
    const unsigned char* rec = a.ws + WS_RK + (size_t)chain * NCK * RK_BYTES;
    f32x4 T[4];
#pragma unroll
    for (int rt = 0; rt < 4; ++rt) T[rt] = (f32x4){0.f, 0.f, 0.f, 0.f};
    bf16x8 pa[4][2], ra[2], qa, vb; f32x4 zc[4];
#define RKB_LOAD(ck) do { const unsigned char* rp_ = rec + (size_t)(ck) * RK_BYTES; \
        _Pragma("unroll") for (int rt = 0; rt < 4; ++rt) { _Pragma("unroll") for (int ks = 0; ks < 2; ++ks) pa[rt][ks] = *(const bf16x8*)(rp_ + RK_PA + ((size_t)((rt * 2 + ks) * 64 + t.lane)) * 16); \
            zc[rt] = *(const f32x4*)(rp_ + RK_ZC + ((size_t)((rt * 4 + w) * 64 + t.lane)) * 16); } \
        _Pragma("unroll") for (int ks = 0; ks < 2; ++ks) ra[ks] = *(const bf16x8*)(rp_ + RK_RA + ((size_t)(ks * 64 + t.lane)) * 16); \
        qa = *(const bf16x8*)(rp_ + RK_QA + (size_t)t.lane * 16); vb = *(const bf16x8*)(rp_ + RK_VB + ((size_t)(w * 64 + t.lane)) * 16); } while (0)
    RKB_LOAD(0);
    for (int ck = 0; ck < NCK; ++ck) {
        bf16x8 cpa[4][2], cra[2], cqa = qa, cvb = vb; f32x4 czc[4];
#pragma unroll
        for (int rt = 0; rt < 4; ++rt) { cpa[rt][0] = pa[rt][0]; cpa[rt][1] = pa[rt][1]; czc[rt] = zc[rt]; }
        cra[0] = ra[0]; cra[1] = ra[1];
        if (ck + 1 < NCK) RKB_LOAD(ck + 1);
        bf16x8 bfr[2];
#pragma unroll
        for (int ks = 0; ks < 2; ++ks) { u32x4 wv; wv.x = pk2(T[2 * ks][0], T[2 * ks][1]); wv.y = pk2(T[2 * ks][2], T[2 * ks][3]); wv.z = pk2(T[2 * ks + 1][0], T[2 * ks + 1][1]); wv.w = pk2(T[2 * ks + 1][2], T[2 * ks + 1][3]);
            bfr[ks] = __builtin_bit_cast(bf16x8, wv); }
        f32x4 o = {0.f, 0.f, 0.f, 0.f};
        o = __builtin_amdgcn_mfma_f32_16x16x32_bf16(cra[0], bfr[0], o, 0, 0, 0);
        o = __builtin_amdgcn_mfma_f32_16x16x32_bf16(cra[1], bfr[1], o, 0, 0, 0);
        o = __builtin_amdgcn_mfma_f32_16x16x32_bf16(cqa, cvb, o, 0, 0, 0);
#pragma unroll
        for (int rt = 0; rt < 4; ++rt) { f32x4 n = __builtin_amdgcn_mfma_f32_16x16x32_bf16(cpa[rt][0], bfr[0], czc[rt], 0, 0, 0); T[rt] = __builtin_amdgcn_mfma_f32_16x16x32_bf16(cpa[rt][1], bfr[1], n, 0, 0, 0); }
#pragma unroll
        for (int r = 0; r < 4; ++r) { const int row = chain_row(b, dir, ck * RKT + 4 * hq + r); OR[((size_t)dir * M + row) * 256 + h * 64 + 16 * w + lc] = o[r]; }
    }
#undef RKB_LOAD
}


constexpr int GLA_UNITS = BATCH * GNC;
__device__ __forceinline__ int gc_row0(int b, int c) { return c < GC_CTX ? ML + b * CTX + 32 * c : b * SEQ + 32 * (c - GC_CTX); }
__device__ __forceinline__ int gc_chain_pos(int c, int dir) { return dir == 0 ? c : (c < GC_CTX ? GC_CTX - 1 - c : GC_CTX + (GC_LAT - 1 - (c - GC_CTX))); }
__device__ __forceinline__ void gla_prefix(LAS float* PRE, int lane) {
    const int d = lane & 31, r0 = (lane >> 5) * 16; float run = 0.f;
#pragma unroll
    for (int i = 0; i < 16; ++i) { run += PRE[(r0 + i) * 33 + d]; PRE[(r0 + i) * 33 + d] = run; }
    WAVE_LDS_FENCE();
    if (lane >= 32) { const float add = PRE[15 * 33 + d];
#pragma unroll
        for (int i = 0; i < 16; ++i) PRE[(16 + i) * 33 + d] += add; }
    WAVE_LDS_FENCE();
}
__device__ __forceinline__ void gla_a1_unit(const Args& a, const Tc& t, int u) {
    const float* U = (const float*)(a.ws + WS_U); const float* GG = (const float*)(a.ws + WS_GG);
    float* GZ = (float*)(a.ws + WS_GZ); float* GDEC = (float*)(a.ws + WS_GDEC);
    const int c = u % GNC, b = u / GNC, row0 = gc_row0(b, c);
    const int h = t.wave & 3, dir = t.wave >> 2, chain = (b * 4 + h) * 2 + dir, cc = gc_chain_pos(c, dir);
    LAS float* PRE = (LAS float*)(t.lds + t.wave * 12288);
    LAS bf16_t* KT = (LAS bf16_t*)(PRE + 32 * 33 + 8);
    LAS bf16_t* VT = KT + 32 * 40;
    const int rho = t.lane & 31, hf = t.lane >> 5;
#pragma unroll
    for (int q = 0; q < 4; ++q) { const f32x4 g = *(const f32x4*)(GG + ((size_t)dir * M + row0 + rho) * 128 + h * 32 + hf * 16 + 4 * q);
#pragma unroll
        for (int e = 0; e < 4; ++e) PRE[rho * 33 + hf * 16 + 4 * q + e] = g[e]; }
    WAVE_LDS_FENCE();
    f32x4 graw[4];
#pragma unroll
    for (int q = 0; q < 4; ++q)
#pragma unroll
        for (int e = 0; e < 4; ++e) graw[q][e] = PRE[rho * 33 + hf * 16 + 4 * q + e];
    WAVE_LDS_FENCE();
    gla_prefix(PRE, t.lane);
#pragma unroll
    for (int q = 0; q < 4; ++q) { const f32x4 k = *(const f32x4*)(U + (size_t)(row0 + rho) * NU + U_GK + h * 32 + hf * 16 + 4 * q);
#pragma unroll
        for (int e = 0; e < 4; ++e) { const int d = hf * 16 + 4 * q + e; const float pre = PRE[rho * 33 + d], tot = PRE[31 * 33 + d];
            const float w = dir == 0 ? expf(tot - pre) : expf(pre - graw[q][e]);
            KT[d * 40 + rho] = (bf16_t)f2bf(k[e] * w); } }
#pragma unroll
    for (int q = 0; q < 8; ++q) { const f32x4 v = *(const f32x4*)(U + (size_t)(row0 + rho) * NU + U_GV + h * 64 + hf * 32 + 4 * q);
#pragma unroll
        for (int e = 0; e < 4; ++e) VT[(hf * 32 + 4 * q + e) * 40 + rho] = (bf16_t)f2bf(v[e]); }
    if (t.lane < 32) GDEC[((size_t)chain * GNC + cc) * 32 + t.lane] = expf(PRE[31 * 33 + t.lane]);
    WAVE_LDS_FENCE();
    float* zb = GZ + ((size_t)chain * GNC + cc) * 2048;
#pragma unroll
    for (int vt = 0; vt < 4; ++vt)
#pragma unroll
        for (int dt = 0; dt < 2; ++dt) { f32x4 acc = {0.f, 0.f, 0.f, 0.f};
            acc = mma16(acc, VT + vt * 16 * 40, 40, KT + dt * 16 * 40, 40, 32, t.lane);
#pragma unroll
            for (int r = 0; r < 4; ++r) zb[(16 * vt + 4 * (t.lane >> 4) + r) * 32 + 16 * dt + (t.lane & 15)] = acc[r]; }
    WAVE_LDS_FENCE();
}
__device__ __forceinline__ void gla_b_carry(const Args& a, const Tc& t, int wg, int nwg) {
    const float* GZ = (const float*)(a.ws + WS_GZ); const float* GDEC = (const float*)(a.ws + WS_GDEC); bf16_t* GST = (bf16_t*)(a.ws + WS_GST);
    for (int idx = wg * NTHREADS + t.tid; idx < BATCH * 8 * 512; idx += nwg * NTHREADS) {
        const int chain = idx >> 9, e4 = (idx & 511) * 4, d0 = e4 & 31;
        const float* zc = GZ + (size_t)chain * GNC * 2048 + e4; bf16_t* sc = GST + (size_t)chain * GNC * 2048 + e4; const float* dc = GDEC + (size_t)chain * GNC * 32 + d0;
        f32x4 s = {0.f, 0.f, 0.f, 0.f};
        static_assert(GNC % 4 == 0, "carry unroll");
        for (int cc = 0; cc < GNC; cc += 4) {
            f32x4 z[4], d[4];
#pragma unroll
            for (int q = 0; q < 4; ++q) { z[q] = *(const f32x4*)(zc + (size_t)(cc + q) * 2048); d[q] = *(const f32x4*)(dc + (size_t)(cc + q) * 32); }
#pragma unroll
            for (int q = 0; q < 4; ++q) { u32x2 w; w.x = pk2(s[0], s[1]); w.y = pk2(s[2], s[3]); *(u32x2*)(sc + (size_t)(cc + q) * 2048) = w; s = s * d[q] + z[q]; }
        }
    }
}
__device__ __forceinline__ void gla_c_unit(const Args& a, const Tc& t, int u) {
    const float* U = (const float*)(a.ws + WS_U); const float* GG = (const float*)(a.ws + WS_GG);
    const bf16_t* GST = (const bf16_t*)(a.ws + WS_GST); float* OG = (float*)(a.ws + WS_OG);
    const int c = u % GNC, b = u / GNC, row0 = gc_row0(b, c);
    const int h = t.wave & 3, dir = t.wave >> 2, chain = (b * 4 + h) * 2 + dir, cc = gc_chain_pos(c, dir);
    LAS float* PRE = (LAS float*)(t.lds + t.wave * 14592);
    LAS bf16_t* QN = (LAS bf16_t*)(PRE + 32 * 33 + 8);
    LAS bf16_t* KN = QN + 32 * 40;
    LAS bf16_t* VT = KN + 32 * 40;
    const int rho = t.lane & 31, hf = t.lane >> 5, hq = t.lane >> 4, lc = t.lane & 15;
#pragma unroll
    for (int q = 0; q < 4; ++q) { const f32x4 g = *(const f32x4*)(GG + ((size_t)dir * M + row0 + rho) * 128 + h * 32 + hf * 16 + 4 * q);
#pragma unroll
        for (int e = 0; e < 4; ++e) PRE[rho * 33 + hf * 16 + 4 * q + e] = g[e]; }
    WAVE_LDS_FENCE();
    f32x4 graw[4];
#pragma unroll
    for (int q = 0; q < 4; ++q)
#pragma unroll
        for (int e = 0; e < 4; ++e) graw[q][e] = PRE[rho * 33 + hf * 16 + 4 * q + e];
    WAVE_LDS_FENCE();
    gla_prefix(PRE, t.lane);
#pragma unroll
    for (int q = 0; q < 4; ++q) { const f32x4 qv = *(const f32x4*)(U + (size_t)(row0 + rho) * NU + U_GQ + h * 32 + hf * 16 + 4 * q), kv = *(const f32x4*)(U + (size_t)(row0 + rho) * NU + U_GK + h * 32 + hf * 16 + 4 * q);
#pragma unroll
        for (int e = 0; e < 4; ++e) { const int d = hf * 16 + 4 * q + e; const float pre = PRE[rho * 33 + d], tot = PRE[31 * 33 + d], ref = PRE[15 * 33 + d];
            const float ex = pre - graw[q][e], qs = qv[e] * 0.17677669529663687f;
            float fq, fk;
            if (dir == 0) { fq = expf(pre - ref); fk = expf(ref - pre); } else { fq = expf(ref - ex); fk = expf(ex - ref); }
            (void)tot;
            QN[rho * 40 + d] = (bf16_t)f2bf(qs * fq); KN[rho * 40 + d] = (bf16_t)f2bf(kv[e] * fk); } }
    bf16x8 q2f[2];
#pragma unroll
    for (int it = 0; it < 2; ++it) { const int ro = 16 * it + lc; const float* qp = U + (size_t)(row0 + ro) * NU + U_GQ + h * 32 + 8 * hq; const float* gp = GG + ((size_t)dir * M + row0 + ro) * 128 + h * 32 + 8 * hq;
        const f32x4 qa = *(const f32x4*)qp, qb = *(const f32x4*)(qp + 4), ga = *(const f32x4*)gp, gb = *(const f32x4*)(gp + 4);
#pragma unroll
        for (int e = 0; e < 8; ++e) { const int d = 8 * hq + e; const float pre = PRE[ro * 33 + d], tot = PRE[31 * 33 + d]; const float qv = e < 4 ? qa[e & 3] : qb[e & 3], gv = e < 4 ? ga[e & 3] : gb[e & 3];
            const float f2 = dir == 0 ? expf(pre) : expf(tot - (pre - gv));
            q2f[it][e] = (short)f2bf(qv * 0.17677669529663687f * f2); } }
#pragma unroll
    for (int q = 0; q < 8; ++q) { const f32x4 v = *(const f32x4*)(U + (size_t)(row0 + rho) * NU + U_GV + h * 64 + hf * 32 + 4 * q);
#pragma unroll
        for (int e = 0; e < 4; ++e) VT[(hf * 32 + 4 * q + e) * 40 + rho] = (bf16_t)f2bf(v[e]); }
    WAVE_LDS_FENCE();
    f32x4 att[2][2];
#pragma unroll
    for (int it = 0; it < 2; ++it)
#pragma unroll
        for (int jt = 0; jt < 2; ++jt) { att[it][jt] = (f32x4){0.f, 0.f, 0.f, 0.f}; att[it][jt] = mma16(att[it][jt], QN + it * 16 * 40, 40, KN + jt * 16 * 40, 40, 32, t.lane); }
    WAVE_LDS_FENCE();
#pragma unroll
    for (int it = 0; it < 2; ++it)
#pragma unroll
        for (int jt = 0; jt < 2; ++jt)
#pragma unroll
            for (int r = 0; r < 4; ++r) { const int ro = 16 * it + 4 * hq + r, rp = 16 * jt + lc; const bool keep = dir == 0 ? (rp <= ro) : (rp >= ro);
                QN[ro * 40 + rp] = (bf16_t)f2bf(keep ? att[it][jt][r] : 0.f); }
    WAVE_LDS_FENCE();
    const bf16_t* sb = GST + ((size_t)chain * GNC + cc) * 2048;
#pragma unroll
    for (int it = 0; it < 2; ++it)
#pragma unroll
        for (int vt = 0; vt < 4; ++vt) { f32x4 acc = {0.f, 0.f, 0.f, 0.f};
            acc = mma16(acc, QN + it * 16 * 40, 40, VT + vt * 16 * 40, 40, 32, t.lane);
            const bf16x8 sf = *(const bf16x8*)(sb + (size_t)(16 * vt + lc) * 32 + 8 * hq);
            acc = __builtin_amdgcn_mfma_f32_16x16x32_bf16(q2f[it], sf, acc, 0, 0, 0);
#pragma unroll
            for (int r = 0; r < 4; ++r) OG[((size_t)dir * M + row0 + 16 * it + 4 * hq + r) * 256 + h * 64 + 16 * vt + lc] = acc[r]; }
    WAVE_LDS_FENCE();
}

__device__ __forceinline__ void phase_mixout(const Args& a, const Tc& t, int l, int Mtok) {
    const float* U = (const float*)(a.ws + WS_U); const float* RW7 = (const float*)(a.ws + WS_RW7); const float* SXBC = (const float*)(a.ws + WS_SXBC);
    const float* OG = (const float*)(a.ws + WS_OG); const float* OR = (const float*)(a.ws + WS_OR); const float* OS = (const float*)(a.ws + WS_OS);
    bf16_t* MIX = (bf16_t*)(a.ws + WS_MIX);
    const float* mu = a.in[I_RMU] + (size_t)l * 2 * 928; const float* g2 = a.in[I_RG2] + (size_t)l * 64 * 256;
    const float* gng = a.in[I_GNG] + (size_t)l * 256; const float* lng = a.in[I_RLG] + (size_t)l * 256; const float* lnb = a.in[I_RLB] + (size_t)l * 256;
    const float* rrk = a.in[I_RRK] + (size_t)l * 256; const float* sd = a.in[I_SD] + (size_t)l * 8; const float* sng = a.in[I_SNG] + (size_t)l * 512;
    LAS float* SG = (LAS float*)t.lds;
    LAS float* RED = (LAS float*)(t.lds + 4096);
    const size_t P = (size_t)M * 256;
    for (int tile = t.bid; tile < Mtok / 16; tile += t.G) {
        const int r0 = tile * 16; int slo, shi; seg_bounds(r0, slo, shi);
        {   const int tt = t.tid >> 5, r = t.tid & 31, row = r0 + tt; const float* up = U + (size_t)row * NU; const bool hp = row - 1 >= slo, hn = row + 1 < shi;
#pragma unroll
            for (int q = 0; q < 2; ++q) { const int col = U_RLGT + q * 32 + r, mi = col - U_RW; const float u = up[col], pv = hp ? up[col - NU] : 0.f, nv = hn ? up[col + NU] : 0.f;
                SG[tt * 64 + q * 32 + r] = sigmoidf_(u + mu[mi] * (pv - u) + mu[928 + mi] * (nv - u)); } }
        __syncthreads();
        {
            const int c = t.tid & 255, tt0 = (t.tid >> 8) * 8;
            float ag[8];
#pragma unroll
            for (int j = 0; j < 8; ++j) ag[j] = 0.f;
            for (int r = 0; r < 64; ++r) { const float w = g2[r * 256 + c];
#pragma unroll
                for (int j = 0; j < 8; ++j) ag[j] += SG[(tt0 + j) * 64 + r] * w; }
            const float gn = gng[c], lg = lng[c], lb = lnb[c], rk = rrk[c];
#pragma unroll
            for (int j = 0; j < 8; ++j) { const int row = r0 + tt0 + j;
                const float og_ = OG[(size_t)row * 256 + c] + OG[P + (size_t)row * 256 + c];
                const float ms = wave_sum(og_ * og_) * (1.0f / 64.0f);
                const float o1 = og_ * (1.0f / sqrtf(ms + 1e-6f)) * gn * siluf_(U[(size_t)row * NU + U_GOG + c]);
                const float orr = OR[(size_t)row * 256 + c] + OR[P + (size_t)row * 256 + c];
                const float mean = wave_sum(orr) * (1.0f / 64.0f); const float dd = orr - mean; const float var = wave_sum(dd * dd) * (1.0f / 64.0f);
                const float on = dd * (1.0f / sqrtf(var + 64e-5f)) * lg + lb;
                const float rr = RW7[(size_t)row * 256 + c], kk = RW7[P + (size_t)row * 256 + c], vv = RW7[2 * P + (size_t)row * 256 + c];
                const float bon = wave_sum(rr * kk * rk) * vv;
                const float o2 = (on + bon) * ag[j];
                MIX[(size_t)row * D + c] = (bf16_t)f2bf(o1); MIX[(size_t)row * D + 256 + c] = (bf16_t)f2bf(o2); }
        }
        {
            const int c = t.tid; const float dh = sd[c >> 6], ng = sng[c];
            float y[16];
#pragma unroll
            for (int q = 0; q < 16; ++q) { const int row = r0 + q;
                float v = OS[(size_t)row * 512 + c] + OS[(size_t)M * 512 + (size_t)row * 512 + c] + dh * SXBC[(size_t)row * 1024 + c];
                v *= siluf_(U[(size_t)row * NU + U_SZ + c]); y[q] = v;
                const float ss = wave_sum(v * v); if (t.lane == 0) RED[q * 8 + t.wave] = ss; }
            __syncthreads();
            const int gb = (t.wave >> 2) * 4;
#pragma unroll
            for (int q = 0; q < 16; ++q) { const float ms = (RED[q * 8 + gb] + RED[q * 8 + gb + 1] + RED[q * 8 + gb + 2] + RED[q * 8 + gb + 3]) * (1.0f / 256.0f);
                MIX[(size_t)(r0 + q) * D + 512 + c] = (bf16_t)f2bf(y[q] * (1.0f / sqrtf(ms + 1e-6f)) * ng); }
        }
        __syncthreads();
    }
}

__device__ __forceinline__ void phase_router(const Args& a, const Tc& t, int l, int Mtok) {
    const int gw = t.bid * NWAVES + t.wave, NGW = t.G * NWAVES;
    const float* X = (const float*)(a.ws + WS_X); bf16_t* H = (bf16_t*)(a.ws + WS_H); const float* MODS = (const float*)(a.ws + WS_MODS) + (size_t)l * NR * 6144;
    const float* rw = a.in[I_ROUTW] + (size_t)l * D * NEXP; const float* rb = a.in[I_ROUTB] + (size_t)l * NEXP;
    int* TOPI = (int*)(a.ws + WS_TOPI); float* TOPP = (float*)(a.ws + WS_TOPP);
    unsigned* CNT = (unsigned*)(a.ws + WS_CTL) + CW_CNT + l * 64;
    LAS int* hist = (LAS int*)(t.lds + LDS_MISC + 64);
    if (t.tid < NEXP) hist[t.tid] = 0;
    __syncthreads();
    for (int row = gw; row < Mtok; row += NGW) {
        f32x4 v[4], h[4];
#pragma unroll
        for (int j = 0; j < 4; ++j) v[j] = *(const f32x4*)(X + (size_t)row * D + 4 * t.lane + 256 * j);
        const float* md = MODS + (size_t)mod_row(row) * 6144;
        norm_mod_store(v, a.in[I_N2G] + (size_t)l * D, md + 3 * 1024, md + 4 * 1024, H + (size_t)row * D, t.lane, h);
        float lg[NEXP];
#pragma unroll
        for (int e = 0; e < NEXP; ++e) lg[e] = 0.f;
#pragma unroll
        for (int j = 0; j < 4; ++j)
#pragma unroll
            for (int q = 0; q < 4; ++q) { const float hv = h[j][q]; const float* wr_ = rw + (size_t)(4 * t.lane + 256 * j + q) * NEXP;
#pragma unroll
                for (int e4 = 0; e4 < NEXP / 4; ++e4) { const f32x4 w = *(const f32x4*)(wr_ + 4 * e4);
                    lg[4 * e4] += hv * w[0]; lg[4 * e4 + 1] += hv * w[1]; lg[4 * e4 + 2] += hv * w[2]; lg[4 * e4 + 3] += hv * w[3]; } }
#pragma unroll
        for (int e = 0; e < NEXP; ++e) lg[e] = wave_sum(lg[e]) + rb[e];
        int ti[4]; float tv[4];
#pragma unroll
        for (int k = 0; k < 4; ++k) { float best = -3.0e38f; int bi = 0;
#pragma unroll
            for (int e = 0; e < NEXP; ++e) { bool taken = false;
#pragma unroll
                for (int k2 = 0; k2 < k; ++k2) taken = taken || (ti[k2] == e);
                if (!taken && lg[e] > best) { best = lg[e]; bi = e; } }
            ti[k] = bi; tv[k] = best; }
        const float e0 = 1.0f, e1 = expf(tv[1] - tv[0]), e2 = expf(tv[2] - tv[0]), e3 = expf(tv[3] - tv[0]); const float inv = 1.0f / (e0 + e1 + e2 + e3);
        if (t.lane == 0) {
            TOPI[row * 4 + 0] = ti[0]; TOPI[row * 4 + 1] = ti[1]; TOPI[row * 4 + 2] = ti[2]; TOPI[row * 4 + 3] = ti[3];
            TOPP[row * 4 + 0] = e0 * inv; TOPP[row * 4 + 1] = e1 * inv; TOPP[row * 4 + 2] = e2 * inv; TOPP[row * 4 + 3] = e3 * inv;
#pragma unroll
            for (int k = 0; k < 4; ++k) atomicAdd((int*)&hist[ti[k]], 1);
        }
    }
    __syncthreads();
    if (t.tid < NEXP && hist[t.tid] != 0) atomicAdd(&CNT[t.tid], (unsigned)hist[t.tid]);
}

__device__ __forceinline__ int moe_offsets(const unsigned* CNT, LAS int* off, LAS int* cnt, int tid) {
    if (tid < NEXP) { int o = 0; for (int e = 0; e < tid; ++e) o += ((int)CNT[e] + 255) & ~255; off[tid] = o; cnt[tid] = (int)CNT[tid]; }
    __syncthreads();
    return (off[NEXP - 1] + ((cnt[NEXP - 1] + 255) & ~255)) >> 8;
}
__device__ __forceinline__ void phase_lists(const Args& a, const Tc& t, int l, int Mtok) {
    const int* TOPI = (const int*)(a.ws + WS_TOPI); const float* TOPP = (const float*)(a.ws + WS_TOPP);
    int* POS = (int*)(a.ws + WS_POS); int* ROWIDX = (int*)(a.ws + WS_ROWIDX); float* ROWGATE = (float*)(a.ws + WS_ROWGATE);
    unsigned* CNT = (unsigned*)(a.ws + WS_CTL) + CW_CNT + l * 64; unsigned* CUR = (unsigned*)(a.ws + WS_CTL) + CW_CUR + l * 64;
    LAS int* off = (LAS int*)(t.lds + LDS_MISC + 64); LAS int* cnt = off + 64; LAS int* hist = off + 128; LAS int* base = off + 192; LAS int* cur = off + 256;
    if (t.tid < NEXP) { hist[t.tid] = 0; cur[t.tid] = 0; }
    moe_offsets(CNT, off, cnt, t.tid);
    const int rpb = (Mtok + t.G - 1) / t.G, s0 = t.bid * rpb * 4; int s1 = (t.bid + 1) * rpb * 4; if (s1 > Mtok * 4) s1 = Mtok * 4;
    for (int s = s0 + t.tid; s < s1; s += NTHREADS) atomicAdd((int*)&hist[TOPI[s]], 1);
    __syncthreads();
    if (t.tid < NEXP) base[t.tid] = hist[t.tid] ? (int)atomicAdd(&CUR[t.tid], (unsigned)hist[t.tid]) : 0;
    __syncthreads();
    for (int s = s0 + t.tid; s < s1; s += NTHREADS) { const int e = TOPI[s]; const int p = off[e] + base[e] + atomicAdd((int*)&cur[e], 1);
        POS[s] = p; ROWIDX[p] = s >> 2; ROWGATE[p] = TOPP[s]; }
    for (int e = t.bid; e < NEXP; e += t.G) { const int lo = off[e] + cnt[e], hi = off[e] + ((cnt[e] + 255) & ~255);
        for (int p = lo + t.tid; p < hi; p += NTHREADS) { ROWIDX[p] = 0; ROWGATE[p] = 0.f; } }
    __syncthreads();
}
__device__ __forceinline__ int moe_tile_table(const Args& a, const Tc& t, int l) {
    unsigned* CNT = (unsigned*)(a.ws + WS_CTL) + CW_CNT + l * 64;
    LAS int* off = (LAS int*)(t.lds + LDS_MISC + 64); LAS int* cnt = off + 64; LAS int* tile_e = (LAS int*)(t.lds + LDS_TILE_E);
    const int ntiles = moe_offsets(CNT, off, cnt, t.tid);
    for (int tt = t.tid; tt < ntiles; tt += NTHREADS) { int e = 0;
        for (int q = 1; q < NEXP; ++q) if ((off[q] >> 8) <= tt) e = q;
        tile_e[tt] = e; }
    __syncthreads();
    return ntiles;
}

__device__ __forceinline__ void phase_combine(const Args& a, const Tc& t, int l, int Mtok) {
    const int gw = t.bid * NWAVES + t.wave, NGW = t.G * NWAVES;
    float* X = (float*)(a.ws + WS_X); bf16_t* H = (bf16_t*)(a.ws + WS_H); const bf16_t* Y = (const bf16_t*)(a.ws + WS_Y); const int* POS = (const int*)(a.ws + WS_POS);
    const float* MODS = (const float*)(a.ws + WS_MODS) + (size_t)l * NR * 6144;
    for (int row = gw; row < Mtok; row += NGW) {
        const float* md = MODS + (size_t)mod_row(row) * 6144 + 5 * 1024;
        const int p0 = POS[row * 4], p1 = POS[row * 4 + 1], p2 = POS[row * 4 + 2], p3 = POS[row * 4 + 3];
        f32x4 v[4], h[4];
#pragma unroll
        for (int j = 0; j < 4; ++j) { const int c = 4 * t.lane + 256 * j;
            const u32x2 y0 = *(const u32x2*)(Y + (size_t)p0 * D + c), y1 = *(const u32x2*)(Y + (size_t)p1 * D + c), y2 = *(const u32x2*)(Y + (size_t)p2 * D + c), y3 = *(const u32x2*)(Y + (size_t)p3 * D + c);
            f32x4 s; s[0] = (bf_lo(y0.x) + bf_lo(y1.x)) + (bf_lo(y2.x) + bf_lo(y3.x)); s[1] = (bf_hi(y0.x) + bf_hi(y1.x)) + (bf_hi(y2.x) + bf_hi(y3.x));
            s[2] = (bf_lo(y0.y) + bf_lo(y1.y)) + (bf_lo(y2.y) + bf_lo(y3.y)); s[3] = (bf_hi(y0.y) + bf_hi(y1.y)) + (bf_hi(y2.y) + bf_hi(y3.y));
            const f32x4 g = *(const f32x4*)(md + c);
            v[j] = *(const f32x4*)(X + (size_t)row * D + c) + g * s; }
        if (l + 1 < DEPTH) {
#pragma unroll
            for (int j = 0; j < 4; ++j) *(f32x4*)(X + (size_t)row * D + 4 * t.lane + 256 * j) = v[j];
            const float* md2 = MODS + (size_t)NR * 6144 + (size_t)mod_row(row) * 6144;
            norm_mod_store(v, a.in[I_N1G] + (size_t)(l + 1) * D, md2, md2 + 1024, H + (size_t)row * D, t.lane, h);
        } else {
            float ss = 0.f;
#pragma unroll
            for (int j = 0; j < 4; ++j) ss += (v[j][0] * v[j][0] + v[j][1] * v[j][1]) + (v[j][2] * v[j][2] + v[j][3] * v[j][3]);
            const float rstd = 1.0f / sqrtf(wave_sum(ss) * (1.0f / D) + 1e-6f);
#pragma unroll
            for (int j = 0; j < 4; ++j) { const int c = 4 * t.lane + 256 * j; const f32x4 g = *(const f32x4*)(a.in[I_FNG] + c); *(f32x4*)(a.out + (size_t)row * D + c) = v[j] * rstd * g; }
        }
    }
}

#ifndef EMU
__device__ __forceinline__ void launder_tid(Tc& t) { int x = threadIdx.x; asm volatile("" : "+v"(x)); t.tid = x; t.lane = x & 63; t.wave = __builtin_amdgcn_readfirstlane(x >> 6); }
#endif
constexpr int PH_PER_LAYER = 12, N_PHASES = 2 + DEPTH * PH_PER_LAYER;
__global__ void __launch_bounds__(NTHREADS, 2) fwd(Args a) {
#ifdef EMU
    unsigned char* lds_raw = EMU_DYN_LDS();
#else
    extern __shared__ __attribute__((aligned(16))) unsigned char lds_raw[];
#endif
    Tc t; t.lds = (LAS unsigned char*)lds_raw; t.tid = threadIdx.x; t.lane = t.tid & 63; t.wave = __builtin_amdgcn_readfirstlane(t.tid >> 6); t.G = gridDim.x; t.bid = blockIdx.x;
    const int lo = a.ph_lo, hi = a.ph_hi;
    volatile LAS unsigned* misc = (volatile LAS unsigned*)(t.lds + LDS_MISC);
    if (t.tid < 16) misc[t.tid] = 0u;
    __syncthreads();
    XcdBarrier bar; bar.bar = (unsigned*)(a.ws + WS_CTL) + CW_BAR; bar.x = 0; bar.st = misc;
    if (hi - lo > 1) bar = xcd_barrier_post((unsigned*)(a.ws + WS_CTL) + CW_BAR, misc);
#ifdef EMU
#define LAUNDER_TID() ((void)0)
#else
#define LAUNDER_TID() launder_tid(t)
#endif
#define IN_PH(k) (lo <= (k) && (k) < hi && (LAUNDER_TID(), true))
#define REPS(bit) (((PROBE_DOUBLE >> (bit)) & 1) ? 2 : 1)
#define SEAM(k) do { if ((k) + 1 < hi) xcd_barrier(bar); } while (0)
    if (IN_PH(0)) { for (int rep = 0; rep < REPS(15); ++rep) phase_pro0(a, t); SEAM(0); }
    if (IN_PH(1)) { phase_pro1(a, t); SEAM(1); }
    for (int l = 0; l < DEPTH; ++l) {
        const int pb = 2 + l * PH_PER_LAYER;
        const bool lastl = (l == DEPTH - 1);
        const int Mtok = lastl ? ML : M;
        const float* MODSL = (const float*)(a.ws + WS_MODS) + (size_t)l * NR * 6144;
        if (IN_PH(pb + 0)) {
            pg8::Gemm g{(const bf16_t*)(a.ws + WS_H), (const bf16_t*)(a.ws + WS_WIN) + (size_t)l * NU * D, D, nullptr};
            pg8::DenseSched S; S.o.init(M / 256, NU / 256, t.G, t.bid);
            pg8::EpiF32 E{(float*)(a.ws + WS_U), NU};
            for (int rep = 0; rep < REPS(0); ++rep) pg8::gemm_phase<pg8::EpiF32, pg8::DenseSched, false>(t.lds, t.tid, g, S, E);
            SEAM(pb + 0);
        }
        if (IN_PH(pb + 1)) { for (int rep = 0; rep < REPS(1); ++rep) phase_prep(a, t, l); SEAM(pb + 1); }
        if (IN_PH(pb + 2)) {
            for (int u = t.bid; u < RW_UNITS + SSD_UNITS + GLA_UNITS; u += t.G) { if (u < RW_UNITS) rwkv_a_unit(a, t, u); else if (u < RW_UNITS + SSD_UNITS) ssd_a1_unit(a, t, l, u - RW_UNITS); else gla_a1_unit(a, t, u - RW_UNITS - SSD_UNITS); }
            SEAM(pb + 2);
        }
        if (IN_PH(pb + 3)) {
            for (int ci = t.bid; ci < BATCH * 8; ci += t.G) rwkv_b_chain(a, t, ci);
            if (t.G > 2 * BATCH * 8) { if (t.bid >= BATCH * 8) { ssd_b_carry(a, t, t.bid - BATCH * 8, t.G - BATCH * 8); gla_b_carry(a, t, t.bid - BATCH * 8, t.G - BATCH * 8); } }
            else { ssd_b_carry(a, t, t.bid, t.G); gla_b_carry(a, t, t.bid, t.G); }
            SEAM(pb + 3);
        }
        if (IN_PH(pb + 4)) {
            for (int u = t.bid; u < SSD_UNITS + GLA_UNITS; u += t.G) { if (u < SSD_UNITS) ssd_c_unit(a, t, l, u); else gla_c_unit(a, t, u - SSD_UNITS); }
            SEAM(pb + 4);
        }
        if (IN_PH(pb + 5)) { for (int rep = 0; rep < REPS(3); ++rep) phase_mixout(a, t, l, Mtok); SEAM(pb + 5); }
        if (IN_PH(pb + 6)) {
            pg8::Gemm g{(const bf16_t*)(a.ws + WS_MIX), (const bf16_t*)(a.ws + WS_WOUT) + (size_t)l * D * D, D, nullptr};
            pg8::DenseSched S; S.o.init(Mtok / 256, D / 256, t.G, t.bid);
            pg8::EpiResid E{(float*)(a.ws + WS_X), MODSL};
            pg8::gemm_phase<pg8::EpiResid, pg8::DenseSched, false>(t.lds, t.tid, g, S, E);
            SEAM(pb + 6);
        }
        if (IN_PH(pb + 7)) { phase_router(a, t, l, Mtok); SEAM(pb + 7); }
        if (IN_PH(pb + 8)) { phase_lists(a, t, l, Mtok); SEAM(pb + 8); }
        if (IN_PH(pb + 9)) {
            const int ntiles = moe_tile_table(a, t, l);
            pg8::Gemm g{(const bf16_t*)(a.ws + WS_H), (const bf16_t*)(a.ws + WS_WGU) + (size_t)l * NEXP * 2048 * D, D, (const int*)(a.ws + WS_ROWIDX)};
            pg8::MoeSched S; S.o.init(ntiles, 8, t.G, t.bid); S.tile_e = (const LAS int*)(t.lds + LDS_TILE_E); S.nct = 8;
            pg8::EpiSwiglu E{(bf16_t*)(a.ws + WS_ACT), a.in[I_BGU] + (size_t)l * NEXP * 2048};
            for (int rep = 0; rep < REPS(7); ++rep) pg8::gemm_phase<pg8::EpiSwiglu, pg8::MoeSched, true>(t.lds, t.tid, g, S, E);
            SEAM(pb + 9);
        }
        if (IN_PH(pb + 10)) {
            const int ntiles = moe_tile_table(a, t, l);
            pg8::Gemm g{(const bf16_t*)(a.ws + WS_ACT), (const bf16_t*)(a.ws + WS_WD) + (size_t)l * NEXP * D * DFF, DFF, nullptr};
            pg8::MoeSched S; S.o.init(ntiles, 4, t.G, t.bid); S.tile_e = (const LAS int*)(t.lds + LDS_TILE_E); S.nct = 4;
            pg8::EpiDown E{(bf16_t*)(a.ws + WS_Y), a.in[I_BDN] + (size_t)l * NEXP * D, (const float*)(a.ws + WS_ROWGATE)};
            for (int rep = 0; rep < REPS(8); ++rep) pg8::gemm_phase<pg8::EpiDown, pg8::MoeSched, false>(t.lds, t.tid, g, S, E);
            SEAM(pb + 10);
        }
        if (IN_PH(pb + 11)) { phase_combine(a, t, l, Mtok); SEAM(pb + 11); }
    }
#undef IN_PH
#undef SEAM
}

}

extern "C" void kernel_launch(void* const* d_in, const int* in_sizes, int n_in, void* d_out, int out_size, void* d_ws, size_t ws_size, hipStream_t stream) {
    using namespace mk;
    static int grid = 0;
    if (grid == 0) {
        if (n_in != 37 || out_size != ML * D || ws_size < WS_END) { fprintf(stderr, "kernel_launch: unexpected shapes (n_in %d out %d ws %zu need %zu)\n", n_in, out_size, ws_size, (size_t)WS_END); grid = -1; return; }
#ifdef EMU
        { const char* e = getenv("EMU_GRID"); grid = e ? atoi(e) : 8; }
#else
        int dev = 0, cus = 0, per_cu = 0;
        if (hipGetDevice(&dev) != hipSuccess || hipDeviceGetAttribute(&cus, hipDeviceAttributeMultiprocessorCount, dev) != hipSuccess) { grid = -1; return; }
        if (hipFuncSetAttribute((const void*)fwd, hipFuncAttributeMaxDynamicSharedMemorySize, LDS_BYTES) != hipSuccess) { fprintf(stderr, "kernel_launch: hipFuncSetAttribute failed\n"); grid = -1; return; }
        if (hipOccupancyMaxActiveBlocksPerMultiprocessor(&per_cu, (const void*)fwd, NTHREADS, LDS_BYTES) != hipSuccess || per_cu < 1) fprintf(stderr, "kernel_launch: occupancy query reports %d\n", per_cu);
        (void)hipGetLastError();
        grid = cus;
#endif
    }
    if (grid < 0) return;
    (void)hipMemsetAsync((char*)d_ws + WS_CTL, 0, CTL_BYTES, stream);
    Args a{};
    for (int i = 0; i < 37; ++i) a.in[i] = (const float*)d_in[i];
    a.out = (float*)d_out; a.ws = (unsigned char*)d_ws;
#if N_LAUNCH_MODE == 1
    a.ph_lo = 0; a.ph_hi = N_PHASES;
    hipLaunchKernelGGL(fwd, dim3(grid), dim3(NTHREADS), LDS_BYTES, stream, a);
#else
    for (int p = 0; p < N_PHASES; ++p) { a.ph_lo = p; a.ph_hi = p + 1; hipLaunchKernelGGL(fwd, dim3(grid), dim3(NTHREADS), LDS_BYTES, stream, a); }
#endif
}
```

```cpp
#ifndef EMU
#include <hip/hip_runtime.h>
#endif
#include <cstdio>
#include <cstdint>
#include <cmath>

#ifndef CFG_BATCH
#define CFG_BATCH 4
#define CFG_SEQ 4096
#define CFG_CTX 256
#define CFG_DEPTH 4
#define CFG_NEXP 32
#endif
#ifndef PROBE_DOUBLE
#define PROBE_DOUBLE 0
#endif
#ifndef N_LAUNCH_MODE
#define N_LAUNCH_MODE 1
#endif

namespace mk {
constexpr int BATCH = CFG_BATCH, SEQ = CFG_SEQ, CTX = CFG_CTX, DEPTH = CFG_DEPTH, NEXP = CFG_NEXP;
constexpr int D = 1024, ML = BATCH * SEQ, MC = BATCH * CTX, M = ML + MC, NR = BATCH + 1;
constexpr int IN_COLS = 3280, NU = 3328;
constexpr int TOPK = 4, DFF = 1024;
constexpr int MAXROWS = M * TOPK + NEXP * 256;
constexpr int NTHREADS = 512, NWAVES = 8;
constexpr int U_GQ = 0, U_GK = 128, U_GV = 256, U_GOG = 512, U_GLF = 768, U_GLB = 784;
constexpr int U_RW = 800, U_RR = 800, U_RK = 1056, U_RV = 1312, U_RLWF = 1568, U_RLWB = 1600, U_RLA = 1632, U_RLGT = 1664;
constexpr int U_SZ = 1728, U_SXBC = 2240, U_SDT = 3264;
static_assert(SEQ % 256 == 0 && CTX % 256 == 0 && M % 256 == 0, "row tiles");

constexpr size_t al256(size_t x) { return (x + 255) & ~(size_t)255; }
constexpr size_t WS_CTL = 0, CTL_BYTES = 1u << 20;
constexpr size_t WS_MODS = WS_CTL + CTL_BYTES;
constexpr size_t WS_X = WS_MODS + al256((size_t)DEPTH * NR * 6144 * 4);
constexpr size_t WS_H = WS_X + al256((size_t)M * D * 4);
constexpr size_t WS_U = WS_H + al256((size_t)M * D * 2);
constexpr size_t WS_GG = WS_U + al256((size_t)M * NU * 4);
constexpr size_t WS_RW7 = WS_GG + al256((size_t)2 * M * 128 * 4);
constexpr size_t WS_SXBC = WS_RW7 + al256((size_t)7 * M * 256 * 4);
constexpr size_t WS_SDT = WS_SXBC + al256((size_t)M * 1024 * 4);
constexpr size_t WS_OG = WS_SDT + al256((size_t)M * 16 * 4);
constexpr size_t WS_OR = WS_OG + al256((size_t)2 * M * 256 * 4);
constexpr size_t WS_OS = WS_OR + al256((size_t)2 * M * 256 * 4);
constexpr size_t WS_MIX = WS_OS + al256((size_t)2 * M * 512 * 4);
constexpr size_t WS_TOPI = WS_MIX + al256((size_t)M * D * 2);
constexpr size_t WS_TOPP = WS_TOPI + al256((size_t)M * 4 * 4);
constexpr size_t WS_POS = WS_TOPP + al256((size_t)M * 4 * 4);
constexpr size_t WS_ROWIDX = WS_POS + al256((size_t)M * 4 * 4);
constexpr size_t WS_ROWGATE = WS_ROWIDX + al256((size_t)MAXROWS * 4);
constexpr size_t WS_ACT = WS_ROWGATE + al256((size_t)MAXROWS * 4);
constexpr size_t WS_Y = WS_ACT + al256((size_t)MAXROWS * DFF * 2);
constexpr size_t WS_WIN = WS_Y + al256((size_t)MAXROWS * D * 2);
constexpr size_t WS_WOUT = WS_WIN + al256((size_t)DEPTH * NU * D * 2);
constexpr size_t WS_WGU = WS_WOUT + al256((size_t)DEPTH * D * D * 2);
constexpr size_t WS_WD = WS_WGU + al256((size_t)DEPTH * NEXP * 2048 * D * 2);
constexpr int CTXC = CTX / 64, LATC = SEQ / 64, NRC = CTXC + LATC;
constexpr size_t WS_SZ = WS_WD + al256((size_t)DEPTH * NEXP * D * DFF * 2);
constexpr size_t WS_SDEC = WS_SZ + al256((size_t)BATCH * 16 * NRC * 64 * 128 * 4);
constexpr size_t WS_SST = WS_SDEC + al256((size_t)BATCH * 16 * NRC * 4);
constexpr int RKT = 16, NCK = (CTX + SEQ) / RKT;
constexpr int RK_PA = 0, RK_RA = 8192, RK_QA = 10240, RK_VB = 11264, RK_ZC = 15360, RK_BYTES = 31744;
constexpr size_t WS_RK = WS_SST + al256((size_t)BATCH * 16 * NRC * 64 * 128 * 2);
constexpr int GC_CTX = CTX / 32, GC_LAT = SEQ / 32, GNC = GC_CTX + GC_LAT;
constexpr size_t WS_GZ = WS_RK + al256((size_t)BATCH * 8 * NCK * RK_BYTES);
constexpr size_t WS_GDEC = WS_GZ + al256((size_t)BATCH * 8 * GNC * 2048 * 4);
constexpr size_t WS_GST = WS_GDEC + al256((size_t)BATCH * 8 * GNC * 32 * 4);
constexpr size_t WS_END = WS_GST + al256((size_t)BATCH * 8 * GNC * 2048 * 2);
constexpr int CW_BAR = 4096;
constexpr int CW_CNT = 16384;
constexpr int CW_CUR = 16384 + 64 * 8;
constexpr int LDS_STAGE = 131072;
constexpr int LDS_TILE_E = LDS_STAGE;
constexpr int LDS_MISC = LDS_STAGE + 2048;
constexpr int LDS_BYTES = 147456;

#ifdef EMU
#define LAS
#define ASM_VM0() ((void)0)
#define ASM_LGKM0() ((void)0)
#define ASM_MEMFENCE() ((void)0)
#define WAIT_V(n) ((void)0)
#define WAIT_L(n) ((void)0)
#define WAVE_LDS_FENCE() emu_wave_sync()
#define LAUNDER_V(x) ((void)0)
#else
#define LAS __attribute__((address_space(3)))
#define ASM_VM0() asm volatile("s_waitcnt vmcnt(0)" ::: "memory")
#define ASM_LGKM0() asm volatile("s_waitcnt lgkmcnt(0)" ::: "memory")
#define ASM_MEMFENCE() asm volatile("" ::: "memory")
#define WAIT_V(n) asm volatile("s_waitcnt vmcnt(" #n ")" ::: "memory")
#define WAIT_L(n) asm volatile("s_waitcnt lgkmcnt(" #n ")" ::: "memory")
#define LAUNDER_V(x) asm volatile("" : "+v"(x))
#define WAVE_LDS_FENCE() do { asm volatile("s_waitcnt lgkmcnt(0)" ::: "memory"); } while (0)
#endif

typedef unsigned short bf16_t;
typedef short bf16x8 __attribute__((ext_vector_type(8)));
typedef float f32x4 __attribute__((ext_vector_type(4)));
typedef float f32x2 __attribute__((ext_vector_type(2)));
typedef unsigned u32x4 __attribute__((ext_vector_type(4)));
typedef unsigned u32x2 __attribute__((ext_vector_type(2)));

__device__ __forceinline__ unsigned f2bf(float f) { unsigned u = __float_as_uint(f); return (u + 0x7fffu + ((u >> 16) & 1u)) >> 16; }
__device__ __forceinline__ unsigned pk2(float lo, float hi) { return f2bf(lo) | (f2bf(hi) << 16); }
__device__ __forceinline__ float bf_lo(unsigned w) { return __uint_as_float(w << 16); }
__device__ __forceinline__ float bf_hi(unsigned w) { return __uint_as_float(w & 0xffff0000u); }
__device__ __forceinline__ float wave_sum(float v) {
#pragma unroll
    for (int o = 1; o < 64; o <<= 1) v += __shfl_xor(v, o);
    return v;
}
__device__ __forceinline__ float sum8(float v) { v += __shfl_xor(v, 1); v += __shfl_xor(v, 2); v += __shfl_xor(v, 4); return v; }
__device__ __forceinline__ float sigmoidf_(float x) { return 1.0f / (1.0f + expf(-x)); }
__device__ __forceinline__ float siluf_(float x) { return x / (1.0f + expf(-x)); }
__device__ __forceinline__ float softplusf_(float x) { return fmaxf(x, 0.f) + log1pf(expf(-fabsf(x))); }
__device__ __forceinline__ float logsigmoidf_(float x) { return -softplusf_(-x); }

#define XB_TMO      128
#define XB_XCNT(j)  (256  + 64 * (j))
#define XB_XSUB(j)  (1280 + 64 * (j))
#define XB_XGEN(j)  (2304 + 64 * (j))
#define XB_TOP      3328
#define XB_TOPGEN   3392
#define XCD_BAR_WORDS 3456
#ifdef EMU
#define XB_SPIN_CAP (0xffffffffu)
#else
#define XB_SPIN_CAP (1u << 22)
#endif
__device__ __forceinline__ unsigned xb_ld(unsigned* p)              { return __hip_atomic_load(p, __ATOMIC_RELAXED, __HIP_MEMORY_SCOPE_AGENT); }
__device__ __forceinline__ unsigned xb_add(unsigned* p, unsigned v) { return __hip_atomic_fetch_add(p, v, __ATOMIC_RELAXED, __HIP_MEMORY_SCOPE_AGENT); }
__device__ __forceinline__ unsigned xb_xcc_id() { return (unsigned)__builtin_amdgcn_s_getreg((3 << 11) | 20) & 0xFu; }
#define XB_SPIN(cond, bar) do { unsigned _sp = 0; while (cond) { __builtin_amdgcn_s_sleep(1); \
    if ((++_sp & 255u) == 0u) { if (xb_ld(&(bar)[XB_TMO])) break; if (_sp > XB_SPIN_CAP) { atomicAdd(&(bar)[XB_TMO], 1u); break; } } } } while (0)
struct XcdBarrier { unsigned* bar; unsigned x; volatile LAS unsigned* st; };
__device__ __forceinline__ XcdBarrier xcd_barrier_post(unsigned* bar, volatile LAS unsigned* st) {
    XcdBarrier b; b.bar = bar; b.x = xb_xcc_id(); b.st = st;
    if (threadIdx.x == 0) (void)xb_add(&bar[XB_XCNT(b.x)], 1u);
    return b;
}
__device__ __forceinline__ void xcd_barrier_complete(unsigned* bar, unsigned x, unsigned& nloc, unsigned& nx) {
    const unsigned G = gridDim.x * gridDim.y * gridDim.z;
    unsigned sum, cnt, mine, sp = 0u;
    for (;;) {
        sum = 0u; cnt = 0u; mine = 0u;
#pragma unroll
        for (unsigned j = 0; j < 16; ++j) { const unsigned c = xb_ld(&bar[XB_XCNT(j)]); sum += c; cnt += (c > 0u) ? 1u : 0u; mine = (j == x) ? c : mine; }
        if (sum == G) break;
        __builtin_amdgcn_s_sleep(1);
        if ((++sp & 255u) == 0u) { if (xb_ld(&bar[XB_TMO])) break; if (sp > XB_SPIN_CAP) { atomicAdd(&bar[XB_TMO], 1u); break; } }
    }
    nloc = mine > 0u ? mine : 1u; nx = cnt > 0u ? cnt : 1u;
}
__device__ __forceinline__ void xcd_barrier(const XcdBarrier& b) {
    ASM_VM0();
    __syncthreads();
    if (threadIdx.x == 0) {
        unsigned* bar = b.bar;
        __builtin_amdgcn_s_waitcnt(0);
        unsigned nloc = b.st[0], nx = b.st[1];
        if (nloc == 0u) { xcd_barrier_complete(bar, b.x, nloc, nx); b.st[0] = nloc; b.st[1] = nx; }
        const unsigned old = xb_add(&bar[XB_XSUB(b.x)], 1u);
        const unsigned gen = old / nloc;
        if (old + 1u == (gen + 1u) * nloc) {
            __builtin_amdgcn_fence(__ATOMIC_RELEASE, "agent");
            ASM_VM0();
            const unsigned og = xb_add(&bar[XB_TOP], 1u);
            const unsigned tg = og / nx;
            if (og + 1u == (tg + 1u) * nx) xb_add(&bar[XB_TOPGEN], 1u);
            else XB_SPIN(xb_ld(&bar[XB_TOPGEN]) == tg, bar);
            __builtin_amdgcn_fence(__ATOMIC_ACQUIRE, "agent");
            xb_add(&bar[XB_XGEN(b.x)], 1u);
            ASM_VM0();
        } else {
            XB_SPIN(xb_ld(&bar[XB_XGEN(b.x)]) == gen, bar);
            __builtin_amdgcn_fence(__ATOMIC_ACQUIRE, "agent");
            ASM_VM0();
        }
    }
    __syncthreads();
}

namespace pg8 {
constexpr int BM = 256, BK = 64, HALF = 128, HTB = HALF * BK * 2, STAGE_BYTES = 8 * HTB, NXCD = 8, WGM = 8;
__host__ __device__ __forceinline__ int lds_byte(int r, int c) { const int st = (r >> 4) * 2 + (c >> 5), rr = r & 15, cc = c & 31, ob = rr * 64 + cc * 2; return st * 1024 + (ob ^ (((ob >> 9) & 1) << 5)); }
__host__ __device__ __forceinline__ void stage_rc(int b, int& R, int& C) { const int st = b / 1024, sb = b % 1024, swz = sb ^ (((sb >> 9) & 1) << 5); R = (st >> 1) * 16 + swz / 64; C = (st & 1) * 32 + (swz % 64) / 2; }
__host__ __device__ __forceinline__ int perm32(int rho) { const int n = rho >> 4, i = rho & 15; return 8 * (i >> 2) + 4 * n + (i & 3); }
struct Unit { int pm, pn, pb; };
struct Gemm { const bf16_t* A; const bf16_t* Bt; int K; const int* rowidx; };
struct Order {
    int nM, nN, nwg, G, c;
    __device__ __forceinline__ void init(int nM_, int nN_, int G_, int c_) { nM = nM_; nN = nN_; nwg = nM * nN; G = G_; c = c_; }
    __device__ __forceinline__ bool tile(int i, int& pm, int& pn) const {
        const long L = (long)i * G + c; if (L >= nwg) return false;
        int wgid = (int)L; { const int q = nwg / NXCD, r = nwg % NXCD, xcd = wgid % NXCD, off = wgid / NXCD; wgid = (xcd < r ? xcd * (q + 1) : r * (q + 1) + (xcd - r) * q) + off; }
        const int nig = WGM * nN, gid = wgid / nig, fm = gid * WGM, gsz = (nM - fm) < WGM ? (nM - fm) : WGM;
        pm = fm + ((wgid % nig) % gsz); pn = (wgid % nig) / gsz; return true;
    }
};
struct DenseSched { Order o; __device__ __forceinline__ bool next(int i, Unit& u) const { if (!o.tile(i, u.pm, u.pn)) return false; u.pb = u.pn; return true; } };
struct MoeSched { Order o; const LAS int* tile_e; int nct;
    __device__ __forceinline__ bool next(int i, Unit& u) const { if (!o.tile(i, u.pm, u.pn)) return false; u.pb = tile_e[u.pm] * nct + u.pn; return true; } };

__device__ __forceinline__ unsigned cvt_pk_bf16(float lo, float hi) {
#ifdef EMU
    return pk2(lo, hi);
#else
    unsigned r; asm volatile("v_cvt_pk_bf16_f32 %0, %1, %2" : "=v"(r) : "v"(lo), "v"(hi)); return r;
#endif
}
struct EpiF32 {
    static constexpr bool PERM = false;
    float* C; int ldc;
    __device__ __forceinline__ void operator()(const f32x4 (&acc)[2][2][4][2], const Unit& u, int wr, int wc, int fr, int fq) const {
        const int row0 = u.pm * BM + wr * 64 + fr, col0 = u.pn * BM + wc * 32 + 4 * fq;
#pragma unroll
        for (int ai = 0; ai < 2; ++ai)
#pragma unroll
            for (int m = 0; m < 4; ++m) { float* rowp = C + (size_t)(row0 + ai * HALF + m * 16) * ldc + col0;
#pragma unroll
                for (int bj = 0; bj < 2; ++bj)
#pragma unroll
                    for (int n = 0; n < 2; ++n) *(f32x4*)(rowp + bj * HALF + n * 16) = acc[ai][bj][m][n]; }
    }
};
struct EpiResid {
    static constexpr bool PERM = false;
    float* X; const float* mods;
    __device__ __forceinline__ void operator()(const f32x4 (&acc)[2][2][4][2], const Unit& u, int wr, int wc, int fr, int fq) const {
        const int row0 = u.pm * BM + wr * 64 + fr, col0 = u.pn * BM + wc * 32 + 4 * fq;
        const int rbase = u.pm * BM; const int mrow = rbase < ML ? rbase / SEQ : BATCH;
        const float* g = mods + (size_t)mrow * 6144 + 2 * 1024 + col0;
        f32x4 gv[2][2];
#pragma unroll
        for (int bj = 0; bj < 2; ++bj)
#pragma unroll
            for (int n = 0; n < 2; ++n) gv[bj][n] = *(const f32x4*)(g + bj * HALF + n * 16);
#pragma unroll
        for (int ai = 0; ai < 2; ++ai)
#pragma unroll
            for (int m = 0; m < 4; ++m) { float* rowp = X + (size_t)(row0 + ai * HALF + m * 16) * D + col0;
#pragma unroll
                for (int bj = 0; bj < 2; ++bj)
#pragma unroll
                    for (int n = 0; n < 2; ++n) { f32x4* p = (f32x4*)(rowp + bj * HALF + n * 16); *p = *p + gv[bj][n] * acc[ai][bj][m][n]; } }
    }
};
struct EpiSwiglu {
    static constexpr bool PERM = true;
    bf16_t* ACT; const float* bgu;
    __device__ __forceinline__ void operator()(const f32x4 (&acc)[2][2][4][2], const Unit& u, int wr, int wc, int fr, int fq) const {
        const int e = u.pb >> 3;
        const int row0 = u.pm * BM + wr * 64 + fr, j0 = u.pn * 128 + wc * 32 + 8 * fq;
        const float* bg = bgu + (size_t)e * 2048 + j0;
        f32x4 bgl[2], bln[2];
#pragma unroll
        for (int n = 0; n < 2; ++n) { bgl[n] = *(const f32x4*)(bg + 4 * n); bln[n] = *(const f32x4*)(bg + 1024 + 4 * n); }
#pragma unroll
        for (int ai = 0; ai < 2; ++ai)
#pragma unroll
            for (int m = 0; m < 4; ++m) { bf16_t* rowp = ACT + (size_t)(row0 + ai * HALF + m * 16) * DFF + j0;
                float o[8];
#pragma unroll
                for (int n = 0; n < 2; ++n)
#pragma unroll
                    for (int j = 0; j < 4; ++j) { float gl = acc[ai][0][m][n][j] + bgl[n][j], ln = acc[ai][1][m][n][j] + bln[n][j];
                        gl = fminf(gl, 7.0f); ln = fminf(fmaxf(ln, -7.0f), 7.0f);
                        o[n * 4 + j] = gl / (1.0f + __expf(-1.702f * gl)) * (ln + 1.0f); }
                u32x4 w; w.x = cvt_pk_bf16(o[0], o[1]); w.y = cvt_pk_bf16(o[2], o[3]); w.z = cvt_pk_bf16(o[4], o[5]); w.w = cvt_pk_bf16(o[6], o[7]);
                *(u32x4*)rowp = w; }
    }
};
struct EpiDown {
    static constexpr bool PERM = true;
    bf16_t* Y; const float* bd; const float* rowgate;
    __device__ __forceinline__ void operator()(const f32x4 (&acc)[2][2][4][2], const Unit& u, int wr, int wc, int fr, int fq) const {
        const int e = u.pb >> 2;
        const int row0 = u.pm * BM + wr * 64 + fr, col0 = u.pn * BM + wc * 32 + 8 * fq;
        const float* b = bd + (size_t)e * 1024 + col0;
        f32x4 bv[2][2];
#pragma unroll
        for (int bj = 0; bj < 2; ++bj)
#pragma unroll
            for (int n = 0; n < 2; ++n) bv[bj][n] = *(const f32x4*)(b + bj * HALF + 4 * n);
#pragma unroll
        for (int ai = 0; ai < 2; ++ai)
#pragma unroll
            for (int m = 0; m < 4; ++m) { const int row = row0 + ai * HALF + m * 16; const float gt = rowgate[row]; bf16_t* rowp = Y + (size_t)row * D + col0;
#pragma unroll
                for (int bj = 0; bj < 2; ++bj) { const f32x4 v0 = (acc[ai][bj][m][0] + bv[bj][0]) * gt, v1 = (acc[ai][bj][m][1] + bv[bj][1]) * gt;
                    u32x4 w; w.x = cvt_pk_bf16(v0[0], v0[1]); w.y = cvt_pk_bf16(v0[2], v0[3]); w.z = cvt_pk_bf16(v1[0], v1[1]); w.w = cvt_pk_bf16(v1[2], v1[3]);
                    *(u32x4*)(rowp + bj * HALF) = w; } }
    }
};

template <class Epi, class Sched, bool GATHER>
__device__ __forceinline__ void gemm_phase(LAS unsigned char* lds, const int tid, const Gemm g, const Sched& S, const Epi& E) {
    const int wid = __builtin_amdgcn_readfirstlane(tid >> 6), lane = tid & 63, wr = wid >> 2, wc = wid & 3, fr = lane & 15, fq = lane >> 4;
    const int K = g.K, nt = K / BK;
    unsigned voffB[2]; int RA[2], CA[2];
#pragma unroll
    for (int i = 0; i < 2; ++i) { int R, C; stage_rc(tid * 16 + i * 8192, R, C); const int Rb = Epi::PERM ? ((R & ~31) + perm32(R & 31)) : R;
        RA[i] = R; CA[i] = C; voffB[i] = (unsigned)(Rb * K + C) * 2u; }
    const size_t kstep = (size_t)(BK * 2);
    const size_t hstep = (size_t)HALF * K * 2;
    const size_t tstep = 2 * hstep;
    const unsigned ldsw = (unsigned)wid * 1024u;
    const int aoff = lds_byte(wr * 64 + fr, fq * 8), boff = lds_byte(wc * 32 + fr, fq * 8);
#define PG8_SA(b, h) (((b) * 2 + (h)) * HTB)
#define PG8_SB(b, h) ((4 + (b) * 2 + (h)) * HTB)
#define PG8_STAGE(bufoff, gbase, voff) do { _Pragma("unroll") for (int _i = 0; _i < 2; ++_i) \
        __builtin_amdgcn_global_load_lds((const unsigned*)((const char*)(gbase) + (voff)[_i]), (LAS unsigned*)(lds + (bufoff) + ldsw + _i * 8192), 16, 0, 0); } while (0)
#define PG8_LDA(dst, b, h) do { _Pragma("unroll") for (int m = 0; m < 4; ++m) _Pragma("unroll") for (int k = 0; k < 2; ++k) dst[m][k] = *(const LAS bf16x8*)(lds + PG8_SA(b, h) + aoff + m * 2048 + k * 1024); } while (0)
#define PG8_LDB(dst, b, h) do { _Pragma("unroll") for (int n = 0; n < 2; ++n) _Pragma("unroll") for (int k = 0; k < 2; ++k) dst[n][k] = *(const LAS bf16x8*)(lds + PG8_SB(b, h) + boff + n * 2048 + k * 1024); } while (0)
#define PG8_MMA(ai, bj, At, Bt) do { __builtin_amdgcn_s_setprio(1); _Pragma("unroll") for (int m = 0; m < 4; ++m) _Pragma("unroll") for (int n = 0; n < 2; ++n) _Pragma("unroll") for (int k = 0; k < 2; ++k) \
        acc[ai][bj][m][n] = __builtin_amdgcn_mfma_f32_16x16x32_bf16(Bt[n][k], At[m][k], acc[ai][bj][m][n], 0, 0, 0); __builtin_amdgcn_s_setprio(0); } while (0)
#define PG8_BAR __builtin_amdgcn_s_barrier()
#define PG8_SCHED __builtin_amdgcn_sched_barrier(0)
#define PG8_AOFF(dst, unit) do { _Pragma("unroll") for (int _h = 0; _h < 2; ++_h) _Pragma("unroll") for (int _i = 0; _i < 2; ++_i) { \
        const int _r = (unit).pm * BM + _h * HALF + RA[_i]; const int _src = GATHER ? g.rowidx[_r] : _r; dst[_h][_i] = (unsigned)(_src * K + CA[_i]) * 2u; } } while (0)
    Unit cur, nxt; int ui = 0;
    if (!S.next(0, cur)) return;
    f32x4 acc[2][2][4][2];
#pragma unroll
    for (int a = 0; a < 2; ++a)
#pragma unroll
        for (int b = 0; b < 2; ++b)
#pragma unroll
            for (int m = 0; m < 4; ++m)
#pragma unroll
                for (int n = 0; n < 2; ++n) acc[a][b][m][n] = (f32x4){0.f, 0.f, 0.f, 0.f};
    bf16x8 At[4][2], B0[2][2], B1[2][2];
    unsigned cvA[2][2], nvA[2][2];
    PG8_AOFF(cvA, cur);
    const char* const gA = (const char*)g.A;
    const char* cB = (const char*)g.Bt + (size_t)cur.pb * tstep;
    PG8_STAGE(PG8_SB(0, 0), cB, voffB); PG8_STAGE(PG8_SA(0, 0), gA, cvA[0]); PG8_STAGE(PG8_SB(0, 1), cB + hstep, voffB); PG8_STAGE(PG8_SA(0, 1), gA, cvA[1]);
    if (wr == 1) PG8_BAR;
    WAIT_V(4); PG8_BAR;
    PG8_STAGE(PG8_SB(1, 0), cB + kstep, voffB); PG8_STAGE(PG8_SA(1, 0), gA + kstep, cvA[0]); PG8_STAGE(PG8_SB(1, 1), cB + hstep + kstep, voffB);
    WAIT_V(6); PG8_BAR;
    for (;;) {
        const bool has_next = S.next(ui + 1, nxt);
        if (has_next) { PG8_AOFF(nvA, nxt); } else {
#pragma unroll
            for (int h = 0; h < 2; ++h)
#pragma unroll
                for (int i = 0; i < 2; ++i) nvA[h][i] = cvA[h][i]; }
        const char* nB = has_next ? (const char*)g.Bt + (size_t)nxt.pb * tstep : cB;
        for (int t = 0; t < nt; t += 2) {
            const bool last = (t == nt - 2);
            const char* a1 = gA + (size_t)(t + 1) * kstep;
            const char* a2 = last ? gA : gA + (size_t)(t + 2) * kstep; const char* b2 = last ? nB : cB + (size_t)(t + 2) * kstep;
            const char* a3 = a2 + kstep; const char* b3 = b2 + kstep;
            unsigned xA0[2], xA1[2];
#pragma unroll
            for (int i = 0; i < 2; ++i) { xA0[i] = last ? nvA[0][i] : cvA[0][i]; xA1[i] = last ? nvA[1][i] : cvA[1][i]; }
            PG8_LDB(B0, 0, 0); PG8_SCHED; PG8_LDA(At, 0, 0); PG8_STAGE(PG8_SA(1, 1), a1, cvA[1]);
            WAIT_L(8); PG8_BAR; WAIT_L(0); PG8_MMA(0, 0, At, B0); PG8_BAR; PG8_SCHED;
            PG8_LDB(B1, 0, 1); PG8_STAGE(PG8_SB(0, 0), b2, voffB);
            PG8_BAR; WAIT_L(0); PG8_MMA(0, 1, At, B1); PG8_BAR;
            PG8_LDA(At, 0, 1); PG8_STAGE(PG8_SA(0, 0), a2, xA0);
            PG8_BAR; WAIT_L(0); PG8_MMA(1, 0, At, B0); PG8_BAR; PG8_SCHED;
            PG8_STAGE(PG8_SB(0, 1), b2 + hstep, voffB);
            WAIT_V(6); PG8_BAR; PG8_MMA(1, 1, At, B1); PG8_BAR;
            PG8_LDB(B0, 1, 0); PG8_SCHED; PG8_LDA(At, 1, 0); PG8_STAGE(PG8_SA(0, 1), a2, xA1);
            WAIT_L(8); PG8_BAR; WAIT_L(0); PG8_MMA(0, 0, At, B0); PG8_BAR; PG8_SCHED;
            PG8_LDB(B1, 1, 1); PG8_STAGE(PG8_SB(1, 0), b3, voffB);
            PG8_BAR; WAIT_L(0); PG8_MMA(0, 1, At, B1); PG8_BAR;
            PG8_LDA(At, 1, 1); PG8_STAGE(PG8_SA(1, 0), a3, xA0);
            PG8_BAR; WAIT_L(0); PG8_MMA(1, 0, At, B0); PG8_BAR; PG8_SCHED;
            PG8_STAGE(PG8_SB(1, 1), b3 + hstep, voffB);
            WAIT_V(6); PG8_BAR; PG8_MMA(1, 1, At, B1); PG8_BAR;
        }
        E(acc, cur, wr, wc, fr, fq);
        if (!has_next) break;
#pragma unroll
        for (int a = 0; a < 2; ++a)
#pragma unroll
            for (int b = 0; b < 2; ++b)
#pragma unroll
                for (int m = 0; m < 4; ++m)
#pragma unroll
                    for (int n = 0; n < 2; ++n) acc[a][b][m][n] = (f32x4){0.f, 0.f, 0.f, 0.f};
        cur = nxt; cB = nB; ++ui;
#pragma unroll
        for (int h = 0; h < 2; ++h)
#pragma unroll
            for (int i = 0; i < 2; ++i) cvA[h][i] = nvA[h][i];
    }
    WAIT_V(0);
    if (wr == 0) PG8_BAR;
    PG8_BAR;
#undef PG8_SA
#undef PG8_SB
#undef PG8_STAGE
#undef PG8_LDA
#undef PG8_LDB
#undef PG8_MMA
#undef PG8_BAR
#undef PG8_SCHED
#undef PG8_AOFF
}
}

struct Args { const float* in[37]; float* out; unsigned char* ws; int ph_lo, ph_hi; };
enum { I_X = 0, I_C, I_CTX, I_CCTX, I_WADA, I_BADA, I_N1G, I_N2G, I_WIN, I_GGW, I_GGB, I_GNG, I_RMU, I_RW0, I_RW2, I_RA0, I_RA2, I_RG2, I_RKK, I_RKA, I_RRK,
       I_RLG, I_RLB, I_SCW, I_SCB, I_SDTB, I_SALOG, I_SD, I_SNG, I_WOUT, I_ROUTW, I_ROUTB, I_WGU, I_BGU, I_WDN, I_BDN, I_FNG };

struct Tc { LAS unsigned char* lds; int tid, lane, wave, G, bid; };

__device__ __forceinline__ void transpose_item(const float* W, int ldw, int k0, int n0, int nv, bf16_t* dst, int K, LAS float* scr, int lane) {
#pragma unroll 8
    for (int i = 0; i < 32; ++i) { const int kk = 2 * i + (lane >> 5), c = lane & 31; scr[kk * 33 + c] = (c < nv) ? W[(size_t)(k0 + kk) * ldw + n0 + c] : 0.f; }
    WAVE_LDS_FENCE();
    const int c = lane & 7;
#pragma unroll
    for (int j = 0; j < 4; ++j) { const int n = (lane >> 3) + 8 * j; const LAS float* s = scr + (8 * c) * 33 + n;
        u32x4 o; o.x = pk2(s[0 * 33], s[1 * 33]); o.y = pk2(s[2 * 33], s[3 * 33]); o.z = pk2(s[4 * 33], s[5 * 33]); o.w = pk2(s[6 * 33], s[7 * 33]);
        *(u32x4*)(dst + (size_t)n * K + k0 + 8 * c) = o; }
    WAVE_LDS_FENCE();
}
__device__ __forceinline__ void phase_pro0(const Args& a, const Tc& t) {
    LAS float* scr = (LAS float*)(t.lds + t.wave * 16384);
    const int gw = t.bid * NWAVES + t.wave, NGW = t.G * NWAVES;
    constexpr int KB = D / 64;
    constexpr int I_IN = KB * (NU / 32), I_OUT = KB * (D / 32), I_GU = KB * (2048 / 32), I_DN = KB * (D / 32);
    constexpr int IPL = I_IN + I_OUT + NEXP * (I_GU + I_DN);
    bf16_t* WIN = (bf16_t*)(a.ws + WS_WIN); bf16_t* WOUT = (bf16_t*)(a.ws + WS_WOUT); bf16_t* WGU = (bf16_t*)(a.ws + WS_WGU); bf16_t* WDN = (bf16_t*)(a.ws + WS_WD);
    for (int it = gw; it < DEPTH * IPL; it += NGW) {
        const int l = it / IPL; int r = it % IPL;
        if (r < I_IN) { const int kb = r / (NU / 32), nb = r % (NU / 32), n0 = nb * 32; int nv = IN_COLS - n0; nv = nv < 0 ? 0 : (nv > 32 ? 32 : nv);
            transpose_item(a.in[I_WIN] + (size_t)l * D * IN_COLS, IN_COLS, kb * 64, n0, nv, WIN + ((size_t)l * NU + n0) * D, D, scr, t.lane); continue; }
        r -= I_IN;
        if (r < I_OUT) { const int kb = r / (D / 32), nb = r % (D / 32);
            transpose_item(a.in[I_WOUT] + (size_t)l * D * D, D, kb * 64, nb * 32, 32, WOUT + ((size_t)l * D + nb * 32) * D, D, scr, t.lane); continue; }
        r -= I_OUT;
        const int e = r / (I_GU + I_DN); r = r % (I_GU + I_DN);
        if (r < I_GU) { const int kb = r / 64, nb = r % 64, n0 = nb * 32; const int half = n0 >> 10, rem = n0 & 1023, pn = rem >> 7, jj = rem & 127;
            transpose_item(a.in[I_WGU] + ((size_t)l * NEXP + e) * D * 2048, 2048, kb * 64, n0, 32, WGU + (((size_t)l * NEXP + e) * 2048 + pn * 256 + half * 128 + jj) * D, D, scr, t.lane); continue; }
        r -= I_GU;
        { const int kb = r / (D / 32), nb = r % (D / 32);
            transpose_item(a.in[I_WDN] + ((size_t)l * NEXP + e) * DFF * D, D, kb * 64, nb * 32, 32, WDN + (((size_t)l * NEXP + e) * D + nb * 32) * DFF, DFF, scr, t.lane); }
    }
    __syncthreads();
    LAS float* sc = (LAS float*)t.lds;
    LAS float* red = (LAS float*)(t.lds + 32768);
    for (int i = t.tid; i < NR * D; i += NTHREADS) { const int r = i / D, k = i % D; const float v = r < BATCH ? a.in[I_C][r * D + k] : a.in[I_CCTX][k]; sc[i] = siluf_(v); }
    __syncthreads();
    float* MODS = (float*)(a.ws + WS_MODS);
    const int jl = t.tid & 127, kq = t.tid >> 7;
    for (int cb = t.bid; cb < DEPTH * 48; cb += t.G) {
        const int l = cb / 48, j = (cb % 48) * 128 + jl;
        const float* w = a.in[I_WADA] + (size_t)l * D * 6144 + j;
        float acc[NR];
#pragma unroll
        for (int r = 0; r < NR; ++r) acc[r] = 0.f;
        for (int k = kq * 256; k < kq * 256 + 256; ++k) { const float wv = w[(size_t)k * 6144];
#pragma unroll
            for (int r = 0; r < NR; ++r) acc[r] += sc[r * D + k] * wv; }
#pragma unroll
        for (int r = 0; r < NR; ++r) red[(kq * NR + r) * 128 + jl] = acc[r];
        __syncthreads();
        if (kq == 0) {
            const float bb = a.in[I_BADA][(size_t)l * 6144 + j];
#pragma unroll
            for (int r = 0; r < NR; ++r) MODS[((size_t)l * NR + r) * 6144 + j] = red[(0 * NR + r) * 128 + jl] + red[(1 * NR + r) * 128 + jl] + red[(2 * NR + r) * 128 + jl] + red[(3 * NR + r) * 128 + jl] + bb;
        }
        __syncthreads();
    }
}

__device__ __forceinline__ int mod_row(int row) { return row < ML ? row / SEQ : BATCH; }
__device__ __forceinline__ void norm_mod_store(const f32x4 (&v)[4], const float* g, const float* shift, const float* scale, bf16_t* hrow, int lane, f32x4 (&hout)[4]) {
    float ss = 0.f;
#pragma unroll
    for (int j = 0; j < 4; ++j) ss += (v[j][0] * v[j][0] + v[j][1] * v[j][1]) + (v[j][2] * v[j][2] + v[j][3] * v[j][3]);
    const float rstd = 1.0f / sqrtf(wave_sum(ss) * (1.0f / D) + 1e-6f);
#pragma unroll
    for (int j = 0; j < 4; ++j) { const int c = 4 * lane + 256 * j;
        const f32x4 gg = *(const f32x4*)(g + c), sh = *(const f32x4*)(shift + c), sc = *(const f32x4*)(scale + c);
        const f32x4 h = (v[j] * rstd * gg) * (sc + 1.0f) + sh; hout[j] = h;
        u32x2 w; w.x = pk2(h[0], h[1]); w.y = pk2(h[2], h[3]); *(u32x2*)(hrow + c) = w; }
}
__device__ __forceinline__ void phase_pro1(const Args& a, const Tc& t) {
    const int gw = t.bid * NWAVES + t.wave, NGW = t.G * NWAVES;
    float* X = (float*)(a.ws + WS_X); bf16_t* H = (bf16_t*)(a.ws + WS_H); const float* MODS = (const float*)(a.ws + WS_MODS);
    for (int row = gw; row < M; row += NGW) {
        const float* src = row < ML ? a.in[I_X] + (size_t)row * D : a.in[I_CTX] + (size_t)(row - ML) * D;
        f32x4 v[4], h[4];
#pragma unroll
        for (int j = 0; j < 4; ++j) { v[j] = *(const f32x4*)(src + 4 * t.lane + 256 * j); *(f32x4*)(X + (size_t)row * D + 4 * t.lane + 256 * j) = v[j]; }
        const float* md = MODS + (size_t)mod_row(row) * 6144;
        norm_mod_store(v, a.in[I_N1G], md, md + 1024, H + (size_t)row * D, t.lane, h);
    }
}

__device__ __forceinline__ void seg_bounds(int row, int& lo, int& hi) {
    if (row < ML) { lo = row & ~63; hi = lo + 64; } else { lo = ML + ((row - ML) / CTX) * CTX; hi = lo + CTX; }
}
__device__ __forceinline__ void phase_prep(const Args& a, const Tc& t, int l) {
    const float* U = (const float*)(a.ws + WS_U);
    float* GG = (float*)(a.ws + WS_GG); float* RW7 = (float*)(a.ws + WS_RW7); float* SXBC = (float*)(a.ws + WS_SXBC); float* SDT = (float*)(a.ws + WS_SDT);
    const float* mu = a.in[I_RMU] + (size_t)l * 2 * 928;
    const float* w0 = a.in[I_RW0] + (size_t)l * 2 * 256; const float* w2 = a.in[I_RW2] + (size_t)l * 2 * 32 * 256;
    const float* a0 = a.in[I_RA0] + (size_t)l * 256; const float* a2 = a.in[I_RA2] + (size_t)l * 32 * 256;
    const float* rkk = a.in[I_RKK] + (size_t)l * 256; const float* rka = a.in[I_RKA] + (size_t)l * 256;
    const float* ggw = a.in[I_GGW] + (size_t)l * 2 * 16 * 128; const float* ggb = a.in[I_GGB] + (size_t)l * 2 * 128;
    const float* cw = a.in[I_SCW] + (size_t)l * 4 * 1024; const float* cb = a.in[I_SCB] + (size_t)l * 1024;
    const float* dtb = a.in[I_SDTB] + (size_t)l * 16;
    LAS float* LOW = (LAS float*)t.lds;
    for (int tile = t.bid; tile < M / 16; tile += t.G) {
        const int r0 = tile * 16; int slo, shi; seg_bounds(r0, slo, shi);
        {
            const int tt = t.tid >> 5, r = t.tid & 31, row = r0 + tt;
            const float* up = U + (size_t)row * NU; const bool hp = row - 1 >= slo, hn = row + 1 < shi;
#pragma unroll
            for (int q = 0; q < 3; ++q) { const int col = U_RLWF + q * 32 + r, mi = col - U_RW;
                const float u = up[col], pv = hp ? up[col - NU] : 0.f, nv = hn ? up[col + NU] : 0.f;
                const float s = u + mu[mi] * (pv - u) + mu[928 + mi] * (nv - u);
                LOW[tt * 128 + q * 32 + r] = q < 2 ? tanhf(s) : s; }
            LOW[tt * 128 + 96 + r] = up[U_GLF + r];
        }
        __syncthreads();
        {
            const int c = t.tid & 255, tt0 = (t.tid >> 8) * 8;
            float aa[8], af[8], ab[8];
#pragma unroll
            for (int j = 0; j < 8; ++j) { aa[j] = a0[c]; af[j] = w0[c]; ab[j] = w0[256 + c]; }
#pragma unroll 2
            for (int r4 = 0; r4 < 8; ++r4) { float wa[4], wf[4], wb[4];
#pragma unroll
                for (int q = 0; q < 4; ++q) { wa[q] = a2[(4 * r4 + q) * 256 + c]; wf[q] = w2[(4 * r4 + q) * 256 + c]; wb[q] = w2[(32 + 4 * r4 + q) * 256 + c]; }
#pragma unroll
                for (int j = 0; j < 8; ++j) { const LAS float* lw = LOW + (tt0 + j) * 128;
                    const f32x4 la = *(const LAS f32x4*)(lw + 64 + 4 * r4), lf = *(const LAS f32x4*)(lw + 4 * r4), lb = *(const LAS f32x4*)(lw + 32 + 4 * r4);
#pragma unroll
                    for (int q = 0; q < 4; ++q) { aa[j] += la[q] * wa[q]; af[j] += lf[q] * wf[q]; ab[j] += lb[q] * wb[q]; } } }
            const float m0r = mu[c], m1r = mu[928 + c], m0k = mu[256 + c], m1k = mu[928 + 256 + c], m0v = mu[512 + c], m1v = mu[928 + 512 + c];
            const float kkg = rkk[c], kag = rka[c];
#pragma unroll
            for (int j = 0; j < 8; ++j) { const int row = r0 + tt0 + j; const float* up = U + (size_t)row * NU; const bool hp = row - 1 >= slo, hn = row + 1 < shi;
                float u, pv, nv;
                u = up[U_RR + c]; pv = hp ? up[U_RR + c - NU] : 0.f; nv = hn ? up[U_RR + c + NU] : 0.f; const float rs = u + m0r * (pv - u) + m1r * (nv - u);
                u = up[U_RK + c]; pv = hp ? up[U_RK + c - NU] : 0.f; nv = hn ? up[U_RK + c + NU] : 0.f; const float ks = u + m0k * (pv - u) + m1k * (nv - u);
                u = up[U_RV + c]; pv = hp ? up[U_RV + c - NU] : 0.f; nv = hn ? up[U_RV + c + NU] : 0.f; const float vs = u + m0v * (pv - u) + m1v * (nv - u);
                const float av = sigmoidf_(aa[j]);
                const float wfv = expf(-0.606531f * sigmoidf_(af[j])), wbv = expf(-0.606531f * sigmoidf_(ab[j]));
                const float kr = ks * kkg; const float ssq = wave_sum(kr * kr); const float kk = kr * (1.0f / sqrtf(ssq + 1e-12f));
                const float kf = ks * (1.0f + (av - 1.0f) * kag);
                const size_t o = (size_t)row * 256 + c, P = (size_t)M * 256;
                RW7[o] = rs; RW7[P + o] = kf; RW7[2 * P + o] = vs; RW7[3 * P + o] = kk; RW7[4 * P + o] = kk * av; RW7[5 * P + o] = wfv; RW7[6 * P + o] = wbv; }
        }
        {
            const int j = t.tid & 127, dq = t.tid >> 7, dir = dq & 1, tt0 = (dq >> 1) * 8;
            float acc[8];
#pragma unroll
            for (int q = 0; q < 8; ++q) acc[q] = ggb[dir * 128 + j];
#pragma unroll
            for (int r4 = 0; r4 < 4; ++r4) { float w[4];
#pragma unroll
                for (int q2 = 0; q2 < 4; ++q2) w[q2] = ggw[(dir * 16 + 4 * r4 + q2) * 128 + j];
#pragma unroll
                for (int q = 0; q < 8; ++q) { const f32x4 lv = *(const LAS f32x4*)(LOW + (tt0 + q) * 128 + 96 + dir * 16 + 4 * r4);
                    acc[q] += (lv[0] * w[0] + lv[1] * w[1]) + (lv[2] * w[2] + lv[3] * w[3]); } }
#pragma unroll
            for (int q = 0; q < 8; ++q) GG[((size_t)dir * M + r0 + tt0 + q) * 128 + j] = logsigmoidf_(acc[q]) * (1.0f / 16.0f);
        }
        {
#pragma unroll
            for (int cc = 0; cc < 2; ++cc) { const int col = t.tid + cc * 512; const float* up = U + U_SXBC + col;
                const float c0 = cw[col], c1 = cw[1024 + col], c2 = cw[2048 + col], c3 = cw[3072 + col], bb = cb[col];
                float um2 = (r0 - 2 >= slo) ? up[(size_t)(r0 - 2) * NU] : 0.f, um1 = (r0 - 1 >= slo) ? up[(size_t)(r0 - 1) * NU] : 0.f, u0 = up[(size_t)r0 * NU];
#pragma unroll
                for (int q = 0; q < 16; ++q) { const int row = r0 + q; const float up1 = (row + 1 < shi) ? up[(size_t)(row + 1) * NU] : 0.f;
                    const float y = c0 * um2 + c1 * um1 + c2 * u0 + c3 * up1 + bb;
                    SXBC[(size_t)row * 1024 + col] = siluf_(y); um2 = um1; um1 = u0; u0 = up1; } }
        }
        if (t.tid < 256) { const int tt = t.tid >> 4, j = t.tid & 15, row = r0 + tt; SDT[(size_t)row * 16 + j] = softplusf_(U[(size_t)row * NU + U_SDT + j] + dtb[j]); }
        __syncthreads();
    }
}

__device__ __forceinline__ int chain_row(int b, int dir, int s) {
    if (s < CTX) return ML + b * CTX + (dir ? CTX - 1 - s : s);
    const int tt = s - CTX; return b * SEQ + (dir ? SEQ - 1 - tt : tt);
}

__device__ __forceinline__ f32x4 mma16(f32x4 acc, const LAS bf16_t* A, int lda, const LAS bf16_t* Bt, int ldb, int K, int lane) {
    const int r = lane & 15, kq = (lane >> 4) * 8;
    for (int k0 = 0; k0 < K; k0 += 32) {
        const bf16x8 av = *(const LAS bf16x8*)(A + r * lda + k0 + kq), bv = *(const LAS bf16x8*)(Bt + r * ldb + k0 + kq);
        acc = __builtin_amdgcn_mfma_f32_16x16x32_bf16(av, bv, acc, 0, 0, 0);
    }
    return acc;
}
__device__ __forceinline__ float wave_incl_scan(float v, int lane) {
#pragma unroll
    for (int o = 1; o < 64; o <<= 1) { const float u = __shfl_up(v, o); if (lane >= o) v += u; }
    return v;
}
__device__ __forceinline__ int rc_row0(int b, int c) { return c < CTXC ? ML + b * CTX + 64 * c : b * SEQ + 64 * (c - CTXC); }
__device__ __forceinline__ int rc_chain_pos(int c, int dir) { return dir == 0 ? c : (c < CTXC ? CTXC - 1 - c : CTXC + (LATC - 1 - (c - CTXC))); }

constexpr int SSD_UNITS = BATCH * 2 * NRC;
__device__ __forceinline__ void ssd_a1_unit(const Args& a, const Tc& t, int l, int u) {
    const float* SXBC = (const float*)(a.ws + WS_SXBC); const float* SDT = (const float*)(a.ws + WS_SDT);
    float* SZ = (float*)(a.ws + WS_SZ); float* SDEC = (float*)(a.ws + WS_SDEC);
    const int c = u % NRC, g = (u / NRC) & 1, b = u / (2 * NRC), row0 = rc_row0(b, c);
    LAS bf16_t* BT = (LAS bf16_t*)t.lds;
    LAS bf16_t* XT = BT + 128 * 72 + t.wave * 64 * 72;
    for (int e = t.tid; e < 64 * 32; e += NTHREADS) { const int rho = e >> 5, n4 = (e & 31) * 4;
        const f32x4 v = *(const f32x4*)(SXBC + (size_t)(row0 + rho) * 1024 + 512 + g * 128 + n4);
#pragma unroll
        for (int q = 0; q < 4; ++q) BT[(n4 + q) * 72 + rho] = (bf16_t)f2bf(v[q]); }
    const int hh = t.wave & 3, dir = t.wave >> 2, h = 4 * g + hh, chain = (b * 8 + h) * 2 + dir, cc = rc_chain_pos(c, dir);
    const float a_neg = -expf(a.in[I_SALOG][(size_t)l * 16 + dir * 8 + h]);
    const float dtv = SDT[(size_t)(row0 + t.lane) * 16 + dir * 8 + h], av = dtv * a_neg;
    const float pre = wave_incl_scan(av, t.lane), tot = __shfl(pre, 63);
    const float wgt = dir == 0 ? expf(tot - pre) : expf(pre - av);
    const float sc = dtv * wgt;
#pragma unroll
    for (int p4 = 0; p4 < 16; ++p4) { const f32x4 x = *(const f32x4*)(SXBC + (size_t)(row0 + t.lane) * 1024 + h * 64 + p4 * 4);
#pragma unroll
        for (int q = 0; q < 4; ++q) XT[(p4 * 4 + q) * 72 + t.lane] = (bf16_t)f2bf(x[q] * sc); }
    if (t.lane == 0) SDEC[(size_t)chain * NRC + cc] = expf(tot);
    __syncthreads();
    float* zb = SZ + ((size_t)chain * NRC + cc) * 64 * 128;
#pragma unroll 1
    for (int pt = 0; pt < 4; ++pt)
#pragma unroll 2
        for (int nt = 0; nt < 8; ++nt) { f32x4 acc = {0.f, 0.f, 0.f, 0.f};
            acc = mma16(acc, XT + pt * 16 * 72, 72, BT + nt * 16 * 72, 72, 64, t.lane);
#pragma unroll
            for (int r = 0; r < 4; ++r) zb[(size_t)(16 * pt + 4 * (t.lane >> 4) + r) * 128 + 16 * nt + (t.lane & 15)] = acc[r]; }
    __syncthreads();
}
__device__ __forceinline__ void ssd_b_carry(const Args& a, const Tc& t, int wg, int nwg) {
    const float* SZ = (const float*)(a.ws + WS_SZ); const float* SDEC = (const float*)(a.ws + WS_SDEC); bf16_t* SST = (bf16_t*)(a.ws + WS_SST);
    for (int idx = wg * NTHREADS + t.tid; idx < BATCH * 16 * 2048; idx += nwg * NTHREADS) {
        const int chain = idx >> 11, e4 = (idx & 2047) * 4;
        const float* zc = SZ + (size_t)chain * NRC * 8192 + e4; bf16_t* sc = SST + (size_t)chain * NRC * 8192 + e4; const float* dc = SDEC + (size_t)chain * NRC;
        f32x4 s = {0.f, 0.f, 0.f, 0.f};
        static_assert(NRC % 4 == 0, "carry unroll");
        for (int cc = 0; cc < NRC; cc += 4) {
            f32x4 z[4]; float d[4];
#pragma unroll
            for (int q = 0; q < 4; ++q) { z[q] = *(const f32x4*)(zc + (size_t)(cc + q) * 8192); d[q] = dc[cc + q]; }
#pragma unroll
            for (int q = 0; q < 4; ++q) { u32x2 w; w.x = pk2(s[0], s[1]); w.y = pk2(s[2], s[3]); *(u32x2*)(sc + (size_t)(cc + q) * 8192) = w; s = s * d[q] + z[q]; }
        }
    }
}
__device__ __forceinline__ void ssd_c_unit(const Args& a, const Tc& t, int l, int u) {
    const float* SXBC = (const float*)(a.ws + WS_SXBC); const float* SDT = (const float*)(a.ws + WS_SDT);
    const bf16_t* SST = (const bf16_t*)(a.ws + WS_SST); float* OS = (float*)(a.ws + WS_OS);
    const int c = u % NRC, g = (u / NRC) & 1, b = u / (2 * NRC), row0 = rc_row0(b, c);
    LAS bf16_t* CM = (LAS bf16_t*)t.lds;
    LAS bf16_t* BM = CM + 64 * 136;
    LAS bf16_t* GS = BM + 64 * 136;
    LAS bf16_t* XT = GS + 64 * 72 + t.wave * 64 * 72;
    LAS float* PRE = (LAS float*)(GS + 64 * 72 + 8 * 64 * 72) + t.wave * 128;
    for (int e = t.tid; e < 64 * 32; e += NTHREADS) { const int rho = e >> 5, n4 = (e & 31) * 4;
        const f32x4 bv = *(const f32x4*)(SXBC + (size_t)(row0 + rho) * 1024 + 512 + g * 128 + n4), cv = *(const f32x4*)(SXBC + (size_t)(row0 + rho) * 1024 + 768 + g * 128 + n4);
        u32x2 wb, wc; wb.x = pk2(bv[0], bv[1]); wb.y = pk2(bv[2], bv[3]); wc.x = pk2(cv[0], cv[1]); wc.y = pk2(cv[2], cv[3]);
        *(LAS u32x2*)(BM + rho * 136 + n4) = wb; *(LAS u32x2*)(CM + rho * 136 + n4) = wc; }
    const int hh = t.wave & 3, dir = t.wave >> 2, h = 4 * g + hh, chain = (b * 8 + h) * 2 + dir, cc = rc_chain_pos(c, dir);
    const float a_neg = -expf(a.in[I_SALOG][(size_t)l * 16 + dir * 8 + h]);
    const float dtv = SDT[(size_t)(row0 + t.lane) * 16 + dir * 8 + h], av = dtv * a_neg;
    const float pre = wave_incl_scan(av, t.lane), tot = __shfl(pre, 63);
    PRE[t.lane] = pre; PRE[64 + t.lane] = pre - av;
#pragma unroll
    for (int p4 = 0; p4 < 16; ++p4) { const f32x4 x = *(const f32x4*)(SXBC + (size_t)(row0 + t.lane) * 1024 + h * 64 + p4 * 4);
#pragma unroll
        for (int q = 0; q < 4; ++q) XT[(p4 * 4 + q) * 72 + t.lane] = (bf16_t)f2bf(x[q] * dtv); }
    __syncthreads();
#pragma unroll
    for (int q = 0; q < 2; ++q) { const int ti = t.wave * 2 + q, it = ti >> 2, jt = ti & 3; f32x4 acc = {0.f, 0.f, 0.f, 0.f};
        acc = mma16(acc, CM + it * 16 * 136, 136, BM + jt * 16 * 136, 136, 128, t.lane);
#pragma unroll
        for (int r = 0; r < 4; ++r) GS[(16 * it + 4 * (t.lane >> 4) + r) * 72 + 16 * jt + (t.lane & 15)] = (bf16_t)f2bf(acc[r]); }
    __syncthreads();
    const bf16_t* sb = SST + ((size_t)chain * NRC + cc) * 8192;
    bf16x8 sf[4][4];
#pragma unroll
    for (int pt = 0; pt < 4; ++pt)
#pragma unroll
        for (int ks = 0; ks < 4; ++ks) sf[pt][ks] = *(const bf16x8*)(sb + (size_t)(16 * pt + (t.lane & 15)) * 128 + 32 * ks + 8 * (t.lane >> 4));
#pragma unroll 1
    for (int it = 0; it < 4; ++it) {
        f32x4 acc[4], acc2[4];
#pragma unroll
        for (int pt = 0; pt < 4; ++pt) { acc[pt] = (f32x4){0.f, 0.f, 0.f, 0.f}; acc2[pt] = (f32x4){0.f, 0.f, 0.f, 0.f}; }
        const int rho = 16 * it + (t.lane & 15);
        const float prer = PRE[rho], exr = PRE[64 + rho];
#pragma unroll
        for (int ks = 0; ks < 2; ++ks) {
            const int rp0 = 32 * ks + 8 * (t.lane >> 4);
            const bf16x8 g8 = *(const LAS bf16x8*)(GS + rho * 72 + rp0);
            bf16x8 af;
#pragma unroll
            for (int e = 0; e < 8; ++e) { const int rp = rp0 + e; const float gv = __uint_as_float(((unsigned)(unsigned short)g8[e]) << 16);
                float f;
                if (dir == 0) f = rp <= rho ? expf(prer - PRE[rp]) : 0.f; else f = rp >= rho ? expf(PRE[64 + rp] - exr) : 0.f;
                af[e] = (short)f2bf(gv * f); }
#pragma unroll
            for (int pt = 0; pt < 4; ++pt) { const bf16x8 bfr = *(const LAS bf16x8*)(XT + (16 * pt + (t.lane & 15)) * 72 + rp0); acc[pt] = __builtin_amdgcn_mfma_f32_16x16x32_bf16(af, bfr, acc[pt], 0, 0, 0); }
        }
#pragma unroll
        for (int ks = 0; ks < 4; ++ks) {
            const bf16x8 cf = *(const LAS bf16x8*)(CM + rho * 136 + 32 * ks + 8 * (t.lane >> 4));
#pragma unroll
            for (int pt = 0; pt < 4; ++pt) acc2[pt] = __builtin_amdgcn_mfma_f32_16x16x32_bf16(cf, sf[pt][ks], acc2[pt], 0, 0, 0);
        }
#pragma unroll
        for (int r = 0; r < 4; ++r) { const int ro = 16 * it + 4 * (t.lane >> 4) + r; const float f = dir == 0 ? expf(PRE[ro]) : expf(tot - PRE[64 + ro]);
#pragma unroll
            for (int pt = 0; pt < 4; ++pt) OS[((size_t)dir * M + row0 + ro) * 512 + h * 64 + 16 * pt + (t.lane & 15)] = acc[pt][r] + f * acc2[pt][r]; }
    }
    __syncthreads();
}


constexpr int RW_UNITS = BATCH * 8 * NCK, RW_PAIRS = RW_UNITS / 2, RWA_HALF = 57344;
static_assert(RW_UNITS % 2 == 0, "unit pairs");
__device__ __forceinline__ void rwkv_a_all(const Args& a, const Tc& t) {
    const float* RW7 = (const float*)(a.ws + WS_RW7);
    const size_t P7 = (size_t)M * 256;
    const int half = t.tid >> 8, ht = t.tid & 255, hw = t.wave & 3, hq = t.lane >> 4, lc = t.lane & 15;
    LAS unsigned char* hb = t.lds + half * RWA_HALF;
    LAS float* RAW = (LAS float*)hb;
    LAS float* RtF = RAW;
    LAS float* KhF = RAW + 1024;
    LAS float* AtF = RAW + 3 * 1024;
    LAS float* Uf = RAW + 6 * 1024;
    LAS float* Qkf = Uf + 256;
    LAS float* Nuf = Qkf + 256;
    LAS float* WTs = Nuf + 256;
    LAS bf16_t* BtN = (LAS bf16_t*)(WTs + 64);
    LAS bf16_t* KtN = BtN + 16 * 72; LAS bf16_t* AtN = KtN + 16 * 72; LAS bf16_t* RtN = AtN + 16 * 72;
    LAS bf16_t* KpT = BtN;
    LAS bf16_t* BhT = RtN + 16 * 72;
    LAS bf16_t* VT = BhT + 64 * 40; LAS bf16_t* ApS = VT + 64 * 40;
    LAS bf16_t* NpS = ApS + 64 * 40;
    LAS bf16_t* QbT = NpS + 16 * 40;
    f32x4 pf[6];
#define RWA_LOAD(pair) do { const int u_ = 2 * (pair) + half, ck_ = u_ % NCK, ch_ = u_ / NCK, dir_ = ch_ & 1, h_ = (ch_ >> 1) & 3, b_ = ch_ >> 3; \
        _Pragma("unroll") for (int q = 0; q < 6; ++q) { const int e = ht + 256 * q, vec = e >> 8, rem = e & 255, i = rem >> 4, c4 = rem & 15; \
            const int row = chain_row(b_, dir_, ck_ * RKT + i); const int vs = vec < 5 ? vec : 5 + dir_; \
            pf[q] = *(const f32x4*)(RW7 + (size_t)vs * P7 + (size_t)row * 256 + h_ * 64 + c4 * 4); } } while (0)
    if (t.bid < RW_PAIRS) RWA_LOAD(t.bid);
    for (int pair = t.bid; pair < RW_PAIRS; pair += t.G) {
        const int u = 2 * pair + half, ck = u % NCK, chain = u / NCK;
        unsigned char* rec = a.ws + WS_RK + ((size_t)chain * NCK + ck) * RK_BYTES;
#pragma unroll
        for (int q = 0; q < 6; ++q) *(LAS f32x4*)(RAW + (ht + 256 * q) * 4) = pf[q];
        for (int e = ht; e < 3 * 64 * 8; e += 256) { const int arr = e >> 9, rem = e & 511, r = rem >> 3, c2 = rem & 7; *(LAS unsigned*)(BhT + arr * 64 * 40 + r * 40 + 16 + 2 * c2) = 0u; }
        { const int arr = ht >> 7, rem = ht & 127, r = rem >> 3, c2 = rem & 7; *(LAS unsigned*)(NpS + arr * 16 * 40 + r * 40 + 16 + 2 * c2) = 0u; }
        __syncthreads();
        if (pair + t.G < RW_PAIRS) RWA_LOAD(pair + t.G);
        { const int j = ht & 63, ig = ht >> 6; float wc = 1.f, wT = 1.f;
#pragma unroll
            for (int i = 0; i < 16; ++i) { const float wv = RAW[5 * 1024 + i * 64 + j]; wT *= wv; if (i < 4 * ig) wc *= wv; }
            if (ig == 0) WTs[j] = wT;
#pragma unroll
            for (int q = 0; q < 4; ++q) { const int i = 4 * ig + q; const float wp = wc; wc *= RAW[5 * 1024 + i * 64 + j]; const float iw = 1.0f / wc;
                const float at = RAW[3 * 1024 + i * 64 + j] * wp, rt = RAW[i * 64 + j] * wc, bt = RAW[4 * 1024 + i * 64 + j] * iw, kt = RAW[1024 + i * 64 + j] * iw;
                AtN[i * 72 + j] = (bf16_t)f2bf(at); RtN[i * 72 + j] = (bf16_t)f2bf(rt); BtN[i * 72 + j] = (bf16_t)f2bf(bt); KtN[i * 72 + j] = (bf16_t)f2bf(kt);
                BhT[j * 40 + i] = (bf16_t)f2bf(bt * wT); VT[j * 40 + i] = (bf16_t)f2bf(RAW[2 * 1024 + i * 64 + j]);
                KhF[i * 64 + j] = kt * wT; RtF[i * 64 + j] = rt; AtF[i * 64 + j] = at; } }
        __syncthreads();
        { f32x4 acc = {0.f, 0.f, 0.f, 0.f};
            acc = mma16(acc, (hw == 0 || hw == 3) ? BtN : KtN, 72, hw < 2 ? AtN : RtN, 72, 64, t.lane);
#pragma unroll
            for (int r = 0; r < 4; ++r) { const int s_ = 4 * hq + r, t_ = lc; const bool keep = hw < 2 ? (s_ < t_) : (s_ <= t_); const float v = keep ? acc[r] : 0.f;
                if (hw == 0) Uf[s_ * 16 + t_] = v; else if (hw == 1) Nuf[s_ * 16 + t_] = v; else if (hw == 2) Qkf[s_ * 16 + t_] = v; else QbT[t_ * 40 + s_] = (bf16_t)f2bf(v); } }
        __syncthreads();
        if (ht < 80) { float x[16]; const bool isA = ht < 64; const int rr = isA ? ht : ht - 64;
#pragma unroll
            for (int tt = 0; tt < 16; ++tt) { float acc = isA ? AtF[tt * 64 + rr] : Nuf[rr * 16 + tt];
#pragma unroll
                for (int s_ = 0; s_ < 16; ++s_) if (s_ < tt) acc -= x[s_] * Uf[s_ * 16 + tt];
                x[tt] = acc; if (isA) ApS[rr * 40 + tt] = (bf16_t)f2bf(acc); else NpS[rr * 40 + tt] = (bf16_t)f2bf(acc); } }
        else if (ht >= 128) { for (int e = ht - 128; e < 64 * 8; e += 128) { const int r = e >> 3, c2 = e & 7; *(LAS unsigned*)(KpT + r * 40 + 16 + 2 * c2) = 0u; } }
        __syncthreads();
        for (int ti = hw; ti < 25; ti += 4) {
            f32x4 acc = {0.f, 0.f, 0.f, 0.f};
            if (ti < 16) { const int jt = ti >> 2, jt2 = ti & 3;
                acc = mma16(acc, ApS + jt * 16 * 40, 40, BhT + jt2 * 16 * 40, 40, 32, t.lane);
                unsigned short o[4];
#pragma unroll
                for (int r = 0; r < 4; ++r) { const int j = 16 * jt + 4 * hq + r, j2 = 16 * jt2 + lc; const float dg = (j == j2) ? WTs[j] : 0.f; o[r] = (unsigned short)f2bf(dg - acc[r]); }
                u32x2 w; w.x = o[0] | ((unsigned)o[1] << 16); w.y = o[2] | ((unsigned)o[3] << 16);
                *(u32x2*)(rec + RK_PA + ((size_t)((jt2 * 2 + (jt >> 1)) * 64 + t.lane) * 8 + 4 * (jt & 1)) * 2) = w;
            } else if (ti < 20) { const int jt = ti - 16;
                acc = mma16(acc, ApS + jt * 16 * 40, 40, QbT, 40, 32, t.lane);
                unsigned short o[4];
#pragma unroll
                for (int r = 0; r < 4; ++r) { const int j = 16 * jt + 4 * hq + r; o[r] = (unsigned short)f2bf(RtF[lc * 64 + j] - acc[r]); }
                u32x2 w; w.x = o[0] | ((unsigned)o[1] << 16); w.y = o[2] | ((unsigned)o[3] << 16);
                *(u32x2*)(rec + RK_RA + ((size_t)(((jt >> 1) * 64 + t.lane) * 8 + 4 * (jt & 1))) * 2) = w;
            } else if (ti == 20) {
                acc = mma16(acc, NpS, 40, QbT, 40, 32, t.lane);
                unsigned short o[4];
#pragma unroll
                for (int r = 0; r < 4; ++r) o[r] = (unsigned short)f2bf(Qkf[(4 * hq + r) * 16 + lc] - acc[r]);
                u32x2 w; w.x = o[0] | ((unsigned)o[1] << 16); w.y = o[2] | ((unsigned)o[3] << 16);
                *(u32x2*)(rec + RK_QA + ((size_t)((lc + 16 * (hq >> 1)) * 8 + 4 * (hq & 1))) * 2) = w;
                u32x2 z; z.x = 0u; z.y = 0u; *(u32x2*)(rec + RK_QA + ((size_t)((32 + lc + 16 * (hq >> 1)) * 8 + 4 * (hq & 1))) * 2) = z;
            } else { const int jt2 = ti - 21;
                acc = mma16(acc, NpS, 40, BhT + jt2 * 16 * 40, 40, 32, t.lane);
#pragma unroll
                for (int r = 0; r < 4; ++r) { const int s_ = 4 * hq + r, j2 = 16 * jt2 + lc; KpT[j2 * 40 + s_] = (bf16_t)f2bf(KhF[s_ * 64 + j2] - acc[r]); }
            }
        }
        for (int e = ht; e < 4 * 64 * 4; e += 256) { const int it = e >> 8, rem = e & 255, ln = rem >> 2, e2 = (rem & 3) * 2, hp = ln >> 4, i2 = 16 * it + (ln & 15);
            unsigned w = 0u; if (hp < 2) { const int s0 = 8 * hp + e2; w = f2bf(RAW[2 * 1024 + s0 * 64 + i2]) | (f2bf(RAW[2 * 1024 + (s0 + 1) * 64 + i2]) << 16); }
            *(unsigned*)(rec + RK_VB + ((size_t)((it * 64 + ln) * 8 + e2)) * 2) = w; }
        __syncthreads();
#pragma unroll
        for (int q = 0; q < 4; ++q) { const int ti = hw * 4 + q, rt = ti >> 2, it = ti & 3; f32x4 acc = {0.f, 0.f, 0.f, 0.f};
            acc = mma16(acc, KpT + rt * 16 * 40, 40, VT + it * 16 * 40, 40, 32, t.lane);
            *(f32x4*)(rec + RK_ZC + ((size_t)((rt * 4 + it) * 64 + t.lane)) * 16) = acc; }
        __syncthreads();
    }
#undef RWA_LOAD
}
constexpr int RKB_TASKS = BATCH * 8 * 4, RKB_NS = 8, RKB_D = 6, RKB_SLOT = 16384;
__device__ __forceinline__ void rkb_issue(const unsigned char* rec, int ck, int w, int lw, int lane, LAS unsigned char* ring) {
    const unsigned char* rp = rec + (size_t)ck * RK_BYTES; LAS unsigned char* slot = ring + (ck % RKB_NS) * RKB_SLOT;
#pragma unroll
    for (int q = 0; q < 4; ++q) { const int p = 4 * lw + q; const unsigned char* src;
        if (p < 8) src = rp + RK_PA + (size_t)(p * 64 + lane) * 16; else if (p < 10) src = rp + RK_RA + (size_t)((p - 8) * 64 + lane) * 16; else if (p == 10) src = rp + RK_QA + (size_t)lane * 16;
        else if (p < 15) src = rp + RK_ZC + (size_t)(((p - 11) * 4 + w) * 64 + lane) * 16; else src = rp + RK_VB + (size_t)(w * 64 + lane) * 16;
        __builtin_amdgcn_global_load_lds((const unsigned*)src, (LAS unsigned*)(slot + p * 1024), 16, 0, 0); }
}
__device__ __forceinline__ void rwkv_b_task(const Args& a, const Tc& t, int task) {
    float* OR = (float*)(a.ws + WS_OR);
    const int w = task & 3, chain = task >> 2, dir = chain & 1, h = (chain >> 1) & 3, b = chain >> 3, hq = t.lane >> 4, lc = t.lane & 15;
    const unsigned char* rec = a.ws + WS_RK + (size_t)chain * NCK * RK_BYTES;
    LAS unsigned char* ring = t.lds;
    const bool loader = (t.wave >= 1 && t.wave <= 4); const int lw = t.wave - 1;
    if (loader) {
#pragma unroll 1
        for (int ck = 0; ck < RKB_D; ++ck) rkb_issue(rec, ck, w, lw, t.lane, ring);
    }
    f32x4 T[4];
#pragma unroll
    for (int rt = 0; rt < 4; ++rt) T[rt] = (f32x4){0.f, 0.f, 0.f, 0.f};
#pragma unroll 1
    for (int ck = 0; ck < NCK; ++ck) {
        if (loader) {
            if (ck + RKB_D <= NCK) WAIT_V(20); else WAIT_V(0);
        }
        __builtin_amdgcn_s_barrier();
        if (loader) { if (ck + RKB_D < NCK) rkb_issue(rec, ck + RKB_D, w, lw, t.lane, ring); }
        else if (t.wave == 0) {
            const LAS unsigned char* slot = ring + (ck % RKB_NS) * RKB_SLOT;
            bf16x8 pa[4][2], ra[2], qa, vb; f32x4 zc[4];
#pragma unroll
            for (int rt = 0; rt < 4; ++rt) {
#pragma unroll
                for (int ks = 0; ks < 2; ++ks) pa[rt][ks] = *(const LAS bf16x8*)(slot + ((rt * 2 + ks) * 64 + t.lane) * 16);
                zc[rt] = *(const LAS f32x4*)(slot + ((11 + rt) * 64 + t.lane) * 16); }
#pragma unroll
            for (int ks = 0; ks < 2; ++ks) ra[ks] = *(const LAS bf16x8*)(slot + ((8 + ks) * 64 + t.lane) * 16);
            qa = *(const LAS bf16x8*)(slot + (10 * 64 + t.lane) * 16); vb = *(const LAS bf16x8*)(slot + (15 * 64 + t.lane) * 16);
            bf16x8 bfr[2];
#pragma unroll
            for (int ks = 0; ks < 2; ++ks) { u32x4 wv; wv.x = pk2(T[2 * ks][0], T[2 * ks][1]); wv.y = pk2(T[2 * ks][2], T[2 * ks][3]); wv.z = pk2(T[2 * ks + 1][0], T[2 * ks + 1][1]); wv.w = pk2(T[2 * ks + 1][2], T[2 * ks + 1][3]);
                bfr[ks] = __builtin_bit_cast(bf16x8, wv); }
            f32x4 o = {0.f, 0.f, 0.f, 0.f};
            o = __builtin_amdgcn_mfma_f32_16x16x32_bf16(ra[0], bfr[0], o, 0, 0, 0);
            o = __builtin_amdgcn_mfma_f32_16x16x32_bf16(ra[1], bfr[1], o, 0, 0, 0);
            o = __builtin_amdgcn_mfma_f32_16x16x32_bf16(qa, vb, o, 0, 0, 0);
#pragma unroll
            for (int rt = 0; rt < 4; ++rt) { f32x4 n = __builtin_amdgcn_mfma_f32_16x16x32_bf16(pa[rt][0], bfr[0], zc[rt], 0, 0, 0); T[rt] = __builtin_amdgcn_mfma_f32_16x16x32_bf16(pa[rt][1], bfr[1], n, 0, 0, 0); }
#pragma unroll
            for (int r = 0; r < 4; ++r) { const int row = chain_row(b, dir, ck * RKT + 4 * hq + r); OR[((size_t)dir * M + row) * 256 + h * 64 + 16 * w + lc] = o[r]; }
        }
    }
    __builtin_amdgcn_s_barrier();
}

constexpr int GLA_UNITS = BATCH * GNC;
__device__ __forceinline__ int gc_row0(int b, int c) { return c < GC_CTX ? ML + b * CTX + 32 * c : b * SEQ + 32 * (c - GC_CTX); }
__device__ __forceinline__ int gc_chain_pos(int c, int dir) { return dir == 0 ? c : (c < GC_CTX ? GC_CTX - 1 - c : GC_CTX + (GC_LAT - 1 - (c - GC_CTX))); }
__device__ __forceinline__ void gla_prefix(LAS float* PRE, int lane) {
    const int d = lane & 31, r0 = (lane >> 5) * 16; float run = 0.f;
#pragma unroll
    for (int i = 0; i < 16; ++i) { run += PRE[(r0 + i) * 33 + d]; PRE[(r0 + i) * 33 + d] = run; }
    WAVE_LDS_FENCE();
    if (lane >= 32) { const float add = PRE[15 * 33 + d];
#pragma unroll
        for (int i = 0; i < 16; ++i) PRE[(16 + i) * 33 + d] += add; }
    WAVE_LDS_FENCE();
}
__device__ __forceinline__ void gla_a1_unit(const Args& a, const Tc& t, int u) {
    const float* U = (const float*)(a.ws + WS_U); const float* GG = (const float*)(a.ws + WS_GG);
    float* GZ = (float*)(a.ws + WS_GZ); float* GDEC = (float*)(a.ws + WS_GDEC);
    const int c = u % GNC, b = u / GNC, row0 = gc_row0(b, c);
    const int h = t.wave & 3, dir = t.wave >> 2, chain = (b * 4 + h) * 2 + dir, cc = gc_chain_pos(c, dir);
    LAS float* PRE = (LAS float*)(t.lds + t.wave * 12288);
    LAS bf16_t* KT = (LAS bf16_t*)(PRE + 32 * 33 + 8);
    LAS bf16_t* VT = KT + 32 * 40;
    const int rho = t.lane & 31, hf = t.lane >> 5;
#pragma unroll
    for (int q = 0; q < 4; ++q) { const f32x4 g = *(const f32x4*)(GG + ((size_t)dir * M + row0 + rho) * 128 + h * 32 + hf * 16 + 4 * q);
#pragma unroll
        for (int e = 0; e < 4; ++e) PRE[rho * 33 + hf * 16 + 4 * q + e] = g[e]; }
    WAVE_LDS_FENCE();
    f32x4 graw[4];
#pragma unroll
    for (int q = 0; q < 4; ++q)
#pragma unroll
        for (int e = 0; e < 4; ++e) graw[q][e] = PRE[rho * 33 + hf * 16 + 4 * q + e];
    WAVE_LDS_FENCE();
    gla_prefix(PRE, t.lane);
#pragma unroll
    for (int q = 0; q < 4; ++q) { const f32x4 k = *(const f32x4*)(U + (size_t)(row0 + rho) * NU + U_GK + h * 32 + hf * 16 + 4 * q);
#pragma unroll
        for (int e = 0; e < 4; ++e) { const int d = hf * 16 + 4 * q + e; const float pre = PRE[rho * 33 + d], tot = PRE[31 * 33 + d];
            const float w = dir == 0 ? expf(tot - pre) : expf(pre - graw[q][e]);
            KT[d * 40 + rho] = (bf16_t)f2bf(k[e] * w); } }
#pragma unroll
    for (int q = 0; q < 8; ++q) { const f32x4 v = *(const f32x4*)(U + (size_t)(row0 + rho) * NU + U_GV + h * 64 + hf * 32 + 4 * q);
#pragma unroll
        for (int e = 0; e < 4; ++e) VT[(hf * 32 + 4 * q + e) * 40 + rho] = (bf16_t)f2bf(v[e]); }
    if (t.lane < 32) GDEC[((size_t)chain * GNC + cc) * 32 + t.lane] = expf(PRE[31 * 33 + t.lane]);
    WAVE_LDS_FENCE();
    float* zb = GZ + ((size_t)chain * GNC + cc) * 2048;
#pragma unroll
    for (int vt = 0; vt < 4; ++vt)
#pragma unroll
        for (int dt = 0; dt < 2; ++dt) { f32x4 acc = {0.f, 0.f, 0.f, 0.f};
            acc = mma16(acc, VT + vt * 16 * 40, 40, KT + dt * 16 * 40, 40, 32, t.lane);
#pragma unroll
            for (int r = 0; r < 4; ++r) zb[(16 * vt + 4 * (t.lane >> 4) + r) * 32 + 16 * dt + (t.lane & 15)] = acc[r]; }
    WAVE_LDS_FENCE();
}
__device__ __forceinline__ void gla_b_carry(const Args& a, const Tc& t, int wg, int nwg) {
    const float* GZ = (const float*)(a.ws + WS_GZ); const float* GDEC = (const float*)(a.ws + WS_GDEC); bf16_t* GST = (bf16_t*)(a.ws + WS_GST);
    for (int idx = wg * NTHREADS + t.tid; idx < BATCH * 8 * 512; idx += nwg * NTHREADS) {
        const int chain = idx >> 9, e4 = (idx & 511) * 4, d0 = e4 & 31;
        const float* zc = GZ + (size_t)chain * GNC * 2048 + e4; bf16_t* sc = GST + (size_t)chain * GNC * 2048 + e4; const float* dc = GDEC + (size_t)chain * GNC * 32 + d0;
        f32x4 s = {0.f, 0.f, 0.f, 0.f};
        static_assert(GNC % 4 == 0, "carry unroll");
        for (int cc = 0; cc < GNC; cc += 4) {
            f32x4 z[4], d[4];
#pragma unroll
            for (int q = 0; q < 4; ++q) { z[q] = *(const f32x4*)(zc + (size_t)(cc + q) * 2048); d[q] = *(const f32x4*)(dc + (size_t)(cc + q) * 32); }
#pragma unroll
            for (int q = 0; q < 4; ++q) { u32x2 w; w.x = pk2(s[0], s[1]); w.y = pk2(s[2], s[3]); *(u32x2*)(sc + (size_t)(cc + q) * 2048) = w; s = s * d[q] + z[q]; }
        }
    }
}
__device__ __forceinline__ void gla_c_unit(const Args& a, const Tc& t, int u) {
    const float* U = (const float*)(a.ws + WS_U); const float* GG = (const float*)(a.ws + WS_GG);
    const bf16_t* GST = (const bf16_t*)(a.ws + WS_GST); float* OG = (float*)(a.ws + WS_OG);
    const int c = u % GNC, b = u / GNC, row0 = gc_row0(b, c);
    const int h = t.wave & 3, dir = t.wave >> 2, chain = (b * 4 + h) * 2 + dir, cc = gc_chain_pos(c, dir);
    LAS float* PRE = (LAS float*)(t.lds + t.wave * 14592);
    LAS bf16_t* QN = (LAS bf16_t*)(PRE + 32 * 33 + 8);
    LAS bf16_t* KN = QN + 32 * 40;
    LAS bf16_t* VT = KN + 32 * 40;
    const int rho = t.lane & 31, hf = t.lane >> 5, hq = t.lane >> 4, lc = t.lane & 15;
#pragma unroll
    for (int q = 0; q < 4; ++q) { const f32x4 g = *(const f32x4*)(GG + ((size_t)dir * M + row0 + rho) * 128 + h * 32 + hf * 16 + 4 * q);
#pragma unroll
        for (int e = 0; e < 4; ++e) PRE[rho * 33 + hf * 16 + 4 * q + e] = g[e]; }
    WAVE_LDS_FENCE();
    f32x4 graw[4];
#pragma unroll
    for (int q = 0; q < 4; ++q)
#pragma unroll
        for (int e = 0; e < 4; ++e) graw[q][e] = PRE[rho * 33 + hf * 16 + 4 * q + e];
    WAVE_LDS_FENCE();
    gla_prefix(PRE, t.lane);
#pragma unroll
    for (int q = 0; q < 4; ++q) { const f32x4 qv = *(const f32x4*)(U + (size_t)(row0 + rho) * NU + U_GQ + h * 32 + hf * 16 + 4 * q), kv = *(const f32x4*)(U + (size_t)(row0 + rho) * NU + U_GK + h * 32 + hf * 16 + 4 * q);
#pragma unroll
        for (int e = 0; e < 4; ++e) { const int d = hf * 16 + 4 * q + e; const float pre = PRE[rho * 33 + d], tot = PRE[31 * 33 + d], ref = PRE[15 * 33 + d];
            const float ex = pre - graw[q][e], qs = qv[e] * 0.17677669529663687f;
            float fq, fk;
            if (dir == 0) { fq = expf(pre - ref); fk = expf(ref - pre); } else { fq = expf(ref - ex); fk = expf(ex - ref); }
            (void)tot;
            QN[rho * 40 + d] = (bf16_t)f2bf(qs * fq); KN[rho * 40 + d] = (bf16_t)f2bf(kv[e] * fk); } }
    bf16x8 q2f[2];
#pragma unroll
    for (int it = 0; it < 2; ++it) { const int ro = 16 * it + lc; const float* qp = U + (size_t)(row0 + ro) * NU + U_GQ + h * 32 + 8 * hq; const float* gp = GG + ((size_t)dir * M + row0 + ro) * 128 + h * 32 + 8 * hq;
        const f32x4 qa = *(const f32x4*)qp, qb = *(const f32x4*)(qp + 4), ga = *(const f32x4*)gp, gb = *(const f32x4*)(gp + 4);
#pragma unroll
        for (int e = 0; e < 8; ++e) { const int d = 8 * hq + e; const float pre = PRE[ro * 33 + d], tot = PRE[31 * 33 + d]; const float qv = e < 4 ? qa[e & 3] : qb[e & 3], gv = e < 4 ? ga[e & 3] : gb[e & 3];
            const float f2 = dir == 0 ? expf(pre) : expf(tot - (pre - gv));
            q2f[it][e] = (short)f2bf(qv * 0.17677669529663687f * f2); } }
#pragma unroll
    for (int q = 0; q < 8; ++q) { const f32x4 v = *(const f32x4*)(U + (size_t)(row0 + rho) * NU + U_GV + h * 64 + hf * 32 + 4 * q);
#pragma unroll
        for (int e = 0; e < 4; ++e) VT[(hf * 32 + 4 * q + e) * 40 + rho] = (bf16_t)f2bf(v[e]); }
    WAVE_LDS_FENCE();
    f32x4 att[2][2];
#pragma unroll
    for (int it = 0; it < 2; ++it)
#pragma unroll
        for (int jt = 0; jt < 2; ++jt) { att[it][jt] = (f32x4){0.f, 0.f, 0.f, 0.f}; att[it][jt] = mma16(att[it][jt], QN + it * 16 * 40, 40, KN + jt * 16 * 40, 40, 32, t.lane); }
    WAVE_LDS_FENCE();
#pragma unroll
    for (int it = 0; it < 2; ++it)
#pragma unroll
        for (int jt = 0; jt < 2; ++jt)
#pragma unroll
            for (int r = 0; r < 4; ++r) { const int ro = 16 * it + 4 * hq + r, rp = 16 * jt + lc; const bool keep = dir == 0 ? (rp <= ro) : (rp >= ro);
                QN[ro * 40 + rp] = (bf16_t)f2bf(keep ? att[it][jt][r] : 0.f); }
    WAVE_LDS_FENCE();
    const bf16_t* sb = GST + ((size_t)chain * GNC + cc) * 2048;
#pragma unroll
    for (int it = 0; it < 2; ++it)
#pragma unroll
        for (int vt = 0; vt < 4; ++vt) { f32x4 acc = {0.f, 0.f, 0.f, 0.f};
            acc = mma16(acc, QN + it * 16 * 40, 40, VT + vt * 16 * 40, 40, 32, t.lane);
            const bf16x8 sf = *(const bf16x8*)(sb + (size_t)(16 * vt + lc) * 32 + 8 * hq);
            acc = __builtin_amdgcn_mfma_f32_16x16x32_bf16(q2f[it], sf, acc, 0, 0, 0);
#pragma unroll
            for (int r = 0; r < 4; ++r) OG[((size_t)dir * M + row0 + 16 * it + 4 * hq + r) * 256 + h * 64 + 16 * vt + lc] = acc[r]; }
    WAVE_LDS_FENCE();
}

__device__ __forceinline__ void phase_mixout(const Args& a, const Tc& t, int l, int Mtok) {
    const float* U = (const float*)(a.ws + WS_U); const float* RW7 = (const float*)(a.ws + WS_RW7); const float* SXBC = (const float*)(a.ws + WS_SXBC);
    const float* OG = (const float*)(a.ws + WS_OG); const float* OR = (const float*)(a.ws + WS_OR); const float* OS = (const float*)(a.ws + WS_OS);
    bf16_t* MIX = (bf16_t*)(a.ws + WS_MIX);
    const float* mu = a.in[I_RMU] + (size_t)l * 2 * 928; const float* g2 = a.in[I_RG2] + (size_t)l * 64 * 256;
    const float* gng = a.in[I_GNG] + (size_t)l * 256; const float* lng = a.in[I_RLG] + (size_t)l * 256; const float* lnb = a.in[I_RLB] + (size_t)l * 256;
    const float* rrk = a.in[I_RRK] + (size_t)l * 256; const float* sd = a.in[I_SD] + (size_t)l * 8; const float* sng = a.in[I_SNG] + (size_t)l * 512;
    LAS float* SG = (LAS float*)t.lds;
    LAS float* RED = (LAS float*)(t.lds + 4096);
    const size_t P = (size_t)M * 256;
    for (int tile = t.bid; tile < Mtok / 16; tile += t.G) {
        const int r0 = tile * 16; int slo, shi; seg_bounds(r0, slo, shi);
        {   const int tt = t.tid >> 5, r = t.tid & 31, row = r0 + tt; const float* up = U + (size_t)row * NU; const bool hp = row - 1 >= slo, hn = row + 1 < shi;
#pragma unroll
            for (int q = 0; q < 2; ++q) { const int col = U_RLGT + q * 32 + r, mi = col - U_RW; const float u = up[col], pv = hp ? up[col - NU] : 0.f, nv = hn ? up[col + NU] : 0.f;
                SG[tt * 64 + q * 32 + r] = sigmoidf_(u + mu[mi] * (pv - u) + mu[928 + mi] * (nv - u)); } }
        __syncthreads();
        {
            const int c = t.tid & 255, tt0 = (t.tid >> 8) * 8;
            float ag[8];
#pragma unroll
            for (int j = 0; j < 8; ++j) ag[j] = 0.f;
#pragma unroll 2
            for (int r4 = 0; r4 < 16; ++r4) { float w[4];
#pragma unroll
                for (int q = 0; q < 4; ++q) w[q] = g2[(4 * r4 + q) * 256 + c];
#pragma unroll
                for (int j = 0; j < 8; ++j) { const f32x4 sv = *(const LAS f32x4*)(SG + (tt0 + j) * 64 + 4 * r4); ag[j] += (sv[0] * w[0] + sv[1] * w[1]) + (sv[2] * w[2] + sv[3] * w[3]); } }
            const float gn = gng[c], lg = lng[c], lb = lnb[c], rk = rrk[c];
#pragma unroll
            for (int j = 0; j < 8; ++j) { const int row = r0 + tt0 + j;
                const float og_ = OG[(size_t)row * 256 + c] + OG[P + (size_t)row * 256 + c];
                const float ms = wave_sum(og_ * og_) * (1.0f / 64.0f);
                const float o1 = og_ * (1.0f / sqrtf(ms + 1e-6f)) * gn * siluf_(U[(size_t)row * NU + U_GOG + c]);
                const float orr = OR[(size_t)row * 256 + c] + OR[P + (size_t)row * 256 + c];
                const float mean = wave_sum(orr) * (1.0f / 64.0f); const float dd = orr - mean; const float var = wave_sum(dd * dd) * (1.0f / 64.0f);
                const float on = dd * (1.0f / sqrtf(var + 64e-5f)) * lg + lb;
                const float rr = RW7[(size_t)row * 256 + c], kk = RW7[P + (size_t)row * 256 + c], vv = RW7[2 * P + (size_t)row * 256 + c];
                const float bon = wave_sum(rr * kk * rk) * vv;
                const float o2 = (on + bon) * ag[j];
                MIX[(size_t)row * D + c] = (bf16_t)f2bf(o1); MIX[(size_t)row * D + 256 + c] = (bf16_t)f2bf(o2); }
        }
        {
            const int c = t.tid; const float dh = sd[c >> 6], ng = sng[c];
            float y[16];
#pragma unroll
            for (int q = 0; q < 16; ++q) { const int row = r0 + q;
                float v = OS[(size_t)row * 512 + c] + OS[(size_t)M * 512 + (size_t)row * 512 + c] + dh * SXBC[(size_t)row * 1024 + c];
                v *= siluf_(U[(size_t)row * NU + U_SZ + c]); y[q] = v;
                const float ss = wave_sum(v * v); if (t.lane == 0) RED[q * 8 + t.wave] = ss; }
            __syncthreads();
            const int gb = (t.wave >> 2) * 4;
#pragma unroll
            for (int q = 0; q < 16; ++q) { const float ms = (RED[q * 8 + gb] + RED[q * 8 + gb + 1] + RED[q * 8 + gb + 2] + RED[q * 8 + gb + 3]) * (1.0f / 256.0f);
                MIX[(size_t)(r0 + q) * D + 512 + c] = (bf16_t)f2bf(y[q] * (1.0f / sqrtf(ms + 1e-6f)) * ng); }
        }
        __syncthreads();
    }
}

static_assert(NEXP <= 32, "router lanes");
__device__ __forceinline__ unsigned long long router_key(float v, int e) { unsigned u = __float_as_uint(v); u = (u & 0x80000000u) ? ~u : (u | 0x80000000u); return ((unsigned long long)u << 32) | (unsigned)(31 - e); }
__device__ __forceinline__ float router_unkey(unsigned long long k) { unsigned u = (unsigned)(k >> 32); u = (u & 0x80000000u) ? (u & 0x7fffffffu) : ~u; return __uint_as_float(u); }
__device__ __forceinline__ void phase_router(const Args& a, const Tc& t, int l, int Mtok) {
    const int gw = t.bid * NWAVES + t.wave, NGW = t.G * NWAVES;
    const float* X = (const float*)(a.ws + WS_X); bf16_t* H = (bf16_t*)(a.ws + WS_H); const float* MODS = (const float*)(a.ws + WS_MODS) + (size_t)l * NR * 6144;
    const float* rw = a.in[I_ROUTW] + (size_t)l * D * NEXP; const float* rb = a.in[I_ROUTB] + (size_t)l * NEXP;
    int* TOPI = (int*)(a.ws + WS_TOPI); float* TOPP = (float*)(a.ws + WS_TOPP);
    unsigned* CNT = (unsigned*)(a.ws + WS_CTL) + CW_CNT + l * 64;
    LAS int* hist = (LAS int*)(t.lds + LDS_MISC + 64);
    LAS float* HT = (LAS float*)(t.lds + t.wave * 16384);
    if (t.tid < NEXP) hist[t.tid] = 0;
    __syncthreads();
    const int e = t.lane & 31, ch = t.lane >> 5; const bool ev = e < NEXP;
    const float bias = ev ? rb[e] : 0.f;
    for (int r0 = gw * 4; r0 < Mtok; r0 += NGW * 4) {
#pragma unroll
        for (int rr = 0; rr < 4; ++rr) { const int row = r0 + rr;
            f32x4 v[4], h[4];
#pragma unroll
            for (int j = 0; j < 4; ++j) v[j] = *(const f32x4*)(X + (size_t)row * D + 4 * t.lane + 256 * j);
            const float* md = MODS + (size_t)mod_row(row) * 6144;
            norm_mod_store(v, a.in[I_N2G] + (size_t)l * D, md + 3 * 1024, md + 4 * 1024, H + (size_t)row * D, t.lane, h);
#pragma unroll
            for (int j = 0; j < 4; ++j) *(LAS f32x4*)(HT + rr * 1024 + 4 * t.lane + 256 * j) = h[j]; }
        WAVE_LDS_FENCE();
        float acc[4] = {0.f, 0.f, 0.f, 0.f};
        const float* wp = rw + (size_t)ch * NEXP + (ev ? e : 0);
#pragma unroll 4
        for (int c4 = 0; c4 < 256; ++c4) {
            float wv[2];
#pragma unroll
            for (int q = 0; q < 2; ++q) wv[q] = wp[(size_t)(2 * (2 * c4 + q)) * NEXP];
#pragma unroll
            for (int rr = 0; rr < 4; ++rr) { const f32x4 hv = *(const LAS f32x4*)(HT + rr * 1024 + 4 * c4);
                acc[rr] += (ch ? hv[1] : hv[0]) * wv[0] + (ch ? hv[3] : hv[2]) * wv[1]; }
        }
        WAVE_LDS_FENCE();
#pragma unroll
        for (int rr = 0; rr < 4; ++rr) { const int row = r0 + rr;
            float lg = acc[rr] + __shfl_xor(acc[rr], 32) + bias; if (!ev) lg = -3.0e38f;
            unsigned long long key = router_key(lg, e);
            int ti[4]; float tv[4];
#pragma unroll
            for (int k = 0; k < 4; ++k) { unsigned long long m = key;
#pragma unroll
                for (int o = 1; o < 32; o <<= 1) { const unsigned long long other = __shfl_xor(m, o); m = other > m ? other : m; }
                ti[k] = 31 - (int)(unsigned)(m & 0xffffffffu); tv[k] = router_unkey(m);
                if (ti[k] == e) key = 0ull; }
            const float e0 = 1.0f, e1 = expf(tv[1] - tv[0]), e2 = expf(tv[2] - tv[0]), e3 = expf(tv[3] - tv[0]); const float inv = 1.0f / (e0 + e1 + e2 + e3);
            if (t.lane == 0) {
                TOPI[row * 4 + 0] = ti[0]; TOPI[row * 4 + 1] = ti[1]; TOPI[row * 4 + 2] = ti[2]; TOPI[row * 4 + 3] = ti[3];
                TOPP[row * 4 + 0] = e0 * inv; TOPP[row * 4 + 1] = e1 * inv; TOPP[row * 4 + 2] = e2 * inv; TOPP[row * 4 + 3] = e3 * inv;
#pragma unroll
                for (int k = 0; k < 4; ++k) atomicAdd((int*)&hist[ti[k]], 1);
            } }
    }
    __syncthreads();
    if (t.tid < NEXP && hist[t.tid] != 0) atomicAdd(&CNT[t.tid], (unsigned)hist[t.tid]);
}

__device__ __forceinline__ int moe_offsets(const unsigned* CNT, LAS int* off, LAS int* cnt, int tid) {
    if (tid < NEXP) { int o = 0; for (int e = 0; e < tid; ++e) o += ((int)CNT[e] + 255) & ~255; off[tid] = o; cnt[tid] = (int)CNT[tid]; }
    __syncthreads();
    return (off[NEXP - 1] + ((cnt[NEXP - 1] + 255) & ~255)) >> 8;
}
__device__ __forceinline__ void phase_lists(const Args& a, const Tc& t, int l, int Mtok) {
    const int* TOPI = (const int*)(a.ws + WS_TOPI); const float* TOPP = (const float*)(a.ws + WS_TOPP);
    int* POS = (int*)(a.ws + WS_POS); int* ROWIDX = (int*)(a.ws + WS_ROWIDX); float* ROWGATE = (float*)(a.ws + WS_ROWGATE);
    unsigned* CNT = (unsigned*)(a.ws + WS_CTL) + CW_CNT + l * 64; unsigned* CUR = (unsigned*)(a.ws + WS_CTL) + CW_CUR + l * 64;
    LAS int* off = (LAS int*)(t.lds + LDS_MISC + 64); LAS int* cnt = off + 64; LAS int* hist = off + 128; LAS int* base = off + 192; LAS int* cur = off + 256;
    if (t.tid < NEXP) { hist[t.tid] = 0; cur[t.tid] = 0; }
    moe_offsets(CNT, off, cnt, t.tid);
    const int rpb = (Mtok + t.G - 1) / t.G, s0 = t.bid * rpb * 4; int s1 = (t.bid + 1) * rpb * 4; if (s1 > Mtok * 4) s1 = Mtok * 4;
    for (int s = s0 + t.tid; s < s1; s += NTHREADS) atomicAdd((int*)&hist[TOPI[s]], 1);
    __syncthreads();
    if (t.tid < NEXP) base[t.tid] = hist[t.tid] ? (int)atomicAdd(&CUR[t.tid], (unsigned)hist[t.tid]) : 0;
    __syncthreads();
    for (int s = s0 + t.tid; s < s1; s += NTHREADS) { const int e = TOPI[s]; const int p = off[e] + base[e] + atomicAdd((int*)&cur[e], 1);
        POS[s] = p; ROWIDX[p] = s >> 2; ROWGATE[p] = TOPP[s]; }
    for (int e = t.bid; e < NEXP; e += t.G) { const int lo = off[e] + cnt[e], hi = off[e] + ((cnt[e] + 255) & ~255);
        for (int p = lo + t.tid; p < hi; p += NTHREADS) { ROWIDX[p] = 0; ROWGATE[p] = 0.f; } }
    __syncthreads();
}
__device__ __forceinline__ int moe_tile_table(const Args& a, const Tc& t, int l) {
    unsigned* CNT = (unsigned*)(a.ws + WS_CTL) + CW_CNT + l * 64;
    LAS int* off = (LAS int*)(t.lds + LDS_MISC + 64); LAS int* cnt = off + 64; LAS int* tile_e = (LAS int*)(t.lds + LDS_TILE_E);
    const int ntiles = moe_offsets(CNT, off, cnt, t.tid);
    for (int tt = t.tid; tt < ntiles; tt += NTHREADS) { int e = 0;
        for (int q = 1; q < NEXP; ++q) if ((off[q] >> 8) <= tt) e = q;
        tile_e[tt] = e; }
    __syncthreads();
    return ntiles;
}

__device__ __forceinline__ void phase_combine(const Args& a, const Tc& t, int l, int Mtok) {
    const int gw = t.bid * NWAVES + t.wave, NGW = t.G * NWAVES;
    float* X = (float*)(a.ws + WS_X); bf16_t* H = (bf16_t*)(a.ws + WS_H); const bf16_t* Y = (const bf16_t*)(a.ws + WS_Y); const int* POS = (const int*)(a.ws + WS_POS);
    const float* MODS = (const float*)(a.ws + WS_MODS) + (size_t)l * NR * 6144;
    for (int row = gw; row < Mtok; row += NGW) {
        const float* md = MODS + (size_t)mod_row(row) * 6144 + 5 * 1024;
        const int p0 = POS[row * 4], p1 = POS[row * 4 + 1], p2 = POS[row * 4 + 2], p3 = POS[row * 4 + 3];
        f32x4 v[4], h[4];
#pragma unroll
        for (int j = 0; j < 4; ++j) { const int c = 4 * t.lane + 256 * j;
            const u32x2 y0 = *(const u32x2*)(Y + (size_t)p0 * D + c), y1 = *(const u32x2*)(Y + (size_t)p1 * D + c), y2 = *(const u32x2*)(Y + (size_t)p2 * D + c), y3 = *(const u32x2*)(Y + (size_t)p3 * D + c);
            f32x4 s; s[0] = (bf_lo(y0.x) + bf_lo(y1.x)) + (bf_lo(y2.x) + bf_lo(y3.x)); s[1] = (bf_hi(y0.x) + bf_hi(y1.x)) + (bf_hi(y2.x) + bf_hi(y3.x));
            s[2] = (bf_lo(y0.y) + bf_lo(y1.y)) + (bf_lo(y2.y) + bf_lo(y3.y)); s[3] = (bf_hi(y0.y) + bf_hi(y1.y)) + (bf_hi(y2.y) + bf_hi(y3.y));
            const f32x4 g = *(const f32x4*)(md + c);
            v[j] = *(const f32x4*)(X + (size_t)row * D + c) + g * s; }
        if (l + 1 < DEPTH) {
#pragma unroll
            for (int j = 0; j < 4; ++j) *(f32x4*)(X + (size_t)row * D + 4 * t.lane + 256 * j) = v[j];
            const float* md2 = MODS + (size_t)NR * 6144 + (size_t)mod_row(row) * 6144;
            norm_mod_store(v, a.in[I_N1G] + (size_t)(l + 1) * D, md2, md2 + 1024, H + (size_t)row * D, t.lane, h);
        } else {
            float ss = 0.f;
#pragma unroll
            for (int j = 0; j < 4; ++j) ss += (v[j][0] * v[j][0] + v[j][1] * v[j][1]) + (v[j][2] * v[j][2] + v[j][3] * v[j][3]);
            const float rstd = 1.0f / sqrtf(wave_sum(ss) * (1.0f / D) + 1e-6f);
#pragma unroll
            for (int j = 0; j < 4; ++j) { const int c = 4 * t.lane + 256 * j; const f32x4 g = *(const f32x4*)(a.in[I_FNG] + c); *(f32x4*)(a.out + (size_t)row * D + c) = v[j] * rstd * g; }
        }
    }
}

#ifndef EMU
__device__ __forceinline__ void launder_tid(Tc& t) { int x = threadIdx.x; asm volatile("" : "+v"(x)); t.tid = x; t.lane = x & 63; t.wave = __builtin_amdgcn_readfirstlane(x >> 6); }
#endif
constexpr int PH_PER_LAYER = 12, N_PHASES = 2 + DEPTH * PH_PER_LAYER;
__global__ void __launch_bounds__(NTHREADS, 2) fwd(Args a) {
#ifdef EMU
    unsigned char* lds_raw = EMU_DYN_LDS();
#else
    extern __shared__ __attribute__((aligned(16))) unsigned char lds_raw[];
#endif
    Tc t; t.lds = (LAS unsigned char*)lds_raw; t.tid = threadIdx.x; t.lane = t.tid & 63; t.wave = __builtin_amdgcn_readfirstlane(t.tid >> 6); t.G = gridDim.x; t.bid = blockIdx.x;
    const int lo = a.ph_lo, hi = a.ph_hi;
    volatile LAS unsigned* misc = (volatile LAS unsigned*)(t.lds + LDS_MISC);
    if (t.tid < 16) misc[t.tid] = 0u;
    __syncthreads();
    XcdBarrier bar; bar.bar = (unsigned*)(a.ws + WS_CTL) + CW_BAR; bar.x = 0; bar.st = misc;
    if (hi - lo > 1) bar = xcd_barrier_post((unsigned*)(a.ws + WS_CTL) + CW_BAR, misc);
#ifdef EMU
#define LAUNDER_TID() ((void)0)
#else
#define LAUNDER_TID() launder_tid(t)
#endif
#define IN_PH(k) (lo <= (k) && (k) < hi && (LAUNDER_TID(), true))
#define REPS(bit) (((PROBE_DOUBLE >> (bit)) & 1) ? 2 : 1)
#define SEAM(k) do { if ((k) + 1 < hi) xcd_barrier(bar); } while (0)
    if (IN_PH(0)) { for (int rep = 0; rep < REPS(15); ++rep) phase_pro0(a, t); SEAM(0); }
    if (IN_PH(1)) { phase_pro1(a, t); SEAM(1); }
    for (int l = 0; l < DEPTH; ++l) {
        const int pb = 2 + l * PH_PER_LAYER;
        const bool lastl = (l == DEPTH - 1);
        const int Mtok = lastl ? ML : M;
        const float* MODSL = (const float*)(a.ws + WS_MODS) + (size_t)l * NR * 6144;
        if (IN_PH(pb + 0)) {
            pg8::Gemm g{(const bf16_t*)(a.ws + WS_H), (const bf16_t*)(a.ws + WS_WIN) + (size_t)l * NU * D, D, nullptr};
            pg8::DenseSched S; S.o.init(M / 256, NU / 256, t.G, t.bid);
            pg8::EpiF32 E{(float*)(a.ws + WS_U), NU};
            for (int rep = 0; rep < REPS(0); ++rep) pg8::gemm_phase<pg8::EpiF32, pg8::DenseSched, false>(t.lds, t.tid, g, S, E);
            SEAM(pb + 0);
        }
        if (IN_PH(pb + 1)) { for (int rep = 0; rep < REPS(1); ++rep) phase_prep(a, t, l); SEAM(pb + 1); }
        if (IN_PH(pb + 2)) {
            rwkv_a_all(a, t);
            for (int u = t.bid; u < SSD_UNITS + GLA_UNITS; u += t.G) { if (u < SSD_UNITS) ssd_a1_unit(a, t, l, u); else gla_a1_unit(a, t, u - SSD_UNITS); }
            SEAM(pb + 2);
        }
        if (IN_PH(pb + 3)) {
            for (int rep = 0; rep < REPS(5); ++rep) for (int task = t.bid; task < RKB_TASKS; task += t.G) rwkv_b_task(a, t, task);
            if (t.G >= 2 * RKB_TASKS) { if (t.bid >= RKB_TASKS) { ssd_b_carry(a, t, t.bid - RKB_TASKS, t.G - RKB_TASKS); gla_b_carry(a, t, t.bid - RKB_TASKS, t.G - RKB_TASKS); } }
            else { ssd_b_carry(a, t, t.bid, t.G); gla_b_carry(a, t, t.bid, t.G); }
            SEAM(pb + 3);
        }
        if (IN_PH(pb + 4)) {
            for (int rep = 0; rep < REPS(6); ++rep) for (int u = t.bid; u < SSD_UNITS + GLA_UNITS; u += t.G) { if (u < SSD_UNITS) ssd_c_unit(a, t, l, u); else gla_c_unit(a, t, u - SSD_UNITS); }
            SEAM(pb + 4);
        }
        if (IN_PH(pb + 5)) { for (int rep = 0; rep < REPS(3); ++rep) phase_mixout(a, t, l, Mtok); SEAM(pb + 5); }
        if (IN_PH(pb + 6)) {
            pg8::Gemm g{(const bf16_t*)(a.ws + WS_MIX), (const bf16_t*)(a.ws + WS_WOUT) + (size_t)l * D * D, D, nullptr};
            pg8::DenseSched S; S.o.init(Mtok / 256, D / 256, t.G, t.bid);
            pg8::EpiResid E{(float*)(a.ws + WS_X), MODSL};
            pg8::gemm_phase<pg8::EpiResid, pg8::DenseSched, false>(t.lds, t.tid, g, S, E);
            SEAM(pb + 6);
        }
        if (IN_PH(pb + 7)) { phase_router(a, t, l, Mtok); SEAM(pb + 7); }
        if (IN_PH(pb + 8)) { phase_lists(a, t, l, Mtok); SEAM(pb + 8); }
        if (IN_PH(pb + 9)) {
            const int ntiles = moe_tile_table(a, t, l);
            pg8::Gemm g{(const bf16_t*)(a.ws + WS_H), (const bf16_t*)(a.ws + WS_WGU) + (size_t)l * NEXP * 2048 * D, D, (const int*)(a.ws + WS_ROWIDX)};
            pg8::MoeSched S; S.o.init(ntiles, 8, t.G, t.bid); S.tile_e = (const LAS int*)(t.lds + LDS_TILE_E); S.nct = 8;
            pg8::EpiSwiglu E{(bf16_t*)(a.ws + WS_ACT), a.in[I_BGU] + (size_t)l * NEXP * 2048};
            for (int rep = 0; rep < REPS(7); ++rep) pg8::gemm_phase<pg8::EpiSwiglu, pg8::MoeSched, true>(t.lds, t.tid, g, S, E);
            SEAM(pb + 9);
        }
        if (IN_PH(pb + 10)) {
            const int ntiles = moe_tile_table(a, t, l);
            pg8::Gemm g{(const bf16_t*)(a.ws + WS_ACT), (const bf16_t*)(a.ws + WS_WD) + (size_t)l * NEXP * D * DFF, DFF, nullptr};
            pg8::MoeSched S; S.o.init(ntiles, 4, t.G, t.bid); S.tile_e = (const LAS int*)(t.lds + LDS_TILE_E); S.nct = 4;
            pg8::EpiDown E{(bf16_t*)(a.ws + WS_Y), a.in[I_BDN] + (size_t)l * NEXP * D, (const float*)(a.ws + WS_ROWGATE)};
            for (int rep = 0; rep < REPS(8); ++rep) pg8::gemm_phase<pg8::EpiDown, pg8::MoeSched, false>(t.lds, t.tid, g, S, E);
            SEAM(pb + 10);
        }
        if (IN_PH(pb + 11)) { phase_combine(a, t, l, Mtok); SEAM(pb + 11); }
    }
#undef IN_PH
#undef SEAM
}

}

extern "C" void kernel_launch(void* const* d_in, const int* in_sizes, int n_in, void* d_out, int out_size, void* d_ws, size_t ws_size, hipStream_t stream) {
    using namespace mk;
    static int grid = 0;
    if (grid == 0) {
        if (n_in != 37 || out_size != ML * D || ws_size < WS_END) { fprintf(stderr, "kernel_launch: unexpected shapes (n_in %d out %d ws %zu need %zu)\n", n_in, out_size, ws_size, (size_t)WS_END); grid = -1; return; }
#ifdef EMU
        { const char* e = getenv("EMU_GRID"); grid = e ? atoi(e) : 8; }
#else
        int dev = 0, cus = 0, per_cu = 0;
        if (hipGetDevice(&dev) != hipSuccess || hipDeviceGetAttribute(&cus, hipDeviceAttributeMultiprocessorCount, dev) != hipSuccess) { grid = -1; return; }
        if (hipFuncSetAttribute((const void*)fwd, hipFuncAttributeMaxDynamicSharedMemorySize, LDS_BYTES) != hipSuccess) { fprintf(stderr, "kernel_launch: hipFuncSetAttribute failed\n"); grid = -1; return; }
        if (hipOccupancyMaxActiveBlocksPerMultiprocessor(&per_cu, (const void*)fwd, NTHREADS, LDS_BYTES) != hipSuccess || per_cu < 1) fprintf(stderr, "kernel_launch: occupancy query reports %d\n", per_cu);
        (void)hipGetLastError();
        grid = cus;
#endif
    }
    if (grid < 0) return;
    (void)hipMemsetAsync((char*)d_ws + WS_CTL, 0, CTL_BYTES, stream);
    Args a{};
    for (int i = 0; i < 37; ++i) a.in[i] = (const float*)d_in[i];
    a.out = (float*)d_out; a.ws = (unsigned char*)d_ws;
#if N_LAUNCH_MODE == 1
    a.ph_lo = 0; a.ph_hi = N_PHASES;
    hipLaunchKernelGGL(fwd, dim3(grid), dim3(NTHREADS), LDS_BYTES, stream, a);
#else
    for (int p = 0; p < N_PHASES; ++p) { a.ph_lo = p; a.ph_hi = p + 1; hipLaunchKernelGGL(fwd, dim3(grid), dim3(NTHREADS), LDS_BYTES, stream, a); }
#endif
}
```

```cpp
#ifndef EMU
#include <hip/hip_runtime.h>
#endif
#include <cstdio>
#include <cstdint>
#include <cmath>

#ifndef CFG_BATCH
#define CFG_BATCH 4
#define CFG_SEQ 4096
#define CFG_CTX 256
#define CFG_DEPTH 4
#define CFG_NEXP 32
#endif
#ifndef PROBE_DOUBLE
#define PROBE_DOUBLE 0
#endif
#ifndef PROBE_SPIN
#define PROBE_SPIN (-1)
#endif
#ifndef N_LAUNCH_MODE
#define N_LAUNCH_MODE 1
#endif

namespace mk {
constexpr int BATCH = CFG_BATCH, SEQ = CFG_SEQ, CTX = CFG_CTX, DEPTH = CFG_DEPTH, NEXP = CFG_NEXP;
constexpr int D = 1024, ML = BATCH * SEQ, MC = BATCH * CTX, M = ML + MC, NR = BATCH + 1;
constexpr int IN_COLS = 3280, NU = 3328;
constexpr int TOPK = 4, DFF = 1024;
constexpr int MAXROWS = M * TOPK + NEXP * 256;
constexpr int NTHREADS = 512, NWAVES = 8;
constexpr int U_GQ = 0, U_GK = 128, U_GV = 256, U_GOG = 512, U_GLF = 768, U_GLB = 784;
constexpr int U_RW = 800, U_RR = 800, U_RK = 1056, U_RV = 1312, U_RLWF = 1568, U_RLWB = 1600, U_RLA = 1632, U_RLGT = 1664;
constexpr int U_SZ = 1728, U_SXBC = 2240, U_SDT = 3264;
static_assert(SEQ % 256 == 0 && CTX % 256 == 0 && M % 256 == 0, "row tiles");

constexpr size_t al256(size_t x) { return (x + 255) & ~(size_t)255; }
constexpr size_t WS_CTL = 0, CTL_BYTES = 1u << 20;
constexpr size_t WS_MODS = WS_CTL + CTL_BYTES;
constexpr size_t WS_X = WS_MODS + al256((size_t)DEPTH * NR * 6144 * 4);
constexpr size_t WS_H = WS_X + al256((size_t)M * D * 4);
constexpr size_t WS_U = WS_H + al256((size_t)M * D * 2);
constexpr size_t WS_GG = WS_U + al256((size_t)M * NU * 4);
constexpr size_t WS_RW7 = WS_GG + al256((size_t)2 * M * 128 * 4);
constexpr size_t WS_SXBC = WS_RW7 + al256((size_t)7 * M * 256 * 4);
constexpr size_t WS_SDT = WS_SXBC + al256((size_t)M * 1024 * 4);
constexpr size_t WS_OG = WS_SDT + al256((size_t)M * 16 * 4);
constexpr size_t WS_OR = WS_OG + al256((size_t)2 * M * 256 * 4);
constexpr size_t WS_OS = WS_OR + al256((size_t)2 * M * 256 * 4);
constexpr size_t WS_MIX = WS_OS + al256((size_t)2 * M * 512 * 4);
constexpr size_t WS_TOPI = WS_MIX + al256((size_t)M * D * 2);
constexpr size_t WS_TOPP = WS_TOPI + al256((size_t)M * 4 * 4);
constexpr size_t WS_POS = WS_TOPP + al256((size_t)M * 4 * 4);
constexpr size_t WS_ROWIDX = WS_POS + al256((size_t)M * 4 * 4);
constexpr size_t WS_ROWGATE = WS_ROWIDX + al256((size_t)MAXROWS * 4);
constexpr size_t WS_ACT = WS_ROWGATE + al256((size_t)MAXROWS * 4);
constexpr size_t WS_Y = WS_ACT + al256((size_t)MAXROWS * DFF * 2);
constexpr size_t WS_WIN = WS_Y + al256((size_t)MAXROWS * D * 2);
constexpr size_t WS_WOUT = WS_WIN + al256((size_t)DEPTH * NU * D * 2);
constexpr size_t WS_WGU = WS_WOUT + al256((size_t)DEPTH * D * D * 2);
constexpr size_t WS_WD = WS_WGU + al256((size_t)DEPTH * NEXP * 2048 * D * 2);
constexpr int CTXC = CTX / 64, LATC = SEQ / 64, NRC = CTXC + LATC;
constexpr size_t WS_SZ = WS_WD + al256((size_t)DEPTH * NEXP * D * DFF * 2);
constexpr size_t WS_SDEC = WS_SZ + al256((size_t)BATCH * 16 * NRC * 64 * 128 * 2);
constexpr size_t WS_SST = WS_SDEC + al256((size_t)BATCH * 16 * NRC * 4);
constexpr int RKT = 16, NCK = (CTX + SEQ) / RKT;
constexpr int RK_PA = 0, RK_RA = 8192, RK_QA = 10240, RK_VB = 11264, RK_ZC = 15360, RK_BYTES = 23552;
constexpr size_t WS_RK = WS_SST + al256((size_t)BATCH * 16 * NRC * 64 * 128 * 2);
constexpr int GC_CTX = CTX / 32, GC_LAT = SEQ / 32, GNC = GC_CTX + GC_LAT;
constexpr size_t WS_GZ = WS_RK + al256((size_t)BATCH * 8 * NCK * RK_BYTES);
constexpr size_t WS_GDEC = WS_GZ + al256((size_t)BATCH * 8 * GNC * 2048 * 4);
constexpr size_t WS_GST = WS_GDEC + al256((size_t)BATCH * 8 * GNC * 32 * 4);
constexpr size_t WS_END = WS_GST + al256((size_t)BATCH * 8 * GNC * 2048 * 2);
constexpr int CW_BAR = 4096;
constexpr int CW_CNT = 16384;
constexpr int CW_CUR = 16384 + 64 * 8;
constexpr int LDS_STAGE = 131072;
constexpr int LDS_TILE_E = LDS_STAGE;
constexpr int LDS_MISC = LDS_STAGE + 2048;
constexpr int LDS_PTRS = LDS_MISC + 2048;
constexpr int LDS_BYTES = 147456;

#ifdef EMU
#define LAS
#define ASM_VM0() ((void)0)
#define ASM_LGKM0() ((void)0)
#define ASM_MEMFENCE() ((void)0)
#define WAIT_V(n) ((void)0)
#define WAIT_L(n) ((void)0)
#define WAVE_LDS_FENCE() emu_wave_sync()
#define LAUNDER_V(x) ((void)0)
#define LDS_BARRIER() emu_block_sync()
#else
#define LAS __attribute__((address_space(3)))
#define ASM_VM0() asm volatile("s_waitcnt vmcnt(0)" ::: "memory")
#define ASM_LGKM0() asm volatile("s_waitcnt lgkmcnt(0)" ::: "memory")
#define ASM_MEMFENCE() asm volatile("" ::: "memory")
#define WAIT_V(n) asm volatile("s_waitcnt vmcnt(" #n ")" ::: "memory")
#define WAIT_L(n) asm volatile("s_waitcnt lgkmcnt(" #n ")" ::: "memory")
#define LDS_BARRIER() do { asm volatile("s_waitcnt lgkmcnt(0)" ::: "memory"); __builtin_amdgcn_s_barrier(); asm volatile("" ::: "memory"); } while (0)
#define LAUNDER_V(x) asm volatile("" : "+v"(x))
#define WAVE_LDS_FENCE() do { asm volatile("s_waitcnt lgkmcnt(0)" ::: "memory"); } while (0)
#endif

typedef unsigned short bf16_t;
typedef short bf16x8 __attribute__((ext_vector_type(8)));
typedef float f32x4 __attribute__((ext_vector_type(4)));
typedef float f32x2 __attribute__((ext_vector_type(2)));
typedef unsigned u32x4 __attribute__((ext_vector_type(4)));
typedef unsigned u32x2 __attribute__((ext_vector_type(2)));

#ifdef EMU
__device__ __forceinline__ unsigned f2bf(float f) { unsigned u = __float_as_uint(f); return (u + 0x7fffu + ((u >> 16) & 1u)) >> 16; }
__device__ __forceinline__ unsigned pk2(float lo, float hi) { return f2bf(lo) | (f2bf(hi) << 16); }
#else
typedef __bf16 hw_bf16x2 __attribute__((ext_vector_type(2)));
__device__ __forceinline__ unsigned pk2(float lo, float hi) { const f32x2 v = {lo, hi}; return __builtin_bit_cast(unsigned, __builtin_convertvector(v, hw_bf16x2)); }
__device__ __forceinline__ unsigned f2bf(float f) { return pk2(f, f) & 0xffffu; }
#endif
typedef int i32x4 __attribute__((ext_vector_type(4)));
typedef int i32x8 __attribute__((ext_vector_type(8)));
#ifdef EMU
__device__ __forceinline__ unsigned f2e4m3(float f) {
    const unsigned sgn = (__float_as_uint(f) >> 24) & 0x80u; float a = fabsf(f); if (!(a < 448.f)) a = 448.f;
    if (a < 0.015625f) { const int q = (int)nearbyintf(a * 512.f); return sgn | (unsigned)q; }
    int e; const float m = frexpf(a, &e); int q = (int)nearbyintf(m * 16.f); int ee = e - 1;
    if (q == 16) { q = 8; ++ee; }
    return sgn | (unsigned)(((ee + 7) << 3) | (q - 8));
}
__device__ __forceinline__ unsigned pk4_fp8(float a, float b, float c, float d) { return f2e4m3(a) | (f2e4m3(b) << 8) | (f2e4m3(c) << 16) | (f2e4m3(d) << 24); }
#else
__device__ __forceinline__ unsigned pk4_fp8(float a, float b, float c, float d) {
    a = __builtin_amdgcn_fmed3f(a, -448.f, 448.f); b = __builtin_amdgcn_fmed3f(b, -448.f, 448.f); c = __builtin_amdgcn_fmed3f(c, -448.f, 448.f); d = __builtin_amdgcn_fmed3f(d, -448.f, 448.f);
    int w = __builtin_amdgcn_cvt_pk_fp8_f32(a, b, 0, false); w = __builtin_amdgcn_cvt_pk_fp8_f32(c, d, w, true); return (unsigned)w;
}
#endif
__device__ __forceinline__ float bf_lo(unsigned w) { return __uint_as_float(w << 16); }
__device__ __forceinline__ float bf_hi(unsigned w) { return __uint_as_float(w & 0xffff0000u); }
__device__ __forceinline__ float ldbf(const bf16_t* p) { return __uint_as_float(((unsigned)*p) << 16); }
__device__ __forceinline__ f32x4 ldbf4(const bf16_t* p) { const u32x2 w = *(const u32x2*)p; return (f32x4){bf_lo(w.x), bf_hi(w.x), bf_lo(w.y), bf_hi(w.y)}; }
__device__ __forceinline__ void stbf(bf16_t* p, float v) { *p = (bf16_t)f2bf(v); }
__device__ __forceinline__ float wave_sum(float v) {
#pragma unroll
    for (int o = 1; o < 64; o <<= 1) v += __shfl_xor(v, o);
    return v;
}
__device__ __forceinline__ float sum8(float v) { v += __shfl_xor(v, 1); v += __shfl_xor(v, 2); v += __shfl_xor(v, 4); return v; }
__device__ __forceinline__ float fexp(float x) { return __builtin_amdgcn_exp2f(x * 1.4426950408889634f); }
__device__ __forceinline__ float frcp(float x) { return __builtin_amdgcn_rcpf(x); }
__device__ __forceinline__ float frsq(float x) { return __builtin_amdgcn_rsqf(x); }
__device__ __forceinline__ float flog(float x) { return __builtin_amdgcn_logf(x) * 0.6931471805599453f; }
__device__ __forceinline__ float sigmoidf_(float x) { return frcp(1.0f + fexp(-x)); }
__device__ __forceinline__ float siluf_(float x) { return x * frcp(1.0f + fexp(-x)); }
__device__ __forceinline__ float ftanh(float x) { return 1.0f - 2.0f * frcp(fexp(2.0f * x) + 1.0f); }
__device__ __forceinline__ float softplusf_(float x) { return fmaxf(x, 0.f) + flog(1.0f + fexp(-fabsf(x))); }
__device__ __forceinline__ float logsigmoidf_(float x) { return -softplusf_(-x); }

#define XB_TMO      128
#define XB_XCNT(j)  (256  + 64 * (j))
#define XB_XSUB(j)  (1280 + 64 * (j))
#define XB_XGEN(j)  (2304 + 64 * (j))
#define XB_TOP      3328
#define XB_TOPGEN   3392
#define XCD_BAR_WORDS 3456
#ifdef EMU
#define XB_SPIN_CAP (0xffffffffu)
#else
#define XB_SPIN_CAP (1u << 22)
#endif
__device__ __forceinline__ unsigned xb_ld(unsigned* p)              { return __hip_atomic_load(p, __ATOMIC_RELAXED, __HIP_MEMORY_SCOPE_AGENT); }
__device__ __forceinline__ unsigned xb_add(unsigned* p, unsigned v) { return __hip_atomic_fetch_add(p, v, __ATOMIC_RELAXED, __HIP_MEMORY_SCOPE_AGENT); }
__device__ __forceinline__ unsigned xb_xcc_id() { return (unsigned)__builtin_amdgcn_s_getreg((3 << 11) | 20) & 0xFu; }
#define XB_SPIN(cond, bar) do { unsigned _sp = 0; while (cond) { __builtin_amdgcn_s_sleep(1); \
    if ((++_sp & 255u) == 0u) { if (xb_ld(&(bar)[XB_TMO])) break; if (_sp > XB_SPIN_CAP) { atomicAdd(&(bar)[XB_TMO], 1u); break; } } } } while (0)
struct XcdBarrier { unsigned* bar; unsigned x; volatile LAS unsigned* st; };
__device__ __forceinline__ XcdBarrier xcd_barrier_post(unsigned* bar, volatile LAS unsigned* st) {
    XcdBarrier b; b.bar = bar; b.x = xb_xcc_id(); b.st = st;
    if (threadIdx.x == 0) (void)xb_add(&bar[XB_XCNT(b.x)], 1u);
    return b;
}
__device__ __forceinline__ void xcd_barrier_complete(unsigned* bar, unsigned x, unsigned& nloc, unsigned& nx) {
    const unsigned G = gridDim.x * gridDim.y * gridDim.z;
    unsigned sum, cnt, mine, sp = 0u;
    for (;;) {
        sum = 0u; cnt = 0u; mine = 0u;
#pragma unroll
        for (unsigned j = 0; j < 16; ++j) { const unsigned c = xb_ld(&bar[XB_XCNT(j)]); sum += c; cnt += (c > 0u) ? 1u : 0u; mine = (j == x) ? c : mine; }
        if (sum == G) break;
        __builtin_amdgcn_s_sleep(1);
        if ((++sp & 255u) == 0u) { if (xb_ld(&bar[XB_TMO])) break; if (sp > XB_SPIN_CAP) { atomicAdd(&bar[XB_TMO], 1u); break; } }
    }
    nloc = mine > 0u ? mine : 1u; nx = cnt > 0u ? cnt : 1u;
}
__device__ __forceinline__ void xcd_barrier(const XcdBarrier& b) {
    ASM_VM0();
    __syncthreads();
    if (threadIdx.x == 0) {
        unsigned* bar = b.bar;
        __builtin_amdgcn_s_waitcnt(0);
        unsigned nloc = b.st[0], nx = b.st[1];
        if (nloc == 0u) { xcd_barrier_complete(bar, b.x, nloc, nx); b.st[0] = nloc; b.st[1] = nx; }
        const unsigned old = xb_add(&bar[XB_XSUB(b.x)], 1u);
        const unsigned gen = old / nloc;
        if (old + 1u == (gen + 1u) * nloc) {
            __builtin_amdgcn_fence(__ATOMIC_RELEASE, "agent");
            ASM_VM0();
            const unsigned og = xb_add(&bar[XB_TOP], 1u);
            const unsigned tg = og / nx;
            if (og + 1u == (tg + 1u) * nx) xb_add(&bar[XB_TOPGEN], 1u);
            else XB_SPIN(xb_ld(&bar[XB_TOPGEN]) == tg, bar);
            __builtin_amdgcn_fence(__ATOMIC_ACQUIRE, "agent");
            xb_add(&bar[XB_XGEN(b.x)], 1u);
            ASM_VM0();
        } else {
            XB_SPIN(xb_ld(&bar[XB_XGEN(b.x)]) == gen, bar);
            __builtin_amdgcn_fence(__ATOMIC_ACQUIRE, "agent");
            ASM_VM0();
        }
    }
    __syncthreads();
}

namespace pg8 {
constexpr int BM = 256, BK = 64, HALF = 128, HTB = HALF * BK * 2, STAGE_BYTES = 8 * HTB, NXCD = 8, WGM = 8;
__host__ __device__ __forceinline__ int lds_byte(int r, int c) { const int st = (r >> 4) * 2 + (c >> 5), rr = r & 15, cc = c & 31, ob = rr * 64 + cc * 2; return st * 1024 + (ob ^ (((ob >> 9) & 1) << 5)); }
__host__ __device__ __forceinline__ void stage_rc(int b, int& R, int& C) { const int st = b / 1024, sb = b % 1024, swz = sb ^ (((sb >> 9) & 1) << 5); R = (st >> 1) * 16 + swz / 64; C = (st & 1) * 32 + (swz % 64) / 2; }
__host__ __device__ __forceinline__ int perm32(int rho) { const int n = rho >> 4, i = rho & 15; return 8 * (i >> 2) + 4 * n + (i & 3); }
struct Unit { int pm, pn, pb; };
struct Gemm { const bf16_t* A; const bf16_t* Bt; int K; const int* rowidx; };
struct Order {
    int nM, nN, nwg, G, c;
    __device__ __forceinline__ void init(int nM_, int nN_, int G_, int c_) { nM = nM_; nN = nN_; nwg = nM * nN; G = G_; c = c_; }
    __device__ __forceinline__ bool tile(int i, int& pm, int& pn) const {
        const long L = (long)i * G + c; if (L >= nwg) return false;
        int wgid = (int)L; { const int q = nwg / NXCD, r = nwg % NXCD, xcd = wgid % NXCD, off = wgid / NXCD; wgid = (xcd < r ? xcd * (q + 1) : r * (q + 1) + (xcd - r) * q) + off; }
        const int nig = WGM * nN, gid = wgid / nig, fm = gid * WGM, gsz = (nM - fm) < WGM ? (nM - fm) : WGM;
        pm = fm + ((wgid % nig) % gsz); pn = (wgid % nig) / gsz; return true;
    }
};
struct DenseSched { Order o; __device__ __forceinline__ bool next(int i, Unit& u) const { if (!o.tile(i, u.pm, u.pn)) return false; u.pb = u.pn; return true; } };
struct MoeSched { Order o; const LAS int* tile_e; int nct;
    __device__ __forceinline__ bool next(int i, Unit& u) const { if (!o.tile(i, u.pm, u.pn)) return false; u.pb = tile_e[u.pm] * nct + u.pn; return true; } };

__device__ __forceinline__ unsigned cvt_pk_bf16(float lo, float hi) {
#ifdef EMU
    return pk2(lo, hi);
#else
    return pk2(lo, hi);
#endif
}
struct EpiF32 {
    static constexpr bool PERM = false;
    float* C; int ldc;
    __device__ __forceinline__ void operator()(const f32x4 (&acc)[2][2][4][2], const Unit& u, int wr, int wc, int fr, int fq) const {
        const int row0 = u.pm * BM + wr * 64 + fr, col0 = u.pn * BM + wc * 32 + 4 * fq;
#pragma unroll
        for (int ai = 0; ai < 2; ++ai)
#pragma unroll
            for (int m = 0; m < 4; ++m) { float* rowp = C + (size_t)(row0 + ai * HALF + m * 16) * ldc + col0;
#pragma unroll
                for (int bj = 0; bj < 2; ++bj)
#pragma unroll
                    for (int n = 0; n < 2; ++n) *(f32x4*)(rowp + bj * HALF + n * 16) = acc[ai][bj][m][n]; }
    }
};
struct EpiBf16 {
    static constexpr bool PERM = true;
    bf16_t* C; int ldc;
    __device__ __forceinline__ void operator()(const f32x4 (&acc)[2][2][4][2], const Unit& u, int wr, int wc, int fr, int fq) const {
        const int row0 = u.pm * BM + wr * 64 + fr, col0 = u.pn * BM + wc * 32 + 8 * fq;
#pragma unroll
        for (int ai = 0; ai < 2; ++ai)
#pragma unroll
            for (int m = 0; m < 4; ++m) { bf16_t* rowp = C + (size_t)(row0 + ai * HALF + m * 16) * ldc + col0;
#pragma unroll
                for (int bj = 0; bj < 2; ++bj) { const f32x4 v0 = acc[ai][bj][m][0], v1 = acc[ai][bj][m][1];
                    u32x4 w; w.x = cvt_pk_bf16(v0[0], v0[1]); w.y = cvt_pk_bf16(v0[2], v0[3]); w.z = cvt_pk_bf16(v1[0], v1[1]); w.w = cvt_pk_bf16(v1[2], v1[3]);
                    *(u32x4*)(rowp + bj * HALF) = w; } }
    }
};
struct EpiResid {
    static constexpr bool PERM = true;
    bf16_t* X; const float* mods;
    __device__ __forceinline__ void operator()(const f32x4 (&acc)[2][2][4][2], const Unit& u, int wr, int wc, int fr, int fq) const {
        const int row0 = u.pm * BM + wr * 64 + fr, col0 = u.pn * BM + wc * 32 + 8 * fq;
        const int rbase = u.pm * BM; const int mrow = rbase < ML ? rbase / SEQ : BATCH;
        const float* g = mods + (size_t)mrow * 6144 + 2 * 1024 + col0;
        f32x4 gv[2][2];
#pragma unroll
        for (int bj = 0; bj < 2; ++bj)
#pragma unroll
            for (int n = 0; n < 2; ++n) gv[bj][n] = *(const f32x4*)(g + bj * HALF + 4 * n);
#pragma unroll
        for (int ai = 0; ai < 2; ++ai)
#pragma unroll
            for (int m = 0; m < 4; ++m) { bf16_t* rowp = X + (size_t)(row0 + ai * HALF + m * 16) * D + col0;
#pragma unroll
                for (int bj = 0; bj < 2; ++bj) { u32x4* p = (u32x4*)(rowp + bj * HALF); const u32x4 xo = *p;
                    const f32x4 v0 = (f32x4){bf_lo(xo.x), bf_hi(xo.x), bf_lo(xo.y), bf_hi(xo.y)} + gv[bj][0] * acc[ai][bj][m][0];
                    const f32x4 v1 = (f32x4){bf_lo(xo.z), bf_hi(xo.z), bf_lo(xo.w), bf_hi(xo.w)} + gv[bj][1] * acc[ai][bj][m][1];
                    u32x4 w; w.x = cvt_pk_bf16(v0[0], v0[1]); w.y = cvt_pk_bf16(v0[2], v0[3]); w.z = cvt_pk_bf16(v1[0], v1[1]); w.w = cvt_pk_bf16(v1[2], v1[3]);
                    *p = w; } }
    }
};
constexpr float F8_WSCALE = 64.0f, F8_ASCALE = 4.0f;
struct EpiSwiglu {
    static constexpr bool PERM = true;
    unsigned char* ACT; const float* bgu;
    __device__ __forceinline__ void operator()(const f32x4 (&acc)[2][2][4][2], const Unit& u, int wr, int wc, int fr, int fq) const {
        const int e = u.pb >> 3;
        const int row0 = u.pm * BM + wr * 64 + fr, j0 = u.pn * 128 + wc * 32 + 8 * fq;
        const float* bg = bgu + (size_t)e * 2048 + j0;
        f32x4 bgl[2], bln[2];
#pragma unroll
        for (int n = 0; n < 2; ++n) { bgl[n] = *(const f32x4*)(bg + 4 * n); bln[n] = *(const f32x4*)(bg + 1024 + 4 * n); }
#pragma unroll
        for (int ai = 0; ai < 2; ++ai)
#pragma unroll
            for (int m = 0; m < 4; ++m) { unsigned char* rowp = ACT + (size_t)(row0 + ai * HALF + m * 16) * DFF + j0;
                float o[8];
#pragma unroll
                for (int n = 0; n < 2; ++n)
#pragma unroll
                    for (int j = 0; j < 4; ++j) { float gl = acc[ai][0][m][n][j] * (1.0f / F8_WSCALE) + bgl[n][j], ln = acc[ai][1][m][n][j] * (1.0f / F8_WSCALE) + bln[n][j];
                        gl = fminf(gl, 7.0f); ln = fminf(fmaxf(ln, -7.0f), 7.0f);
                        o[n * 4 + j] = gl * __builtin_amdgcn_rcpf(1.0f + __builtin_amdgcn_exp2f(-1.702f * 1.4426950408889634f * gl)) * (ln * F8_ASCALE + F8_ASCALE); }
                u32x2 w; w.x = pk4_fp8(o[0], o[1], o[2], o[3]); w.y = pk4_fp8(o[4], o[5], o[6], o[7]);
                *(u32x2*)rowp = w; }
    }
};
struct EpiDown {
    static constexpr bool PERM = true;
    bf16_t* Y; const float* bd; const float* rowgate;
    __device__ __forceinline__ void operator()(const f32x4 (&acc)[2][2][4][2], const Unit& u, int wr, int wc, int fr, int fq) const {
        const int e = u.pb >> 2;
        const int row0 = u.pm * BM + wr * 64 + fr, col0 = u.pn * BM + wc * 32 + 8 * fq;
        const float* b = bd + (size_t)e * 1024 + col0;
        f32x4 bv[2][2];
#pragma unroll
        for (int bj = 0; bj < 2; ++bj)
#pragma unroll
            for (int n = 0; n < 2; ++n) bv[bj][n] = *(const f32x4*)(b + bj * HALF + 4 * n);
#pragma unroll
        for (int ai = 0; ai < 2; ++ai)
#pragma unroll
            for (int m = 0; m < 4; ++m) { const int row = row0 + ai * HALF + m * 16; const float gt = rowgate[row]; bf16_t* rowp = Y + (size_t)row * D + col0;
#pragma unroll
                for (int bj = 0; bj < 2; ++bj) { const f32x4 v0 = (acc[ai][bj][m][0] * (1.0f / (F8_WSCALE * F8_ASCALE)) + bv[bj][0]) * gt, v1 = (acc[ai][bj][m][1] * (1.0f / (F8_WSCALE * F8_ASCALE)) + bv[bj][1]) * gt;
                    u32x4 w; w.x = cvt_pk_bf16(v0[0], v0[1]); w.y = cvt_pk_bf16(v0[2], v0[3]); w.z = cvt_pk_bf16(v1[0], v1[1]); w.w = cvt_pk_bf16(v1[2], v1[3]);
                    *(u32x4*)(rowp + bj * HALF) = w; } }
    }
};

__device__ __forceinline__ f32x4 mma_f8(bf16x8 a0, bf16x8 a1, bf16x8 b0, bf16x8 b1, f32x4 c) {
#ifdef EMU
    return emu_mfma16_f8(a0, a1, b0, b1, c);
#else
    const i32x4 a0i = __builtin_bit_cast(i32x4, a0), a1i = __builtin_bit_cast(i32x4, a1), b0i = __builtin_bit_cast(i32x4, b0), b1i = __builtin_bit_cast(i32x4, b1);
    const i32x8 A = __builtin_shufflevector(a0i, a1i, 0, 1, 2, 3, 4, 5, 6, 7), B = __builtin_shufflevector(b0i, b1i, 0, 1, 2, 3, 4, 5, 6, 7);
    asm volatile("v_mfma_f32_16x16x128_f8f6f4 %0, %1, %2, %0" : "+v"(c) : "v"(A), "v"(B));
    return c;
#endif
}
template <class Epi, class Sched, bool GATHER, bool F8 = false>
__device__ __forceinline__ void gemm_phase(LAS unsigned char* lds, const int tid, const Gemm g, const Sched& S, const Epi& E) {
    const int wid = __builtin_amdgcn_readfirstlane(tid >> 6), lane = tid & 63, wr = wid >> 2, wc = wid & 3, fr = lane & 15, fq = lane >> 4;
    const int K = g.K, nt = K / BK;
    unsigned voffB[2]; int RA[2], CA[2];
#pragma unroll
    for (int i = 0; i < 2; ++i) { int R, C; stage_rc(tid * 16 + i * 8192, R, C); const int Rb = Epi::PERM ? ((R & ~31) + perm32(R & 31)) : R;
        RA[i] = R; CA[i] = C; voffB[i] = (unsigned)(Rb * K + C) * 2u; }
    const size_t kstep = (size_t)(BK * 2);
    const size_t hstep = (size_t)HALF * K * 2;
    const size_t tstep = 2 * hstep;
    const unsigned ldsw = (unsigned)wid * 1024u;
    const int aoff = lds_byte(wr * 64 + fr, fq * 8), boff = lds_byte(wc * 32 + fr, fq * 8);
#define PG8_SA(b, h) (((b) * 2 + (h)) * HTB)
#define PG8_SB(b, h) ((4 + (b) * 2 + (h)) * HTB)
#define PG8_STAGE(bufoff, gbase, voff) do { _Pragma("unroll") for (int _i = 0; _i < 2; ++_i) \
        __builtin_amdgcn_global_load_lds((const unsigned*)((const char*)(gbase) + (voff)[_i]), (LAS unsigned*)(lds + (bufoff) + ldsw + _i * 8192), 16, 0, 0); } while (0)
#define PG8_LDA(dst, b, h) do { _Pragma("unroll") for (int m = 0; m < 4; ++m) _Pragma("unroll") for (int k = 0; k < 2; ++k) dst[m][k] = *(const LAS bf16x8*)(lds + PG8_SA(b, h) + aoff + m * 2048 + k * 1024); } while (0)
#define PG8_LDB(dst, b, h) do { _Pragma("unroll") for (int n = 0; n < 2; ++n) _Pragma("unroll") for (int k = 0; k < 2; ++k) dst[n][k] = *(const LAS bf16x8*)(lds + PG8_SB(b, h) + boff + n * 2048 + k * 1024); } while (0)
#define PG8_MMA(ai, bj, At, Bt) do { __builtin_amdgcn_s_setprio(1); _Pragma("unroll") for (int m = 0; m < 4; ++m) _Pragma("unroll") for (int n = 0; n < 2; ++n) { \
        if constexpr (F8) acc[ai][bj][m][n] = mma_f8(Bt[n][0], Bt[n][1], At[m][0], At[m][1], acc[ai][bj][m][n]); \
        else { _Pragma("unroll") for (int k = 0; k < 2; ++k) acc[ai][bj][m][n] = __builtin_amdgcn_mfma_f32_16x16x32_bf16(Bt[n][k], At[m][k], acc[ai][bj][m][n], 0, 0, 0); } } __builtin_amdgcn_s_setprio(0); } while (0)
#define PG8_BAR __builtin_amdgcn_s_barrier()
#define PG8_SCHED __builtin_amdgcn_sched_barrier(0)
#define PG8_AOFF(dst, unit) do { _Pragma("unroll") for (int _h = 0; _h < 2; ++_h) _Pragma("unroll") for (int _i = 0; _i < 2; ++_i) { \
        const int _r = (unit).pm * BM + _h * HALF + RA[_i]; const int _src = GATHER ? g.rowidx[_r] : _r; dst[_h][_i] = (unsigned)(_src * K + CA[_i]) * 2u; } } while (0)
    Unit cur, nxt; int ui = 0;
    if (!S.next(0, cur)) return;
    f32x4 acc[2][2][4][2];
#pragma unroll
    for (int a = 0; a < 2; ++a)
#pragma unroll
        for (int b = 0; b < 2; ++b)
#pragma unroll
            for (int m = 0; m < 4; ++m)
#pragma unroll
                for (int n = 0; n < 2; ++n) acc[a][b][m][n] = (f32x4){0.f, 0.f, 0.f, 0.f};
    bf16x8 At[4][2], B0[2][2], B1[2][2];
    unsigned cvA[2][2], nvA[2][2];
    PG8_AOFF(cvA, cur);
    const char* const gA = (const char*)g.A;
    const char* cB = (const char*)g.Bt + (size_t)cur.pb * tstep;
    PG8_STAGE(PG8_SB(0, 0), cB, voffB); PG8_STAGE(PG8_SA(0, 0), gA, cvA[0]); PG8_STAGE(PG8_SB(0, 1), cB + hstep, voffB); PG8_STAGE(PG8_SA(0, 1), gA, cvA[1]);
    if (wr == 1) PG8_BAR;
    WAIT_V(4); PG8_BAR;
    PG8_STAGE(PG8_SB(1, 0), cB + kstep, voffB); PG8_STAGE(PG8_SA(1, 0), gA + kstep, cvA[0]); PG8_STAGE(PG8_SB(1, 1), cB + hstep + kstep, voffB);
    WAIT_V(6); PG8_BAR;
    for (;;) {
        const bool has_next = S.next(ui + 1, nxt);
        if (has_next) { PG8_AOFF(nvA, nxt); } else {
#pragma unroll
            for (int h = 0; h < 2; ++h)
#pragma unroll
                for (int i = 0; i < 2; ++i) nvA[h][i] = cvA[h][i]; }
        const char* nB = has_next ? (const char*)g.Bt + (size_t)nxt.pb * tstep : cB;
        for (int t = 0; t < nt; t += 2) {
            const bool last = (t == nt - 2);
            const char* a1 = gA + (size_t)(t + 1) * kstep;
            const char* a2 = last ? gA : gA + (size_t)(t + 2) * kstep; const char* b2 = last ? nB : cB + (size_t)(t + 2) * kstep;
            const char* a3 = a2 + kstep; const char* b3 = b2 + kstep;
            unsigned xA0[2], xA1[2];
#pragma unroll
            for (int i = 0; i < 2; ++i) { xA0[i] = last ? nvA[0][i] : cvA[0][i]; xA1[i] = last ? nvA[1][i] : cvA[1][i]; }
            PG8_LDB(B0, 0, 0); PG8_SCHED; PG8_LDA(At, 0, 0); PG8_STAGE(PG8_SA(1, 1), a1, cvA[1]);
            WAIT_L(8); PG8_BAR; WAIT_L(0); PG8_MMA(0, 0, At, B0); PG8_BAR; PG8_SCHED;
            PG8_LDB(B1, 0, 1); PG8_STAGE(PG8_SB(0, 0), b2, voffB);
            PG8_BAR; WAIT_L(0); PG8_MMA(0, 1, At, B1); PG8_BAR;
            PG8_LDA(At, 0, 1); PG8_STAGE(PG8_SA(0, 0), a2, xA0);
            PG8_BAR; WAIT_L(0); PG8_MMA(1, 0, At, B0); PG8_BAR; PG8_SCHED;
            PG8_STAGE(PG8_SB(0, 1), b2 + hstep, voffB);
            WAIT_V(6); PG8_BAR; PG8_MMA(1, 1, At, B1); PG8_BAR;
            PG8_LDB(B0, 1, 0); PG8_SCHED; PG8_LDA(At, 1, 0); PG8_STAGE(PG8_SA(0, 1), a2, xA1);
            WAIT_L(8); PG8_BAR; WAIT_L(0); PG8_MMA(0, 0, At, B0); PG8_BAR; PG8_SCHED;
            PG8_LDB(B1, 1, 1); PG8_STAGE(PG8_SB(1, 0), b3, voffB);
            PG8_BAR; WAIT_L(0); PG8_MMA(0, 1, At, B1); PG8_BAR;
            PG8_LDA(At, 1, 1); PG8_STAGE(PG8_SA(1, 0), a3, xA0);
            PG8_BAR; WAIT_L(0); PG8_MMA(1, 0, At, B0); PG8_BAR; PG8_SCHED;
            PG8_STAGE(PG8_SB(1, 1), b3 + hstep, voffB);
            WAIT_V(6); PG8_BAR; PG8_MMA(1, 1, At, B1); PG8_BAR;
        }
#ifndef EMU
        if constexpr (F8) asm volatile("s_nop 15\n\ts_nop 15" ::: "memory");
#endif
        E(acc, cur, wr, wc, fr, fq);
        if (!has_next) break;
#pragma unroll
        for (int a = 0; a < 2; ++a)
#pragma unroll
            for (int b = 0; b < 2; ++b)
#pragma unroll
                for (int m = 0; m < 4; ++m)
#pragma unroll
                    for (int n = 0; n < 2; ++n) acc[a][b][m][n] = (f32x4){0.f, 0.f, 0.f, 0.f};
        cur = nxt; cB = nB; ++ui;
#pragma unroll
        for (int h = 0; h < 2; ++h)
#pragma unroll
            for (int i = 0; i < 2; ++i) cvA[h][i] = nvA[h][i];
    }
    WAIT_V(0);
    if (wr == 0) PG8_BAR;
    PG8_BAR;
#undef PG8_SA
#undef PG8_SB
#undef PG8_STAGE
#undef PG8_LDA
#undef PG8_LDB
#undef PG8_MMA
#undef PG8_BAR
#undef PG8_SCHED
#undef PG8_AOFF
}
}

struct Args { const float* in[37]; float* out; unsigned char* ws; int ph_lo, ph_hi; };
enum { I_X = 0, I_C, I_CTX, I_CCTX, I_WADA, I_BADA, I_N1G, I_N2G, I_WIN, I_GGW, I_GGB, I_GNG, I_RMU, I_RW0, I_RW2, I_RA0, I_RA2, I_RG2, I_RKK, I_RKA, I_RRK,
       I_RLG, I_RLB, I_SCW, I_SCB, I_SDTB, I_SALOG, I_SD, I_SNG, I_WOUT, I_ROUTW, I_ROUTB, I_WGU, I_BGU, I_WDN, I_BDN, I_FNG };

struct Tc { LAS unsigned char* lds; int tid, lane, wave, G, bid; };
__device__ __forceinline__ const float* inp(const Tc& t, int i) {
    const unsigned long long v = ((const LAS unsigned long long*)(t.lds + LDS_PTRS))[i];
    const unsigned lo = __builtin_amdgcn_readfirstlane((unsigned)v), hi = __builtin_amdgcn_readfirstlane((unsigned)(v >> 32));
    return (const float*)(((unsigned long long)hi << 32) | lo);
}

struct CvItem { const float* W; bf16_t* dst; int ldw, k0, n0, nv, K; };
__device__ __forceinline__ void cv_load(const CvItem& it, float (&ld)[32], int lane) {
    const int c = lane & 31; const float* wp = it.W + (size_t)(it.k0 + (lane >> 5)) * it.ldw + it.n0 + (c < it.nv ? c : 0);
#pragma unroll
    for (int i = 0; i < 32; ++i) ld[i] = wp[(size_t)(2 * i) * it.ldw];
}
__device__ __forceinline__ void cv_store(const CvItem& it, const float (&ld)[32], LAS float* scr, int lane) {
    { const int c = lane & 31;
#pragma unroll
      for (int i = 0; i < 32; ++i) scr[(2 * i + (lane >> 5)) * 33 + c] = (c < it.nv) ? ld[i] : 0.f; }
    WAVE_LDS_FENCE();
    const int c = lane & 7;
#pragma unroll
    for (int j = 0; j < 4; ++j) { const int n = (lane >> 3) + 8 * j; const LAS float* s = scr + (8 * c) * 33 + n;
        u32x4 o; o.x = pk2(s[0 * 33], s[1 * 33]); o.y = pk2(s[2 * 33], s[3 * 33]); o.z = pk2(s[4 * 33], s[5 * 33]); o.w = pk2(s[6 * 33], s[7 * 33]);
        *(u32x4*)(it.dst + (size_t)n * it.K + it.k0 + 8 * c) = o; }
    WAVE_LDS_FENCE();
}
__device__ __forceinline__ void cv_store8(const CvItem& it, const float (&ld)[32], LAS float* scr, int lane) {
    { const int c = lane & 31;
#pragma unroll
      for (int i = 0; i < 32; ++i) scr[(2 * i + (lane >> 5)) * 33 + c] = ld[i] * pg8::F8_WSCALE; }
    WAVE_LDS_FENCE();
    const int c = lane & 7; unsigned char* d8 = (unsigned char*)it.dst;
#pragma unroll
    for (int j = 0; j < 4; ++j) { const int n = (lane >> 3) + 8 * j; const LAS float* s = scr + (8 * c) * 33 + n;
        u32x2 o; o.x = pk4_fp8(s[0 * 33], s[1 * 33], s[2 * 33], s[3 * 33]); o.y = pk4_fp8(s[4 * 33], s[5 * 33], s[6 * 33], s[7 * 33]);
        *(u32x2*)(d8 + (size_t)n * it.K + it.k0 + 8 * c) = o; }
    WAVE_LDS_FENCE();
}
constexpr int CV_KB = D / 64, CV_I_IN = CV_KB * (NU / 32), CV_I_OUT = CV_KB * (D / 32), CV_I_GU = CV_KB * (2048 / 32), CV_I_DN = CV_KB * (D / 32);
constexpr int CV_MOE_ITEMS = NEXP * (CV_I_GU + CV_I_DN);
constexpr int CV_E_IN = CV_MOE_ITEMS / 6, CV_E_B = CV_MOE_ITEMS / 2;
__device__ __forceinline__ CvItem cv_moe_item(const Args& a, int l, int it) {
    unsigned char* WGU = a.ws + WS_WGU; unsigned char* WDN = a.ws + WS_WD;
    const int e = it / (CV_I_GU + CV_I_DN); int r = it % (CV_I_GU + CV_I_DN); CvItem ci;
    if (r < CV_I_GU) { const int kb = r / 64, nb = r % 64, n0 = nb * 32; const int half = n0 >> 10, rem = n0 & 1023, pn = rem >> 7, jj = rem & 127;
        ci.W = a.in[I_WGU] + ((size_t)l * NEXP + e) * D * 2048; ci.ldw = 2048; ci.k0 = kb * 64; ci.n0 = n0; ci.nv = 32; ci.dst = (bf16_t*)(WGU + (((size_t)l * NEXP + e) * 2048 + pn * 256 + half * 128 + jj) * D); ci.K = D; }
    else { r -= CV_I_GU; const int kb = r / (D / 32), nb = r % (D / 32);
        ci.W = a.in[I_WDN] + ((size_t)l * NEXP + e) * DFF * D; ci.ldw = D; ci.k0 = kb * 64; ci.n0 = nb * 32; ci.nv = 32; ci.dst = (bf16_t*)(WDN + (((size_t)l * NEXP + e) * D + nb * 32) * DFF); ci.K = DFF; }
    return ci;
}
__device__ __forceinline__ CvItem cv_dense_item(const Args& a, int it) {
    bf16_t* WIN = (bf16_t*)(a.ws + WS_WIN); bf16_t* WOUT = (bf16_t*)(a.ws + WS_WOUT);
    const int l = it / (CV_I_IN + CV_I_OUT); int r = it % (CV_I_IN + CV_I_OUT); CvItem ci;
    if (r < CV_I_IN) { const int kb = r / (NU / 32), nb = r % (NU / 32), n0 = nb * 32; int nv = IN_COLS - n0; nv = nv < 0 ? 0 : (nv > 32 ? 32 : nv);
        ci.W = a.in[I_WIN] + (size_t)l * D * IN_COLS; ci.ldw = IN_COLS; ci.k0 = kb * 64; ci.n0 = n0; ci.nv = nv; ci.dst = WIN + ((size_t)l * NU + n0) * D; ci.K = D; }
    else { r -= CV_I_IN; const int kb = r / (D / 32), nb = r % (D / 32);
        ci.W = a.in[I_WOUT] + (size_t)l * D * D; ci.ldw = D; ci.k0 = kb * 64; ci.n0 = nb * 32; ci.nv = 32; ci.dst = WOUT + ((size_t)l * D + nb * 32) * D; ci.K = D; }
    return ci;
}
__device__ __forceinline__ void convert_moe(const Args& a, const Tc& t, int l, int i0, int i1, int gw, int ngw) {
    LAS float* scr = (LAS float*)(t.lds + t.wave * 16384);
    float ld[32], ln[32];
    if (i0 + gw < i1) { const CvItem c0 = cv_moe_item(a, l, i0 + gw); cv_load(c0, ld, t.lane); }
    for (int it = i0 + gw; it < i1; it += ngw) {
        const CvItem cur = cv_moe_item(a, l, it);
        const bool more = it + ngw < i1;
        if (more) { const CvItem nx = cv_moe_item(a, l, it + ngw); cv_load(nx, ln, t.lane); }
        cv_store8(cur, ld, scr, t.lane);
        if (more) {
#pragma unroll
            for (int i = 0; i < 32; ++i) ld[i] = ln[i]; }
    }
}
__device__ __forceinline__ void convert_in_slack(const Args& a, const Tc& t, int l, int i0, int i1, int nunits) {
    const int rem = nunits % t.G;
    if (t.bid >= rem) convert_moe(a, t, l, i0, i1, (t.bid - rem) * NWAVES + t.wave, (t.G - rem) * NWAVES);
}
__device__ __forceinline__ void phase_pro0(const Args& a, const Tc& t) {
    LAS float* scr = (LAS float*)(t.lds + t.wave * 16384);
    const int gw = t.bid * NWAVES + t.wave, NGW = t.G * NWAVES;
    { float ld[32];
      for (int it = gw; it < DEPTH * (CV_I_IN + CV_I_OUT); it += NGW) { const CvItem ci = cv_dense_item(a, it); cv_load(ci, ld, t.lane); cv_store(ci, ld, scr, t.lane); } }
    __syncthreads();
    LAS float* sc = (LAS float*)t.lds;
    LAS float* red = (LAS float*)(t.lds + 32768);
    for (int i = t.tid; i < NR * D; i += NTHREADS) { const int r = i / D, k = i % D; const float v = r < BATCH ? a.in[I_C][r * D + k] : a.in[I_CCTX][k]; sc[i] = siluf_(v); }
    __syncthreads();
    float* MODS = (float*)(a.ws + WS_MODS);
    const int jl = t.tid & 127, kq = t.tid >> 7;
    for (int cb = t.bid; cb < DEPTH * 48; cb += t.G) {
        const int l = cb / 48, j = (cb % 48) * 128 + jl;
        const float* w = a.in[I_WADA] + (size_t)l * D * 6144 + j;
        float acc[NR];
#pragma unroll
        for (int r = 0; r < NR; ++r) acc[r] = 0.f;
        for (int k = kq * 256; k < kq * 256 + 256; ++k) { const float wv = w[(size_t)k * 6144];
#pragma unroll
            for (int r = 0; r < NR; ++r) acc[r] += sc[r * D + k] * wv; }
#pragma unroll
        for (int r = 0; r < NR; ++r) red[(kq * NR + r) * 128 + jl] = acc[r];
        __syncthreads();
        if (kq == 0) {
            const float bb = a.in[I_BADA][(size_t)l * 6144 + j];
#pragma unroll
            for (int r = 0; r < NR; ++r) MODS[((size_t)l * NR + r) * 6144 + j] = red[(0 * NR + r) * 128 + jl] + red[(1 * NR + r) * 128 + jl] + red[(2 * NR + r) * 128 + jl] + red[(3 * NR + r) * 128 + jl] + bb;
        }
        __syncthreads();
    }
}

__device__ __forceinline__ int mod_row(int row) { return row < ML ? row / SEQ : BATCH; }
template <bool F8 = false>
__device__ __forceinline__ void norm_mod_store(const f32x4 (&v)[4], const float* g, const float* shift, const float* scale, bf16_t* hrow, int lane, f32x4 (&hout)[4]) {
    float ss = 0.f;
#pragma unroll
    for (int j = 0; j < 4; ++j) ss += (v[j][0] * v[j][0] + v[j][1] * v[j][1]) + (v[j][2] * v[j][2] + v[j][3] * v[j][3]);
    const float rstd = frsq(wave_sum(ss) * (1.0f / D) + 1e-6f);
#pragma unroll
    for (int j = 0; j < 4; ++j) { const int c = 4 * lane + 256 * j;
        const f32x4 gg = *(const f32x4*)(g + c), sh = *(const f32x4*)(shift + c), sc = *(const f32x4*)(scale + c);
        const f32x4 h = (v[j] * rstd * gg) * (sc + 1.0f) + sh; hout[j] = h;
        if constexpr (F8) { *(unsigned*)((unsigned char*)hrow + c) = pk4_fp8(h[0], h[1], h[2], h[3]); }
        else { u32x2 w; w.x = pk2(h[0], h[1]); w.y = pk2(h[2], h[3]); *(u32x2*)(hrow + c) = w; } }
}
__device__ __forceinline__ void phase_pro1(const Args& a, const Tc& t) {
    const int gw = t.bid * NWAVES + t.wave, NGW = t.G * NWAVES;
    bf16_t* X = (bf16_t*)(a.ws + WS_X); bf16_t* H = (bf16_t*)(a.ws + WS_H); const float* MODS = (const float*)(a.ws + WS_MODS);
    for (int row = gw; row < M; row += NGW) {
        const float* src = row < ML ? a.in[I_X] + (size_t)row * D : a.in[I_CTX] + (size_t)(row - ML) * D;
        f32x4 v[4], h[4];
#pragma unroll
        for (int j = 0; j < 4; ++j) { v[j] = *(const f32x4*)(src + 4 * t.lane + 256 * j); u32x2 w; w.x = pk2(v[j][0], v[j][1]); w.y = pk2(v[j][2], v[j][3]); *(u32x2*)(X + (size_t)row * D + 4 * t.lane + 256 * j) = w; }
        const float* md = MODS + (size_t)mod_row(row) * 6144;
        norm_mod_store(v, a.in[I_N1G], md, md + 1024, H + (size_t)row * D, t.lane, h);
    }
}

__device__ __forceinline__ float ld_or0(const float* p, const float* safe, bool ok) { const float v = *(ok ? p : safe); return ok ? v : 0.f; }
__device__ __forceinline__ float ld_or0(const bf16_t* p, const bf16_t* safe, bool ok) { const float v = ldbf(ok ? p : safe); return ok ? v : 0.f; }
__device__ __forceinline__ void seg_bounds(int row, int& lo, int& hi) {
    if (row < ML) { lo = row & ~63; hi = lo + 64; } else { lo = ML + ((row - ML) / CTX) * CTX; hi = lo + CTX; }
}
__device__ __forceinline__ void phase_prep(const Args& a, const Tc& t, int l) {
    const bf16_t* U = (const bf16_t*)(a.ws + WS_U);
    float* GG = (float*)(a.ws + WS_GG); bf16_t* RW7 = (bf16_t*)(a.ws + WS_RW7); bf16_t* SXBC = (bf16_t*)(a.ws + WS_SXBC); float* SDT = (float*)(a.ws + WS_SDT);
    const float* mu = a.in[I_RMU] + (size_t)l * 2 * 928;
    const float* w0 = a.in[I_RW0] + (size_t)l * 2 * 256; const float* w2 = a.in[I_RW2] + (size_t)l * 2 * 32 * 256;
    const float* a0 = a.in[I_RA0] + (size_t)l * 256; const float* a2 = a.in[I_RA2] + (size_t)l * 32 * 256;
    const float* rkk = a.in[I_RKK] + (size_t)l * 256; const float* rka = a.in[I_RKA] + (size_t)l * 256;
    const float* ggw = a.in[I_GGW] + (size_t)l * 2 * 16 * 128; const float* ggb = a.in[I_GGB] + (size_t)l * 2 * 128;
    const float* cw = a.in[I_SCW] + (size_t)l * 4 * 1024; const float* cb = a.in[I_SCB] + (size_t)l * 1024;
    const float* dtb = a.in[I_SDTB] + (size_t)l * 16;
    LAS float* LOW = (LAS float*)t.lds;
    LAS float* A2S = LOW + 16 * 128; LAS float* W2S = A2S + 32 * 256; LAS float* GWS = W2S + 64 * 256;
    for (int e = t.tid; e < 32 * 256 / 4; e += NTHREADS) *(LAS f32x4*)(A2S + 4 * e) = *(const f32x4*)(a2 + 4 * e);
    for (int e = t.tid; e < 64 * 256 / 4; e += NTHREADS) *(LAS f32x4*)(W2S + 4 * e) = *(const f32x4*)(w2 + 4 * e);
    for (int e = t.tid; e < 32 * 128 / 4; e += NTHREADS) *(LAS f32x4*)(GWS + 4 * e) = *(const f32x4*)(ggw + 4 * e);
    LDS_BARRIER();
    for (int tile = t.bid; tile < M / 16; tile += t.G) {
        const int r0 = tile * 16; int slo, shi; seg_bounds(r0, slo, shi);
        {
            const int tt = t.tid >> 5, r = t.tid & 31, row = r0 + tt;
            const bf16_t* up = U + (size_t)row * NU; const bool hp = row - 1 >= slo, hn = row + 1 < shi;
#pragma unroll
            for (int q = 0; q < 3; ++q) { const int col = U_RLWF + q * 32 + r, mi = col - U_RW;
                const float u = ldbf(up + col), pv = ld_or0(up + col - NU, up + col, hp), nv = ld_or0(up + col + NU, up + col, hn);
                const float s = u + mu[mi] * (pv - u) + mu[928 + mi] * (nv - u);
                LOW[tt * 128 + q * 32 + r] = q < 2 ? ftanh(s) : s; }
            LOW[tt * 128 + 96 + r] = ldbf(up + U_GLF + r);
        }
        LDS_BARRIER();
        {
            const int c = t.tid & 255, tt0 = (t.tid >> 8) * 8;
            float lu[10][3];
#pragma unroll
            for (int jj = 0; jj < 10; ++jj) { const int row = r0 + tt0 + jj - 1; const bool ok = row >= slo && row < shi; const bf16_t* up = U + (size_t)(ok ? row : r0) * NU;
                const float x0 = ldbf(up + U_RR + c), x1 = ldbf(up + U_RK + c), x2 = ldbf(up + U_RV + c); lu[jj][0] = ok ? x0 : 0.f; lu[jj][1] = ok ? x1 : 0.f; lu[jj][2] = ok ? x2 : 0.f; }
            float aa[8], af[8], ab[8];
#pragma unroll
            for (int j = 0; j < 8; ++j) { aa[j] = a0[c]; af[j] = w0[c]; ab[j] = w0[256 + c]; }
#pragma unroll 2
            for (int r4 = 0; r4 < 8; ++r4) { float wa[4], wf[4], wb[4];
#pragma unroll
                for (int q = 0; q < 4; ++q) { wa[q] = A2S[(4 * r4 + q) * 256 + c]; wf[q] = W2S[(4 * r4 + q) * 256 + c]; wb[q] = W2S[(32 + 4 * r4 + q) * 256 + c]; }
#pragma unroll
                for (int j = 0; j < 8; ++j) { const LAS float* lw = LOW + (tt0 + j) * 128;
                    const f32x4 la = *(const LAS f32x4*)(lw + 64 + 4 * r4), lf = *(const LAS f32x4*)(lw + 4 * r4), lb = *(const LAS f32x4*)(lw + 32 + 4 * r4);
#pragma unroll
                    for (int q = 0; q < 4; ++q) { aa[j] += la[q] * wa[q]; af[j] += lf[q] * wf[q]; ab[j] += lb[q] * wb[q]; } } }
            const float m0r = mu[c], m1r = mu[928 + c], m0k = mu[256 + c], m1k = mu[928 + 256 + c], m0v = mu[512 + c], m1v = mu[928 + 512 + c];
            const float kkg = rkk[c], kag = rka[c];
#pragma unroll
            for (int j = 0; j < 8; ++j) { const int row = r0 + tt0 + j;
                float u, pv, nv;
                u = lu[j + 1][0]; pv = lu[j][0]; nv = lu[j + 2][0]; const float rs = u + m0r * (pv - u) + m1r * (nv - u);
                u = lu[j + 1][1]; pv = lu[j][1]; nv = lu[j + 2][1]; const float ks = u + m0k * (pv - u) + m1k * (nv - u);
                u = lu[j + 1][2]; pv = lu[j][2]; nv = lu[j + 2][2]; const float vs = u + m0v * (pv - u) + m1v * (nv - u);
                const float av = sigmoidf_(aa[j]);
                const float wfv = fexp(-0.606531f * sigmoidf_(af[j])), wbv = fexp(-0.606531f * sigmoidf_(ab[j]));
                const float kr = ks * kkg; const float ssq = wave_sum(kr * kr); const float kk = kr * (frsq(ssq + 1e-12f));
                const float kf = ks * (1.0f + (av - 1.0f) * kag);
                const size_t o = (size_t)row * 256 + c, P = (size_t)M * 256;
                stbf(RW7 + o, rs); stbf(RW7 + P + o, kf); stbf(RW7 + 2 * P + o, vs); stbf(RW7 + 3 * P + o, kk); stbf(RW7 + 4 * P + o, kk * av); stbf(RW7 + 5 * P + o, wfv); stbf(RW7 + 6 * P + o, wbv); }
        }
        {
            const int j = t.tid & 127, dq = t.tid >> 7, dir = dq & 1, tt0 = (dq >> 1) * 8;
            float acc[8];
#pragma unroll
            for (int q = 0; q < 8; ++q) acc[q] = ggb[dir * 128 + j];
#pragma unroll
            for (int r4 = 0; r4 < 4; ++r4) { float w[4];
#pragma unroll
                for (int q2 = 0; q2 < 4; ++q2) w[q2] = GWS[(dir * 16 + 4 * r4 + q2) * 128 + j];
#pragma unroll
                for (int q = 0; q < 8; ++q) { const f32x4 lv = *(const LAS f32x4*)(LOW + (tt0 + q) * 128 + 96 + dir * 16 + 4 * r4);
                    acc[q] += (lv[0] * w[0] + lv[1] * w[1]) + (lv[2] * w[2] + lv[3] * w[3]); } }
#pragma unroll
            for (int q = 0; q < 8; ++q) GG[((size_t)dir * M + r0 + tt0 + q) * 128 + j] = logsigmoidf_(acc[q]) * (1.0f / 16.0f);
        }
        {
#pragma unroll
            for (int cc = 0; cc < 2; ++cc) { const int col = t.tid + cc * 512; const bf16_t* up = U + U_SXBC + col;
                const float c0 = cw[col], c1 = cw[1024 + col], c2 = cw[2048 + col], c3 = cw[3072 + col], bb = cb[col];
                const bf16_t* uc = up + (size_t)r0 * NU;
                float lc_[19];
#pragma unroll
                for (int q = 0; q < 19; ++q) lc_[q] = ld_or0(uc + (ptrdiff_t)(q - 2) * NU, uc, (r0 + q - 2 >= slo) && (r0 + q - 2 < shi));
                float um2 = lc_[0], um1 = lc_[1], u0 = lc_[2];
#pragma unroll
                for (int q = 0; q < 16; ++q) { const int row = r0 + q; const float up1 = lc_[q + 3];
                    const float y = c0 * um2 + c1 * um1 + c2 * u0 + c3 * up1 + bb;
                    stbf(SXBC + (size_t)row * 1024 + col, siluf_(y)); um2 = um1; um1 = u0; u0 = up1; } }
        }
        if (t.tid < 256) { const int tt = t.tid >> 4, j = t.tid & 15, row = r0 + tt; SDT[(size_t)row * 16 + j] = softplusf_(ldbf(U + (size_t)row * NU + U_SDT + j) + dtb[j]); }
        LDS_BARRIER();
    }
}

__device__ __forceinline__ int chain_row(int b, int dir, int s) {
    if (s < CTX) return ML + b * CTX + (dir ? CTX - 1 - s : s);
    const int tt = s - CTX; return b * SEQ + (dir ? SEQ - 1 - tt : tt);
}

__device__ __forceinline__ f32x4 mma16(f32x4 acc, const LAS bf16_t* A, int lda, const LAS bf16_t* Bt, int ldb, int K, int lane) {
    const int r = lane & 15, kq = (lane >> 4) * 8;
    for (int k0 = 0; k0 < K; k0 += 32) {
        const bf16x8 av = *(const LAS bf16x8*)(A + r * lda + k0 + kq), bv = *(const LAS bf16x8*)(Bt + r * ldb + k0 + kq);
        acc = __builtin_amdgcn_mfma_f32_16x16x32_bf16(av, bv, acc, 0, 0, 0);
    }
    return acc;
}
__device__ __forceinline__ float wave_incl_scan(float v, int lane) {
#pragma unroll
    for (int o = 1; o < 64; o <<= 1) { const float u = __shfl_up(v, o); if (lane >= o) v += u; }
    return v;
}
__device__ __forceinline__ int rc_row0(int b, int c) { return c < CTXC ? ML + b * CTX + 64 * c : b * SEQ + 64 * (c - CTXC); }
__device__ __forceinline__ int rc_chain_pos(int c, int dir) { return dir == 0 ? c : (c < CTXC ? CTXC - 1 - c : CTXC + (LATC - 1 - (c - CTXC))); }

constexpr int SSD_UNITS = BATCH * 2 * NRC;
__device__ __forceinline__ void ssd_a1_unit(const Args& a, const Tc& t, int l, int u) {
    const bf16_t* SXBC = (const bf16_t*)(a.ws + WS_SXBC); const float* SDT = (const float*)(a.ws + WS_SDT);
    bf16_t* SZ = (bf16_t*)(a.ws + WS_SZ); float* SDEC = (float*)(a.ws + WS_SDEC);
    const int c = u % NRC, g = (u / NRC) & 1, b = u / (2 * NRC), row0 = rc_row0(b, c);
    LAS bf16_t* BT = (LAS bf16_t*)t.lds;
    LAS bf16_t* XT = BT + 128 * 72 + t.wave * 64 * 72;
    for (int e = t.tid; e < 64 * 32; e += NTHREADS) { const int rho = e >> 5, n4 = (e & 31) * 4;
        const f32x4 v = ldbf4(SXBC + (size_t)(row0 + rho) * 1024 + 512 + g * 128 + n4);
#pragma unroll
        for (int q = 0; q < 4; ++q) BT[(n4 + q) * 72 + rho] = (bf16_t)f2bf(v[q]); }
    const int hh = t.wave & 3, dir = t.wave >> 2, h = 4 * g + hh, chain = (b * 8 + h) * 2 + dir, cc = rc_chain_pos(c, dir);
    const float a_neg = -fexp(a.in[I_SALOG][(size_t)l * 16 + dir * 8 + h]);
    const float dtv = SDT[(size_t)(row0 + t.lane) * 16 + dir * 8 + h], av = dtv * a_neg;
    const float pre = wave_incl_scan(av, t.lane), tot = __shfl(pre, 63);
    const float wgt = dir == 0 ? fexp(tot - pre) : fexp(pre - av);
    const float sc = dtv * wgt;
#pragma unroll
    for (int p4 = 0; p4 < 16; ++p4) { const f32x4 x = ldbf4(SXBC + (size_t)(row0 + t.lane) * 1024 + h * 64 + p4 * 4);
#pragma unroll
        for (int q = 0; q < 4; ++q) XT[(p4 * 4 + q) * 72 + t.lane] = (bf16_t)f2bf(x[q] * sc); }
    if (t.lane == 0) SDEC[(size_t)chain * NRC + cc] = fexp(tot);
    LDS_BARRIER();
    bf16_t* zb = SZ + ((size_t)chain * NRC + cc) * 64 * 128;
#pragma unroll 1
    for (int pt = 0; pt < 4; ++pt)
#pragma unroll 2
        for (int nt = 0; nt < 8; ++nt) { f32x4 acc = {0.f, 0.f, 0.f, 0.f};
            acc = mma16(acc, XT + pt * 16 * 72, 72, BT + nt * 16 * 72, 72, 64, t.lane);
#pragma unroll
            for (int r = 0; r < 4; ++r) zb[(size_t)(16 * pt + 4 * (t.lane >> 4) + r) * 128 + 16 * nt + (t.lane & 15)] = (bf16_t)f2bf(acc[r]); }
    LDS_BARRIER();
}
constexpr int CAR_DEP = 4;
__device__ __forceinline__ void ssd_b_carry(const Args& a, const Tc& t, int wg, int nwg) {
    const bf16_t* SZ = (const bf16_t*)(a.ws + WS_SZ); const float* SDEC = (const float*)(a.ws + WS_SDEC); bf16_t* SST = (bf16_t*)(a.ws + WS_SST);
    static_assert(NRC % 4 == 0, "carry unroll");
    constexpr int NG = NRC / 4;
    for (int idx = wg * NTHREADS + t.tid; idx < BATCH * 16 * 2048; idx += nwg * NTHREADS) {
        const int chain = idx >> 11, e4 = (idx & 2047) * 4;
        const bf16_t* zc = SZ + (size_t)chain * NRC * 8192 + e4; bf16_t* sc = SST + (size_t)chain * NRC * 8192 + e4; const float* dc = SDEC + (size_t)chain * NRC;
        f32x4 s = {0.f, 0.f, 0.f, 0.f};
        u32x2 z[CAR_DEP][4]; float d[CAR_DEP][4];
#pragma unroll
        for (int g = 0; g < CAR_DEP - 1 && g < NG; ++g)
#pragma unroll
            for (int q = 0; q < 4; ++q) { z[g][q] = *(const u32x2*)(zc + (size_t)(4 * g + q) * 8192); d[g][q] = dc[4 * g + q]; }
#pragma unroll
        for (int g = 0; g < NG; ++g) {
            if (g + CAR_DEP - 1 < NG) {
#pragma unroll
                for (int q = 0; q < 4; ++q) { z[(g + CAR_DEP - 1) % CAR_DEP][q] = *(const u32x2*)(zc + (size_t)(4 * (g + CAR_DEP - 1) + q) * 8192); d[(g + CAR_DEP - 1) % CAR_DEP][q] = dc[4 * (g + CAR_DEP - 1) + q]; } }
#pragma unroll
            for (int q = 0; q < 4; ++q) { u32x2 w; w.x = pk2(s[0], s[1]); w.y = pk2(s[2], s[3]); *(u32x2*)(sc + (size_t)(4 * g + q) * 8192) = w;
                const u32x2 zw = z[g % CAR_DEP][q]; s = s * d[g % CAR_DEP][q] + (f32x4){bf_lo(zw.x), bf_hi(zw.x), bf_lo(zw.y), bf_hi(zw.y)}; }
        }
    }
}
__device__ __forceinline__ void ssd_c_unit(const Args& a, const Tc& t, int l, int u) {
    const bf16_t* SXBC = (const bf16_t*)(a.ws + WS_SXBC); const float* SDT = (const float*)(a.ws + WS_SDT);
    const bf16_t* SST = (const bf16_t*)(a.ws + WS_SST); bf16_t* OS = (bf16_t*)(a.ws + WS_OS);
    const int c = u % NRC, g = (u / NRC) & 1, b = u / (2 * NRC), row0 = rc_row0(b, c);
    LAS bf16_t* CM = (LAS bf16_t*)t.lds;
    LAS bf16_t* BM = CM + 64 * 136;
    LAS bf16_t* GS = BM + 64 * 136;
    LAS bf16_t* XT = GS + 64 * 72 + t.wave * 64 * 72;
    LAS float* PRE = (LAS float*)(GS + 64 * 72 + 8 * 64 * 72) + t.wave * 128;
    for (int e = t.tid; e < 64 * 32; e += NTHREADS) { const int rho = e >> 5, n4 = (e & 31) * 4;
        const f32x4 bv = ldbf4(SXBC + (size_t)(row0 + rho) * 1024 + 512 + g * 128 + n4), cv = ldbf4(SXBC + (size_t)(row0 + rho) * 1024 + 768 + g * 128 + n4);
        u32x2 wb, wc; wb.x = pk2(bv[0], bv[1]); wb.y = pk2(bv[2], bv[3]); wc.x = pk2(cv[0], cv[1]); wc.y = pk2(cv[2], cv[3]);
        *(LAS u32x2*)(BM + rho * 136 + n4) = wb; *(LAS u32x2*)(CM + rho * 136 + n4) = wc; }
    const int hh = t.wave & 3, dir = t.wave >> 2, h = 4 * g + hh, chain = (b * 8 + h) * 2 + dir, cc = rc_chain_pos(c, dir);
    const bf16_t* sb = SST + ((size_t)chain * NRC + cc) * 8192;
    bf16x8 sf[4][4];
#pragma unroll
    for (int pt = 0; pt < 4; ++pt)
#pragma unroll
        for (int ks = 0; ks < 4; ++ks) sf[pt][ks] = *(const bf16x8*)(sb + (size_t)(16 * pt + (t.lane & 15)) * 128 + 32 * ks + 8 * (t.lane >> 4));
    const float a_neg = -fexp(a.in[I_SALOG][(size_t)l * 16 + dir * 8 + h]);
    const float dtv = SDT[(size_t)(row0 + t.lane) * 16 + dir * 8 + h], av = dtv * a_neg;
    const float pre = wave_incl_scan(av, t.lane), tot = __shfl(pre, 63);
    PRE[t.lane] = pre; PRE[64 + t.lane] = pre - av;
#pragma unroll
    for (int p4 = 0; p4 < 16; ++p4) { const f32x4 x = ldbf4(SXBC + (size_t)(row0 + t.lane) * 1024 + h * 64 + p4 * 4);
#pragma unroll
        for (int q = 0; q < 4; ++q) XT[(p4 * 4 + q) * 72 + t.lane] = (bf16_t)f2bf(x[q] * dtv); }
    LDS_BARRIER();
#pragma unroll
    for (int q = 0; q < 2; ++q) { const int ti = t.wave * 2 + q, it = ti >> 2, jt = ti & 3; f32x4 acc = {0.f, 0.f, 0.f, 0.f};
        acc = mma16(acc, CM + it * 16 * 136, 136, BM + jt * 16 * 136, 136, 128, t.lane);
#pragma unroll
        for (int r = 0; r < 4; ++r) GS[(16 * it + 4 * (t.lane >> 4) + r) * 72 + 16 * jt + (t.lane & 15)] = (bf16_t)f2bf(acc[r]); }
    LDS_BARRIER();
#pragma unroll 1
    for (int it = 0; it < 4; ++it) {
        f32x4 acc[4], acc2[4];
#pragma unroll
        for (int pt = 0; pt < 4; ++pt) { acc[pt] = (f32x4){0.f, 0.f, 0.f, 0.f}; acc2[pt] = (f32x4){0.f, 0.f, 0.f, 0.f}; }
        const int rho = 16 * it + (t.lane & 15);
        const float prer = PRE[rho], exr = PRE[64 + rho];
#pragma unroll
        for (int ks = 0; ks < 2; ++ks) {
            const int rp0 = 32 * ks + 8 * (t.lane >> 4);
            const bf16x8 g8 = *(const LAS bf16x8*)(GS + rho * 72 + rp0);
            bf16x8 af;
#pragma unroll
            for (int e = 0; e < 8; ++e) { const int rp = rp0 + e; const float gv = __uint_as_float(((unsigned)(unsigned short)g8[e]) << 16);
                float f;
                if (dir == 0) f = rp <= rho ? fexp(prer - PRE[rp]) : 0.f; else f = rp >= rho ? fexp(PRE[64 + rp] - exr) : 0.f;
                af[e] = (short)f2bf(gv * f); }
#pragma unroll
            for (int pt = 0; pt < 4; ++pt) { const bf16x8 bfr = *(const LAS bf16x8*)(XT + (16 * pt + (t.lane & 15)) * 72 + rp0); acc[pt] = __builtin_amdgcn_mfma_f32_16x16x32_bf16(af, bfr, acc[pt], 0, 0, 0); }
        }
#pragma unroll
        for (int ks = 0; ks < 4; ++ks) {
            const bf16x8 cf = *(const LAS bf16x8*)(CM + rho * 136 + 32 * ks + 8 * (t.lane >> 4));
#pragma unroll
            for (int pt = 0; pt < 4; ++pt) acc2[pt] = __builtin_amdgcn_mfma_f32_16x16x32_bf16(cf, sf[pt][ks], acc2[pt], 0, 0, 0);
        }
#pragma unroll
        for (int r = 0; r < 4; ++r) { const int ro = 16 * it + 4 * (t.lane >> 4) + r; const float f = dir == 0 ? fexp(PRE[ro]) : fexp(tot - PRE[64 + ro]);
#pragma unroll
            for (int pt = 0; pt < 4; ++pt) stbf(OS + ((size_t)dir * M + row0 + ro) * 512 + h * 64 + 16 * pt + (t.lane & 15), acc[pt][r] + f * acc2[pt][r]); }
    }
    LDS_BARRIER();
}


constexpr int RW_UNITS = BATCH * 8 * NCK, RW_PAIRS = RW_UNITS / 2, RWA_HALF = 57344;
static_assert(RW_UNITS % 2 == 0, "unit pairs");
__device__ __forceinline__ void rwkv_a_all(const Args& a, const Tc& t) {
    const bf16_t* RW7 = (const bf16_t*)(a.ws + WS_RW7);
    const size_t P7 = (size_t)M * 256;
    const int half = t.tid >> 8, ht = t.tid & 255, hw = t.wave & 3, hq = t.lane >> 4, lc = t.lane & 15;
    LAS unsigned char* hb = t.lds + half * RWA_HALF;
    LAS float* RAW = (LAS float*)hb;
    LAS float* RtF = RAW;
    LAS float* KhF = RAW + 1024;
    LAS float* AtF = RAW + 3 * 1024;
    LAS float* Uf = RAW + 6 * 1024;
    LAS float* Qkf = Uf + 256;
    LAS float* Nuf = Qkf + 256;
    LAS float* WTs = Nuf + 256;
    LAS bf16_t* BtN = (LAS bf16_t*)(WTs + 64);
    LAS bf16_t* KtN = BtN + 16 * 72; LAS bf16_t* AtN = KtN + 16 * 72; LAS bf16_t* RtN = AtN + 16 * 72;
    LAS bf16_t* KpT = BtN;
    LAS bf16_t* BhT = RtN + 16 * 72;
    LAS bf16_t* VT = BhT + 64 * 40; LAS bf16_t* ApS = VT + 64 * 40;
    LAS bf16_t* NpS = ApS + 64 * 40;
    LAS bf16_t* QbT = NpS + 16 * 40;
    f32x4 pf[6];
#define RWA_LOAD(pair) do { const int u_ = 2 * (pair) + half, ck_ = u_ % NCK, ch_ = u_ / NCK, dir_ = ch_ & 1, h_ = (ch_ >> 1) & 3, b_ = ch_ >> 3; \
        _Pragma("unroll") for (int q = 0; q < 6; ++q) { const int e = ht + 256 * q, vec = e >> 8, rem = e & 255, i = rem >> 4, c4 = rem & 15; \
            const int row = chain_row(b_, dir_, ck_ * RKT + i); const int vs = vec < 5 ? vec : 5 + dir_; \
            pf[q] = ldbf4(RW7 + (size_t)vs * P7 + (size_t)row * 256 + h_ * 64 + c4 * 4); } } while (0)
    if (t.bid < RW_PAIRS) RWA_LOAD(t.bid);
    for (int pair = t.bid; pair < RW_PAIRS; pair += t.G) {
        const int u = 2 * pair + half, ck = u % NCK, chain = u / NCK;
        unsigned char* rec = a.ws + WS_RK + ((size_t)chain * NCK + ck) * RK_BYTES;
#pragma unroll
        for (int q = 0; q < 6; ++q) *(LAS f32x4*)(RAW + (ht + 256 * q) * 4) = pf[q];
        for (int e = ht; e < 3 * 64 * 8; e += 256) { const int arr = e >> 9, rem = e & 511, r = rem >> 3, c2 = rem & 7; *(LAS unsigned*)(BhT + arr * 64 * 40 + r * 40 + 16 + 2 * c2) = 0u; }
        { const int arr = ht >> 7, rem = ht & 127, r = rem >> 3, c2 = rem & 7; *(LAS unsigned*)(NpS + arr * 16 * 40 + r * 40 + 16 + 2 * c2) = 0u; }
        LDS_BARRIER();
        if (pair + t.G < RW_PAIRS) RWA_LOAD(pair + t.G);
        { const int j = ht & 63, ig = ht >> 6; float wc = 1.f, wT = 1.f;
#pragma unroll
            for (int i = 0; i < 16; ++i) { const float wv = RAW[5 * 1024 + i * 64 + j]; wT *= wv; if (i < 4 * ig) wc *= wv; }
            if (ig == 0) WTs[j] = wT;
            float bh4[4], v4[4];
#pragma unroll
            for (int q = 0; q < 4; ++q) { const int i = 4 * ig + q; const float wp = wc; wc *= RAW[5 * 1024 + i * 64 + j]; const float iw = frcp(wc);
                const float at = RAW[3 * 1024 + i * 64 + j] * wp, rt = RAW[i * 64 + j] * wc, bt = RAW[4 * 1024 + i * 64 + j] * iw, kt = RAW[1024 + i * 64 + j] * iw;
                AtN[i * 72 + j] = (bf16_t)f2bf(at); RtN[i * 72 + j] = (bf16_t)f2bf(rt); BtN[i * 72 + j] = (bf16_t)f2bf(bt); KtN[i * 72 + j] = (bf16_t)f2bf(kt);
                bh4[q] = bt * wT; v4[q] = RAW[2 * 1024 + i * 64 + j];
                KhF[i * 64 + j] = kt * wT; RtF[i * 64 + j] = rt; AtF[i * 64 + j] = at; }
            { u32x2 wb, wv; wb.x = pk2(bh4[0], bh4[1]); wb.y = pk2(bh4[2], bh4[3]); wv.x = pk2(v4[0], v4[1]); wv.y = pk2(v4[2], v4[3]);
              *(LAS u32x2*)(BhT + j * 40 + 4 * ig) = wb; *(LAS u32x2*)(VT + j * 40 + 4 * ig) = wv; } }
        LDS_BARRIER();
        { f32x4 acc = {0.f, 0.f, 0.f, 0.f};
            acc = mma16(acc, (hw == 0 || hw == 3) ? BtN : KtN, 72, hw < 2 ? AtN : RtN, 72, 64, t.lane);
            f32x4 mv;
#pragma unroll
            for (int r = 0; r < 4; ++r) { const int s_ = 4 * hq + r, t_ = lc; const bool keep = hw < 2 ? (s_ < t_) : (s_ <= t_); mv[r] = keep ? acc[r] : 0.f; }
            if (hw == 0) *(LAS f32x4*)(Uf + lc * 16 + 4 * hq) = mv;
            else if (hw == 3) { u32x2 w; w.x = pk2(mv[0], mv[1]); w.y = pk2(mv[2], mv[3]); *(LAS u32x2*)(QbT + lc * 40 + 4 * hq) = w; }
            else {
#pragma unroll
                for (int r = 0; r < 4; ++r) { const int s_ = 4 * hq + r; if (hw == 1) Nuf[s_ * 16 + lc] = mv[r]; else Qkf[s_ * 16 + lc] = mv[r]; } } }
        LDS_BARRIER();
        if (ht < 80) { float x[16]; const bool isA = ht < 64; const int rr = isA ? ht : ht - 64;
#pragma unroll
            for (int tt = 0; tt < 16; ++tt) { float acc = isA ? AtF[tt * 64 + rr] : Nuf[rr * 16 + tt];
                f32x4 uc[4];
#pragma unroll
                for (int q = 0; q < 4; ++q) uc[q] = *(const LAS f32x4*)(Uf + tt * 16 + 4 * q);
#pragma unroll
                for (int s_ = 0; s_ < 16; ++s_) if (s_ < tt) acc -= x[s_] * uc[s_ >> 2][s_ & 3];
                x[tt] = acc; }
            u32x4 w0, w1; w0.x = pk2(x[0], x[1]); w0.y = pk2(x[2], x[3]); w0.z = pk2(x[4], x[5]); w0.w = pk2(x[6], x[7]); w1.x = pk2(x[8], x[9]); w1.y = pk2(x[10], x[11]); w1.z = pk2(x[12], x[13]); w1.w = pk2(x[14], x[15]);
            LAS bf16_t* xr = (isA ? ApS : NpS) + rr * 40; *(LAS u32x4*)xr = w0; *(LAS u32x4*)(xr + 8) = w1; }
        else if (ht >= 128) { for (int e = ht - 128; e < 64 * 8; e += 128) { const int r = e >> 3, c2 = e & 7; *(LAS unsigned*)(KpT + r * 40 + 16 + 2 * c2) = 0u; } }
        LDS_BARRIER();
        for (int ti = hw; ti < 25; ti += 4) {
            f32x4 acc = {0.f, 0.f, 0.f, 0.f};
            if (ti < 16) { const int jt = ti >> 2, jt2 = ti & 3;
                acc = mma16(acc, ApS + jt * 16 * 40, 40, BhT + jt2 * 16 * 40, 40, 32, t.lane);
                unsigned short o[4];
#pragma unroll
                for (int r = 0; r < 4; ++r) { const int j = 16 * jt + 4 * hq + r, j2 = 16 * jt2 + lc; const float dg = (j == j2) ? WTs[j] : 0.f; o[r] = (unsigned short)f2bf(dg - acc[r]); }
                u32x2 w; w.x = o[0] | ((unsigned)o[1] << 16); w.y = o[2] | ((unsigned)o[3] << 16);
                *(u32x2*)(rec + RK_PA + ((size_t)((jt2 * 2 + (jt >> 1)) * 64 + t.lane) * 8 + 4 * (jt & 1)) * 2) = w;
            } else if (ti < 20) { const int jt = ti - 16;
                acc = mma16(acc, ApS + jt * 16 * 40, 40, QbT, 40, 32, t.lane);
                unsigned short o[4];
                const f32x4 rt4 = *(const LAS f32x4*)(RtF + lc * 64 + 16 * jt + 4 * hq);
#pragma unroll
                for (int r = 0; r < 4; ++r) o[r] = (unsigned short)f2bf(rt4[r] - acc[r]);
                u32x2 w; w.x = o[0] | ((unsigned)o[1] << 16); w.y = o[2] | ((unsigned)o[3] << 16);
                *(u32x2*)(rec + RK_RA + ((size_t)(((jt >> 1) * 64 + t.lane) * 8 + 4 * (jt & 1))) * 2) = w;
            } else if (ti == 20) {
                acc = mma16(acc, NpS, 40, QbT, 40, 32, t.lane);
                unsigned short o[4];
#pragma unroll
                for (int r = 0; r < 4; ++r) o[r] = (unsigned short)f2bf(Qkf[(4 * hq + r) * 16 + lc] - acc[r]);
                u32x2 w; w.x = o[0] | ((unsigned)o[1] << 16); w.y = o[2] | ((unsigned)o[3] << 16);
                *(u32x2*)(rec + RK_QA + ((size_t)((lc + 16 * (hq >> 1)) * 8 + 4 * (hq & 1))) * 2) = w;
                u32x2 z; z.x = 0u; z.y = 0u; *(u32x2*)(rec + RK_QA + ((size_t)((32 + lc + 16 * (hq >> 1)) * 8 + 4 * (hq & 1))) * 2) = z;
            } else { const int jt2 = ti - 21;
                acc = mma16(acc, NpS, 40, BhT + jt2 * 16 * 40, 40, 32, t.lane);
                float kp[4];
#pragma unroll
                for (int r = 0; r < 4; ++r) { const int s_ = 4 * hq + r, j2 = 16 * jt2 + lc; kp[r] = KhF[s_ * 64 + j2] - acc[r]; }
                u32x2 w; w.x = pk2(kp[0], kp[1]); w.y = pk2(kp[2], kp[3]); *(LAS u32x2*)(KpT + (16 * jt2 + lc) * 40 + 4 * hq) = w;
            }
        }
        for (int e = ht; e < 4 * 64 * 4; e += 256) { const int it = e >> 8, rem = e & 255, ln = rem >> 2, e2 = (rem & 3) * 2, hp = ln >> 4, i2 = 16 * it + (ln & 15);
            unsigned w = 0u; if (hp < 2) { const int s0 = 8 * hp + e2; w = f2bf(RAW[2 * 1024 + s0 * 64 + i2]) | (f2bf(RAW[2 * 1024 + (s0 + 1) * 64 + i2]) << 16); }
            *(unsigned*)(rec + RK_VB + ((size_t)((it * 64 + ln) * 8 + e2)) * 2) = w; }
        LDS_BARRIER();
#pragma unroll
        for (int q = 0; q < 4; ++q) { const int ti = hw * 4 + q, rt = ti >> 2, it = ti & 3; f32x4 acc = {0.f, 0.f, 0.f, 0.f};
            acc = mma16(acc, KpT + rt * 16 * 40, 40, VT + it * 16 * 40, 40, 32, t.lane);
            u32x2 zw; zw.x = pk2(acc[0], acc[1]); zw.y = pk2(acc[2], acc[3]);
            *(u32x2*)(rec + RK_ZC + ((size_t)((rt * 4 + it) * 64 + t.lane)) * 8) = zw; }
        LDS_BARRIER();
    }
#undef RWA_LOAD
}
constexpr int RKB_TASKS = BATCH * 8 * 2, RKB_NS = 7, RKB_D = 5, RKB_SLOT = 17408;
__device__ __forceinline__ void rkb_piece(const unsigned char* rp, int p, int w0, int lane, LAS unsigned char* slot) {
    const unsigned char* src;
    if (p < 8) src = rp + RK_PA + (size_t)(p * 64 + lane) * 16; else if (p < 10) src = rp + RK_RA + (size_t)((p - 8) * 64 + lane) * 16; else if (p == 10) src = rp + RK_QA + (size_t)lane * 16;
    else if (p < 15) src = rp + RK_ZC + (size_t)(((p - 11) * 4 + w0 + (lane >> 5)) * 64) * 8 + (size_t)(lane & 31) * 16;
    else src = rp + RK_VB + (size_t)((w0 + (p - 15)) * 64 + lane) * 16;
    __builtin_amdgcn_global_load_lds((const unsigned*)src, (LAS unsigned*)(slot + p * 1024), 16, 0, 0);
}
__device__ __forceinline__ void rkb_issue(const unsigned char* rec, int ck, int w0, int lw, int lane, LAS unsigned char* ring) {
    const unsigned char* rp = rec + (size_t)ck * RK_BYTES; LAS unsigned char* slot = ring + (ck % RKB_NS) * RKB_SLOT;
#pragma unroll
    for (int q = 0; q < 4; ++q) rkb_piece(rp, 4 * lw + q, w0, lane, slot);
    if (lw == 0) rkb_piece(rp, 16, w0, lane, slot);
}
__device__ __forceinline__ void rwkv_b_task(const Args& a, const Tc& t, int task) {
    bf16_t* OR = (bf16_t*)(a.ws + WS_OR);
    const int hb = task & 1, chain = task >> 1, dir = chain & 1, h = (chain >> 1) & 3, b = chain >> 3, hq = t.lane >> 4, lc = t.lane & 15;
    const int w0 = 2 * hb, w = w0 + (t.wave & 1);
    const unsigned char* rec = a.ws + WS_RK + (size_t)chain * NCK * RK_BYTES;
    LAS unsigned char* ring = t.lds;
    const bool loader = (t.wave >= 2 && t.wave <= 5); const int lw = t.wave - 2;
    if (loader) {
#pragma unroll 1
        for (int ck = 0; ck < RKB_D; ++ck) rkb_issue(rec, ck, w0, lw, t.lane, ring);
    }
    f32x4 T[4], oprev = {0.f, 0.f, 0.f, 0.f};
#pragma unroll
    for (int rt = 0; rt < 4; ++rt) T[rt] = (f32x4){0.f, 0.f, 0.f, 0.f};
#pragma unroll 1
    for (int ck = 0; ck < NCK; ++ck) {
        if (loader) {
            if (ck + RKB_D <= NCK) { if (lw == 0) WAIT_V(20); else WAIT_V(16); } else WAIT_V(0);
        }
        __builtin_amdgcn_s_barrier();
        if (loader) { if (ck + RKB_D < NCK) rkb_issue(rec, ck + RKB_D, w0, lw, t.lane, ring); }
        else if (t.wave < 2) {
            const LAS unsigned char* slot = ring + (ck % RKB_NS) * RKB_SLOT;
            bf16x8 pa[4][2], ra[2], qa, vb; u32x2 zraw[4];
#pragma unroll
            for (int rt = 0; rt < 4; ++rt) {
#pragma unroll
                for (int ks = 0; ks < 2; ++ks) pa[rt][ks] = *(const LAS bf16x8*)(slot + ((rt * 2 + ks) * 64 + t.lane) * 16);
                zraw[rt] = *(const LAS u32x2*)(slot + (11 + rt) * 1024 + t.wave * 512 + t.lane * 8); }
#pragma unroll
            for (int ks = 0; ks < 2; ++ks) ra[ks] = *(const LAS bf16x8*)(slot + ((8 + ks) * 64 + t.lane) * 16);
            qa = *(const LAS bf16x8*)(slot + (10 * 64 + t.lane) * 16); vb = *(const LAS bf16x8*)(slot + ((15 + t.wave) * 64 + t.lane) * 16);
            if (ck > 0) { const int row = chain_row(b, dir, (ck - 1) * RKT + lc); u32x2 ow; ow.x = pk2(oprev[0], oprev[1]); ow.y = pk2(oprev[2], oprev[3]);
                *(u32x2*)(OR + ((size_t)dir * M + row) * 256 + h * 64 + 16 * w + 4 * hq) = ow; }
            WAIT_L(0); __builtin_amdgcn_sched_barrier(0);
            bf16x8 bfr[2];
#pragma unroll
            for (int ks = 0; ks < 2; ++ks) { u32x4 wv; wv.x = pk2(T[2 * ks][0], T[2 * ks][1]); wv.y = pk2(T[2 * ks][2], T[2 * ks][3]); wv.z = pk2(T[2 * ks + 1][0], T[2 * ks + 1][1]); wv.w = pk2(T[2 * ks + 1][2], T[2 * ks + 1][3]);
                bfr[ks] = __builtin_bit_cast(bf16x8, wv); }
#pragma unroll
            for (int rt = 0; rt < 4; ++rt) { const u32x2 zw = zraw[rt]; T[rt] = (f32x4){bf_lo(zw.x), bf_hi(zw.x), bf_lo(zw.y), bf_hi(zw.y)}; }
#pragma unroll
            for (int rt = 0; rt < 4; ++rt) T[rt] = __builtin_amdgcn_mfma_f32_16x16x32_bf16(pa[rt][0], bfr[0], T[rt], 0, 0, 0);
#pragma unroll
            for (int rt = 0; rt < 4; ++rt) T[rt] = __builtin_amdgcn_mfma_f32_16x16x32_bf16(pa[rt][1], bfr[1], T[rt], 0, 0, 0);
            const f32x4 zero4 = {0.f, 0.f, 0.f, 0.f};
            oprev = __builtin_amdgcn_mfma_f32_16x16x32_bf16(bfr[0], ra[0], zero4, 0, 0, 0);
            oprev = __builtin_amdgcn_mfma_f32_16x16x32_bf16(bfr[1], ra[1], oprev, 0, 0, 0);
            oprev = __builtin_amdgcn_mfma_f32_16x16x32_bf16(vb, qa, oprev, 0, 0, 0);
        }
    }
    if (t.wave < 2) { const int row = chain_row(b, dir, (NCK - 1) * RKT + lc); u32x2 ow; ow.x = pk2(oprev[0], oprev[1]); ow.y = pk2(oprev[2], oprev[3]);
        *(u32x2*)(OR + ((size_t)dir * M + row) * 256 + h * 64 + 16 * w + 4 * hq) = ow; }
    __builtin_amdgcn_s_barrier();
}

constexpr int GLA_UNITS = BATCH * GNC;
__device__ __forceinline__ int gc_row0(int b, int c) { return c < GC_CTX ? ML + b * CTX + 32 * c : b * SEQ + 32 * (c - GC_CTX); }
__device__ __forceinline__ int gc_chain_pos(int c, int dir) { return dir == 0 ? c : (c < GC_CTX ? GC_CTX - 1 - c : GC_CTX + (GC_LAT - 1 - (c - GC_CTX))); }
__device__ __forceinline__ void gla_prefix(LAS float* PRE, int lane) {
    const int d = lane & 31, r0 = (lane >> 5) * 16; float run = 0.f;
#pragma unroll
    for (int i = 0; i < 16; ++i) { run += PRE[(r0 + i) * 33 + d]; PRE[(r0 + i) * 33 + d] = run; }
    WAVE_LDS_FENCE();
    if (lane >= 32) { const float add = PRE[15 * 33 + d];
#pragma unroll
        for (int i = 0; i < 16; ++i) PRE[(16 + i) * 33 + d] += add; }
    WAVE_LDS_FENCE();
}
__device__ __forceinline__ void gla_a1_unit(const Args& a, const Tc& t, int u) {
    const bf16_t* U = (const bf16_t*)(a.ws + WS_U); const float* GG = (const float*)(a.ws + WS_GG);
    float* GZ = (float*)(a.ws + WS_GZ); float* GDEC = (float*)(a.ws + WS_GDEC);
    const int c = u % GNC, b = u / GNC, row0 = gc_row0(b, c);
    const int h = t.wave & 3, dir = t.wave >> 2, chain = (b * 4 + h) * 2 + dir, cc = gc_chain_pos(c, dir);
    LAS float* PRE = (LAS float*)(t.lds + t.wave * 12288);
    LAS bf16_t* KT = (LAS bf16_t*)(PRE + 32 * 33 + 8);
    LAS bf16_t* VT = KT + 32 * 40;
    const int rho = t.lane & 31, hf = t.lane >> 5;
#pragma unroll
    for (int q = 0; q < 4; ++q) { const f32x4 g = *(const f32x4*)(GG + ((size_t)dir * M + row0 + rho) * 128 + h * 32 + hf * 16 + 4 * q);
#pragma unroll
        for (int e = 0; e < 4; ++e) PRE[rho * 33 + hf * 16 + 4 * q + e] = g[e]; }
    WAVE_LDS_FENCE();
    f32x4 graw[4];
#pragma unroll
    for (int q = 0; q < 4; ++q)
#pragma unroll
        for (int e = 0; e < 4; ++e) graw[q][e] = PRE[rho * 33 + hf * 16 + 4 * q + e];
    WAVE_LDS_FENCE();
    gla_prefix(PRE, t.lane);
#pragma unroll
    for (int q = 0; q < 4; ++q) { const f32x4 k = ldbf4(U + (size_t)(row0 + rho) * NU + U_GK + h * 32 + hf * 16 + 4 * q);
#pragma unroll
        for (int e = 0; e < 4; ++e) { const int d = hf * 16 + 4 * q + e; const float pre = PRE[rho * 33 + d], tot = PRE[31 * 33 + d];
            const float w = dir == 0 ? fexp(tot - pre) : fexp(pre - graw[q][e]);
            KT[d * 40 + rho] = (bf16_t)f2bf(k[e] * w); } }
#pragma unroll
    for (int q = 0; q < 8; ++q) { const f32x4 v = ldbf4(U + (size_t)(row0 + rho) * NU + U_GV + h * 64 + hf * 32 + 4 * q);
#pragma unroll
        for (int e = 0; e < 4; ++e) VT[(hf * 32 + 4 * q + e) * 40 + rho] = (bf16_t)f2bf(v[e]); }
    if (t.lane < 32) GDEC[((size_t)chain * GNC + cc) * 32 + t.lane] = fexp(PRE[31 * 33 + t.lane]);
    WAVE_LDS_FENCE();
    float* zb = GZ + ((size_t)chain * GNC + cc) * 2048;
#pragma unroll
    for (int vt = 0; vt < 4; ++vt)
#pragma unroll
        for (int dt = 0; dt < 2; ++dt) { f32x4 acc = {0.f, 0.f, 0.f, 0.f};
            acc = mma16(acc, VT + vt * 16 * 40, 40, KT + dt * 16 * 40, 40, 32, t.lane);
#pragma unroll
            for (int r = 0; r < 4; ++r) zb[(16 * vt + 4 * (t.lane >> 4) + r) * 32 + 16 * dt + (t.lane & 15)] = acc[r]; }
    WAVE_LDS_FENCE();
}
__device__ __forceinline__ void gla_b_carry(const Args& a, const Tc& t, int wg, int nwg) {
    const float* GZ = (const float*)(a.ws + WS_GZ); const float* GDEC = (const float*)(a.ws + WS_GDEC); bf16_t* GST = (bf16_t*)(a.ws + WS_GST);
    static_assert(GNC % 4 == 0, "carry unroll");
    constexpr int NG = GNC / 4, DEP = 3;
    for (int idx = (nwg - 1 - wg) * NTHREADS + t.tid; idx < BATCH * 8 * 512; idx += nwg * NTHREADS) {
        const int chain = idx >> 9, e4 = (idx & 511) * 4, d0 = e4 & 31;
        const float* zc = GZ + (size_t)chain * GNC * 2048 + e4; bf16_t* sc = GST + (size_t)chain * GNC * 2048 + e4; const float* dc = GDEC + (size_t)chain * GNC * 32 + d0;
        f32x4 s = {0.f, 0.f, 0.f, 0.f};
        f32x4 z[DEP][4], d[DEP][4];
#pragma unroll
        for (int g = 0; g < DEP - 1 && g < NG; ++g)
#pragma unroll
            for (int q = 0; q < 4; ++q) { z[g][q] = *(const f32x4*)(zc + (size_t)(4 * g + q) * 2048); d[g][q] = *(const f32x4*)(dc + (size_t)(4 * g + q) * 32); }
#pragma unroll
        for (int g = 0; g < NG; ++g) {
            if (g + DEP - 1 < NG) {
#pragma unroll
                for (int q = 0; q < 4; ++q) { z[(g + DEP - 1) % DEP][q] = *(const f32x4*)(zc + (size_t)(4 * (g + DEP - 1) + q) * 2048); d[(g + DEP - 1) % DEP][q] = *(const f32x4*)(dc + (size_t)(4 * (g + DEP - 1) + q) * 32); } }
#pragma unroll
            for (int q = 0; q < 4; ++q) { u32x2 w; w.x = pk2(s[0], s[1]); w.y = pk2(s[2], s[3]); *(u32x2*)(sc + (size_t)(4 * g + q) * 2048) = w; s = s * d[g % DEP][q] + z[g % DEP][q]; }
        }
    }
}
__device__ __forceinline__ void gla_c_unit(const Args& a, const Tc& t, int u) {
    const bf16_t* U = (const bf16_t*)(a.ws + WS_U); const float* GG = (const float*)(a.ws + WS_GG);
    const bf16_t* GST = (const bf16_t*)(a.ws + WS_GST); bf16_t* OG = (bf16_t*)(a.ws + WS_OG);
    const int c = u % GNC, b = u / GNC, row0 = gc_row0(b, c);
    const int h = t.wave & 3, dir = t.wave >> 2, chain = (b * 4 + h) * 2 + dir, cc = gc_chain_pos(c, dir);
    LAS float* PRE = (LAS float*)(t.lds + t.wave * 14592);
    LAS bf16_t* QN = (LAS bf16_t*)(PRE + 32 * 33 + 8);
    LAS bf16_t* KN = QN + 32 * 40;
    LAS bf16_t* VT = KN + 32 * 40;
    const int rho = t.lane & 31, hf = t.lane >> 5, hq = t.lane >> 4, lc = t.lane & 15;
#pragma unroll
    for (int q = 0; q < 4; ++q) { const f32x4 g = *(const f32x4*)(GG + ((size_t)dir * M + row0 + rho) * 128 + h * 32 + hf * 16 + 4 * q);
#pragma unroll
        for (int e = 0; e < 4; ++e) PRE[rho * 33 + hf * 16 + 4 * q + e] = g[e]; }
    WAVE_LDS_FENCE();
    f32x4 graw[4];
#pragma unroll
    for (int q = 0; q < 4; ++q)
#pragma unroll
        for (int e = 0; e < 4; ++e) graw[q][e] = PRE[rho * 33 + hf * 16 + 4 * q + e];
    WAVE_LDS_FENCE();
    gla_prefix(PRE, t.lane);
#pragma unroll
    for (int q = 0; q < 4; ++q) { const f32x4 qv = ldbf4(U + (size_t)(row0 + rho) * NU + U_GQ + h * 32 + hf * 16 + 4 * q), kv = ldbf4(U + (size_t)(row0 + rho) * NU + U_GK + h * 32 + hf * 16 + 4 * q);
#pragma unroll
        for (int e = 0; e < 4; ++e) { const int d = hf * 16 + 4 * q + e; const float pre = PRE[rho * 33 + d], tot = PRE[31 * 33 + d], ref = PRE[15 * 33 + d];
            const float ex = pre - graw[q][e], qs = qv[e] * 0.17677669529663687f;
            float fq, fk;
            if (dir == 0) { fq = fexp(pre - ref); fk = fexp(ref - pre); } else { fq = fexp(ref - ex); fk = fexp(ex - ref); }
            (void)tot;
            QN[rho * 40 + d] = (bf16_t)f2bf(qs * fq); KN[rho * 40 + d] = (bf16_t)f2bf(kv[e] * fk); } }
    bf16x8 q2f[2];
#pragma unroll
    for (int it = 0; it < 2; ++it) { const int ro = 16 * it + lc; const bf16_t* qp = U + (size_t)(row0 + ro) * NU + U_GQ + h * 32 + 8 * hq; const float* gp = GG + ((size_t)dir * M + row0 + ro) * 128 + h * 32 + 8 * hq;
        const f32x4 qa = ldbf4(qp), qb = ldbf4(qp + 4), ga = *(const f32x4*)gp, gb = *(const f32x4*)(gp + 4);
#pragma unroll
        for (int e = 0; e < 8; ++e) { const int d = 8 * hq + e; const float pre = PRE[ro * 33 + d], tot = PRE[31 * 33 + d]; const float qv = e < 4 ? qa[e & 3] : qb[e & 3], gv = e < 4 ? ga[e & 3] : gb[e & 3];
            const float f2 = dir == 0 ? fexp(pre) : fexp(tot - (pre - gv));
            q2f[it][e] = (short)f2bf(qv * 0.17677669529663687f * f2); } }
#pragma unroll
    for (int q = 0; q < 8; ++q) { const f32x4 v = ldbf4(U + (size_t)(row0 + rho) * NU + U_GV + h * 64 + hf * 32 + 4 * q);
#pragma unroll
        for (int e = 0; e < 4; ++e) VT[(hf * 32 + 4 * q + e) * 40 + rho] = (bf16_t)f2bf(v[e]); }
    WAVE_LDS_FENCE();
    f32x4 att[2][2];
#pragma unroll
    for (int it = 0; it < 2; ++it)
#pragma unroll
        for (int jt = 0; jt < 2; ++jt) { att[it][jt] = (f32x4){0.f, 0.f, 0.f, 0.f}; att[it][jt] = mma16(att[it][jt], QN + it * 16 * 40, 40, KN + jt * 16 * 40, 40, 32, t.lane); }
    WAVE_LDS_FENCE();
#pragma unroll
    for (int it = 0; it < 2; ++it)
#pragma unroll
        for (int jt = 0; jt < 2; ++jt)
#pragma unroll
            for (int r = 0; r < 4; ++r) { const int ro = 16 * it + 4 * hq + r, rp = 16 * jt + lc; const bool keep = dir == 0 ? (rp <= ro) : (rp >= ro);
                QN[ro * 40 + rp] = (bf16_t)f2bf(keep ? att[it][jt][r] : 0.f); }
    WAVE_LDS_FENCE();
    const bf16_t* sb = GST + ((size_t)chain * GNC + cc) * 2048;
#pragma unroll
    for (int it = 0; it < 2; ++it)
#pragma unroll
        for (int vt = 0; vt < 4; ++vt) { f32x4 acc = {0.f, 0.f, 0.f, 0.f};
            acc = mma16(acc, QN + it * 16 * 40, 40, VT + vt * 16 * 40, 40, 32, t.lane);
            const bf16x8 sf = *(const bf16x8*)(sb + (size_t)(16 * vt + lc) * 32 + 8 * hq);
            acc = __builtin_amdgcn_mfma_f32_16x16x32_bf16(q2f[it], sf, acc, 0, 0, 0);
#pragma unroll
            for (int r = 0; r < 4; ++r) stbf(OG + ((size_t)dir * M + row0 + 16 * it + 4 * hq + r) * 256 + h * 64 + 16 * vt + lc, acc[r]); }
    WAVE_LDS_FENCE();
}

__device__ __forceinline__ void phase_mixout(const Args& a, const Tc& t, int l, int Mtok) {
    const bf16_t* U = (const bf16_t*)(a.ws + WS_U); const bf16_t* RW7 = (const bf16_t*)(a.ws + WS_RW7); const bf16_t* SXBC = (const bf16_t*)(a.ws + WS_SXBC);
    const bf16_t* OG = (const bf16_t*)(a.ws + WS_OG); const bf16_t* OR = (const bf16_t*)(a.ws + WS_OR); const bf16_t* OS = (const bf16_t*)(a.ws + WS_OS);
    bf16_t* MIX = (bf16_t*)(a.ws + WS_MIX);
    const float* mu = a.in[I_RMU] + (size_t)l * 2 * 928; const float* g2 = a.in[I_RG2] + (size_t)l * 64 * 256;
    const float* gng = a.in[I_GNG] + (size_t)l * 256; const float* lng = a.in[I_RLG] + (size_t)l * 256; const float* lnb = a.in[I_RLB] + (size_t)l * 256;
    const float* rrk = a.in[I_RRK] + (size_t)l * 256; const float* sd = a.in[I_SD] + (size_t)l * 8; const float* sng = a.in[I_SNG] + (size_t)l * 512;
    LAS float* SG = (LAS float*)t.lds;
    LAS float* RED = (LAS float*)(t.lds + 4096);
    const size_t P = (size_t)M * 256;
    LAS float* G2S = (LAS float*)(t.lds + 8192);
    for (int e = t.tid; e < 64 * 256 / 4; e += NTHREADS) *(LAS f32x4*)(G2S + 4 * e) = *(const f32x4*)(g2 + 4 * e);
    LDS_BARRIER();
    for (int tile = t.bid; tile < Mtok / 16; tile += t.G) {
        const int r0 = tile * 16; int slo, shi; seg_bounds(r0, slo, shi);
        unsigned lgr[8][4], lsd[16][2];
        {   const int c = t.tid & 255, tt0 = (t.tid >> 8) * 8;
#pragma unroll
            for (int j = 0; j < 8; ++j) { const size_t row = (size_t)(r0 + tt0 + j);
                lgr[j][0] = (unsigned)OG[row * 256 + c] | ((unsigned)OG[P + row * 256 + c] << 16);
                lgr[j][1] = (unsigned)OR[row * 256 + c] | ((unsigned)OR[P + row * 256 + c] << 16);
                lgr[j][2] = (unsigned)U[row * NU + U_GOG + c] | ((unsigned)RW7[row * 256 + c] << 16);
                lgr[j][3] = (unsigned)RW7[P + row * 256 + c] | ((unsigned)RW7[2 * P + row * 256 + c] << 16); }
            const int cs = t.tid;
#pragma unroll
            for (int q = 0; q < 16; ++q) { const size_t row = (size_t)(r0 + q);
                lsd[q][0] = (unsigned)OS[row * 512 + cs] | ((unsigned)OS[(size_t)M * 512 + row * 512 + cs] << 16);
                lsd[q][1] = (unsigned)SXBC[row * 1024 + cs] | ((unsigned)U[row * NU + U_SZ + cs] << 16); } }
        {   const int tt = t.tid >> 5, r = t.tid & 31, row = r0 + tt; const bf16_t* up = U + (size_t)row * NU; const bool hp = row - 1 >= slo, hn = row + 1 < shi;
#pragma unroll
            for (int q = 0; q < 2; ++q) { const int col = U_RLGT + q * 32 + r, mi = col - U_RW; const float u = ldbf(up + col), pv = ld_or0(up + col - NU, up + col, hp), nv = ld_or0(up + col + NU, up + col, hn);
                SG[tt * 64 + q * 32 + r] = sigmoidf_(u + mu[mi] * (pv - u) + mu[928 + mi] * (nv - u)); } }
        LDS_BARRIER();
        {
            const int c = t.tid & 255, tt0 = (t.tid >> 8) * 8;
            float ag[8];
#pragma unroll
            for (int j = 0; j < 8; ++j) ag[j] = 0.f;
#pragma unroll 2
            for (int r4 = 0; r4 < 16; ++r4) { float w[4];
#pragma unroll
                for (int q = 0; q < 4; ++q) w[q] = G2S[(4 * r4 + q) * 256 + c];
#pragma unroll
                for (int j = 0; j < 8; ++j) { const f32x4 sv = *(const LAS f32x4*)(SG + (tt0 + j) * 64 + 4 * r4); ag[j] += (sv[0] * w[0] + sv[1] * w[1]) + (sv[2] * w[2] + sv[3] * w[3]); } }
            const float gn = gng[c], lg = lng[c], lb = lnb[c], rk = rrk[c];
#pragma unroll
            for (int j = 0; j < 8; ++j) { const int row = r0 + tt0 + j;
                const float og_ = bf_lo(lgr[j][0]) + bf_hi(lgr[j][0]);
                const float ms = wave_sum(og_ * og_) * (1.0f / 64.0f);
                const float o1 = og_ * (frsq(ms + 1e-6f)) * gn * siluf_(bf_lo(lgr[j][2]));
                const float orr = bf_lo(lgr[j][1]) + bf_hi(lgr[j][1]);
                const float mean = wave_sum(orr) * (1.0f / 64.0f); const float dd = orr - mean; const float var = wave_sum(dd * dd) * (1.0f / 64.0f);
                const float on = dd * (frsq(var + 64e-5f)) * lg + lb;
                const float bon = wave_sum(bf_hi(lgr[j][2]) * bf_lo(lgr[j][3]) * rk) * bf_hi(lgr[j][3]);
                const float o2 = (on + bon) * ag[j];
                MIX[(size_t)row * D + c] = (bf16_t)f2bf(o1); MIX[(size_t)row * D + 256 + c] = (bf16_t)f2bf(o2); }
        }
        {
            const int c = t.tid; const float dh = sd[c >> 6], ng = sng[c];
            float y[16];
#pragma unroll
            for (int q = 0; q < 16; ++q) {
                float v = bf_lo(lsd[q][0]) + bf_hi(lsd[q][0]) + dh * bf_lo(lsd[q][1]);
                v *= siluf_(bf_hi(lsd[q][1])); y[q] = v;
                const float ss = wave_sum(v * v); if (t.lane == 0) RED[q * 8 + t.wave] = ss; }
            LDS_BARRIER();
            const int gb = (t.wave >> 2) * 4;
#pragma unroll
            for (int q = 0; q < 16; ++q) { const float ms = (RED[q * 8 + gb] + RED[q * 8 + gb + 1] + RED[q * 8 + gb + 2] + RED[q * 8 + gb + 3]) * (1.0f / 256.0f);
                MIX[(size_t)(r0 + q) * D + 512 + c] = (bf16_t)f2bf(y[q] * (frsq(ms + 1e-6f)) * ng); }
        }
        LDS_BARRIER();
    }
}

static_assert(NEXP <= 32, "router lanes");
__device__ __forceinline__ unsigned long long router_key(float v, int e) { unsigned u = __float_as_uint(v); u = (u & 0x80000000u) ? ~u : (u | 0x80000000u); return ((unsigned long long)u << 32) | (unsigned)(31 - e); }
__device__ __forceinline__ float router_unkey(unsigned long long k) { unsigned u = (unsigned)(k >> 32); u = (u & 0x80000000u) ? (u & 0x7fffffffu) : ~u; return __uint_as_float(u); }
__device__ __forceinline__ void phase_router(const Args& a, const Tc& t, int l, int Mtok) {
    const bf16_t* X = (const bf16_t*)(a.ws + WS_X); bf16_t* H = (bf16_t*)(a.ws + WS_H); const float* MODS = (const float*)(a.ws + WS_MODS) + (size_t)l * NR * 6144;
    const float* rw = a.in[I_ROUTW] + (size_t)l * D * NEXP; const float* rb = a.in[I_ROUTB] + (size_t)l * NEXP;
    int* TOPI = (int*)(a.ws + WS_TOPI); float* TOPP = (float*)(a.ws + WS_TOPP);
    unsigned* CNT = (unsigned*)(a.ws + WS_CTL) + CW_CNT + l * 64;
    LAS int* hist = (LAS int*)(t.lds + LDS_MISC + 64);
    LAS float* HT = (LAS float*)t.lds;
    LAS float* PART = HT + 16 * 1028;
    if (t.tid < NEXP) hist[t.tid] = 0;
    __syncthreads();
    const int hq = t.lane >> 4, lc = t.lane & 15, e = t.lane & 31, rh = t.lane >> 5; const bool ev = e < NEXP;
    const float bias = ev ? rb[e] : 0.f;
    constexpr int NT = NEXP > 16 ? 2 : 1;
    float wreg[NT][32];
#pragma unroll
    for (int nt = 0; nt < NT; ++nt)
#pragma unroll
        for (int ks = 0; ks < 32; ++ks) { const int k = 128 * t.wave + 4 * ks + hq, col = 16 * nt + lc; wreg[nt][ks] = col < NEXP ? rw[(size_t)k * NEXP + col] : 0.f; }
    for (int tile = t.bid; tile < Mtok / 16; tile += t.G) {
        const int r0 = tile * 16;
#pragma unroll
        for (int rr = 0; rr < 2; ++rr) { const int lr = 2 * t.wave + rr, row = r0 + lr;
            f32x4 v[4], h[4];
#pragma unroll
            for (int j = 0; j < 4; ++j) v[j] = ldbf4(X + (size_t)row * D + 4 * t.lane + 256 * j);
            const float* md = MODS + (size_t)mod_row(row) * 6144;
            norm_mod_store<true>(v, a.in[I_N2G] + (size_t)l * D, md + 3 * 1024, md + 4 * 1024, (bf16_t*)((unsigned char*)H + (size_t)row * D), t.lane, h);
#pragma unroll
            for (int j = 0; j < 4; ++j) *(LAS f32x4*)(HT + lr * 1028 + 4 * t.lane + 256 * j) = h[j]; }
        LDS_BARRIER();
        f32x4 acc[NT];
#pragma unroll
        for (int nt = 0; nt < NT; ++nt) acc[nt] = (f32x4){0.f, 0.f, 0.f, 0.f};
#pragma unroll
        for (int ks = 0; ks < 32; ++ks) { const float av = HT[lc * 1028 + 128 * t.wave + 4 * ks + hq];
#pragma unroll
            for (int nt = 0; nt < NT; ++nt) acc[nt] = __builtin_amdgcn_mfma_f32_16x16x4f32(av, wreg[nt][ks], acc[nt], 0, 0, 0); }
#pragma unroll
        for (int nt = 0; nt < NT; ++nt)
#pragma unroll
            for (int r = 0; r < 4; ++r) PART[(t.wave * 16 + 4 * hq + r) * 33 + 16 * nt + lc] = acc[nt][r];
        LDS_BARRIER();
        {   const int lr = 2 * t.wave + rh, row = r0 + lr;
            float lg = bias;
#pragma unroll
            for (int w2 = 0; w2 < 8; ++w2) lg += PART[(w2 * 16 + lr) * 33 + (ev ? e : 0)];
            if (!ev) lg = -3.0e38f;
            unsigned long long key = router_key(lg, e);
            int ti[4]; float tv[4];
#pragma unroll
            for (int k = 0; k < 4; ++k) { unsigned long long m = key;
#pragma unroll
                for (int o = 1; o < 32; o <<= 1) { const unsigned long long other = __shfl_xor(m, o); m = other > m ? other : m; }
                ti[k] = 31 - (int)(unsigned)(m & 0xffffffffu); tv[k] = router_unkey(m);
                if (ti[k] == e) key = 0ull; }
            const float e0 = 1.0f, e1 = fexp(tv[1] - tv[0]), e2 = fexp(tv[2] - tv[0]), e3 = fexp(tv[3] - tv[0]); const float inv = frcp(e0 + e1 + e2 + e3);
            if (e == 0) {
                TOPI[row * 4 + 0] = ti[0]; TOPI[row * 4 + 1] = ti[1]; TOPI[row * 4 + 2] = ti[2]; TOPI[row * 4 + 3] = ti[3];
                TOPP[row * 4 + 0] = e0 * inv; TOPP[row * 4 + 1] = e1 * inv; TOPP[row * 4 + 2] = e2 * inv; TOPP[row * 4 + 3] = e3 * inv;
#pragma unroll
                for (int k = 0; k < 4; ++k) atomicAdd((int*)&hist[ti[k]], 1);
            } }
        LDS_BARRIER();
    }
    __syncthreads();
    if (t.tid < NEXP && hist[t.tid] != 0) atomicAdd(&CNT[t.tid], (unsigned)hist[t.tid]);
}

__device__ __forceinline__ int moe_offsets(const unsigned* CNT, LAS int* off, LAS int* cnt, int tid) {
    if (tid < NEXP) { int o = 0; for (int e = 0; e < tid; ++e) o += ((int)CNT[e] + 255) & ~255; off[tid] = o; cnt[tid] = (int)CNT[tid]; }
    __syncthreads();
    return (off[NEXP - 1] + ((cnt[NEXP - 1] + 255) & ~255)) >> 8;
}
__device__ __forceinline__ void phase_lists(const Args& a, const Tc& t, int l, int Mtok) {
    const int* TOPI = (const int*)(a.ws + WS_TOPI); const float* TOPP = (const float*)(a.ws + WS_TOPP);
    int* POS = (int*)(a.ws + WS_POS); int* ROWIDX = (int*)(a.ws + WS_ROWIDX); float* ROWGATE = (float*)(a.ws + WS_ROWGATE);
    unsigned* CNT = (unsigned*)(a.ws + WS_CTL) + CW_CNT + l * 64; unsigned* CUR = (unsigned*)(a.ws + WS_CTL) + CW_CUR + l * 64;
    LAS int* off = (LAS int*)(t.lds + LDS_MISC + 64); LAS int* cnt = off + 64; LAS int* hist = off + 128; LAS int* base = off + 192; LAS int* cur = off + 256;
    if (t.tid < NEXP) { hist[t.tid] = 0; cur[t.tid] = 0; }
    moe_offsets(CNT, off, cnt, t.tid);
    const int rpb = (Mtok + t.G - 1) / t.G, s0 = t.bid * rpb * 4; int s1 = (t.bid + 1) * rpb * 4; if (s1 > Mtok * 4) s1 = Mtok * 4;
    for (int s = s0 + t.tid; s < s1; s += NTHREADS) atomicAdd((int*)&hist[TOPI[s]], 1);
    __syncthreads();
    if (t.tid < NEXP) base[t.tid] = hist[t.tid] ? (int)atomicAdd(&CUR[t.tid], (unsigned)hist[t.tid]) : 0;
    __syncthreads();
    for (int s = s0 + t.tid; s < s1; s += NTHREADS) { const int e = TOPI[s]; const int p = off[e] + base[e] + atomicAdd((int*)&cur[e], 1);
        POS[s] = p; ROWIDX[p] = s >> 2; ROWGATE[p] = TOPP[s]; }
    for (int e = t.bid; e < NEXP; e += t.G) { const int lo = off[e] + cnt[e], hi = off[e] + ((cnt[e] + 255) & ~255);
        for (int p = lo + t.tid; p < hi; p += NTHREADS) { ROWIDX[p] = 0; ROWGATE[p] = 0.f; } }
    __syncthreads();
}
__device__ __forceinline__ int moe_tile_table(const Args& a, const Tc& t, int l) {
    unsigned* CNT = (unsigned*)(a.ws + WS_CTL) + CW_CNT + l * 64;
    LAS int* off = (LAS int*)(t.lds + LDS_MISC + 64); LAS int* cnt = off + 64; LAS int* tile_e = (LAS int*)(t.lds + LDS_TILE_E);
    const int ntiles = moe_offsets(CNT, off, cnt, t.tid);
    for (int tt = t.tid; tt < ntiles; tt += NTHREADS) { int e = 0;
        for (int q = 1; q < NEXP; ++q) if ((off[q] >> 8) <= tt) e = q;
        tile_e[tt] = e; }
    __syncthreads();
    return ntiles;
}

__device__ __forceinline__ void phase_combine(const Args& a, const Tc& t, int l, int Mtok) {
    const int gw = t.bid * NWAVES + t.wave, NGW = t.G * NWAVES;
    bf16_t* X = (bf16_t*)(a.ws + WS_X); bf16_t* H = (bf16_t*)(a.ws + WS_H); const bf16_t* Y = (const bf16_t*)(a.ws + WS_Y); const int* POS = (const int*)(a.ws + WS_POS);
    const float* MODS = (const float*)(a.ws + WS_MODS) + (size_t)l * NR * 6144;
    for (int rp = gw * 2; rp < Mtok; rp += NGW * 2) {
        int ps[2][4];
#pragma unroll
        for (int q = 0; q < 2; ++q) { const u32x4 pv = *(const u32x4*)(POS + (size_t)(rp + q) * 4); ps[q][0] = (int)pv.x; ps[q][1] = (int)pv.y; ps[q][2] = (int)pv.z; ps[q][3] = (int)pv.w; }
        u32x2 yv[2][4][4]; f32x4 xv[2][4];
#pragma unroll
        for (int q = 0; q < 2; ++q)
#pragma unroll
            for (int j = 0; j < 4; ++j) { const int c = 4 * t.lane + 256 * j; xv[q][j] = ldbf4(X + (size_t)(rp + q) * D + c);
#pragma unroll
                for (int k = 0; k < 4; ++k) yv[q][k][j] = *(const u32x2*)(Y + (size_t)ps[q][k] * D + c); }
#pragma unroll
        for (int q = 0; q < 2; ++q) { const int row = rp + q;
            const float* md = MODS + (size_t)mod_row(row) * 6144 + 5 * 1024;
            f32x4 v[4], h[4];
#pragma unroll
            for (int j = 0; j < 4; ++j) { const int c = 4 * t.lane + 256 * j;
                const u32x2 y0 = yv[q][0][j], y1 = yv[q][1][j], y2 = yv[q][2][j], y3 = yv[q][3][j];
                f32x4 s_; s_[0] = (bf_lo(y0.x) + bf_lo(y1.x)) + (bf_lo(y2.x) + bf_lo(y3.x)); s_[1] = (bf_hi(y0.x) + bf_hi(y1.x)) + (bf_hi(y2.x) + bf_hi(y3.x));
                s_[2] = (bf_lo(y0.y) + bf_lo(y1.y)) + (bf_lo(y2.y) + bf_lo(y3.y)); s_[3] = (bf_hi(y0.y) + bf_hi(y1.y)) + (bf_hi(y2.y) + bf_hi(y3.y));
                const f32x4 g = *(const f32x4*)(md + c);
                v[j] = xv[q][j] + g * s_; }
            if (l + 1 < DEPTH) {
#pragma unroll
                for (int j = 0; j < 4; ++j) { u32x2 w; w.x = pk2(v[j][0], v[j][1]); w.y = pk2(v[j][2], v[j][3]); *(u32x2*)(X + (size_t)row * D + 4 * t.lane + 256 * j) = w; }
                const float* md2 = MODS + (size_t)NR * 6144 + (size_t)mod_row(row) * 6144;
                norm_mod_store(v, a.in[I_N1G] + (size_t)(l + 1) * D, md2, md2 + 1024, H + (size_t)row * D, t.lane, h);
            } else {
                float ss = 0.f;
#pragma unroll
                for (int j = 0; j < 4; ++j) ss += (v[j][0] * v[j][0] + v[j][1] * v[j][1]) + (v[j][2] * v[j][2] + v[j][3] * v[j][3]);
                const float rstd = frsq(wave_sum(ss) * (1.0f / D) + 1e-6f);
#pragma unroll
                for (int j = 0; j < 4; ++j) { const int c = 4 * t.lane + 256 * j; const f32x4 g = *(const f32x4*)(a.in[I_FNG] + c); *(f32x4*)(a.out + (size_t)row * D + c) = v[j] * rstd * g; }
            } }
    }
}

#ifndef EMU
__device__ __forceinline__ void launder_ws(Args& al) {
    __attribute__((address_space(1))) unsigned char* p = (__attribute__((address_space(1))) unsigned char*)al.ws; asm volatile("" : "+s"(p)); al.ws = (unsigned char*)p; }
__device__ __forceinline__ void launder_tid(Tc& t) { int x = threadIdx.x; asm volatile("" : "+v"(x)); t.tid = x; t.lane = x & 63; t.wave = __builtin_amdgcn_readfirstlane(x >> 6); }
#endif
constexpr int PH_PER_LAYER = 12, N_PHASES = 2 + DEPTH * PH_PER_LAYER;
__global__ void __launch_bounds__(NTHREADS, 2) fwd(Args a) {
#ifdef EMU
    unsigned char* lds_raw = EMU_DYN_LDS();
#else
    extern __shared__ __attribute__((aligned(16))) unsigned char lds_raw[];
#endif
    Tc t; t.lds = (LAS unsigned char*)lds_raw; t.tid = threadIdx.x; t.lane = t.tid & 63; t.wave = __builtin_amdgcn_readfirstlane(t.tid >> 6); t.G = gridDim.x; t.bid = blockIdx.x;
    const int lo = a.ph_lo, hi = a.ph_hi;
    Args al = a;
    volatile LAS unsigned* misc = (volatile LAS unsigned*)(t.lds + LDS_MISC);
    if (t.tid < 16) misc[t.tid] = 0u;
    if (t.tid == 0) { LAS unsigned long long* tb = (LAS unsigned long long*)(t.lds + LDS_PTRS);
#pragma unroll
        for (int i = 0; i < 37; ++i) tb[i] = (unsigned long long)a.in[i]; }
    __syncthreads();
    XcdBarrier bar; bar.bar = (unsigned*)(a.ws + WS_CTL) + CW_BAR; bar.x = 0; bar.st = misc;
    if (hi - lo > 1) bar = xcd_barrier_post((unsigned*)(a.ws + WS_CTL) + CW_BAR, misc);
#ifdef EMU
#define LAUNDER_TID() ((void)0)
#else
#define LAUNDER_TID() launder_tid(t)
#endif
#if PROBE_SPIN >= 0 && !defined(EMU)
    unsigned long long pt_acc = 0ull, pt_t0 = 0ull;
#define PT_MATCH(k) ((PROBE_SPIN >= 100) ? ((k) == PROBE_SPIN - 100) : ((k) >= 2 && ((k) - 2) % PH_PER_LAYER == PROBE_SPIN))
#define PT_BEGIN(k) (PT_MATCH(k) ? (pt_t0 = wall_clock64(), true) : true)
#define PT_END(k) do { if (PT_MATCH(k)) pt_acc += wall_clock64() - pt_t0; } while (0)
#else
#define PT_BEGIN(k) true
#define PT_END(k) ((void)0)
#endif
#ifdef EMU
#define LAUNDER_WS() ((void)0)
#else
#define LAUNDER_WS() launder_ws(al)
#endif
#define IN_PH(k) (lo <= (k) && (k) < hi && (LAUNDER_TID(), LAUNDER_WS(), true) && PT_BEGIN(k))
#define REPS(bit) (((PROBE_DOUBLE >> (bit)) & 1) ? 2 : 1)
#ifdef EMU
#define SEAM(k) do { if ((k) + 1 < hi) xcd_barrier(bar); PT_END(k); } while (0)
#else
#define SEAM(k) do { if ((k) + 1 < hi) { XcdBarrier b2_ = bar; __attribute__((address_space(1))) unsigned* bp_ = (__attribute__((address_space(1))) unsigned*)b2_.bar; asm volatile("" : "+s"(bp_)); b2_.bar = (unsigned*)bp_; xcd_barrier(b2_); } PT_END(k); } while (0)
#endif
    if (IN_PH(0)) { for (int rep = 0; rep < REPS(15); ++rep) phase_pro0(al, t); SEAM(0); }
    if (IN_PH(1)) { phase_pro1(al, t); SEAM(1); }
    for (int l = 0; l < DEPTH; ++l) {
        const int pb = 2 + l * PH_PER_LAYER;
        const bool lastl = (l == DEPTH - 1);
        const int Mtok = lastl ? ML : M;
        const float* MODSL = (const float*)(al.ws + WS_MODS) + (size_t)l * NR * 6144;
        if (IN_PH(pb + 0)) {
            pg8::Gemm g{(const bf16_t*)(al.ws + WS_H), (const bf16_t*)(al.ws + WS_WIN) + (size_t)l * NU * D, D, nullptr};
            pg8::DenseSched S; S.o.init(M / 256, NU / 256, t.G, t.bid);
            pg8::EpiBf16 E{(bf16_t*)(al.ws + WS_U), NU};
            for (int rep = 0; rep < REPS(0); ++rep) pg8::gemm_phase<pg8::EpiBf16, pg8::DenseSched, false>(t.lds, t.tid, g, S, E);
            convert_in_slack(al, t, l, 0, CV_E_IN, (M / 256) * (NU / 256));
            SEAM(pb + 0);
        }
        if (IN_PH(pb + 1)) { for (int rep = 0; rep < REPS(1); ++rep) phase_prep(al, t, l); SEAM(pb + 1); }
        if (IN_PH(pb + 2)) {
            for (int rep = 0; rep < REPS(4); ++rep) rwkv_a_all(al, t);
            for (int rep = 0; rep < REPS(10); ++rep)
            for (int u = t.bid; u < SSD_UNITS + GLA_UNITS; u += t.G) { if (u < SSD_UNITS) ssd_a1_unit(al, t, l, u); else gla_a1_unit(al, t, u - SSD_UNITS); }
            SEAM(pb + 2);
        }
        if (IN_PH(pb + 3)) {
            for (int rep = 0; rep < REPS(5); ++rep) for (int task = t.bid; task < RKB_TASKS; task += t.G) rwkv_b_task(al, t, task);
            if (t.G >= 2 * RKB_TASKS) { if (t.bid >= RKB_TASKS) { ssd_b_carry(al, t, t.bid - RKB_TASKS, t.G - RKB_TASKS); gla_b_carry(al, t, t.bid - RKB_TASKS, t.G - RKB_TASKS);
                    __syncthreads(); convert_moe(al, t, l, CV_E_IN, lastl ? CV_MOE_ITEMS : CV_E_B, (t.bid - RKB_TASKS) * NWAVES + t.wave, (t.G - RKB_TASKS) * NWAVES); } }
            else { ssd_b_carry(al, t, t.bid, t.G); gla_b_carry(al, t, t.bid, t.G); __syncthreads(); convert_moe(al, t, l, CV_E_IN, lastl ? CV_MOE_ITEMS : CV_E_B, t.bid * NWAVES + t.wave, t.G * NWAVES); }
            SEAM(pb + 3);
        }
        if (IN_PH(pb + 4)) {
            for (int rep = 0; rep < REPS(6); ++rep) for (int u = t.bid; u < SSD_UNITS + GLA_UNITS; u += t.G) { if (u < SSD_UNITS) ssd_c_unit(al, t, l, u); else gla_c_unit(al, t, u - SSD_UNITS); }
            SEAM(pb + 4);
        }
        if (IN_PH(pb + 5)) { for (int rep = 0; rep < REPS(3); ++rep) phase_mixout(al, t, l, Mtok); SEAM(pb + 5); }
        if (IN_PH(pb + 6)) {
            pg8::Gemm g{(const bf16_t*)(al.ws + WS_MIX), (const bf16_t*)(al.ws + WS_WOUT) + (size_t)l * D * D, D, nullptr};
            pg8::DenseSched S; S.o.init(Mtok / 256, D / 256, t.G, t.bid);
            pg8::EpiResid E{(bf16_t*)(al.ws + WS_X), MODSL};
            pg8::gemm_phase<pg8::EpiResid, pg8::DenseSched, false>(t.lds, t.tid, g, S, E);
            if (!lastl) convert_in_slack(al, t, l, CV_E_B, CV_MOE_ITEMS, (Mtok / 256) * (D / 256));
            SEAM(pb + 6);
        }
        if (IN_PH(pb + 7)) { phase_router(al, t, l, Mtok); SEAM(pb + 7); }
        if (IN_PH(pb + 8)) { phase_lists(al, t, l, Mtok); SEAM(pb + 8); }
        if (IN_PH(pb + 9)) {
            const int ntiles = moe_tile_table(al, t, l);
            pg8::Gemm g{(const bf16_t*)(al.ws + WS_H), (const bf16_t*)(al.ws + WS_WGU + (size_t)l * NEXP * 2048 * D), D / 2, (const int*)(al.ws + WS_ROWIDX)};
            pg8::MoeSched S; S.o.init(ntiles, 8, t.G, t.bid); S.tile_e = (const LAS int*)(t.lds + LDS_TILE_E); S.nct = 8;
            pg8::EpiSwiglu E{al.ws + WS_ACT, al.in[I_BGU] + (size_t)l * NEXP * 2048};
            for (int rep = 0; rep < REPS(7); ++rep) pg8::gemm_phase<pg8::EpiSwiglu, pg8::MoeSched, true, true>(t.lds, t.tid, g, S, E);
            SEAM(pb + 9);
        }
        if (IN_PH(pb + 10)) {
            const int ntiles = moe_tile_table(al, t, l);
            pg8::Gemm g{(const bf16_t*)(al.ws + WS_ACT), (const bf16_t*)(al.ws + WS_WD + (size_t)l * NEXP * D * DFF), DFF / 2, nullptr};
            pg8::MoeSched S; S.o.init(ntiles, 4, t.G, t.bid); S.tile_e = (const LAS int*)(t.lds + LDS_TILE_E); S.nct = 4;
            pg8::EpiDown E{(bf16_t*)(al.ws + WS_Y), al.in[I_BDN] + (size_t)l * NEXP * D, (const float*)(al.ws + WS_ROWGATE)};
            for (int rep = 0; rep < REPS(8); ++rep) pg8::gemm_phase<pg8::EpiDown, pg8::MoeSched, false, true>(t.lds, t.tid, g, S, E);
            SEAM(pb + 10);
        }
        if (IN_PH(pb + 11)) { phase_combine(al, t, l, Mtok); SEAM(pb + 11); }
    }
#if PROBE_SPIN >= 0 && !defined(EMU)
    if (t.bid == 0) { const unsigned long long te = wall_clock64(); while (wall_clock64() - te < 4ull * pt_acc) __builtin_amdgcn_s_sleep(8); }
#endif
#undef IN_PH
#undef SEAM
}

}

extern "C" void kernel_launch(void* const* d_in, const int* in_sizes, int n_in, void* d_out, int out_size, void* d_ws, size_t ws_size, hipStream_t stream) {
    using namespace mk;
    static int grid = 0;
    if (grid == 0) {
        if (n_in != 37 || out_size != ML * D || ws_size < WS_END) { fprintf(stderr, "kernel_launch: unexpected shapes (n_in %d out %d ws %zu need %zu)\n", n_in, out_size, ws_size, (size_t)WS_END); grid = -1; return; }
#ifdef EMU
        { const char* e = getenv("EMU_GRID"); grid = e ? atoi(e) : 8; }
#else
        int dev = 0, cus = 0, per_cu = 0;
        if (hipGetDevice(&dev) != hipSuccess || hipDeviceGetAttribute(&cus, hipDeviceAttributeMultiprocessorCount, dev) != hipSuccess) { grid = -1; return; }
        if (hipFuncSetAttribute((const void*)fwd, hipFuncAttributeMaxDynamicSharedMemorySize, LDS_BYTES) != hipSuccess) { fprintf(stderr, "kernel_launch: hipFuncSetAttribute failed\n"); grid = -1; return; }
        if (hipOccupancyMaxActiveBlocksPerMultiprocessor(&per_cu, (const void*)fwd, NTHREADS, LDS_BYTES) != hipSuccess || per_cu < 1) fprintf(stderr, "kernel_launch: occupancy query reports %d\n", per_cu);
        (void)hipGetLastError();
        grid = cus;
#endif
    }
    if (grid < 0) return;
    (void)hipMemsetAsync((char*)d_ws + WS_CTL, 0, CTL_BYTES, stream);
    Args a{};
    for (int i = 0; i < 37; ++i) a.in[i] = (const float*)d_in[i];
    a.out = (float*)d_out; a.ws = (unsigned char*)d_ws;
#if N_LAUNCH_MODE == 1
    a.ph_lo = 0; a.ph_hi = N_PHASES;
    hipLaunchKernelGGL(fwd, dim3(grid), dim3(NTHREADS), LDS_BYTES, stream, a);
#else
    for (int p = 0; p < N_PHASES; ++p) { a.ph_lo = p; a.ph_hi = p + 1; hipLaunchKernelGGL(fwd, dim3(grid), dim3(NTHREADS), LDS_BYTES, stream, a); }
#endif
}
```

```cpp
#ifndef EMU
#include <hip/hip_runtime.h>
#endif
#include <cstdio>
#include <cstdint>
#include <cmath>

#ifndef CFG_BATCH
#define CFG_BATCH 4
#define CFG_SEQ 4096
#define CFG_CTX 256
#define CFG_DEPTH 4
#define CFG_NEXP 32
#endif
#ifndef PROBE_DOUBLE
#define PROBE_DOUBLE 0
#endif
#ifndef PROBE_SPIN
#define PROBE_SPIN (-1)
#endif
#ifndef N_LAUNCH_MODE
#define N_LAUNCH_MODE 1
#endif

namespace mk {
constexpr int BATCH = CFG_BATCH, SEQ = CFG_SEQ, CTX = CFG_CTX, DEPTH = CFG_DEPTH, NEXP = CFG_NEXP;
constexpr int D = 1024, ML = BATCH * SEQ, MC = BATCH * CTX, M = ML + MC, NR = BATCH + 1;
constexpr int IN_COLS = 3280, NU = 3328;
constexpr int TOPK = 4, DFF = 1024;
constexpr int MAXROWS = M * TOPK + NEXP * 256;
constexpr int NTHREADS = 512, NWAVES = 8;
constexpr int U_GQ = 0, U_GK = 128, U_GV = 256, U_GOG = 512, U_GLF = 768, U_GLB = 784;
constexpr int U_RW = 800, U_RR = 800, U_RK = 1056, U_RV = 1312, U_RLWF = 1568, U_RLWB = 1600, U_RLA = 1632, U_RLGT = 1664;
constexpr int U_SZ = 1728, U_SXBC = 2240, U_SDT = 3264;
static_assert(SEQ % 256 == 0 && CTX % 256 == 0 && M % 256 == 0, "row tiles");

constexpr size_t al256(size_t x) { return (x + 255) & ~(size_t)255; }
constexpr size_t WS_CTL = 0, CTL_BYTES = 1u << 20;
constexpr size_t WS_MODS = WS_CTL + CTL_BYTES;
constexpr size_t WS_X = WS_MODS + al256((size_t)DEPTH * NR * 6144 * 4);
constexpr size_t WS_H = WS_X + al256((size_t)M * D * 4);
constexpr size_t WS_U = WS_H + al256((size_t)M * D * 2);
constexpr size_t WS_GG = WS_U + al256((size_t)M * NU * 4);
constexpr size_t WS_RW7 = WS_GG + al256((size_t)2 * M * 128 * 4);
constexpr size_t WS_SXBC = WS_RW7 + al256((size_t)7 * M * 256 * 4);
constexpr size_t WS_SDT = WS_SXBC + al256((size_t)M * 1024 * 4);
constexpr size_t WS_OG = WS_SDT + al256((size_t)M * 16 * 4);
constexpr size_t WS_OR = WS_OG + al256((size_t)2 * M * 256 * 4);
constexpr size_t WS_OS = WS_OR + al256((size_t)2 * M * 256 * 4);
constexpr size_t WS_MIX = WS_OS + al256((size_t)2 * M * 512 * 4);
constexpr size_t WS_TOPI = WS_MIX + al256((size_t)M * D * 2);
constexpr size_t WS_TOPP = WS_TOPI + al256((size_t)M * 4 * 4);
constexpr size_t WS_POS = WS_TOPP + al256((size_t)M * 4 * 4);
constexpr size_t WS_ROWIDX = WS_POS + al256((size_t)M * 4 * 4);
constexpr size_t WS_ROWGATE = WS_ROWIDX + al256((size_t)MAXROWS * 4);
constexpr size_t WS_ACT = WS_ROWGATE + al256((size_t)MAXROWS * 4);
constexpr size_t WS_Y = WS_ACT + al256((size_t)MAXROWS * DFF * 2);
constexpr size_t WS_WIN = WS_Y + al256((size_t)MAXROWS * D * 2);
constexpr size_t WS_WOUT = WS_WIN + al256((size_t)DEPTH * NU * D * 2);
constexpr size_t WS_WGU = WS_WOUT + al256((size_t)DEPTH * D * D * 2);
constexpr size_t WS_WD = WS_WGU + al256((size_t)DEPTH * NEXP * 2048 * D * 2);
constexpr int CTXC = CTX / 64, LATC = SEQ / 64, NRC = CTXC + LATC;
constexpr size_t WS_SZ = WS_WD + al256((size_t)DEPTH * NEXP * D * DFF * 2);
constexpr size_t WS_SDEC = WS_SZ + al256((size_t)BATCH * 16 * NRC * 64 * 128 * 2);
constexpr size_t WS_SST = WS_SDEC + al256((size_t)BATCH * 16 * NRC * 4);
constexpr int RKT = 16, NCK = (CTX + SEQ) / RKT;
constexpr int RK_PA = 0, RK_RA = 8192, RK_QA = 10240, RK_VB = 11264, RK_ZC = 15360, RK_BYTES = 23552;
constexpr size_t WS_RK = WS_SST + al256((size_t)BATCH * 16 * NRC * 64 * 128 * 2);
constexpr int GC_CTX = CTX / 32, GC_LAT = SEQ / 32, GNC = GC_CTX + GC_LAT;
constexpr size_t WS_GZ = WS_RK + al256((size_t)BATCH * 8 * NCK * RK_BYTES);
constexpr size_t WS_GDEC = WS_GZ + al256((size_t)BATCH * 8 * GNC * 2048 * 4);
constexpr size_t WS_GST = WS_GDEC + al256((size_t)BATCH * 8 * GNC * 32 * 4);
constexpr size_t WS_END = WS_GST + al256((size_t)BATCH * 8 * GNC * 2048 * 2);
constexpr int CW_BAR = 4096;
constexpr int CW_CNT = 16384;
constexpr int CW_CUR = 16384 + 64 * 8;
constexpr int LDS_STAGE = 131072;
constexpr int LDS_TILE_E = LDS_STAGE;
constexpr int LDS_MISC = LDS_STAGE + 2048;
constexpr int LDS_PTRS = LDS_MISC + 2048;
constexpr int LDS_BYTES = 147456;

#ifdef EMU
#define LAS
#define ASM_VM0() ((void)0)
#define ASM_LGKM0() ((void)0)
#define ASM_MEMFENCE() ((void)0)
#define WAIT_V(n) ((void)0)
#define WAIT_L(n) ((void)0)
#define WAVE_LDS_FENCE() emu_wave_sync()
#define LAUNDER_V(x) ((void)0)
#define LDS_BARRIER() emu_block_sync()
#else
#define LAS __attribute__((address_space(3)))
#define ASM_VM0() asm volatile("s_waitcnt vmcnt(0)" ::: "memory")
#define ASM_LGKM0() asm volatile("s_waitcnt lgkmcnt(0)" ::: "memory")
#define ASM_MEMFENCE() asm volatile("" ::: "memory")
#define WAIT_V(n) asm volatile("s_waitcnt vmcnt(" #n ")" ::: "memory")
#define WAIT_L(n) asm volatile("s_waitcnt lgkmcnt(" #n ")" ::: "memory")
#define LDS_BARRIER() do { asm volatile("s_waitcnt lgkmcnt(0)" ::: "memory"); __builtin_amdgcn_s_barrier(); asm volatile("" ::: "memory"); } while (0)
#define LAUNDER_V(x) asm volatile("" : "+v"(x))
#define WAVE_LDS_FENCE() do { asm volatile("s_waitcnt lgkmcnt(0)" ::: "memory"); } while (0)
#endif

typedef unsigned short bf16_t;
typedef short bf16x8 __attribute__((ext_vector_type(8)));
typedef float f32x4 __attribute__((ext_vector_type(4)));
typedef float f32x2 __attribute__((ext_vector_type(2)));
typedef unsigned u32x4 __attribute__((ext_vector_type(4)));
typedef unsigned u32x2 __attribute__((ext_vector_type(2)));

#ifdef EMU
__device__ __forceinline__ unsigned f2bf(float f) { unsigned u = __float_as_uint(f); return (u + 0x7fffu + ((u >> 16) & 1u)) >> 16; }
__device__ __forceinline__ unsigned pk2(float lo, float hi) { return f2bf(lo) | (f2bf(hi) << 16); }
#else
typedef __bf16 hw_bf16x2 __attribute__((ext_vector_type(2)));
__device__ __forceinline__ unsigned pk2(float lo, float hi) { const f32x2 v = {lo, hi}; return __builtin_bit_cast(unsigned, __builtin_convertvector(v, hw_bf16x2)); }
__device__ __forceinline__ unsigned f2bf(float f) { return pk2(f, f) & 0xffffu; }
#endif
typedef int i32x4 __attribute__((ext_vector_type(4)));
typedef int i32x8 __attribute__((ext_vector_type(8)));
#ifdef EMU
__device__ __forceinline__ unsigned f2e4m3(float f) {
    const unsigned sgn = (__float_as_uint(f) >> 24) & 0x80u; float a = fabsf(f); if (!(a < 448.f)) a = 448.f;
    if (a < 0.015625f) { const int q = (int)nearbyintf(a * 512.f); return sgn | (unsigned)q; }
    int e; const float m = frexpf(a, &e); int q = (int)nearbyintf(m * 16.f); int ee = e - 1;
    if (q == 16) { q = 8; ++ee; }
    return sgn | (unsigned)(((ee + 7) << 3) | (q - 8));
}
__device__ __forceinline__ unsigned pk4_fp8(float a, float b, float c, float d) { return f2e4m3(a) | (f2e4m3(b) << 8) | (f2e4m3(c) << 16) | (f2e4m3(d) << 24); }
#else
__device__ __forceinline__ unsigned pk4_fp8(float a, float b, float c, float d) {
    a = __builtin_amdgcn_fmed3f(a, -448.f, 448.f); b = __builtin_amdgcn_fmed3f(b, -448.f, 448.f); c = __builtin_amdgcn_fmed3f(c, -448.f, 448.f); d = __builtin_amdgcn_fmed3f(d, -448.f, 448.f);
    int w = __builtin_amdgcn_cvt_pk_fp8_f32(a, b, 0, false); w = __builtin_amdgcn_cvt_pk_fp8_f32(c, d, w, true); return (unsigned)w;
}
#endif
__device__ __forceinline__ float bf_lo(unsigned w) { return __uint_as_float(w << 16); }
__device__ __forceinline__ float bf_hi(unsigned w) { return __uint_as_float(w & 0xffff0000u); }
__device__ __forceinline__ float ldbf(const bf16_t* p) { return __uint_as_float(((unsigned)*p) << 16); }
__device__ __forceinline__ f32x4 ldbf4(const bf16_t* p) { const u32x2 w = *(const u32x2*)p; return (f32x4){bf_lo(w.x), bf_hi(w.x), bf_lo(w.y), bf_hi(w.y)}; }
__device__ __forceinline__ void stbf(bf16_t* p, float v) { *p = (bf16_t)f2bf(v); }
__device__ __forceinline__ float wave_sum(float v) {
#pragma unroll
    for (int o = 1; o < 64; o <<= 1) v += __shfl_xor(v, o);
    return v;
}
__device__ __forceinline__ float sum8(float v) { v += __shfl_xor(v, 1); v += __shfl_xor(v, 2); v += __shfl_xor(v, 4); return v; }
__device__ __forceinline__ float fexp(float x) { return __builtin_amdgcn_exp2f(x * 1.4426950408889634f); }
__device__ __forceinline__ float frcp(float x) { return __builtin_amdgcn_rcpf(x); }
__device__ __forceinline__ float frsq(float x) { return __builtin_amdgcn_rsqf(x); }
__device__ __forceinline__ float flog(float x) { return __builtin_amdgcn_logf(x) * 0.6931471805599453f; }
__device__ __forceinline__ float sigmoidf_(float x) { return frcp(1.0f + fexp(-x)); }
__device__ __forceinline__ float siluf_(float x) { return x * frcp(1.0f + fexp(-x)); }
__device__ __forceinline__ float ftanh(float x) { return 1.0f - 2.0f * frcp(fexp(2.0f * x) + 1.0f); }
__device__ __forceinline__ float softplusf_(float x) { return fmaxf(x, 0.f) + flog(1.0f + fexp(-fabsf(x))); }
__device__ __forceinline__ float logsigmoidf_(float x) { return -softplusf_(-x); }

#define XB_TMO      128
#define XB_XCNT(j)  (256  + 64 * (j))
#define XB_XSUB(j)  (1280 + 64 * (j))
#define XB_XGEN(j)  (2304 + 64 * (j))
#define XB_TOP      3328
#define XB_TOPGEN   3392
#define XCD_BAR_WORDS 3456
#ifdef EMU
#define XB_SPIN_CAP (0xffffffffu)
#else
#define XB_SPIN_CAP (1u << 22)
#endif
__device__ __forceinline__ unsigned xb_ld(unsigned* p)              { return __hip_atomic_load(p, __ATOMIC_RELAXED, __HIP_MEMORY_SCOPE_AGENT); }
__device__ __forceinline__ unsigned xb_add(unsigned* p, unsigned v) { return __hip_atomic_fetch_add(p, v, __ATOMIC_RELAXED, __HIP_MEMORY_SCOPE_AGENT); }
__device__ __forceinline__ unsigned xb_xcc_id() { return (unsigned)__builtin_amdgcn_s_getreg((3 << 11) | 20) & 0xFu; }
#define XB_SPIN(cond, bar) do { unsigned _sp = 0; while (cond) { __builtin_amdgcn_s_sleep(1); \
    if ((++_sp & 255u) == 0u) { if (xb_ld(&(bar)[XB_TMO])) break; if (_sp > XB_SPIN_CAP) { atomicAdd(&(bar)[XB_TMO], 1u); break; } } } } while (0)
struct XcdBarrier { unsigned* bar; unsigned x; volatile LAS unsigned* st; };
__device__ __forceinline__ XcdBarrier xcd_barrier_post(unsigned* bar, volatile LAS unsigned* st) {
    XcdBarrier b; b.bar = bar; b.x = xb_xcc_id(); b.st = st;
    if (threadIdx.x == 0) (void)xb_add(&bar[XB_XCNT(b.x)], 1u);
    return b;
}
__device__ __forceinline__ void xcd_barrier_complete(unsigned* bar, unsigned x, unsigned& nloc, unsigned& nx) {
    const unsigned G = gridDim.x * gridDim.y * gridDim.z;
    unsigned sum, cnt, mine, sp = 0u;
    for (;;) {
        sum = 0u; cnt = 0u; mine = 0u;
#pragma unroll
        for (unsigned j = 0; j < 16; ++j) { const unsigned c = xb_ld(&bar[XB_XCNT(j)]); sum += c; cnt += (c > 0u) ? 1u : 0u; mine = (j == x) ? c : mine; }
        if (sum == G) break;
        __builtin_amdgcn_s_sleep(1);
        if ((++sp & 255u) == 0u) { if (xb_ld(&bar[XB_TMO])) break; if (sp > XB_SPIN_CAP) { atomicAdd(&bar[XB_TMO], 1u); break; } }
    }
    nloc = mine > 0u ? mine : 1u; nx = cnt > 0u ? cnt : 1u;
}
__device__ __forceinline__ void xcd_barrier(const XcdBarrier& b) {
    ASM_VM0();
    __syncthreads();
    if (threadIdx.x == 0) {
        unsigned* bar = b.bar;
        __builtin_amdgcn_s_waitcnt(0);
        unsigned nloc = b.st[0], nx = b.st[1];
        if (nloc == 0u) { xcd_barrier_complete(bar, b.x, nloc, nx); b.st[0] = nloc; b.st[1] = nx; }
        const unsigned old = xb_add(&bar[XB_XSUB(b.x)], 1u);
        const unsigned gen = old / nloc;
        if (old + 1u == (gen + 1u) * nloc) {
            __builtin_amdgcn_fence(__ATOMIC_RELEASE, "agent");
            ASM_VM0();
            const unsigned og = xb_add(&bar[XB_TOP], 1u);
            const unsigned tg = og / nx;
            if (og + 1u == (tg + 1u) * nx) xb_add(&bar[XB_TOPGEN], 1u);
            else XB_SPIN(xb_ld(&bar[XB_TOPGEN]) == tg, bar);
            __builtin_amdgcn_fence(__ATOMIC_ACQUIRE, "agent");
            xb_add(&bar[XB_XGEN(b.x)], 1u);
            ASM_VM0();
        } else {
            XB_SPIN(xb_ld(&bar[XB_XGEN(b.x)]) == gen, bar);
            __builtin_amdgcn_fence(__ATOMIC_ACQUIRE, "agent");
            ASM_VM0();
        }
    }
    __syncthreads();
}

namespace pg8 {
constexpr int BM = 256, BK = 64, HALF = 128, HTB = HALF * BK * 2, STAGE_BYTES = 8 * HTB, NXCD = 8, WGM = 8;
__host__ __device__ __forceinline__ int lds_byte(int r, int c) { const int st = (r >> 4) * 2 + (c >> 5), rr = r & 15, cc = c & 31, ob = rr * 64 + cc * 2; return st * 1024 + (ob ^ (((ob >> 9) & 1) << 5)); }
__host__ __device__ __forceinline__ void stage_rc(int b, int& R, int& C) { const int st = b / 1024, sb = b % 1024, swz = sb ^ (((sb >> 9) & 1) << 5); R = (st >> 1) * 16 + swz / 64; C = (st & 1) * 32 + (swz % 64) / 2; }
__host__ __device__ __forceinline__ int perm32(int rho) { const int n = rho >> 4, i = rho & 15; return 8 * (i >> 2) + 4 * n + (i & 3); }
struct Unit { int pm, pn, pb; };
struct Gemm { const bf16_t* A; const bf16_t* Bt; int K; const int* rowidx; };
struct Order {
    int nM, nN, nwg, G, c;
    __device__ __forceinline__ void init(int nM_, int nN_, int G_, int c_) { nM = nM_; nN = nN_; nwg = nM * nN; G = G_; c = c_; }
    __device__ __forceinline__ bool tile(int i, int& pm, int& pn) const {
        const long L = (long)i * G + c; if (L >= nwg) return false;
        int wgid = (int)L; { const int q = nwg / NXCD, r = nwg % NXCD, xcd = wgid % NXCD, off = wgid / NXCD; wgid = (xcd < r ? xcd * (q + 1) : r * (q + 1) + (xcd - r) * q) + off; }
        const int nig = WGM * nN, gid = wgid / nig, fm = gid * WGM, gsz = (nM - fm) < WGM ? (nM - fm) : WGM;
        pm = fm + ((wgid % nig) % gsz); pn = (wgid % nig) / gsz; return true;
    }
};
struct DenseSched { Order o; __device__ __forceinline__ bool next(int i, Unit& u) const { if (!o.tile(i, u.pm, u.pn)) return false; u.pb = u.pn; return true; } };
struct MoeSched { Order o; const LAS int* tile_e; int nct;
    __device__ __forceinline__ bool next(int i, Unit& u) const { if (!o.tile(i, u.pm, u.pn)) return false; u.pb = tile_e[u.pm] * nct + u.pn; return true; } };

__device__ __forceinline__ unsigned cvt_pk_bf16(float lo, float hi) {
#ifdef EMU
    return pk2(lo, hi);
#else
    return pk2(lo, hi);
#endif
}
struct EpiF32 {
    static constexpr bool PERM = false;
    float* C; int ldc;
    __device__ __forceinline__ void operator()(const f32x4 (&acc)[2][2][4][2], const Unit& u, int wr, int wc, int fr, int fq) const {
        const int row0 = u.pm * BM + wr * 64 + fr, col0 = u.pn * BM + wc * 32 + 4 * fq;
#pragma unroll
        for (int ai = 0; ai < 2; ++ai)
#pragma unroll
            for (int m = 0; m < 4; ++m) { float* rowp = C + (size_t)(row0 + ai * HALF + m * 16) * ldc + col0;
#pragma unroll
                for (int bj = 0; bj < 2; ++bj)
#pragma unroll
                    for (int n = 0; n < 2; ++n) *(f32x4*)(rowp + bj * HALF + n * 16) = acc[ai][bj][m][n]; }
    }
};
struct EpiBf16 {
    static constexpr bool PERM = true;
    bf16_t* C; int ldc;
    __device__ __forceinline__ void operator()(const f32x4 (&acc)[2][2][4][2], const Unit& u, int wr, int wc, int fr, int fq) const {
        const int row0 = u.pm * BM + wr * 64 + fr, col0 = u.pn * BM + wc * 32 + 8 * fq;
#pragma unroll
        for (int ai = 0; ai < 2; ++ai)
#pragma unroll
            for (int m = 0; m < 4; ++m) { bf16_t* rowp = C + (size_t)(row0 + ai * HALF + m * 16) * ldc + col0;
#pragma unroll
                for (int bj = 0; bj < 2; ++bj) { const f32x4 v0 = acc[ai][bj][m][0], v1 = acc[ai][bj][m][1];
                    u32x4 w; w.x = cvt_pk_bf16(v0[0], v0[1]); w.y = cvt_pk_bf16(v0[2], v0[3]); w.z = cvt_pk_bf16(v1[0], v1[1]); w.w = cvt_pk_bf16(v1[2], v1[3]);
                    *(u32x4*)(rowp + bj * HALF) = w; } }
    }
};
struct EpiResid {
    static constexpr bool PERM = true;
    bf16_t* X; const float* mods;
    __device__ __forceinline__ void operator()(const f32x4 (&acc)[2][2][4][2], const Unit& u, int wr, int wc, int fr, int fq) const {
        const int row0 = u.pm * BM + wr * 64 + fr, col0 = u.pn * BM + wc * 32 + 8 * fq;
        const int rbase = u.pm * BM; const int mrow = rbase < ML ? rbase / SEQ : BATCH;
        const float* g = mods + (size_t)mrow * 6144 + 2 * 1024 + col0;
        f32x4 gv[2][2];
#pragma unroll
        for (int bj = 0; bj < 2; ++bj)
#pragma unroll
            for (int n = 0; n < 2; ++n) gv[bj][n] = *(const f32x4*)(g + bj * HALF + 4 * n);
#pragma unroll
        for (int ai = 0; ai < 2; ++ai)
#pragma unroll
            for (int m = 0; m < 4; ++m) { bf16_t* rowp = X + (size_t)(row0 + ai * HALF + m * 16) * D + col0;
#pragma unroll
                for (int bj = 0; bj < 2; ++bj) { u32x4* p = (u32x4*)(rowp + bj * HALF); const u32x4 xo = *p;
                    const f32x4 v0 = (f32x4){bf_lo(xo.x), bf_hi(xo.x), bf_lo(xo.y), bf_hi(xo.y)} + gv[bj][0] * acc[ai][bj][m][0];
                    const f32x4 v1 = (f32x4){bf_lo(xo.z), bf_hi(xo.z), bf_lo(xo.w), bf_hi(xo.w)} + gv[bj][1] * acc[ai][bj][m][1];
                    u32x4 w; w.x = cvt_pk_bf16(v0[0], v0[1]); w.y = cvt_pk_bf16(v0[2], v0[3]); w.z = cvt_pk_bf16(v1[0], v1[1]); w.w = cvt_pk_bf16(v1[2], v1[3]);
                    *p = w; } }
    }
};
constexpr float F8_WSCALE = 64.0f, F8_ASCALE = 4.0f;
struct EpiSwiglu {
    static constexpr bool PERM = true;
    unsigned char* ACT; const float* bgu;
    __device__ __forceinline__ void operator()(const f32x4 (&acc)[2][2][4][2], const Unit& u, int wr, int wc, int fr, int fq) const {
        const int e = u.pb >> 3;
        const int row0 = u.pm * BM + wr * 64 + fr, j0 = u.pn * 128 + wc * 32 + 8 * fq;
        const float* bg = bgu + (size_t)e * 2048 + j0;
        f32x4 bgl[2], bln[2];
#pragma unroll
        for (int n = 0; n < 2; ++n) { bgl[n] = *(const f32x4*)(bg + 4 * n); bln[n] = *(const f32x4*)(bg + 1024 + 4 * n); }
#pragma unroll
        for (int ai = 0; ai < 2; ++ai)
#pragma unroll
            for (int m = 0; m < 4; ++m) { unsigned char* rowp = ACT + (size_t)(row0 + ai * HALF + m * 16) * DFF + j0;
                float o[8];
#pragma unroll
                for (int n = 0; n < 2; ++n)
#pragma unroll
                    for (int j = 0; j < 4; ++j) { float gl = acc[ai][0][m][n][j] * (1.0f / F8_WSCALE) + bgl[n][j], ln = acc[ai][1][m][n][j] * (1.0f / F8_WSCALE) + bln[n][j];
                        gl = fminf(gl, 7.0f); ln = fminf(fmaxf(ln, -7.0f), 7.0f);
                        o[n * 4 + j] = gl * __builtin_amdgcn_rcpf(1.0f + __builtin_amdgcn_exp2f(-1.702f * 1.4426950408889634f * gl)) * (ln * F8_ASCALE + F8_ASCALE); }
                u32x2 w; w.x = pk4_fp8(o[0], o[1], o[2], o[3]); w.y = pk4_fp8(o[4], o[5], o[6], o[7]);
                *(u32x2*)rowp = w; }
    }
};
struct EpiDown {
    static constexpr bool PERM = true;
    bf16_t* Y; const float* bd; const float* rowgate;
    __device__ __forceinline__ void operator()(const f32x4 (&acc)[2][2][4][2], const Unit& u, int wr, int wc, int fr, int fq) const {
        const int e = u.pb >> 2;
        const int row0 = u.pm * BM + wr * 64 + fr, col0 = u.pn * BM + wc * 32 + 8 * fq;
        const float* b = bd + (size_t)e * 1024 + col0;
        f32x4 bv[2][2];
#pragma unroll
        for (int bj = 0; bj < 2; ++bj)
#pragma unroll
            for (int n = 0; n < 2; ++n) bv[bj][n] = *(const f32x4*)(b + bj * HALF + 4 * n);
#pragma unroll
        for (int ai = 0; ai < 2; ++ai)
#pragma unroll
            for (int m = 0; m < 4; ++m) { const int row = row0 + ai * HALF + m * 16; const float gt = rowgate[row]; bf16_t* rowp = Y + (size_t)row * D + col0;
#pragma unroll
                for (int bj = 0; bj < 2; ++bj) { const f32x4 v0 = (acc[ai][bj][m][0] * (1.0f / (F8_WSCALE * F8_ASCALE)) + bv[bj][0]) * gt, v1 = (acc[ai][bj][m][1] * (1.0f / (F8_WSCALE * F8_ASCALE)) + bv[bj][1]) * gt;
                    u32x4 w; w.x = cvt_pk_bf16(v0[0], v0[1]); w.y = cvt_pk_bf16(v0[2], v0[3]); w.z = cvt_pk_bf16(v1[0], v1[1]); w.w = cvt_pk_bf16(v1[2], v1[3]);
                    *(u32x4*)(rowp + bj * HALF) = w; } }
    }
};

__device__ __forceinline__ f32x4 mma_f8(bf16x8 a0, bf16x8 a1, bf16x8 b0, bf16x8 b1, f32x4 c) {
#ifdef EMU
    return emu_mfma16_f8(a0, a1, b0, b1, c);
#else
    const i32x4 a0i = __builtin_bit_cast(i32x4, a0), a1i = __builtin_bit_cast(i32x4, a1), b0i = __builtin_bit_cast(i32x4, b0), b1i = __builtin_bit_cast(i32x4, b1);
    const i32x8 A = __builtin_shufflevector(a0i, a1i, 0, 1, 2, 3, 4, 5, 6, 7), B = __builtin_shufflevector(b0i, b1i, 0, 1, 2, 3, 4, 5, 6, 7);
    asm volatile("v_mfma_f32_16x16x128_f8f6f4 %0, %1, %2, %0" : "+v"(c) : "v"(A), "v"(B));
    return c;
#endif
}
template <class Epi, class Sched, bool GATHER, bool F8 = false>
__device__ __forceinline__ void gemm_phase(LAS unsigned char* lds, const int tid, const Gemm g, const Sched& S, const Epi& E) {
    const int wid = __builtin_amdgcn_readfirstlane(tid >> 6), lane = tid & 63, wr = wid >> 2, wc = wid & 3, fr = lane & 15, fq = lane >> 4;
    const int K = g.K, nt = K / BK;
    unsigned voffB[2]; int RA[2], CA[2];
#pragma unroll
    for (int i = 0; i < 2; ++i) { int R, C; stage_rc(tid * 16 + i * 8192, R, C); const int Rb = Epi::PERM ? ((R & ~31) + perm32(R & 31)) : R;
        RA[i] = R; CA[i] = C; voffB[i] = (unsigned)(Rb * K + C) * 2u; }
    const size_t kstep = (size_t)(BK * 2);
    const size_t hstep = (size_t)HALF * K * 2;
    const size_t tstep = 2 * hstep;
    const unsigned ldsw = (unsigned)wid * 1024u;
    const int aoff = lds_byte(wr * 64 + fr, fq * 8), boff = lds_byte(wc * 32 + fr, fq * 8);
#define PG8_SA(b, h) (((b) * 2 + (h)) * HTB)
#define PG8_SB(b, h) ((4 + (b) * 2 + (h)) * HTB)
#define PG8_STAGE(bufoff, gbase, voff) do { _Pragma("unroll") for (int _i = 0; _i < 2; ++_i) \
        __builtin_amdgcn_global_load_lds((const unsigned*)((const char*)(gbase) + (voff)[_i]), (LAS unsigned*)(lds + (bufoff) + ldsw + _i * 8192), 16, 0, 0); } while (0)
#define PG8_LDA(dst, b, h) do { _Pragma("unroll") for (int m = 0; m < 4; ++m) _Pragma("unroll") for (int k = 0; k < 2; ++k) dst[m][k] = *(const LAS bf16x8*)(lds + PG8_SA(b, h) + aoff + m * 2048 + k * 1024); } while (0)
#define PG8_LDB(dst, b, h) do { _Pragma("unroll") for (int n = 0; n < 2; ++n) _Pragma("unroll") for (int k = 0; k < 2; ++k) dst[n][k] = *(const LAS bf16x8*)(lds + PG8_SB(b, h) + boff + n * 2048 + k * 1024); } while (0)
#define PG8_MMA(ai, bj, At, Bt) do { __builtin_amdgcn_s_setprio(1); _Pragma("unroll") for (int m = 0; m < 4; ++m) _Pragma("unroll") for (int n = 0; n < 2; ++n) { \
        if constexpr (F8) acc[ai][bj][m][n] = mma_f8(Bt[n][0], Bt[n][1], At[m][0], At[m][1], acc[ai][bj][m][n]); \
        else { _Pragma("unroll") for (int k = 0; k < 2; ++k) acc[ai][bj][m][n] = __builtin_amdgcn_mfma_f32_16x16x32_bf16(Bt[n][k], At[m][k], acc[ai][bj][m][n], 0, 0, 0); } } __builtin_amdgcn_s_setprio(0); } while (0)
#define PG8_BAR __builtin_amdgcn_s_barrier()
#define PG8_SCHED __builtin_amdgcn_sched_barrier(0)
#define PG8_AOFF(dst, unit) do { _Pragma("unroll") for (int _h = 0; _h < 2; ++_h) _Pragma("unroll") for (int _i = 0; _i < 2; ++_i) { \
        const int _r = (unit).pm * BM + _h * HALF + RA[_i]; const int _src = GATHER ? g.rowidx[_r] : _r; dst[_h][_i] = (unsigned)(_src * K + CA[_i]) * 2u; } } while (0)
    Unit cur, nxt; int ui = 0;
    if (!S.next(0, cur)) return;
    f32x4 acc[2][2][4][2];
#pragma unroll
    for (int a = 0; a < 2; ++a)
#pragma unroll
        for (int b = 0; b < 2; ++b)
#pragma unroll
            for (int m = 0; m < 4; ++m)
#pragma unroll
                for (int n = 0; n < 2; ++n) acc[a][b][m][n] = (f32x4){0.f, 0.f, 0.f, 0.f};
    bf16x8 At[4][2], B0[2][2], B1[2][2];
    unsigned cvA[2][2], nvA[2][2];
    PG8_AOFF(cvA, cur);
    const char* const gA = (const char*)g.A;
    const char* cB = (const char*)g.Bt + (size_t)cur.pb * tstep;
    PG8_STAGE(PG8_SB(0, 0), cB, voffB); PG8_STAGE(PG8_SA(0, 0), gA, cvA[0]); PG8_STAGE(PG8_SB(0, 1), cB + hstep, voffB); PG8_STAGE(PG8_SA(0, 1), gA, cvA[1]);
    if (wr == 1) PG8_BAR;
    WAIT_V(4); PG8_BAR;
    PG8_STAGE(PG8_SB(1, 0), cB + kstep, voffB); PG8_STAGE(PG8_SA(1, 0), gA + kstep, cvA[0]); PG8_STAGE(PG8_SB(1, 1), cB + hstep + kstep, voffB);
    WAIT_V(6); PG8_BAR;
    for (;;) {
        const bool has_next = S.next(ui + 1, nxt);
        if (has_next) { PG8_AOFF(nvA, nxt); } else {
#pragma unroll
            for (int h = 0; h < 2; ++h)
#pragma unroll
                for (int i = 0; i < 2; ++i) nvA[h][i] = cvA[h][i]; }
        const char* nB = has_next ? (const char*)g.Bt + (size_t)nxt.pb * tstep : cB;
        for (int t = 0; t < nt; t += 2) {
            const bool last = (t == nt - 2);
            const char* a1 = gA + (size_t)(t + 1) * kstep;
            const char* a2 = last ? gA : gA + (size_t)(t + 2) * kstep; const char* b2 = last ? nB : cB + (size_t)(t + 2) * kstep;
            const char* a3 = a2 + kstep; const char* b3 = b2 + kstep;
            unsigned xA0[2], xA1[2];
#pragma unroll
            for (int i = 0; i < 2; ++i) { xA0[i] = last ? nvA[0][i] : cvA[0][i]; xA1[i] = last ? nvA[1][i] : cvA[1][i]; }
            PG8_LDB(B0, 0, 0); PG8_SCHED; PG8_LDA(At, 0, 0); PG8_STAGE(PG8_SA(1, 1), a1, cvA[1]);
            WAIT_L(8); PG8_BAR; WAIT_L(0); PG8_MMA(0, 0, At, B0); PG8_BAR; PG8_SCHED;
            PG8_LDB(B1, 0, 1); PG8_STAGE(PG8_SB(0, 0), b2, voffB);
            PG8_BAR; WAIT_L(0); PG8_MMA(0, 1, At, B1); PG8_BAR;
            PG8_LDA(At, 0, 1); PG8_STAGE(PG8_SA(0, 0), a2, xA0);
            PG8_BAR; WAIT_L(0); PG8_MMA(1, 0, At, B0); PG8_BAR; PG8_SCHED;
            PG8_STAGE(PG8_SB(0, 1), b2 + hstep, voffB);
            WAIT_V(6); PG8_BAR; PG8_MMA(1, 1, At, B1); PG8_BAR;
            PG8_LDB(B0, 1, 0); PG8_SCHED; PG8_LDA(At, 1, 0); PG8_STAGE(PG8_SA(0, 1), a2, xA1);
            WAIT_L(8); PG8_BAR; WAIT_L(0); PG8_MMA(0, 0, At, B0); PG8_BAR; PG8_SCHED;
            PG8_LDB(B1, 1, 1); PG8_STAGE(PG8_SB(1, 0), b3, voffB);
            PG8_BAR; WAIT_L(0); PG8_MMA(0, 1, At, B1); PG8_BAR;
            PG8_LDA(At, 1, 1); PG8_STAGE(PG8_SA(1, 0), a3, xA0);
            PG8_BAR; WAIT_L(0); PG8_MMA(1, 0, At, B0); PG8_BAR; PG8_SCHED;
            PG8_STAGE(PG8_SB(1, 1), b3 + hstep, voffB);
            WAIT_V(6); PG8_BAR; PG8_MMA(1, 1, At, B1); PG8_BAR;
        }
#ifndef EMU
        if constexpr (F8) asm volatile("s_nop 15\n\ts_nop 15" ::: "memory");
#endif
        E(acc, cur, wr, wc, fr, fq);
        if (!has_next) break;
#pragma unroll
        for (int a = 0; a < 2; ++a)
#pragma unroll
            for (int b = 0; b < 2; ++b)
#pragma unroll
                for (int m = 0; m < 4; ++m)
#pragma unroll
                    for (int n = 0; n < 2; ++n) acc[a][b][m][n] = (f32x4){0.f, 0.f, 0.f, 0.f};
        cur = nxt; cB = nB; ++ui;
#pragma unroll
        for (int h = 0; h < 2; ++h)
#pragma unroll
            for (int i = 0; i < 2; ++i) cvA[h][i] = nvA[h][i];
    }
    WAIT_V(0);
    if (wr == 0) PG8_BAR;
    PG8_BAR;
#undef PG8_SA
#undef PG8_SB
#undef PG8_STAGE
#undef PG8_LDA
#undef PG8_LDB
#undef PG8_MMA
#undef PG8_BAR
#undef PG8_SCHED
#undef PG8_AOFF
}
}

struct Args { const float* in[37]; float* out; unsigned char* ws; int ph_lo, ph_hi; };
enum { I_X = 0, I_C, I_CTX, I_CCTX, I_WADA, I_BADA, I_N1G, I_N2G, I_WIN, I_GGW, I_GGB, I_GNG, I_RMU, I_RW0, I_RW2, I_RA0, I_RA2, I_RG2, I_RKK, I_RKA, I_RRK,
       I_RLG, I_RLB, I_SCW, I_SCB, I_SDTB, I_SALOG, I_SD, I_SNG, I_WOUT, I_ROUTW, I_ROUTB, I_WGU, I_BGU, I_WDN, I_BDN, I_FNG };

struct Tc { LAS unsigned char* lds; int tid, lane, wave, G, bid; };
__device__ __forceinline__ const float* inp(const Tc& t, int i) {
    const unsigned long long v = ((const LAS unsigned long long*)(t.lds + LDS_PTRS))[i];
    const unsigned lo = __builtin_amdgcn_readfirstlane((unsigned)v), hi = __builtin_amdgcn_readfirstlane((unsigned)(v >> 32));
    return (const float*)(((unsigned long long)hi << 32) | lo);
}

struct CvItem { const float* W; bf16_t* dst; int ldw, k0, n0, nv, K; };
__device__ __forceinline__ void cv_load(const CvItem& it, float (&ld)[32], int lane) {
    const int c = lane & 31; const float* wp = it.W + (size_t)(it.k0 + (lane >> 5)) * it.ldw + it.n0 + (c < it.nv ? c : 0);
#pragma unroll
    for (int i = 0; i < 32; ++i) ld[i] = wp[(size_t)(2 * i) * it.ldw];
}
__device__ __forceinline__ void cv_store(const CvItem& it, const float (&ld)[32], LAS float* scr, int lane) {
    { const int c = lane & 31;
#pragma unroll
      for (int i = 0; i < 32; ++i) scr[(2 * i + (lane >> 5)) * 33 + c] = (c < it.nv) ? ld[i] : 0.f; }
    WAVE_LDS_FENCE();
    const int c = lane & 7;
#pragma unroll
    for (int j = 0; j < 4; ++j) { const int n = (lane >> 3) + 8 * j; const LAS float* s = scr + (8 * c) * 33 + n;
        u32x4 o; o.x = pk2(s[0 * 33], s[1 * 33]); o.y = pk2(s[2 * 33], s[3 * 33]); o.z = pk2(s[4 * 33], s[5 * 33]); o.w = pk2(s[6 * 33], s[7 * 33]);
        *(u32x4*)(it.dst + (size_t)n * it.K + it.k0 + 8 * c) = o; }
    WAVE_LDS_FENCE();
}
__device__ __forceinline__ void cv_store8(const CvItem& it, const float (&ld)[32], LAS float* scr, int lane) {
    { const int c = lane & 31;
#pragma unroll
      for (int i = 0; i < 32; ++i) scr[(2 * i + (lane >> 5)) * 33 + c] = ld[i] * pg8::F8_WSCALE; }
    WAVE_LDS_FENCE();
    const int c = lane & 7; unsigned char* d8 = (unsigned char*)it.dst;
#pragma unroll
    for (int j = 0; j < 4; ++j) { const int n = (lane >> 3) + 8 * j; const LAS float* s = scr + (8 * c) * 33 + n;
        u32x2 o; o.x = pk4_fp8(s[0 * 33], s[1 * 33], s[2 * 33], s[3 * 33]); o.y = pk4_fp8(s[4 * 33], s[5 * 33], s[6 * 33], s[7 * 33]);
        *(u32x2*)(d8 + (size_t)n * it.K + it.k0 + 8 * c) = o; }
    WAVE_LDS_FENCE();
}
constexpr int CV_KB = D / 64, CV_I_IN = CV_KB * (NU / 32), CV_I_OUT = CV_KB * (D / 32), CV_I_GU = CV_KB * (2048 / 32), CV_I_DN = CV_KB * (D / 32);
constexpr int CV_MOE_ITEMS = NEXP * (CV_I_GU + CV_I_DN);
constexpr int CV_E_IN = CV_MOE_ITEMS / 6, CV_E_B = CV_MOE_ITEMS / 2;
__device__ __forceinline__ CvItem cv_moe_item(const Args& a, int l, int it) {
    unsigned char* WGU = a.ws + WS_WGU; unsigned char* WDN = a.ws + WS_WD;
    const int e = it / (CV_I_GU + CV_I_DN); int r = it % (CV_I_GU + CV_I_DN); CvItem ci;
    if (r < CV_I_GU) { const int kb = r / 64, nb = r % 64, n0 = nb * 32; const int half = n0 >> 10, rem = n0 & 1023, pn = rem >> 7, jj = rem & 127;
        ci.W = a.in[I_WGU] + ((size_t)l * NEXP + e) * D * 2048; ci.ldw = 2048; ci.k0 = kb * 64; ci.n0 = n0; ci.nv = 32; ci.dst = (bf16_t*)(WGU + (((size_t)l * NEXP + e) * 2048 + pn * 256 + half * 128 + jj) * D); ci.K = D; }
    else { r -= CV_I_GU; const int kb = r / (D / 32), nb = r % (D / 32);
        ci.W = a.in[I_WDN] + ((size_t)l * NEXP + e) * DFF * D; ci.ldw = D; ci.k0 = kb * 64; ci.n0 = nb * 32; ci.nv = 32; ci.dst = (bf16_t*)(WDN + (((size_t)l * NEXP + e) * D + nb * 32) * DFF); ci.K = DFF; }
    return ci;
}
__device__ __forceinline__ CvItem cv_dense_item(const Args& a, int it) {
    bf16_t* WIN = (bf16_t*)(a.ws + WS_WIN); bf16_t* WOUT = (bf16_t*)(a.ws + WS_WOUT);
    const int l = it / (CV_I_IN + CV_I_OUT); int r = it % (CV_I_IN + CV_I_OUT); CvItem ci;
    if (r < CV_I_IN) { const int kb = r / (NU / 32), nb = r % (NU / 32), n0 = nb * 32; int nv = IN_COLS - n0; nv = nv < 0 ? 0 : (nv > 32 ? 32 : nv);
        ci.W = a.in[I_WIN] + (size_t)l * D * IN_COLS; ci.ldw = IN_COLS; ci.k0 = kb * 64; ci.n0 = n0; ci.nv = nv; ci.dst = WIN + ((size_t)l * NU + n0) * D; ci.K = D; }
    else { r -= CV_I_IN; const int kb = r / (D / 32), nb = r % (D / 32);
        ci.W = a.in[I_WOUT] + (size_t)l * D * D; ci.ldw = D; ci.k0 = kb * 64; ci.n0 = nb * 32; ci.nv = 32; ci.dst = WOUT + ((size_t)l * D + nb * 32) * D; ci.K = D; }
    return ci;
}
__device__ __forceinline__ void convert_moe(const Args& a, const Tc& t, int l, int i0, int i1, int gw, int ngw) {
    LAS float* scr = (LAS float*)(t.lds + t.wave * 16384);
    float ld[32], ln[32];
    if (i0 + gw < i1) { const CvItem c0 = cv_moe_item(a, l, i0 + gw); cv_load(c0, ld, t.lane); }
    for (int it = i0 + gw; it < i1; it += ngw) {
        const CvItem cur = cv_moe_item(a, l, it);
        const bool more = it + ngw < i1;
        if (more) { const CvItem nx = cv_moe_item(a, l, it + ngw); cv_load(nx, ln, t.lane); }
        cv_store8(cur, ld, scr, t.lane);
        if (more) {
#pragma unroll
            for (int i = 0; i < 32; ++i) ld[i] = ln[i]; }
    }
}
__device__ __forceinline__ void convert_in_slack(const Args& a, const Tc& t, int l, int i0, int i1, int nunits) {
    const int rem = nunits % t.G;
    if (t.bid >= rem) convert_moe(a, t, l, i0, i1, (t.bid - rem) * NWAVES + t.wave, (t.G - rem) * NWAVES);
}
__device__ __forceinline__ void phase_pro0(const Args& a, const Tc& t) {
    LAS float* scr = (LAS float*)(t.lds + t.wave * 16384);
    const int gw = t.bid * NWAVES + t.wave, NGW = t.G * NWAVES;
    { float ld[32];
      for (int it = gw; it < DEPTH * (CV_I_IN + CV_I_OUT); it += NGW) { const CvItem ci = cv_dense_item(a, it); cv_load(ci, ld, t.lane); cv_store(ci, ld, scr, t.lane); } }
    __syncthreads();
    LAS float* sc = (LAS float*)t.lds;
    LAS float* red = (LAS float*)(t.lds + 32768);
    for (int i = t.tid; i < NR * D; i += NTHREADS) { const int r = i / D, k = i % D; const float v = r < BATCH ? a.in[I_C][r * D + k] : a.in[I_CCTX][k]; sc[i] = siluf_(v); }
    __syncthreads();
    float* MODS = (float*)(a.ws + WS_MODS);
    const int jl = t.tid & 127, kq = t.tid >> 7;
    for (int cb = t.bid; cb < DEPTH * 48; cb += t.G) {
        const int l = cb / 48, j = (cb % 48) * 128 + jl;
        const float* w = a.in[I_WADA] + (size_t)l * D * 6144 + j;
        float acc[NR];
#pragma unroll
        for (int r = 0; r < NR; ++r) acc[r] = 0.f;
        for (int k = kq * 256; k < kq * 256 + 256; ++k) { const float wv = w[(size_t)k * 6144];
#pragma unroll
            for (int r = 0; r < NR; ++r) acc[r] += sc[r * D + k] * wv; }
#pragma unroll
        for (int r = 0; r < NR; ++r) red[(kq * NR + r) * 128 + jl] = acc[r];
        __syncthreads();
        if (kq == 0) {
            const float bb = a.in[I_BADA][(size_t)l * 6144 + j];
#pragma unroll
            for (int r = 0; r < NR; ++r) MODS[((size_t)l * NR + r) * 6144 + j] = red[(0 * NR + r) * 128 + jl] + red[(1 * NR + r) * 128 + jl] + red[(2 * NR + r) * 128 + jl] + red[(3 * NR + r) * 128 + jl] + bb;
        }
        __syncthreads();
    }
}

__device__ __forceinline__ int mod_row(int row) { return row < ML ? row / SEQ : BATCH; }
template <bool F8 = false>
__device__ __forceinline__ void norm_mod_store(const f32x4 (&v)[4], const float* g, const float* shift, const float* scale, bf16_t* hrow, int lane, f32x4 (&hout)[4]) {
    float ss = 0.f;
#pragma unroll
    for (int j = 0; j < 4; ++j) ss += (v[j][0] * v[j][0] + v[j][1] * v[j][1]) + (v[j][2] * v[j][2] + v[j][3] * v[j][3]);
    const float rstd = frsq(wave_sum(ss) * (1.0f / D) + 1e-6f);
#pragma unroll
    for (int j = 0; j < 4; ++j) { const int c = 4 * lane + 256 * j;
        const f32x4 gg = *(const f32x4*)(g + c), sh = *(const f32x4*)(shift + c), sc = *(const f32x4*)(scale + c);
        const f32x4 h = (v[j] * rstd * gg) * (sc + 1.0f) + sh; hout[j] = h;
        if constexpr (F8) { *(unsigned*)((unsigned char*)hrow + c) = pk4_fp8(h[0], h[1], h[2], h[3]); }
        else { u32x2 w; w.x = pk2(h[0], h[1]); w.y = pk2(h[2], h[3]); *(u32x2*)(hrow + c) = w; } }
}
__device__ __forceinline__ void phase_pro1(const Args& a, const Tc& t) {
    const int gw = t.bid * NWAVES + t.wave, NGW = t.G * NWAVES;
    bf16_t* X = (bf16_t*)(a.ws + WS_X); bf16_t* H = (bf16_t*)(a.ws + WS_H); const float* MODS = (const float*)(a.ws + WS_MODS);
    for (int row = gw; row < M; row += NGW) {
        const float* src = row < ML ? a.in[I_X] + (size_t)row * D : a.in[I_CTX] + (size_t)(row - ML) * D;
        f32x4 v[4], h[4];
#pragma unroll
        for (int j = 0; j < 4; ++j) { v[j] = *(const f32x4*)(src + 4 * t.lane + 256 * j); u32x2 w; w.x = pk2(v[j][0], v[j][1]); w.y = pk2(v[j][2], v[j][3]); *(u32x2*)(X + (size_t)row * D + 4 * t.lane + 256 * j) = w; }
        const float* md = MODS + (size_t)mod_row(row) * 6144;
        norm_mod_store(v, a.in[I_N1G], md, md + 1024, H + (size_t)row * D, t.lane, h);
    }
}

__device__ __forceinline__ float ld_or0(const float* p, const float* safe, bool ok) { const float v = *(ok ? p : safe); return ok ? v : 0.f; }
__device__ __forceinline__ float ld_or0(const bf16_t* p, const bf16_t* safe, bool ok) { const float v = ldbf(ok ? p : safe); return ok ? v : 0.f; }
__device__ __forceinline__ void seg_bounds(int row, int& lo, int& hi) {
    if (row < ML) { lo = row & ~63; hi = lo + 64; } else { lo = ML + ((row - ML) / CTX) * CTX; hi = lo + CTX; }
}
__device__ __forceinline__ void phase_prep(const Args& a, const Tc& t, int l) {
    const bf16_t* U = (const bf16_t*)(a.ws + WS_U);
    float* GG = (float*)(a.ws + WS_GG); bf16_t* RW7 = (bf16_t*)(a.ws + WS_RW7); bf16_t* SXBC = (bf16_t*)(a.ws + WS_SXBC); float* SDT = (float*)(a.ws + WS_SDT);
    const float* mu = a.in[I_RMU] + (size_t)l * 2 * 928;
    const float* w0 = a.in[I_RW0] + (size_t)l * 2 * 256; const float* w2 = a.in[I_RW2] + (size_t)l * 2 * 32 * 256;
    const float* a0 = a.in[I_RA0] + (size_t)l * 256; const float* a2 = a.in[I_RA2] + (size_t)l * 32 * 256;
    const float* rkk = a.in[I_RKK] + (size_t)l * 256; const float* rka = a.in[I_RKA] + (size_t)l * 256;
    const float* ggw = a.in[I_GGW] + (size_t)l * 2 * 16 * 128; const float* ggb = a.in[I_GGB] + (size_t)l * 2 * 128;
    const float* cw = a.in[I_SCW] + (size_t)l * 4 * 1024; const float* cb = a.in[I_SCB] + (size_t)l * 1024;
    const float* dtb = a.in[I_SDTB] + (size_t)l * 16;
    LAS float* LOW = (LAS float*)t.lds;
    LAS float* A2S = LOW + 16 * 128; LAS float* W2S = A2S + 32 * 256; LAS float* GWS = W2S + 64 * 256;
    for (int e = t.tid; e < 32 * 256 / 4; e += NTHREADS) *(LAS f32x4*)(A2S + 4 * e) = *(const f32x4*)(a2 + 4 * e);
    for (int e = t.tid; e < 64 * 256 / 4; e += NTHREADS) *(LAS f32x4*)(W2S + 4 * e) = *(const f32x4*)(w2 + 4 * e);
    for (int e = t.tid; e < 32 * 128 / 4; e += NTHREADS) *(LAS f32x4*)(GWS + 4 * e) = *(const f32x4*)(ggw + 4 * e);
    LDS_BARRIER();
    for (int tile = t.bid; tile < M / 16; tile += t.G) {
        const int r0 = tile * 16; int slo, shi; seg_bounds(r0, slo, shi);
        {
            const int tt = t.tid >> 5, r = t.tid & 31, row = r0 + tt;
            const bf16_t* up = U + (size_t)row * NU; const bool hp = row - 1 >= slo, hn = row + 1 < shi;
#pragma unroll
            for (int q = 0; q < 3; ++q) { const int col = U_RLWF + q * 32 + r, mi = col - U_RW;
                const float u = ldbf(up + col), pv = ld_or0(up + col - NU, up + col, hp), nv = ld_or0(up + col + NU, up + col, hn);
                const float s = u + mu[mi] * (pv - u) + mu[928 + mi] * (nv - u);
                LOW[tt * 128 + q * 32 + r] = q < 2 ? ftanh(s) : s; }
            LOW[tt * 128 + 96 + r] = ldbf(up + U_GLF + r);
        }
        LDS_BARRIER();
        {
            const int c = t.tid & 255, tt0 = (t.tid >> 8) * 8;
            float lu[10][3];
#pragma unroll
            for (int jj = 0; jj < 10; ++jj) { const int row = r0 + tt0 + jj - 1; const bool ok = row >= slo && row < shi; const bf16_t* up = U + (size_t)(ok ? row : r0) * NU;
                const float x0 = ldbf(up + U_RR + c), x1 = ldbf(up + U_RK + c), x2 = ldbf(up + U_RV + c); lu[jj][0] = ok ? x0 : 0.f; lu[jj][1] = ok ? x1 : 0.f; lu[jj][2] = ok ? x2 : 0.f; }
            float aa[8], af[8], ab[8];
#pragma unroll
            for (int j = 0; j < 8; ++j) { aa[j] = a0[c]; af[j] = w0[c]; ab[j] = w0[256 + c]; }
#pragma unroll 2
            for (int r4 = 0; r4 < 8; ++r4) { float wa[4], wf[4], wb[4];
#pragma unroll
                for (int q = 0; q < 4; ++q) { wa[q] = A2S[(4 * r4 + q) * 256 + c]; wf[q] = W2S[(4 * r4 + q) * 256 + c]; wb[q] = W2S[(32 + 4 * r4 + q) * 256 + c]; }
#pragma unroll
                for (int j = 0; j < 8; ++j) { const LAS float* lw = LOW + (tt0 + j) * 128;
                    const f32x4 la = *(const LAS f32x4*)(lw + 64 + 4 * r4), lf = *(const LAS f32x4*)(lw + 4 * r4), lb = *(const LAS f32x4*)(lw + 32 + 4 * r4);
#pragma unroll
                    for (int q = 0; q < 4; ++q) { aa[j] += la[q] * wa[q]; af[j] += lf[q] * wf[q]; ab[j] += lb[q] * wb[q]; } } }
            const float m0r = mu[c], m1r = mu[928 + c], m0k = mu[256 + c], m1k = mu[928 + 256 + c], m0v = mu[512 + c], m1v = mu[928 + 512 + c];
            const float kkg = rkk[c], kag = rka[c];
#pragma unroll
            for (int j = 0; j < 8; ++j) { const int row = r0 + tt0 + j;
                float u, pv, nv;
                u = lu[j + 1][0]; pv = lu[j][0]; nv = lu[j + 2][0]; const float rs = u + m0r * (pv - u) + m1r * (nv - u);
                u = lu[j + 1][1]; pv = lu[j][1]; nv = lu[j + 2][1]; const float ks = u + m0k * (pv - u) + m1k * (nv - u);
                u = lu[j + 1][2]; pv = lu[j][2]; nv = lu[j + 2][2]; const float vs = u + m0v * (pv - u) + m1v * (nv - u);
                const float av = sigmoidf_(aa[j]);
                const float wfv = fexp(-0.606531f * sigmoidf_(af[j])), wbv = fexp(-0.606531f * sigmoidf_(ab[j]));
                const float kr = ks * kkg; const float ssq = wave_sum(kr * kr); const float kk = kr * (frsq(ssq + 1e-12f));
                const float kf = ks * (1.0f + (av - 1.0f) * kag);
                const size_t o = (size_t)row * 256 + c, P = (size_t)M * 256;
                stbf(RW7 + o, rs); stbf(RW7 + P + o, kf); stbf(RW7 + 2 * P + o, vs); stbf(RW7 + 3 * P + o, kk); stbf(RW7 + 4 * P + o, kk * av); stbf(RW7 + 5 * P + o, wfv); stbf(RW7 + 6 * P + o, wbv); }
        }
        {
            const int j = t.tid & 127, dq = t.tid >> 7, dir = dq & 1, tt0 = (dq >> 1) * 8;
            float acc[8];
#pragma unroll
            for (int q = 0; q < 8; ++q) acc[q] = ggb[dir * 128 + j];
#pragma unroll
            for (int r4 = 0; r4 < 4; ++r4) { float w[4];
#pragma unroll
                for (int q2 = 0; q2 < 4; ++q2) w[q2] = GWS[(dir * 16 + 4 * r4 + q2) * 128 + j];
#pragma unroll
                for (int q = 0; q < 8; ++q) { const f32x4 lv = *(const LAS f32x4*)(LOW + (tt0 + q) * 128 + 96 + dir * 16 + 4 * r4);
                    acc[q] += (lv[0] * w[0] + lv[1] * w[1]) + (lv[2] * w[2] + lv[3] * w[3]); } }
#pragma unroll
            for (int q = 0; q < 8; ++q) GG[((size_t)dir * M + r0 + tt0 + q) * 128 + j] = logsigmoidf_(acc[q]) * (1.0f / 16.0f);
        }
        {
#pragma unroll
            for (int cc = 0; cc < 2; ++cc) { const int col = t.tid + cc * 512; const bf16_t* up = U + U_SXBC + col;
                const float c0 = cw[col], c1 = cw[1024 + col], c2 = cw[2048 + col], c3 = cw[3072 + col], bb = cb[col];
                const bf16_t* uc = up + (size_t)r0 * NU;
                float lc_[19];
#pragma unroll
                for (int q = 0; q < 19; ++q) lc_[q] = ld_or0(uc + (ptrdiff_t)(q - 2) * NU, uc, (r0 + q - 2 >= slo) && (r0 + q - 2 < shi));
                float um2 = lc_[0], um1 = lc_[1], u0 = lc_[2];
#pragma unroll
                for (int q = 0; q < 16; ++q) { const int row = r0 + q; const float up1 = lc_[q + 3];
                    const float y = c0 * um2 + c1 * um1 + c2 * u0 + c3 * up1 + bb;
                    stbf(SXBC + (size_t)row * 1024 + col, siluf_(y)); um2 = um1; um1 = u0; u0 = up1; } }
        }
        if (t.tid < 256) { const int tt = t.tid >> 4, j = t.tid & 15, row = r0 + tt; SDT[(size_t)row * 16 + j] = softplusf_(ldbf(U + (size_t)row * NU + U_SDT + j) + dtb[j]); }
        LDS_BARRIER();
    }
}

__device__ __forceinline__ int chain_row(int b, int dir, int s) {
    if (s < CTX) return ML + b * CTX + (dir ? CTX - 1 - s : s);
    const int tt = s - CTX; return b * SEQ + (dir ? SEQ - 1 - tt : tt);
}

__device__ __forceinline__ f32x4 mma16(f32x4 acc, const LAS bf16_t* A, int lda, const LAS bf16_t* Bt, int ldb, int K, int lane) {
    const int r = lane & 15, kq = (lane >> 4) * 8;
    for (int k0 = 0; k0 < K; k0 += 32) {
        const bf16x8 av = *(const LAS bf16x8*)(A + r * lda + k0 + kq), bv = *(const LAS bf16x8*)(Bt + r * ldb + k0 + kq);
        acc = __builtin_amdgcn_mfma_f32_16x16x32_bf16(av, bv, acc, 0, 0, 0);
    }
    return acc;
}
__device__ __forceinline__ float wave_incl_scan(float v, int lane) {
#pragma unroll
    for (int o = 1; o < 64; o <<= 1) { const float u = __shfl_up(v, o); if (lane >= o) v += u; }
    return v;
}
__device__ __forceinline__ int rc_row0(int b, int c) { return c < CTXC ? ML + b * CTX + 64 * c : b * SEQ + 64 * (c - CTXC); }
__device__ __forceinline__ int rc_chain_pos(int c, int dir) { return dir == 0 ? c : (c < CTXC ? CTXC - 1 - c : CTXC + (LATC - 1 - (c - CTXC))); }

constexpr int SSD_UNITS = BATCH * 2 * NRC;
__device__ __forceinline__ void ssd_a1_unit(const Args& a, const Tc& t, int l, int u) {
    const bf16_t* SXBC = (const bf16_t*)(a.ws + WS_SXBC); const float* SDT = (const float*)(a.ws + WS_SDT);
    bf16_t* SZ = (bf16_t*)(a.ws + WS_SZ); float* SDEC = (float*)(a.ws + WS_SDEC);
    const int c = u % NRC, g = (u / NRC) & 1, b = u / (2 * NRC), row0 = rc_row0(b, c);
    LAS bf16_t* BT = (LAS bf16_t*)t.lds;
    LAS bf16_t* XT = BT + 128 * 72 + t.wave * 64 * 72;
    for (int e = t.tid; e < 64 * 32; e += NTHREADS) { const int rho = e >> 5, n4 = (e & 31) * 4;
        const f32x4 v = ldbf4(SXBC + (size_t)(row0 + rho) * 1024 + 512 + g * 128 + n4);
#pragma unroll
        for (int q = 0; q < 4; ++q) BT[(n4 + q) * 72 + rho] = (bf16_t)f2bf(v[q]); }
    const int hh = t.wave & 3, dir = t.wave >> 2, h = 4 * g + hh, chain = (b * 8 + h) * 2 + dir, cc = rc_chain_pos(c, dir);
    const float a_neg = -fexp(a.in[I_SALOG][(size_t)l * 16 + dir * 8 + h]);
    const float dtv = SDT[(size_t)(row0 + t.lane) * 16 + dir * 8 + h], av = dtv * a_neg;
    const float pre = wave_incl_scan(av, t.lane), tot = __shfl(pre, 63);
    const float wgt = dir == 0 ? fexp(tot - pre) : fexp(pre - av);
    const float sc = dtv * wgt;
#pragma unroll
    for (int p4 = 0; p4 < 16; ++p4) { const f32x4 x = ldbf4(SXBC + (size_t)(row0 + t.lane) * 1024 + h * 64 + p4 * 4);
#pragma unroll
        for (int q = 0; q < 4; ++q) XT[(p4 * 4 + q) * 72 + t.lane] = (bf16_t)f2bf(x[q] * sc); }
    if (t.lane == 0) SDEC[(size_t)chain * NRC + cc] = fexp(tot);
    LDS_BARRIER();
    bf16_t* zb = SZ + ((size_t)chain * NRC + cc) * 64 * 128;
#pragma unroll 1
    for (int pt = 0; pt < 4; ++pt)
#pragma unroll 2
        for (int nt = 0; nt < 8; ++nt) { f32x4 acc = {0.f, 0.f, 0.f, 0.f};
            acc = mma16(acc, XT + pt * 16 * 72, 72, BT + nt * 16 * 72, 72, 64, t.lane);
#pragma unroll
            for (int r = 0; r < 4; ++r) zb[(size_t)(16 * pt + 4 * (t.lane >> 4) + r) * 128 + 16 * nt + (t.lane & 15)] = (bf16_t)f2bf(acc[r]); }
    LDS_BARRIER();
}
constexpr int CAR_DEP = 4;
__device__ __forceinline__ void ssd_b_carry(const Args& a, const Tc& t, int wg, int nwg) {
    const bf16_t* SZ = (const bf16_t*)(a.ws + WS_SZ); const float* SDEC = (const float*)(a.ws + WS_SDEC); bf16_t* SST = (bf16_t*)(a.ws + WS_SST);
    static_assert(NRC % 4 == 0, "carry unroll");
    constexpr int NG = NRC / 4;
    for (int idx = wg * NTHREADS + t.tid; idx < BATCH * 16 * 2048; idx += nwg * NTHREADS) {
        const int chain = idx >> 11, e4 = (idx & 2047) * 4;
        const bf16_t* zc = SZ + (size_t)chain * NRC * 8192 + e4; bf16_t* sc = SST + (size_t)chain * NRC * 8192 + e4; const float* dc = SDEC + (size_t)chain * NRC;
        f32x4 s = {0.f, 0.f, 0.f, 0.f};
        u32x2 z[CAR_DEP][4]; float d[CAR_DEP][4];
#pragma unroll
        for (int g = 0; g < CAR_DEP - 1 && g < NG; ++g)
#pragma unroll
            for (int q = 0; q < 4; ++q) { z[g][q] = *(const u32x2*)(zc + (size_t)(4 * g + q) * 8192); d[g][q] = dc[4 * g + q]; }
#pragma unroll
        for (int g = 0; g < NG; ++g) {
            if (g + CAR_DEP - 1 < NG) {
#pragma unroll
                for (int q = 0; q < 4; ++q) { z[(g + CAR_DEP - 1) % CAR_DEP][q] = *(const u32x2*)(zc + (size_t)(4 * (g + CAR_DEP - 1) + q) * 8192); d[(g + CAR_DEP - 1) % CAR_DEP][q] = dc[4 * (g + CAR_DEP - 1) + q]; } }
#pragma unroll
            for (int q = 0; q < 4; ++q) { u32x2 w; w.x = pk2(s[0], s[1]); w.y = pk2(s[2], s[3]); *(u32x2*)(sc + (size_t)(4 * g + q) * 8192) = w;
                const u32x2 zw = z[g % CAR_DEP][q]; s = s * d[g % CAR_DEP][q] + (f32x4){bf_lo(zw.x), bf_hi(zw.x), bf_lo(zw.y), bf_hi(zw.y)}; }
        }
    }
}
__device__ __forceinline__ void ssd_c_unit(const Args& a, const Tc& t, int l, int u) {
    const bf16_t* SXBC = (const bf16_t*)(a.ws + WS_SXBC); const float* SDT = (const float*)(a.ws + WS_SDT);
    const bf16_t* SST = (const bf16_t*)(a.ws + WS_SST); bf16_t* OS = (bf16_t*)(a.ws + WS_OS);
    const int c = u % NRC, g = (u / NRC) & 1, b = u / (2 * NRC), row0 = rc_row0(b, c);
    LAS bf16_t* CM = (LAS bf16_t*)t.lds;
    LAS bf16_t* BM = CM + 64 * 136;
    LAS bf16_t* GS = BM + 64 * 136;
    LAS bf16_t* XT = GS + 64 * 72 + t.wave * 64 * 72;
    LAS float* PRE = (LAS float*)(GS + 64 * 72 + 8 * 64 * 72) + t.wave * 128;
    for (int e = t.tid; e < 64 * 32; e += NTHREADS) { const int rho = e >> 5, n4 = (e & 31) * 4;
        const f32x4 bv = ldbf4(SXBC + (size_t)(row0 + rho) * 1024 + 512 + g * 128 + n4), cv = ldbf4(SXBC + (size_t)(row0 + rho) * 1024 + 768 + g * 128 + n4);
        u32x2 wb, wc; wb.x = pk2(bv[0], bv[1]); wb.y = pk2(bv[2], bv[3]); wc.x = pk2(cv[0], cv[1]); wc.y = pk2(cv[2], cv[3]);
        *(LAS u32x2*)(BM + rho * 136 + n4) = wb; *(LAS u32x2*)(CM + rho * 136 + n4) = wc; }
    const int hh = t.wave & 3, dir = t.wave >> 2, h = 4 * g + hh, chain = (b * 8 + h) * 2 + dir, cc = rc_chain_pos(c, dir);
    const bf16_t* sb = SST + ((size_t)chain * NRC + cc) * 8192;
    bf16x8 sf[4][4];
#pragma unroll
    for (int pt = 0; pt < 4; ++pt)
#pragma unroll
        for (int ks = 0; ks < 4; ++ks) sf[pt][ks] = *(const bf16x8*)(sb + (size_t)(16 * pt + (t.lane & 15)) * 128 + 32 * ks + 8 * (t.lane >> 4));
    const float a_neg = -fexp(a.in[I_SALOG][(size_t)l * 16 + dir * 8 + h]);
    const float dtv = SDT[(size_t)(row0 + t.lane) * 16 + dir * 8 + h], av = dtv * a_neg;
    const float pre = wave_incl_scan(av, t.lane), tot = __shfl(pre, 63);
    PRE[t.lane] = pre; PRE[64 + t.lane] = pre - av;
#pragma unroll
    for (int p4 = 0; p4 < 16; ++p4) { const f32x4 x = ldbf4(SXBC + (size_t)(row0 + t.lane) * 1024 + h * 64 + p4 * 4);
#pragma unroll
        for (int q = 0; q < 4; ++q) XT[(p4 * 4 + q) * 72 + t.lane] = (bf16_t)f2bf(x[q] * dtv); }
    LDS_BARRIER();
#pragma unroll
    for (int q = 0; q < 2; ++q) { const int ti = t.wave * 2 + q, it = ti >> 2, jt = ti & 3; f32x4 acc = {0.f, 0.f, 0.f, 0.f};
        acc = mma16(acc, CM + it * 16 * 136, 136, BM + jt * 16 * 136, 136, 128, t.lane);
#pragma unroll
        for (int r = 0; r < 4; ++r) GS[(16 * it + 4 * (t.lane >> 4) + r) * 72 + 16 * jt + (t.lane & 15)] = (bf16_t)f2bf(acc[r]); }
    LDS_BARRIER();
#pragma unroll 1
    for (int it = 0; it < 4; ++it) {
        f32x4 acc[4], acc2[4];
#pragma unroll
        for (int pt = 0; pt < 4; ++pt) { acc[pt] = (f32x4){0.f, 0.f, 0.f, 0.f}; acc2[pt] = (f32x4){0.f, 0.f, 0.f, 0.f}; }
        const int rho = 16 * it + (t.lane & 15);
        const float prer = PRE[rho], exr = PRE[64 + rho];
#pragma unroll
        for (int ks = 0; ks < 2; ++ks) {
            const int rp0 = 32 * ks + 8 * (t.lane >> 4);
            const bf16x8 g8 = *(const LAS bf16x8*)(GS + rho * 72 + rp0);
            bf16x8 af;
#pragma unroll
            for (int e = 0; e < 8; ++e) { const int rp = rp0 + e; const float gv = __uint_as_float(((unsigned)(unsigned short)g8[e]) << 16);
                float f;
                if (dir == 0) f = rp <= rho ? fexp(prer - PRE[rp]) : 0.f; else f = rp >= rho ? fexp(PRE[64 + rp] - exr) : 0.f;
                af[e] = (short)f2bf(gv * f); }
#pragma unroll
            for (int pt = 0; pt < 4; ++pt) { const bf16x8 bfr = *(const LAS bf16x8*)(XT + (16 * pt + (t.lane & 15)) * 72 + rp0); acc[pt] = __builtin_amdgcn_mfma_f32_16x16x32_bf16(af, bfr, acc[pt], 0, 0, 0); }
        }
#pragma unroll
        for (int ks = 0; ks < 4; ++ks) {
            const bf16x8 cf = *(const LAS bf16x8*)(CM + rho * 136 + 32 * ks + 8 * (t.lane >> 4));
#pragma unroll
            for (int pt = 0; pt < 4; ++pt) acc2[pt] = __builtin_amdgcn_mfma_f32_16x16x32_bf16(cf, sf[pt][ks], acc2[pt], 0, 0, 0);
        }
#pragma unroll
        for (int r = 0; r < 4; ++r) { const int ro = 16 * it + 4 * (t.lane >> 4) + r; const float f = dir == 0 ? fexp(PRE[ro]) : fexp(tot - PRE[64 + ro]);
#pragma unroll
            for (int pt = 0; pt < 4; ++pt) stbf(OS + ((size_t)dir * M + row0 + ro) * 512 + h * 64 + 16 * pt + (t.lane & 15), acc[pt][r] + f * acc2[pt][r]); }
    }
    LDS_BARRIER();
}


constexpr int RW_UNITS = BATCH * 8 * NCK, RW_PAIRS = RW_UNITS / 2, RWA_HALF = 57344;
static_assert(RW_UNITS % 2 == 0, "unit pairs");
__device__ __forceinline__ void rwkv_a_all(const Args& a, const Tc& t) {
    const bf16_t* RW7 = (const bf16_t*)(a.ws + WS_RW7);
    const size_t P7 = (size_t)M * 256;
    const int half = t.tid >> 8, ht = t.tid & 255, hw = t.wave & 3, hq = t.lane >> 4, lc = t.lane & 15;
    LAS unsigned char* hb = t.lds + half * RWA_HALF;
    LAS float* RAW = (LAS float*)hb;
    LAS float* RtF = RAW;
    LAS float* KhF = RAW + 1024;
    LAS float* AtF = RAW + 3 * 1024;
    LAS float* Uf = RAW + 6 * 1024;
    LAS float* Qkf = Uf + 256;
    LAS float* Nuf = Qkf + 256;
    LAS float* WTs = Nuf + 256;
    LAS bf16_t* BtN = (LAS bf16_t*)(WTs + 64);
    LAS bf16_t* KtN = BtN + 16 * 72; LAS bf16_t* AtN = KtN + 16 * 72; LAS bf16_t* RtN = AtN + 16 * 72;
    LAS bf16_t* KpT = BtN;
    LAS bf16_t* BhT = RtN + 16 * 72;
    LAS bf16_t* VT = BhT + 64 * 40; LAS bf16_t* ApS = VT + 64 * 40;
    LAS bf16_t* NpS = ApS + 64 * 40;
    LAS bf16_t* QbT = NpS + 16 * 40;
    f32x4 pf[6];
#define RWA_LOAD(pair) do { const int u_ = 2 * (pair) + half, ck_ = u_ % NCK, ch_ = u_ / NCK, dir_ = ch_ & 1, h_ = (ch_ >> 1) & 3, b_ = ch_ >> 3; \
        _Pragma("unroll") for (int q = 0; q < 6; ++q) { const int e = ht + 256 * q, vec = e >> 8, rem = e & 255, i = rem >> 4, c4 = rem & 15; \
            const int row = chain_row(b_, dir_, ck_ * RKT + i); const int vs = vec < 5 ? vec : 5 + dir_; \
            pf[q] = ldbf4(RW7 + (size_t)vs * P7 + (size_t)row * 256 + h_ * 64 + c4 * 4); } } while (0)
    if (t.bid < RW_PAIRS) RWA_LOAD(t.bid);
    for (int pair = t.bid; pair < RW_PAIRS; pair += t.G) {
        const int u = 2 * pair + half, ck = u % NCK, chain = u / NCK;
        unsigned char* rec = a.ws + WS_RK + ((size_t)chain * NCK + ck) * RK_BYTES;
#pragma unroll
        for (int q = 0; q < 6; ++q) *(LAS f32x4*)(RAW + (ht + 256 * q) * 4) = pf[q];
        for (int e = ht; e < 3 * 64 * 8; e += 256) { const int arr = e >> 9, rem = e & 511, r = rem >> 3, c2 = rem & 7; *(LAS unsigned*)(BhT + arr * 64 * 40 + r * 40 + 16 + 2 * c2) = 0u; }
        { const int arr = ht >> 7, rem = ht & 127, r = rem >> 3, c2 = rem & 7; *(LAS unsigned*)(NpS + arr * 16 * 40 + r * 40 + 16 + 2 * c2) = 0u; }
        LDS_BARRIER();
        if (pair + t.G < RW_PAIRS) RWA_LOAD(pair + t.G);
        { const int j = ht & 63, ig = ht >> 6; float wc = 1.f, wT = 1.f;
#pragma unroll
            for (int i = 0; i < 16; ++i) { const float wv = RAW[5 * 1024 + i * 64 + j]; wT *= wv; if (i < 4 * ig) wc *= wv; }
            if (ig == 0) WTs[j] = wT;
            float bh4[4], v4[4];
#pragma unroll
            for (int q = 0; q < 4; ++q) { const int i = 4 * ig + q; const float wp = wc; wc *= RAW[5 * 1024 + i * 64 + j]; const float iw = frcp(wc);
                const float at = RAW[3 * 1024 + i * 64 + j] * wp, rt = RAW[i * 64 + j] * wc, bt = RAW[4 * 1024 + i * 64 + j] * iw, kt = RAW[1024 + i * 64 + j] * iw;
                AtN[i * 72 + j] = (bf16_t)f2bf(at); RtN[i * 72 + j] = (bf16_t)f2bf(rt); BtN[i * 72 + j] = (bf16_t)f2bf(bt); KtN[i * 72 + j] = (bf16_t)f2bf(kt);
                bh4[q] = bt * wT; v4[q] = RAW[2 * 1024 + i * 64 + j];
                KhF[i * 64 + j] = kt * wT; RtF[i * 64 + j] = rt; AtF[i * 64 + j] = at; }
            { u32x2 wb, wv; wb.x = pk2(bh4[0], bh4[1]); wb.y = pk2(bh4[2], bh4[3]); wv.x = pk2(v4[0], v4[1]); wv.y = pk2(v4[2], v4[3]);
              *(LAS u32x2*)(BhT + j * 40 + 4 * ig) = wb; *(LAS u32x2*)(VT + j * 40 + 4 * ig) = wv; } }
        LDS_BARRIER();
        { f32x4 acc = {0.f, 0.f, 0.f, 0.f};
            acc = mma16(acc, (hw == 0 || hw == 3) ? BtN : KtN, 72, hw < 2 ? AtN : RtN, 72, 64, t.lane);
            f32x4 mv;
#pragma unroll
            for (int r = 0; r < 4; ++r) { const int s_ = 4 * hq + r, t_ = lc; const bool keep = hw < 2 ? (s_ < t_) : (s_ <= t_); mv[r] = keep ? acc[r] : 0.f; }
            if (hw == 0) *(LAS f32x4*)(Uf + lc * 16 + 4 * hq) = mv;
            else if (hw == 3) { u32x2 w; w.x = pk2(mv[0], mv[1]); w.y = pk2(mv[2], mv[3]); *(LAS u32x2*)(QbT + lc * 40 + 4 * hq) = w; }
            else {
#pragma unroll
                for (int r = 0; r < 4; ++r) { const int s_ = 4 * hq + r; if (hw == 1) Nuf[s_ * 16 + lc] = mv[r]; else Qkf[s_ * 16 + lc] = mv[r]; } } }
        LDS_BARRIER();
        if (ht < 80) { float x[16]; const bool isA = ht < 64; const int rr = isA ? ht : ht - 64;
#pragma unroll
            for (int tt = 0; tt < 16; ++tt) { float acc = isA ? AtF[tt * 64 + rr] : Nuf[rr * 16 + tt];
                f32x4 uc[4];
#pragma unroll
                for (int q = 0; q < 4; ++q) uc[q] = *(const LAS f32x4*)(Uf + tt * 16 + 4 * q);
#pragma unroll
                for (int s_ = 0; s_ < 16; ++s_) if (s_ < tt) acc -= x[s_] * uc[s_ >> 2][s_ & 3];
                x[tt] = acc; }
            u32x4 w0, w1; w0.x = pk2(x[0], x[1]); w0.y = pk2(x[2], x[3]); w0.z = pk2(x[4], x[5]); w0.w = pk2(x[6], x[7]); w1.x = pk2(x[8], x[9]); w1.y = pk2(x[10], x[11]); w1.z = pk2(x[12], x[13]); w1.w = pk2(x[14], x[15]);
            LAS bf16_t* xr = (isA ? ApS : NpS) + rr * 40; *(LAS u32x4*)xr = w0; *(LAS u32x4*)(xr + 8) = w1; }
        else if (ht >= 128) { for (int e = ht - 128; e < 64 * 8; e += 128) { const int r = e >> 3, c2 = e & 7; *(LAS unsigned*)(KpT + r * 40 + 16 + 2 * c2) = 0u; } }
        LDS_BARRIER();
        for (int ti = hw; ti < 25; ti += 4) {
            f32x4 acc = {0.f, 0.f, 0.f, 0.f};
            if (ti < 16) { const int jt = ti >> 2, jt2 = ti & 3;
                acc = mma16(acc, ApS + jt * 16 * 40, 40, BhT + jt2 * 16 * 40, 40, 32, t.lane);
                unsigned short o[4];
#pragma unroll
                for (int r = 0; r < 4; ++r) { const int j = 16 * jt + 4 * hq + r, j2 = 16 * jt2 + lc; const float dg = (j == j2) ? WTs[j] : 0.f; o[r] = (unsigned short)f2bf(dg - acc[r]); }
                u32x2 w; w.x = o[0] | ((unsigned)o[1] << 16); w.y = o[2] | ((unsigned)o[3] << 16);
                *(u32x2*)(rec + RK_PA + ((size_t)((jt2 * 2 + (jt >> 1)) * 64 + t.lane) * 8 + 4 * (jt & 1)) * 2) = w;
            } else if (ti < 20) { const int jt = ti - 16;
                acc = mma16(acc, ApS + jt * 16 * 40, 40, QbT, 40, 32, t.lane);
                unsigned short o[4];
                const f32x4 rt4 = *(const LAS f32x4*)(RtF + lc * 64 + 16 * jt + 4 * hq);
#pragma unroll
                for (int r = 0; r < 4; ++r) o[r] = (unsigned short)f2bf(rt4[r] - acc[r]);
                u32x2 w; w.x = o[0] | ((unsigned)o[1] << 16); w.y = o[2] | ((unsigned)o[3] << 16);
                *(u32x2*)(rec + RK_RA + ((size_t)(((jt >> 1) * 64 + t.lane) * 8 + 4 * (jt & 1))) * 2) = w;
            } else if (ti == 20) {
                acc = mma16(acc, NpS, 40, QbT, 40, 32, t.lane);
                unsigned short o[4];
#pragma unroll
                for (int r = 0; r < 4; ++r) o[r] = (unsigned short)f2bf(Qkf[(4 * hq + r) * 16 + lc] - acc[r]);
                u32x2 w; w.x = o[0] | ((unsigned)o[1] << 16); w.y = o[2] | ((unsigned)o[3] << 16);
                *(u32x2*)(rec + RK_QA + ((size_t)((lc + 16 * (hq >> 1)) * 8 + 4 * (hq & 1))) * 2) = w;
                u32x2 z; z.x = 0u; z.y = 0u; *(u32x2*)(rec + RK_QA + ((size_t)((32 + lc + 16 * (hq >> 1)) * 8 + 4 * (hq & 1))) * 2) = z;
            } else { const int jt2 = ti - 21;
                acc = mma16(acc, NpS, 40, BhT + jt2 * 16 * 40, 40, 32, t.lane);
                float kp[4];
#pragma unroll
                for (int r = 0; r < 4; ++r) { const int s_ = 4 * hq + r, j2 = 16 * jt2 + lc; kp[r] = KhF[s_ * 64 + j2] - acc[r]; }
                u32x2 w; w.x = pk2(kp[0], kp[1]); w.y = pk2(kp[2], kp[3]); *(LAS u32x2*)(KpT + (16 * jt2 + lc) * 40 + 4 * hq) = w;
            }
        }
        for (int e = ht; e < 4 * 64 * 4; e += 256) { const int it = e >> 8, rem = e & 255, ln = rem >> 2, e2 = (rem & 3) * 2, hp = ln >> 4, i2 = 16 * it + (ln & 15);
            unsigned w = 0u; if (hp < 2) { const int s0 = 8 * hp + e2; w = f2bf(RAW[2 * 1024 + s0 * 64 + i2]) | (f2bf(RAW[2 * 1024 + (s0 + 1) * 64 + i2]) << 16); }
            *(unsigned*)(rec + RK_VB + ((size_t)((it * 64 + ln) * 8 + e2)) * 2) = w; }
        LDS_BARRIER();
#pragma unroll
        for (int q = 0; q < 4; ++q) { const int ti = hw * 4 + q, rt = ti >> 2, it = ti & 3; f32x4 acc = {0.f, 0.f, 0.f, 0.f};
            acc = mma16(acc, KpT + rt * 16 * 40, 40, VT + it * 16 * 40, 40, 32, t.lane);
            u32x2 zw; zw.x = pk2(acc[0], acc[1]); zw.y = pk2(acc[2], acc[3]);
            *(u32x2*)(rec + RK_ZC + ((size_t)((rt * 4 + it) * 64 + t.lane)) * 8) = zw; }
        LDS_BARRIER();
    }
#undef RWA_LOAD
}
constexpr int RKB_TASKS = BATCH * 8 * 2, RKB_NS = 7, RKB_D = 5, RKB_SLOT = 17408;
__device__ __forceinline__ void rkb_piece(const unsigned char* rp, int p, int w0, int lane, LAS unsigned char* slot) {
    const unsigned char* src;
    if (p < 8) src = rp + RK_PA + (size_t)(p * 64 + lane) * 16; else if (p < 10) src = rp + RK_RA + (size_t)((p - 8) * 64 + lane) * 16; else if (p == 10) src = rp + RK_QA + (size_t)lane * 16;
    else if (p < 15) src = rp + RK_ZC + (size_t)(((p - 11) * 4 + w0 + (lane >> 5)) * 64) * 8 + (size_t)(lane & 31) * 16;
    else src = rp + RK_VB + (size_t)((w0 + (p - 15)) * 64 + lane) * 16;
    __builtin_amdgcn_global_load_lds((const unsigned*)src, (LAS unsigned*)(slot + p * 1024), 16, 0, 0);
}
__device__ __forceinline__ void rkb_issue(const unsigned char* rec, int ck, int w0, int lw, int lane, LAS unsigned char* ring) {
    const unsigned char* rp = rec + (size_t)ck * RK_BYTES; LAS unsigned char* slot = ring + (ck % RKB_NS) * RKB_SLOT;
#pragma unroll
    for (int q = 0; q < 4; ++q) rkb_piece(rp, 4 * lw + q, w0, lane, slot);
    if (lw == 0) rkb_piece(rp, 16, w0, lane, slot);
}
__device__ __forceinline__ void rwkv_b_task(const Args& a, const Tc& t, int task) {
    bf16_t* OR = (bf16_t*)(a.ws + WS_OR);
    const int hb = task & 1, chain = task >> 1, dir = chain & 1, h = (chain >> 1) & 3, b = chain >> 3, hq = t.lane >> 4, lc = t.lane & 15;
    const int w0 = 2 * hb, w = w0 + (t.wave & 1);
    const unsigned char* rec = a.ws + WS_RK + (size_t)chain * NCK * RK_BYTES;
    LAS unsigned char* ring = t.lds;
    const bool loader = (t.wave >= 2 && t.wave <= 5); const int lw = t.wave - 2;
    if (loader) {
#pragma unroll 1
        for (int ck = 0; ck < RKB_D; ++ck) rkb_issue(rec, ck, w0, lw, t.lane, ring);
    }
    f32x4 T[4];
#pragma unroll
    for (int rt = 0; rt < 4; ++rt) T[rt] = (f32x4){0.f, 0.f, 0.f, 0.f};
#pragma unroll 1
    for (int ck = 0; ck < NCK; ++ck) {
        if (loader) {
            if (ck + RKB_D <= NCK) { if (lw == 0) WAIT_V(20); else WAIT_V(16); } else WAIT_V(0);
        }
        __builtin_amdgcn_s_barrier();
        if (loader) { if (ck + RKB_D < NCK) rkb_issue(rec, ck + RKB_D, w0, lw, t.lane, ring); }
        else if (t.wave < 2) {
            const LAS unsigned char* slot = ring + (ck % RKB_NS) * RKB_SLOT;
            bf16x8 pa[4][2], ra[2], qa, vb; f32x4 zc[4]; u32x2 zraw[4];
#pragma unroll
            for (int rt = 0; rt < 4; ++rt) {
#pragma unroll
                for (int ks = 0; ks < 2; ++ks) pa[rt][ks] = *(const LAS bf16x8*)(slot + ((rt * 2 + ks) * 64 + t.lane) * 16);
                zraw[rt] = *(const LAS u32x2*)(slot + (11 + rt) * 1024 + t.wave * 512 + t.lane * 8); }
#pragma unroll
            for (int ks = 0; ks < 2; ++ks) ra[ks] = *(const LAS bf16x8*)(slot + ((8 + ks) * 64 + t.lane) * 16);
            qa = *(const LAS bf16x8*)(slot + (10 * 64 + t.lane) * 16); vb = *(const LAS bf16x8*)(slot + ((15 + t.wave) * 64 + t.lane) * 16);
            WAIT_L(0); __builtin_amdgcn_sched_barrier(0);
#pragma unroll
            for (int rt = 0; rt < 4; ++rt) { const u32x2 zw = zraw[rt]; zc[rt] = (f32x4){bf_lo(zw.x), bf_hi(zw.x), bf_lo(zw.y), bf_hi(zw.y)}; }
            bf16x8 bfr[2];
#pragma unroll
            for (int ks = 0; ks < 2; ++ks) { u32x4 wv; wv.x = pk2(T[2 * ks][0], T[2 * ks][1]); wv.y = pk2(T[2 * ks][2], T[2 * ks][3]); wv.z = pk2(T[2 * ks + 1][0], T[2 * ks + 1][1]); wv.w = pk2(T[2 * ks + 1][2], T[2 * ks + 1][3]);
                bfr[ks] = __builtin_bit_cast(bf16x8, wv); }
            f32x4 o = {0.f, 0.f, 0.f, 0.f};
            o = __builtin_amdgcn_mfma_f32_16x16x32_bf16(bfr[0], ra[0], o, 0, 0, 0);
            o = __builtin_amdgcn_mfma_f32_16x16x32_bf16(bfr[1], ra[1], o, 0, 0, 0);
            o = __builtin_amdgcn_mfma_f32_16x16x32_bf16(vb, qa, o, 0, 0, 0);
#pragma unroll
            for (int rt = 0; rt < 4; ++rt) { f32x4 n = __builtin_amdgcn_mfma_f32_16x16x32_bf16(pa[rt][0], bfr[0], zc[rt], 0, 0, 0); T[rt] = __builtin_amdgcn_mfma_f32_16x16x32_bf16(pa[rt][1], bfr[1], n, 0, 0, 0); }
            { const int row = chain_row(b, dir, ck * RKT + lc); u32x2 ow; ow.x = pk2(o[0], o[1]); ow.y = pk2(o[2], o[3]);
              *(u32x2*)(OR + ((size_t)dir * M + row) * 256 + h * 64 + 16 * w + 4 * hq) = ow; }
        }
    }
    __builtin_amdgcn_s_barrier();
}

constexpr int GLA_UNITS = BATCH * GNC;
__device__ __forceinline__ int gc_row0(int b, int c) { return c < GC_CTX ? ML + b * CTX + 32 * c : b * SEQ + 32 * (c - GC_CTX); }
__device__ __forceinline__ int gc_chain_pos(int c, int dir) { return dir == 0 ? c : (c < GC_CTX ? GC_CTX - 1 - c : GC_CTX + (GC_LAT - 1 - (c - GC_CTX))); }
__device__ __forceinline__ void gla_prefix(LAS float* PRE, int lane) {
    const int d = lane & 31, r0 = (lane >> 5) * 16; float run = 0.f;
#pragma unroll
    for (int i = 0; i < 16; ++i) { run += PRE[(r0 + i) * 33 + d]; PRE[(r0 + i) * 33 + d] = run; }
    WAVE_LDS_FENCE();
    if (lane >= 32) { const float add = PRE[15 * 33 + d];
#pragma unroll
        for (int i = 0; i < 16; ++i) PRE[(16 + i) * 33 + d] += add; }
    WAVE_LDS_FENCE();
}
__device__ __forceinline__ void gla_a1_unit(const Args& a, const Tc& t, int u) {
    const bf16_t* U = (const bf16_t*)(a.ws + WS_U); const float* GG = (const float*)(a.ws + WS_GG);
    float* GZ = (float*)(a.ws + WS_GZ); float* GDEC = (float*)(a.ws + WS_GDEC);
    const int c = u % GNC, b = u / GNC, row0 = gc_row0(b, c);
    const int h = t.wave & 3, dir = t.wave >> 2, chain = (b * 4 + h) * 2 + dir, cc = gc_chain_pos(c, dir);
    LAS float* PRE = (LAS float*)(t.lds + t.wave * 12288);
    LAS bf16_t* KT = (LAS bf16_t*)(PRE + 32 * 33 + 8);
    LAS bf16_t* VT = KT + 32 * 40;
    const int rho = t.lane & 31, hf = t.lane >> 5;
#pragma unroll
    for (int q = 0; q < 4; ++q) { const f32x4 g = *(const f32x4*)(GG + ((size_t)dir * M + row0 + rho) * 128 + h * 32 + hf * 16 + 4 * q);
#pragma unroll
        for (int e = 0; e < 4; ++e) PRE[rho * 33 + hf * 16 + 4 * q + e] = g[e]; }
    WAVE_LDS_FENCE();
    f32x4 graw[4];
#pragma unroll
    for (int q = 0; q < 4; ++q)
#pragma unroll
        for (int e = 0; e < 4; ++e) graw[q][e] = PRE[rho * 33 + hf * 16 + 4 * q + e];
    WAVE_LDS_FENCE();
    gla_prefix(PRE, t.lane);
#pragma unroll
    for (int q = 0; q < 4; ++q) { const f32x4 k = ldbf4(U + (size_t)(row0 + rho) * NU + U_GK + h * 32 + hf * 16 + 4 * q);
#pragma unroll
        for (int e = 0; e < 4; ++e) { const int d = hf * 16 + 4 * q + e; const float pre = PRE[rho * 33 + d], tot = PRE[31 * 33 + d];
            const float w = dir == 0 ? fexp(tot - pre) : fexp(pre - graw[q][e]);
            KT[d * 40 + rho] = (bf16_t)f2bf(k[e] * w); } }
#pragma unroll
    for (int q = 0; q < 8; ++q) { const f32x4 v = ldbf4(U + (size_t)(row0 + rho) * NU + U_GV + h * 64 + hf * 32 + 4 * q);
#pragma unroll
        for (int e = 0; e < 4; ++e) VT[(hf * 32 + 4 * q + e) * 40 + rho] = (bf16_t)f2bf(v[e]); }
    if (t.lane < 32) GDEC[((size_t)chain * GNC + cc) * 32 + t.lane] = fexp(PRE[31 * 33 + t.lane]);
    WAVE_LDS_FENCE();
    float* zb = GZ + ((size_t)chain * GNC + cc) * 2048;
#pragma unroll
    for (int vt = 0; vt < 4; ++vt)
#pragma unroll
        for (int dt = 0; dt < 2; ++dt) { f32x4 acc = {0.f, 0.f, 0.f, 0.f};
            acc = mma16(acc, VT + vt * 16 * 40, 40, KT + dt * 16 * 40, 40, 32, t.lane);
#pragma unroll
            for (int r = 0; r < 4; ++r) zb[(16 * vt + 4 * (t.lane >> 4) + r) * 32 + 16 * dt + (t.lane & 15)] = acc[r]; }
    WAVE_LDS_FENCE();
}
__device__ __forceinline__ void gla_b_carry(const Args& a, const Tc& t, int wg, int nwg) {
    const float* GZ = (const float*)(a.ws + WS_GZ); const float* GDEC = (const float*)(a.ws + WS_GDEC); bf16_t* GST = (bf16_t*)(a.ws + WS_GST);
    static_assert(GNC % 4 == 0, "carry unroll");
    constexpr int NG = GNC / 4, DEP = 3;
    for (int idx = (nwg - 1 - wg) * NTHREADS + t.tid; idx < BATCH * 8 * 512; idx += nwg * NTHREADS) {
        const int chain = idx >> 9, e4 = (idx & 511) * 4, d0 = e4 & 31;
        const float* zc = GZ + (size_t)chain * GNC * 2048 + e4; bf16_t* sc = GST + (size_t)chain * GNC * 2048 + e4; const float* dc = GDEC + (size_t)chain * GNC * 32 + d0;
        f32x4 s = {0.f, 0.f, 0.f, 0.f};
        f32x4 z[DEP][4], d[DEP][4];
#pragma unroll
        for (int g = 0; g < DEP - 1 && g < NG; ++g)
#pragma unroll
            for (int q = 0; q < 4; ++q) { z[g][q] = *(const f32x4*)(zc + (size_t)(4 * g + q) * 2048); d[g][q] = *(const f32x4*)(dc + (size_t)(4 * g + q) * 32); }
#pragma unroll
        for (int g = 0; g < NG; ++g) {
            if (g + DEP - 1 < NG) {
#pragma unroll
                for (int q = 0; q < 4; ++q) { z[(g + DEP - 1) % DEP][q] = *(const f32x4*)(zc + (size_t)(4 * (g + DEP - 1) + q) * 2048); d[(g + DEP - 1) % DEP][q] = *(const f32x4*)(dc + (size_t)(4 * (g + DEP - 1) + q) * 32); } }
#pragma unroll
            for (int q = 0; q < 4; ++q) { u32x2 w; w.x = pk2(s[0], s[1]); w.y = pk2(s[2], s[3]); *(u32x2*)(sc + (size_t)(4 * g + q) * 2048) = w; s = s * d[g % DEP][q] + z[g % DEP][q]; }
        }
    }
}
__device__ __forceinline__ void gla_c_unit(const Args& a, const Tc& t, int u) {
    const bf16_t* U = (const bf16_t*)(a.ws + WS_U); const float* GG = (const float*)(a.ws + WS_GG);
    const bf16_t* GST = (const bf16_t*)(a.ws + WS_GST); bf16_t* OG = (bf16_t*)(a.ws + WS_OG);
    const int c = u % GNC, b = u / GNC, row0 = gc_row0(b, c);
    const int h = t.wave & 3, dir = t.wave >> 2, chain = (b * 4 + h) * 2 + dir, cc = gc_chain_pos(c, dir);
    LAS float* PRE = (LAS float*)(t.lds + t.wave * 14592);
    LAS bf16_t* QN = (LAS bf16_t*)(PRE + 32 * 33 + 8);
    LAS bf16_t* KN = QN + 32 * 40;
    LAS bf16_t* VT = KN + 32 * 40;
    const int rho = t.lane & 31, hf = t.lane >> 5, hq = t.lane >> 4, lc = t.lane & 15;
#pragma unroll
    for (int q = 0; q < 4; ++q) { const f32x4 g = *(const f32x4*)(GG + ((size_t)dir * M + row0 + rho) * 128 + h * 32 + hf * 16 + 4 * q);
#pragma unroll
        for (int e = 0; e < 4; ++e) PRE[rho * 33 + hf * 16 + 4 * q + e] = g[e]; }
    WAVE_LDS_FENCE();
    f32x4 graw[4];
#pragma unroll
    for (int q = 0; q < 4; ++q)
#pragma unroll
        for (int e = 0; e < 4; ++e) graw[q][e] = PRE[rho * 33 + hf * 16 + 4 * q + e];
    WAVE_LDS_FENCE();
    gla_prefix(PRE, t.lane);
#pragma unroll
    for (int q = 0; q < 4; ++q) { const f32x4 qv = ldbf4(U + (size_t)(row0 + rho) * NU + U_GQ + h * 32 + hf * 16 + 4 * q), kv = ldbf4(U + (size_t)(row0 + rho) * NU + U_GK + h * 32 + hf * 16 + 4 * q);
#pragma unroll
        for (int e = 0; e < 4; ++e) { const int d = hf * 16 + 4 * q + e; const float pre = PRE[rho * 33 + d], tot = PRE[31 * 33 + d], ref = PRE[15 * 33 + d];
            const float ex = pre - graw[q][e], qs = qv[e] * 0.17677669529663687f;
            float fq, fk;
            if (dir == 0) { fq = fexp(pre - ref); fk = fexp(ref - pre); } else { fq = fexp(ref - ex); fk = fexp(ex - ref); }
            (void)tot;
            QN[rho * 40 + d] = (bf16_t)f2bf(qs * fq); KN[rho * 40 + d] = (bf16_t)f2bf(kv[e] * fk); } }
    bf16x8 q2f[2];
#pragma unroll
    for (int it = 0; it < 2; ++it) { const int ro = 16 * it + lc; const bf16_t* qp = U + (size_t)(row0 + ro) * NU + U_GQ + h * 32 + 8 * hq; const float* gp = GG + ((size_t)dir * M + row0 + ro) * 128 + h * 32 + 8 * hq;
        const f32x4 qa = ldbf4(qp), qb = ldbf4(qp + 4), ga = *(const f32x4*)gp, gb = *(const f32x4*)(gp + 4);
#pragma unroll
        for (int e = 0; e < 8; ++e) { const int d = 8 * hq + e; const float pre = PRE[ro * 33 + d], tot = PRE[31 * 33 + d]; const float qv = e < 4 ? qa[e & 3] : qb[e & 3], gv = e < 4 ? ga[e & 3] : gb[e & 3];
            const float f2 = dir == 0 ? fexp(pre) : fexp(tot - (pre - gv));
            q2f[it][e] = (short)f2bf(qv * 0.17677669529663687f * f2); } }
#pragma unroll
    for (int q = 0; q < 8; ++q) { const f32x4 v = ldbf4(U + (size_t)(row0 + rho) * NU + U_GV + h * 64 + hf * 32 + 4 * q);
#pragma unroll
        for (int e = 0; e < 4; ++e) VT[(hf * 32 + 4 * q + e) * 40 + rho] = (bf16_t)f2bf(v[e]); }
    WAVE_LDS_FENCE();
    f32x4 att[2][2];
#pragma unroll
    for (int it = 0; it < 2; ++it)
#pragma unroll
        for (int jt = 0; jt < 2; ++jt) { att[it][jt] = (f32x4){0.f, 0.f, 0.f, 0.f}; att[it][jt] = mma16(att[it][jt], QN + it * 16 * 40, 40, KN + jt * 16 * 40, 40, 32, t.lane); }
    WAVE_LDS_FENCE();
#pragma unroll
    for (int it = 0; it < 2; ++it)
#pragma unroll
        for (int jt = 0; jt < 2; ++jt)
#pragma unroll
            for (int r = 0; r < 4; ++r) { const int ro = 16 * it + 4 * hq + r, rp = 16 * jt + lc; const bool keep = dir == 0 ? (rp <= ro) : (rp >= ro);
                QN[ro * 40 + rp] = (bf16_t)f2bf(keep ? att[it][jt][r] : 0.f); }
    WAVE_LDS_FENCE();
    const bf16_t* sb = GST + ((size_t)chain * GNC + cc) * 2048;
#pragma unroll
    for (int it = 0; it < 2; ++it)
#pragma unroll
        for (int vt = 0; vt < 4; ++vt) { f32x4 acc = {0.f, 0.f, 0.f, 0.f};
            acc = mma16(acc, QN + it * 16 * 40, 40, VT + vt * 16 * 40, 40, 32, t.lane);
            const bf16x8 sf = *(const bf16x8*)(sb + (size_t)(16 * vt + lc) * 32 + 8 * hq);
            acc = __builtin_amdgcn_mfma_f32_16x16x32_bf16(q2f[it], sf, acc, 0, 0, 0);
#pragma unroll
            for (int r = 0; r < 4; ++r) stbf(OG + ((size_t)dir * M + row0 + 16 * it + 4 * hq + r) * 256 + h * 64 + 16 * vt + lc, acc[r]); }
    WAVE_LDS_FENCE();
}

__device__ __forceinline__ void phase_mixout(const Args& a, const Tc& t, int l, int Mtok) {
    const bf16_t* U = (const bf16_t*)(a.ws + WS_U); const bf16_t* RW7 = (const bf16_t*)(a.ws + WS_RW7); const bf16_t* SXBC = (const bf16_t*)(a.ws + WS_SXBC);
    const bf16_t* OG = (const bf16_t*)(a.ws + WS_OG); const bf16_t* OR = (const bf16_t*)(a.ws + WS_OR); const bf16_t* OS = (const bf16_t*)(a.ws + WS_OS);
    bf16_t* MIX = (bf16_t*)(a.ws + WS_MIX);
    const float* mu = a.in[I_RMU] + (size_t)l * 2 * 928; const float* g2 = a.in[I_RG2] + (size_t)l * 64 * 256;
    const float* gng = a.in[I_GNG] + (size_t)l * 256; const float* lng = a.in[I_RLG] + (size_t)l * 256; const float* lnb = a.in[I_RLB] + (size_t)l * 256;
    const float* rrk = a.in[I_RRK] + (size_t)l * 256; const float* sd = a.in[I_SD] + (size_t)l * 8; const float* sng = a.in[I_SNG] + (size_t)l * 512;
    LAS float* SG = (LAS float*)t.lds;
    LAS float* RED = (LAS float*)(t.lds + 4096);
    const size_t P = (size_t)M * 256;
    LAS float* G2S = (LAS float*)(t.lds + 8192);
    for (int e = t.tid; e < 64 * 256 / 4; e += NTHREADS) *(LAS f32x4*)(G2S + 4 * e) = *(const f32x4*)(g2 + 4 * e);
    LDS_BARRIER();
    for (int tile = t.bid; tile < Mtok / 16; tile += t.G) {
        const int r0 = tile * 16; int slo, shi; seg_bounds(r0, slo, shi);
        unsigned lgr[8][4], lsd[16][2];
        {   const int c = t.tid & 255, tt0 = (t.tid >> 8) * 8;
#pragma unroll
            for (int j = 0; j < 8; ++j) { const size_t row = (size_t)(r0 + tt0 + j);
                lgr[j][0] = (unsigned)OG[row * 256 + c] | ((unsigned)OG[P + row * 256 + c] << 16);
                lgr[j][1] = (unsigned)OR[row * 256 + c] | ((unsigned)OR[P + row * 256 + c] << 16);
                lgr[j][2] = (unsigned)U[row * NU + U_GOG + c] | ((unsigned)RW7[row * 256 + c] << 16);
                lgr[j][3] = (unsigned)RW7[P + row * 256 + c] | ((unsigned)RW7[2 * P + row * 256 + c] << 16); }
            const int cs = t.tid;
#pragma unroll
            for (int q = 0; q < 16; ++q) { const size_t row = (size_t)(r0 + q);
                lsd[q][0] = (unsigned)OS[row * 512 + cs] | ((unsigned)OS[(size_t)M * 512 + row * 512 + cs] << 16);
                lsd[q][1] = (unsigned)SXBC[row * 1024 + cs] | ((unsigned)U[row * NU + U_SZ + cs] << 16); } }
        {   const int tt = t.tid >> 5, r = t.tid & 31, row = r0 + tt; const bf16_t* up = U + (size_t)row * NU; const bool hp = row - 1 >= slo, hn = row + 1 < shi;
#pragma unroll
            for (int q = 0; q < 2; ++q) { const int col = U_RLGT + q * 32 + r, mi = col - U_RW; const float u = ldbf(up + col), pv = ld_or0(up + col - NU, up + col, hp), nv = ld_or0(up + col + NU, up + col, hn);
                SG[tt * 64 + q * 32 + r] = sigmoidf_(u + mu[mi] * (pv - u) + mu[928 + mi] * (nv - u)); } }
        LDS_BARRIER();
        {
            const int c = t.tid & 255, tt0 = (t.tid >> 8) * 8;
            float ag[8];
#pragma unroll
            for (int j = 0; j < 8; ++j) ag[j] = 0.f;
#pragma unroll 2
            for (int r4 = 0; r4 < 16; ++r4) { float w[4];
#pragma unroll
                for (int q = 0; q < 4; ++q) w[q] = G2S[(4 * r4 + q) * 256 + c];
#pragma unroll
                for (int j = 0; j < 8; ++j) { const f32x4 sv = *(const LAS f32x4*)(SG + (tt0 + j) * 64 + 4 * r4); ag[j] += (sv[0] * w[0] + sv[1] * w[1]) + (sv[2] * w[2] + sv[3] * w[3]); } }
            const float gn = gng[c], lg = lng[c], lb = lnb[c], rk = rrk[c];
#pragma unroll
            for (int j = 0; j < 8; ++j) { const int row = r0 + tt0 + j;
                const float og_ = bf_lo(lgr[j][0]) + bf_hi(lgr[j][0]);
                const float ms = wave_sum(og_ * og_) * (1.0f / 64.0f);
                const float o1 = og_ * (frsq(ms + 1e-6f)) * gn * siluf_(bf_lo(lgr[j][2]));
                const float orr = bf_lo(lgr[j][1]) + bf_hi(lgr[j][1]);
                const float mean = wave_sum(orr) * (1.0f / 64.0f); const float dd = orr - mean; const float var = wave_sum(dd * dd) * (1.0f / 64.0f);
                const float on = dd * (frsq(var + 64e-5f)) * lg + lb;
                const float bon = wave_sum(bf_hi(lgr[j][2]) * bf_lo(lgr[j][3]) * rk) * bf_hi(lgr[j][3]);
                const float o2 = (on + bon) * ag[j];
                MIX[(size_t)row * D + c] = (bf16_t)f2bf(o1); MIX[(size_t)row * D + 256 + c] = (bf16_t)f2bf(o2); }
        }
        {
            const int c = t.tid; const float dh = sd[c >> 6], ng = sng[c];
            float y[16];
#pragma unroll
            for (int q = 0; q < 16; ++q) {
                float v = bf_lo(lsd[q][0]) + bf_hi(lsd[q][0]) + dh * bf_lo(lsd[q][1]);
                v *= siluf_(bf_hi(lsd[q][1])); y[q] = v;
                const float ss = wave_sum(v * v); if (t.lane == 0) RED[q * 8 + t.wave] = ss; }
            LDS_BARRIER();
            const int gb = (t.wave >> 2) * 4;
#pragma unroll
            for (int q = 0; q < 16; ++q) { const float ms = (RED[q * 8 + gb] + RED[q * 8 + gb + 1] + RED[q * 8 + gb + 2] + RED[q * 8 + gb + 3]) * (1.0f / 256.0f);
                MIX[(size_t)(r0 + q) * D + 512 + c] = (bf16_t)f2bf(y[q] * (frsq(ms + 1e-6f)) * ng); }
        }
        LDS_BARRIER();
    }
}

static_assert(NEXP <= 32, "router lanes");
__device__ __forceinline__ unsigned long long router_key(float v, int e) { unsigned u = __float_as_uint(v); u = (u & 0x80000000u) ? ~u : (u | 0x80000000u); return ((unsigned long long)u << 32) | (unsigned)(31 - e); }
__device__ __forceinline__ float router_unkey(unsigned long long k) { unsigned u = (unsigned)(k >> 32); u = (u & 0x80000000u) ? (u & 0x7fffffffu) : ~u; return __uint_as_float(u); }
__device__ __forceinline__ void phase_router(const Args& a, const Tc& t, int l, int Mtok) {
    const bf16_t* X = (const bf16_t*)(a.ws + WS_X); bf16_t* H = (bf16_t*)(a.ws + WS_H); const float* MODS = (const float*)(a.ws + WS_MODS) + (size_t)l * NR * 6144;
    const float* rw = a.in[I_ROUTW] + (size_t)l * D * NEXP; const float* rb = a.in[I_ROUTB] + (size_t)l * NEXP;
    int* TOPI = (int*)(a.ws + WS_TOPI); float* TOPP = (float*)(a.ws + WS_TOPP);
    unsigned* CNT = (unsigned*)(a.ws + WS_CTL) + CW_CNT + l * 64;
    LAS int* hist = (LAS int*)(t.lds + LDS_MISC + 64);
    LAS float* HT = (LAS float*)t.lds;
    LAS float* PART = HT + 16 * 1028;
    if (t.tid < NEXP) hist[t.tid] = 0;
    __syncthreads();
    const int hq = t.lane >> 4, lc = t.lane & 15, e = t.lane & 31, rh = t.lane >> 5; const bool ev = e < NEXP;
    const float bias = ev ? rb[e] : 0.f;
    constexpr int NT = NEXP > 16 ? 2 : 1;
    float wreg[NT][32];
#pragma unroll
    for (int nt = 0; nt < NT; ++nt)
#pragma unroll
        for (int ks = 0; ks < 32; ++ks) { const int k = 128 * t.wave + 4 * ks + hq, col = 16 * nt + lc; wreg[nt][ks] = col < NEXP ? rw[(size_t)k * NEXP + col] : 0.f; }
    for (int tile = t.bid; tile < Mtok / 16; tile += t.G) {
        const int r0 = tile * 16;
#pragma unroll
        for (int rr = 0; rr < 2; ++rr) { const int lr = 2 * t.wave + rr, row = r0 + lr;
            f32x4 v[4], h[4];
#pragma unroll
            for (int j = 0; j < 4; ++j) v[j] = ldbf4(X + (size_t)row * D + 4 * t.lane + 256 * j);
            const float* md = MODS + (size_t)mod_row(row) * 6144;
            norm_mod_store<true>(v, a.in[I_N2G] + (size_t)l * D, md + 3 * 1024, md + 4 * 1024, (bf16_t*)((unsigned char*)H + (size_t)row * D), t.lane, h);
#pragma unroll
            for (int j = 0; j < 4; ++j) *(LAS f32x4*)(HT + lr * 1028 + 4 * t.lane + 256 * j) = h[j]; }
        LDS_BARRIER();
        f32x4 acc[NT];
#pragma unroll
        for (int nt = 0; nt < NT; ++nt) acc[nt] = (f32x4){0.f, 0.f, 0.f, 0.f};
#pragma unroll
        for (int ks = 0; ks < 32; ++ks) { const float av = HT[lc * 1028 + 128 * t.wave + 4 * ks + hq];
#pragma unroll
            for (int nt = 0; nt < NT; ++nt) acc[nt] = __builtin_amdgcn_mfma_f32_16x16x4f32(av, wreg[nt][ks], acc[nt], 0, 0, 0); }
#pragma unroll
        for (int nt = 0; nt < NT; ++nt)
#pragma unroll
            for (int r = 0; r < 4; ++r) PART[(t.wave * 16 + 4 * hq + r) * 33 + 16 * nt + lc] = acc[nt][r];
        LDS_BARRIER();
        {   const int lr = 2 * t.wave + rh, row = r0 + lr;
            float lg = bias;
#pragma unroll
            for (int w2 = 0; w2 < 8; ++w2) lg += PART[(w2 * 16 + lr) * 33 + (ev ? e : 0)];
            if (!ev) lg = -3.0e38f;
            unsigned long long key = router_key(lg, e);
            int ti[4]; float tv[4];
#pragma unroll
            for (int k = 0; k < 4; ++k) { unsigned long long m = key;
#pragma unroll
                for (int o = 1; o < 32; o <<= 1) { const unsigned long long other = __shfl_xor(m, o); m = other > m ? other : m; }
                ti[k] = 31 - (int)(unsigned)(m & 0xffffffffu); tv[k] = router_unkey(m);
                if (ti[k] == e) key = 0ull; }
            const float e0 = 1.0f, e1 = fexp(tv[1] - tv[0]), e2 = fexp(tv[2] - tv[0]), e3 = fexp(tv[3] - tv[0]); const float inv = frcp(e0 + e1 + e2 + e3);
            if (e == 0) {
                TOPI[row * 4 + 0] = ti[0]; TOPI[row * 4 + 1] = ti[1]; TOPI[row * 4 + 2] = ti[2]; TOPI[row * 4 + 3] = ti[3];
                TOPP[row * 4 + 0] = e0 * inv; TOPP[row * 4 + 1] = e1 * inv; TOPP[row * 4 + 2] = e2 * inv; TOPP[row * 4 + 3] = e3 * inv;
#pragma unroll
                for (int k = 0; k < 4; ++k) atomicAdd((int*)&hist[ti[k]], 1);
            } }
        LDS_BARRIER();
    }
    __syncthreads();
    if (t.tid < NEXP && hist[t.tid] != 0) atomicAdd(&CNT[t.tid], (unsigned)hist[t.tid]);
}

__device__ __forceinline__ int moe_offsets(const unsigned* CNT, LAS int* off, LAS int* cnt, int tid) {
    if (tid < NEXP) { int o = 0; for (int e = 0; e < tid; ++e) o += ((int)CNT[e] + 255) & ~255; off[tid] = o; cnt[tid] = (int)CNT[tid]; }
    __syncthreads();
    return (off[NEXP - 1] + ((cnt[NEXP - 1] + 255) & ~255)) >> 8;
}
__device__ __forceinline__ void phase_lists(const Args& a, const Tc& t, int l, int Mtok) {
    const int* TOPI = (const int*)(a.ws + WS_TOPI); const float* TOPP = (const float*)(a.ws + WS_TOPP);
    int* POS = (int*)(a.ws + WS_POS); int* ROWIDX = (int*)(a.ws + WS_ROWIDX); float* ROWGATE = (float*)(a.ws + WS_ROWGATE);
    unsigned* CNT = (unsigned*)(a.ws + WS_CTL) + CW_CNT + l * 64; unsigned* CUR = (unsigned*)(a.ws + WS_CTL) + CW_CUR + l * 64;
    LAS int* off = (LAS int*)(t.lds + LDS_MISC + 64); LAS int* cnt = off + 64; LAS int* hist = off + 128; LAS int* base = off + 192; LAS int* cur = off + 256;
    if (t.tid < NEXP) { hist[t.tid] = 0; cur[t.tid] = 0; }
    moe_offsets(CNT, off, cnt, t.tid);
    const int rpb = (Mtok + t.G - 1) / t.G, s0 = t.bid * rpb * 4; int s1 = (t.bid + 1) * rpb * 4; if (s1 > Mtok * 4) s1 = Mtok * 4;
    for (int s = s0 + t.tid; s < s1; s += NTHREADS) atomicAdd((int*)&hist[TOPI[s]], 1);
    __syncthreads();
    if (t.tid < NEXP) base[t.tid] = hist[t.tid] ? (int)atomicAdd(&CUR[t.tid], (unsigned)hist[t.tid]) : 0;
    __syncthreads();
    for (int s = s0 + t.tid; s < s1; s += NTHREADS) { const int e = TOPI[s]; const int p = off[e] + base[e] + atomicAdd((int*)&cur[e], 1);
        POS[s] = p; ROWIDX[p] = s >> 2; ROWGATE[p] = TOPP[s]; }
    for (int e = t.bid; e < NEXP; e += t.G) { const int lo = off[e] + cnt[e], hi = off[e] + ((cnt[e] + 255) & ~255);
        for (int p = lo + t.tid; p < hi; p += NTHREADS) { ROWIDX[p] = 0; ROWGATE[p] = 0.f; } }
    __syncthreads();
}
__device__ __forceinline__ int moe_tile_table(const Args& a, const Tc& t, int l) {
    unsigned* CNT = (unsigned*)(a.ws + WS_CTL) + CW_CNT + l * 64;
    LAS int* off = (LAS int*)(t.lds + LDS_MISC + 64); LAS int* cnt = off + 64; LAS int* tile_e = (LAS int*)(t.lds + LDS_TILE_E);
    const int ntiles = moe_offsets(CNT, off, cnt, t.tid);
    for (int tt = t.tid; tt < ntiles; tt += NTHREADS) { int e = 0;
        for (int q = 1; q < NEXP; ++q) if ((off[q] >> 8) <= tt) e = q;
        tile_e[tt] = e; }
    __syncthreads();
    return ntiles;
}

__device__ __forceinline__ void phase_combine(const Args& a, const Tc& t, int l, int Mtok) {
    const int gw = t.bid * NWAVES + t.wave, NGW = t.G * NWAVES;
    bf16_t* X = (bf16_t*)(a.ws + WS_X); bf16_t* H = (bf16_t*)(a.ws + WS_H); const bf16_t* Y = (const bf16_t*)(a.ws + WS_Y); const int* POS = (const int*)(a.ws + WS_POS);
    const float* MODS = (const float*)(a.ws + WS_MODS) + (size_t)l * NR * 6144;
    for (int rp = gw * 2; rp < Mtok; rp += NGW * 2) {
        int ps[2][4];
#pragma unroll
        for (int q = 0; q < 2; ++q) { const u32x4 pv = *(const u32x4*)(POS + (size_t)(rp + q) * 4); ps[q][0] = (int)pv.x; ps[q][1] = (int)pv.y; ps[q][2] = (int)pv.z; ps[q][3] = (int)pv.w; }
        u32x2 yv[2][4][4]; f32x4 xv[2][4];
#pragma unroll
        for (int q = 0; q < 2; ++q)
#pragma unroll
            for (int j = 0; j < 4; ++j) { const int c = 4 * t.lane + 256 * j; xv[q][j] = ldbf4(X + (size_t)(rp + q) * D + c);
#pragma unroll
                for (int k = 0; k < 4; ++k) yv[q][k][j] = *(const u32x2*)(Y + (size_t)ps[q][k] * D + c); }
#pragma unroll
        for (int q = 0; q < 2; ++q) { const int row = rp + q;
            const float* md = MODS + (size_t)mod_row(row) * 6144 + 5 * 1024;
            f32x4 v[4], h[4];
#pragma unroll
            for (int j = 0; j < 4; ++j) { const int c = 4 * t.lane + 256 * j;
                const u32x2 y0 = yv[q][0][j], y1 = yv[q][1][j], y2 = yv[q][2][j], y3 = yv[q][3][j];
                f32x4 s_; s_[0] = (bf_lo(y0.x) + bf_lo(y1.x)) + (bf_lo(y2.x) + bf_lo(y3.x)); s_[1] = (bf_hi(y0.x) + bf_hi(y1.x)) + (bf_hi(y2.x) + bf_hi(y3.x));
                s_[2] = (bf_lo(y0.y) + bf_lo(y1.y)) + (bf_lo(y2.y) + bf_lo(y3.y)); s_[3] = (bf_hi(y0.y) + bf_hi(y1.y)) + (bf_hi(y2.y) + bf_hi(y3.y));
                const f32x4 g = *(const f32x4*)(md + c);
                v[j] = xv[q][j] + g * s_; }
            if (l + 1 < DEPTH) {
#pragma unroll
                for (int j = 0; j < 4; ++j) { u32x2 w; w.x = pk2(v[j][0], v[j][1]); w.y = pk2(v[j][2], v[j][3]); *(u32x2*)(X + (size_t)row * D + 4 * t.lane + 256 * j) = w; }
                const float* md2 = MODS + (size_t)NR * 6144 + (size_t)mod_row(row) * 6144;
                norm_mod_store(v, a.in[I_N1G] + (size_t)(l + 1) * D, md2, md2 + 1024, H + (size_t)row * D, t.lane, h);
            } else {
                float ss = 0.f;
#pragma unroll
                for (int j = 0; j < 4; ++j) ss += (v[j][0] * v[j][0] + v[j][1] * v[j][1]) + (v[j][2] * v[j][2] + v[j][3] * v[j][3]);
                const float rstd = frsq(wave_sum(ss) * (1.0f / D) + 1e-6f);
#pragma unroll
                for (int j = 0; j < 4; ++j) { const int c = 4 * t.lane + 256 * j; const f32x4 g = *(const f32x4*)(a.in[I_FNG] + c); *(f32x4*)(a.out + (size_t)row * D + c) = v[j] * rstd * g; }
            } }
    }
}

#ifndef EMU
__device__ __forceinline__ void launder_ws(Args& al) {
    __attribute__((address_space(1))) unsigned char* p = (__attribute__((address_space(1))) unsigned char*)al.ws; asm volatile("" : "+s"(p)); al.ws = (unsigned char*)p; }
__device__ __forceinline__ void launder_tid(Tc& t) { int x = threadIdx.x; asm volatile("" : "+v"(x)); t.tid = x; t.lane = x & 63; t.wave = __builtin_amdgcn_readfirstlane(x >> 6); }
#endif
constexpr int PH_PER_LAYER = 12, N_PHASES = 2 + DEPTH * PH_PER_LAYER;
__global__ void __launch_bounds__(NTHREADS, 2) fwd(Args a) {
#ifdef EMU
    unsigned char* lds_raw = EMU_DYN_LDS();
#else
    extern __shared__ __attribute__((aligned(16))) unsigned char lds_raw[];
#endif
    Tc t; t.lds = (LAS unsigned char*)lds_raw; t.tid = threadIdx.x; t.lane = t.tid & 63; t.wave = __builtin_amdgcn_readfirstlane(t.tid >> 6); t.G = gridDim.x; t.bid = blockIdx.x;
    const int lo = a.ph_lo, hi = a.ph_hi;
    Args al = a;
    volatile LAS unsigned* misc = (volatile LAS unsigned*)(t.lds + LDS_MISC);
    if (t.tid < 16) misc[t.tid] = 0u;
    if (t.tid == 0) { LAS unsigned long long* tb = (LAS unsigned long long*)(t.lds + LDS_PTRS);
#pragma unroll
        for (int i = 0; i < 37; ++i) tb[i] = (unsigned long long)a.in[i]; }
    __syncthreads();
    XcdBarrier bar; bar.bar = (unsigned*)(a.ws + WS_CTL) + CW_BAR; bar.x = 0; bar.st = misc;
    if (hi - lo > 1) bar = xcd_barrier_post((unsigned*)(a.ws + WS_CTL) + CW_BAR, misc);
#ifdef EMU
#define LAUNDER_TID() ((void)0)
#else
#define LAUNDER_TID() launder_tid(t)
#endif
#if PROBE_SPIN >= 0 && !defined(EMU)
    unsigned long long pt_acc = 0ull, pt_t0 = 0ull;
#define PT_MATCH(k) ((PROBE_SPIN >= 100) ? ((k) == PROBE_SPIN - 100) : ((k) >= 2 && ((k) - 2) % PH_PER_LAYER == PROBE_SPIN))
#define PT_BEGIN(k) (PT_MATCH(k) ? (pt_t0 = wall_clock64(), true) : true)
#define PT_END(k) do { if (PT_MATCH(k)) pt_acc += wall_clock64() - pt_t0; } while (0)
#else
#define PT_BEGIN(k) true
#define PT_END(k) ((void)0)
#endif
#ifdef EMU
#define LAUNDER_WS() ((void)0)
#else
#define LAUNDER_WS() launder_ws(al)
#endif
#define IN_PH(k) (lo <= (k) && (k) < hi && (LAUNDER_TID(), LAUNDER_WS(), true) && PT_BEGIN(k))
#define REPS(bit) (((PROBE_DOUBLE >> (bit)) & 1) ? 2 : 1)
#ifdef EMU
#define SEAM(k) do { if ((k) + 1 < hi) xcd_barrier(bar); PT_END(k); } while (0)
#else
#define SEAM(k) do { if ((k) + 1 < hi) { XcdBarrier b2_ = bar; __attribute__((address_space(1))) unsigned* bp_ = (__attribute__((address_space(1))) unsigned*)b2_.bar; asm volatile("" : "+s"(bp_)); b2_.bar = (unsigned*)bp_; xcd_barrier(b2_); } PT_END(k); } while (0)
#endif
    if (IN_PH(0)) { for (int rep = 0; rep < REPS(15); ++rep) phase_pro0(al, t); SEAM(0); }
    if (IN_PH(1)) { phase_pro1(al, t); SEAM(1); }
    for (int l = 0; l < DEPTH; ++l) {
        const int pb = 2 + l * PH_PER_LAYER;
        const bool lastl = (l == DEPTH - 1);
        const int Mtok = lastl ? ML : M;
        const float* MODSL = (const float*)(al.ws + WS_MODS) + (size_t)l * NR * 6144;
        if (IN_PH(pb + 0)) {
            pg8::Gemm g{(const bf16_t*)(al.ws + WS_H), (const bf16_t*)(al.ws + WS_WIN) + (size_t)l * NU * D, D, nullptr};
            pg8::DenseSched S; S.o.init(M / 256, NU / 256, t.G, t.bid);
            pg8::EpiBf16 E{(bf16_t*)(al.ws + WS_U), NU};
            for (int rep = 0; rep < REPS(0); ++rep) pg8::gemm_phase<pg8::EpiBf16, pg8::DenseSched, false>(t.lds, t.tid, g, S, E);
            convert_in_slack(al, t, l, 0, CV_E_IN, (M / 256) * (NU / 256));
            SEAM(pb + 0);
        }
        if (IN_PH(pb + 1)) { for (int rep = 0; rep < REPS(1); ++rep) phase_prep(al, t, l); SEAM(pb + 1); }
        if (IN_PH(pb + 2)) {
            for (int rep = 0; rep < REPS(4); ++rep) rwkv_a_all(al, t);
            for (int rep = 0; rep < REPS(10); ++rep)
            for (int u = t.bid; u < SSD_UNITS + GLA_UNITS; u += t.G) { if (u < SSD_UNITS) ssd_a1_unit(al, t, l, u); else gla_a1_unit(al, t, u - SSD_UNITS); }
            SEAM(pb + 2);
        }
        if (IN_PH(pb + 3)) {
            for (int rep = 0; rep < REPS(5); ++rep) for (int task = t.bid; task < RKB_TASKS; task += t.G) rwkv_b_task(al, t, task);
            if (t.G >= 2 * RKB_TASKS) { if (t.bid >= RKB_TASKS) { ssd_b_carry(al, t, t.bid - RKB_TASKS, t.G - RKB_TASKS); gla_b_carry(al, t, t.bid - RKB_TASKS, t.G - RKB_TASKS);
                    __syncthreads(); convert_moe(al, t, l, CV_E_IN, lastl ? CV_MOE_ITEMS : CV_E_B, (t.bid - RKB_TASKS) * NWAVES + t.wave, (t.G - RKB_TASKS) * NWAVES); } }
            else { ssd_b_carry(al, t, t.bid, t.G); gla_b_carry(al, t, t.bid, t.G); __syncthreads(); convert_moe(al, t, l, CV_E_IN, lastl ? CV_MOE_ITEMS : CV_E_B, t.bid * NWAVES + t.wave, t.G * NWAVES); }
            SEAM(pb + 3);
        }
        if (IN_PH(pb + 4)) {
            for (int rep = 0; rep < REPS(6); ++rep) for (int u = t.bid; u < SSD_UNITS + GLA_UNITS; u += t.G) { if (u < SSD_UNITS) ssd_c_unit(al, t, l, u); else gla_c_unit(al, t, u - SSD_UNITS); }
            SEAM(pb + 4);
        }
        if (IN_PH(pb + 5)) { for (int rep = 0; rep < REPS(3); ++rep) phase_mixout(al, t, l, Mtok); SEAM(pb + 5); }
        if (IN_PH(pb + 6)) {
            pg8::Gemm g{(const bf16_t*)(al.ws + WS_MIX), (const bf16_t*)(al.ws + WS_WOUT) + (size_t)l * D * D, D, nullptr};
            pg8::DenseSched S; S.o.init(Mtok / 256, D / 256, t.G, t.bid);
            pg8::EpiResid E{(bf16_t*)(al.ws + WS_X), MODSL};
            pg8::gemm_phase<pg8::EpiResid, pg8::DenseSched, false>(t.lds, t.tid, g, S, E);
            if (!lastl) convert_in_slack(al, t, l, CV_E_B, CV_MOE_ITEMS, (Mtok / 256) * (D / 256));
            SEAM(pb + 6);
        }
        if (IN_PH(pb + 7)) { phase_router(al, t, l, Mtok); SEAM(pb + 7); }
        if (IN_PH(pb + 8)) { phase_lists(al, t, l, Mtok); SEAM(pb + 8); }
        if (IN_PH(pb + 9)) {
            const int ntiles = moe_tile_table(al, t, l);
            pg8::Gemm g{(const bf16_t*)(al.ws + WS_H), (const bf16_t*)(al.ws + WS_WGU + (size_t)l * NEXP * 2048 * D), D / 2, (const int*)(al.ws + WS_ROWIDX)};
            pg8::MoeSched S; S.o.init(ntiles, 8, t.G, t.bid); S.tile_e = (const LAS int*)(t.lds + LDS_TILE_E); S.nct = 8;
            pg8::EpiSwiglu E{al.ws + WS_ACT, al.in[I_BGU] + (size_t)l * NEXP * 2048};
            for (int rep = 0; rep < REPS(7); ++rep) pg8::gemm_phase<pg8::EpiSwiglu, pg8::MoeSched, true, true>(t.lds, t.tid, g, S, E);
            SEAM(pb + 9);
        }
        if (IN_PH(pb + 10)) {
            const int ntiles = moe_tile_table(al, t, l);
            pg8::Gemm g{(const bf16_t*)(al.ws + WS_ACT), (const bf16_t*)(al.ws + WS_WD + (size_t)l * NEXP * D * DFF), DFF / 2, nullptr};
            pg8::MoeSched S; S.o.init(ntiles, 4, t.G, t.bid); S.tile_e = (const LAS int*)(t.lds + LDS_TILE_E); S.nct = 4;
            pg8::EpiDown E{(bf16_t*)(al.ws + WS_Y), al.in[I_BDN] + (size_t)l * NEXP * D, (const float*)(al.ws + WS_ROWGATE)};
            for (int rep = 0; rep < REPS(8); ++rep) pg8::gemm_phase<pg8::EpiDown, pg8::MoeSched, false, true>(t.lds, t.tid, g, S, E);
            SEAM(pb + 10);
        }
        if (IN_PH(pb + 11)) { phase_combine(al, t, l, Mtok); SEAM(pb + 11); }
    }
#if PROBE_SPIN >= 0 && !defined(EMU)
    if (t.bid == 0) { const unsigned long long te = wall_clock64(); while (wall_clock64() - te < 4ull * pt_acc) __builtin_amdgcn_s_sleep(8); }
#endif
#undef IN_PH
#undef SEAM
}

}

extern "C" void kernel_launch(void* const* d_in, const int* in_sizes, int n_in, void* d_out, int out_size, void* d_ws, size_t ws_size, hipStream_t stream) {
    using namespace mk;
    static int grid = 0;
    if (grid == 0) {
        if (n_in != 37 || out_size != ML * D || ws_size < WS_END) { fprintf(stderr, "kernel_launch: unexpected shapes (n_in %d out %d ws %zu need %zu)\n", n_in, out_size, ws_size, (size_t)WS_END); grid = -1; return; }
#ifdef EMU
        { const char* e = getenv("EMU_GRID"); grid = e ? atoi(e) : 8; }
#else
        int dev = 0, cus = 0, per_cu = 0;
        if (hipGetDevice(&dev) != hipSuccess || hipDeviceGetAttribute(&cus, hipDeviceAttributeMultiprocessorCount, dev) != hipSuccess) { grid = -1; return; }
        if (hipFuncSetAttribute((const void*)fwd, hipFuncAttributeMaxDynamicSharedMemorySize, LDS_BYTES) != hipSuccess) { fprintf(stderr, "kernel_launch: hipFuncSetAttribute failed\n"); grid = -1; return; }
        if (hipOccupancyMaxActiveBlocksPerMultiprocessor(&per_cu, (const void*)fwd, NTHREADS, LDS_BYTES) != hipSuccess || per_cu < 1) fprintf(stderr, "kernel_launch: occupancy query reports %d\n", per_cu);
        (void)hipGetLastError();
        grid = cus;
#endif
    }
    if (grid < 0) return;
    (void)hipMemsetAsync((char*)d_ws + WS_CTL, 0, CTL_BYTES, stream);
    Args a{};
    for (int i = 0; i < 37; ++i) a.in[i] = (const float*)d_in[i];
    a.out = (float*)d_out; a.ws = (unsigned char*)d_ws;
#if N_LAUNCH_MODE == 1
    a.ph_lo = 0; a.ph_hi = N_PHASES;
    hipLaunchKernelGGL(fwd, dim3(grid), dim3(NTHREADS), LDS_BYTES, stream, a);
#else
    for (int p = 0; p < N_PHASES; ++p) { a.ph_lo = p; a.ph_hi = p + 1; hipLaunchKernelGGL(fwd, dim3(grid), dim3(NTHREADS), LDS_BYTES, stream, a); }
#endif
}
```

```cpp
#ifndef EMU
#include <hip/hip_runtime.h>
#endif
#include <cstdio>
#include <cstdint>
#include <cmath>

#ifndef CFG_BATCH
#define CFG_BATCH 4
#define CFG_SEQ 4096
#define CFG_CTX 256
#define CFG_DEPTH 4
#define CFG_NEXP 32
#endif
#ifndef PROBE_DOUBLE
#define PROBE_DOUBLE 0
#endif
#ifndef PROBE_SPIN
#define PROBE_SPIN (-1)
#endif
#ifndef N_LAUNCH_MODE
#define N_LAUNCH_MODE 1
#endif

namespace mk {
constexpr int BATCH = CFG_BATCH, SEQ = CFG_SEQ, CTX = CFG_CTX, DEPTH = CFG_DEPTH, NEXP = CFG_NEXP;
constexpr int D = 1024, ML = BATCH * SEQ, MC = BATCH * CTX, M = ML + MC, NR = BATCH + 1;
constexpr int IN_COLS = 3280, NU = 3328;
constexpr int TOPK = 4, DFF = 1024;
constexpr int MAXROWS = M * TOPK + NEXP * 256;
constexpr int NTHREADS = 512, NWAVES = 8;
constexpr int U_GQ = 0, U_GK = 128, U_GV = 256, U_GOG = 512, U_GLF = 768, U_GLB = 784;
constexpr int U_RW = 800, U_RR = 800, U_RK = 1056, U_RV = 1312, U_RLWF = 1568, U_RLWB = 1600, U_RLA = 1632, U_RLGT = 1664;
constexpr int U_SZ = 1728, U_SXBC = 2240, U_SDT = 3264;
static_assert(SEQ % 256 == 0 && CTX % 256 == 0 && M % 256 == 0, "row tiles");

constexpr size_t al256(size_t x) { return (x + 255) & ~(size_t)255; }
constexpr size_t WS_CTL = 0, CTL_BYTES = 1u << 20;
constexpr size_t WS_MODS = WS_CTL + CTL_BYTES;
constexpr size_t WS_X = WS_MODS + al256((size_t)DEPTH * NR * 6144 * 4);
constexpr size_t WS_H = WS_X + al256((size_t)M * D * 4);
constexpr size_t WS_U = WS_H + al256((size_t)M * D * 2);
constexpr size_t WS_GG = WS_U + al256((size_t)M * NU * 4);
constexpr size_t WS_RW7 = WS_GG + al256((size_t)2 * M * 128 * 4);
constexpr size_t WS_SXBC = WS_RW7 + al256((size_t)7 * M * 256 * 4);
constexpr size_t WS_SDT = WS_SXBC + al256((size_t)M * 1024 * 4);
constexpr size_t WS_OG = WS_SDT + al256((size_t)M * 16 * 4);
constexpr size_t WS_OR = WS_OG + al256((size_t)2 * M * 256 * 4);
constexpr size_t WS_OS = WS_OR + al256((size_t)2 * M * 256 * 4);
constexpr size_t WS_MIX = WS_OS + al256((size_t)2 * M * 512 * 4);
constexpr size_t WS_TOPI = WS_MIX + al256((size_t)M * D * 2);
constexpr size_t WS_TOPP = WS_TOPI + al256((size_t)M * 4 * 4);
constexpr size_t WS_POS = WS_TOPP + al256((size_t)M * 4 * 4);
constexpr size_t WS_ROWIDX = WS_POS + al256((size_t)M * 4 * 4);
constexpr size_t WS_ROWGATE = WS_ROWIDX + al256((size_t)MAXROWS * 4);
constexpr size_t WS_ACT = WS_ROWGATE + al256((size_t)MAXROWS * 4);
constexpr size_t WS_Y = WS_ACT + al256((size_t)MAXROWS * DFF * 2);
constexpr size_t WS_WIN = WS_Y + al256((size_t)MAXROWS * D * 2);
constexpr size_t WS_WOUT = WS_WIN + al256((size_t)DEPTH * NU * D * 2);
constexpr size_t WS_WGU = WS_WOUT + al256((size_t)DEPTH * D * D * 2);
constexpr size_t WS_WD = WS_WGU + al256((size_t)DEPTH * NEXP * 2048 * D * 2);
constexpr int CTXC = CTX / 64, LATC = SEQ / 64, NRC = CTXC + LATC;
constexpr size_t WS_SZ = WS_WD + al256((size_t)DEPTH * NEXP * D * DFF * 2);
constexpr size_t WS_SDEC = WS_SZ + al256((size_t)BATCH * 16 * NRC * 64 * 128 * 2);
constexpr size_t WS_SST = WS_SDEC + al256((size_t)BATCH * 16 * NRC * 4);
constexpr int RKT = 16, NCK = (CTX + SEQ) / RKT;
constexpr int RK_PA = 0, RK_RA = 8192, RK_QA = 10240, RK_VB = 11264, RK_ZC = 15360, RK_BYTES = 23552;
constexpr size_t WS_RK = WS_SST + al256((size_t)BATCH * 16 * NRC * 64 * 128 * 2);
constexpr int GC_CTX = CTX / 32, GC_LAT = SEQ / 32, GNC = GC_CTX + GC_LAT;
constexpr size_t WS_GZ = WS_RK + al256((size_t)BATCH * 8 * NCK * RK_BYTES);
constexpr size_t WS_GDEC = WS_GZ + al256((size_t)BATCH * 8 * GNC * 2048 * 4);
constexpr size_t WS_GST = WS_GDEC + al256((size_t)BATCH * 8 * GNC * 32 * 4);
constexpr size_t WS_END = WS_GST + al256((size_t)BATCH * 8 * GNC * 2048 * 2);
constexpr int CW_BAR = 4096;
constexpr int CW_CNT = 16384;
constexpr int CW_SUB = 32768;
constexpr int CW_CUR = 16384 + 64 * 8;
constexpr int LDS_STAGE = 131072;
constexpr int LDS_TILE_E = LDS_STAGE;
constexpr int LDS_MISC = LDS_STAGE + 2048;
constexpr int LDS_PTRS = LDS_MISC + 2048;
constexpr int LDS_BYTES = 147456;

#ifdef EMU
#define LAS
#define ASM_VM0() ((void)0)
#define ASM_LGKM0() ((void)0)
#define ASM_MEMFENCE() ((void)0)
#define WAIT_V(n) ((void)0)
#define WAIT_L(n) ((void)0)
#define WAVE_LDS_FENCE() emu_wave_sync()
#define LAUNDER_V(x) ((void)0)
#define LDS_BARRIER() emu_block_sync()
#else
#define LAS __attribute__((address_space(3)))
#define ASM_VM0() asm volatile("s_waitcnt vmcnt(0)" ::: "memory")
#define ASM_LGKM0() asm volatile("s_waitcnt lgkmcnt(0)" ::: "memory")
#define ASM_MEMFENCE() asm volatile("" ::: "memory")
#define WAIT_V(n) asm volatile("s_waitcnt vmcnt(" #n ")" ::: "memory")
#define WAIT_L(n) asm volatile("s_waitcnt lgkmcnt(" #n ")" ::: "memory")
#define LDS_BARRIER() do { asm volatile("s_waitcnt lgkmcnt(0)" ::: "memory"); __builtin_amdgcn_s_barrier(); asm volatile("" ::: "memory"); } while (0)
#define LAUNDER_V(x) asm volatile("" : "+v"(x))
#define WAVE_LDS_FENCE() do { asm volatile("s_waitcnt lgkmcnt(0)" ::: "memory"); } while (0)
#endif

typedef unsigned short bf16_t;
typedef short bf16x8 __attribute__((ext_vector_type(8)));
typedef float f32x4 __attribute__((ext_vector_type(4)));
typedef float f32x2 __attribute__((ext_vector_type(2)));
typedef unsigned u32x4 __attribute__((ext_vector_type(4)));
typedef unsigned u32x2 __attribute__((ext_vector_type(2)));

#ifdef EMU
__device__ __forceinline__ unsigned f2bf(float f) { unsigned u = __float_as_uint(f); return (u + 0x7fffu + ((u >> 16) & 1u)) >> 16; }
__device__ __forceinline__ unsigned pk2(float lo, float hi) { return f2bf(lo) | (f2bf(hi) << 16); }
#else
typedef __bf16 hw_bf16x2 __attribute__((ext_vector_type(2)));
__device__ __forceinline__ unsigned pk2(float lo, float hi) { const f32x2 v = {lo, hi}; return __builtin_bit_cast(unsigned, __builtin_convertvector(v, hw_bf16x2)); }
__device__ __forceinline__ unsigned f2bf(float f) { return pk2(f, f) & 0xffffu; }
#endif
typedef int i32x4 __attribute__((ext_vector_type(4)));
typedef int i32x8 __attribute__((ext_vector_type(8)));
#ifdef EMU
__device__ __forceinline__ unsigned f2e4m3(float f) {
    const unsigned sgn = (__float_as_uint(f) >> 24) & 0x80u; float a = fabsf(f); if (!(a < 448.f)) a = 448.f;
    if (a < 0.015625f) { const int q = (int)nearbyintf(a * 512.f); return sgn | (unsigned)q; }
    int e; const float m = frexpf(a, &e); int q = (int)nearbyintf(m * 16.f); int ee = e - 1;
    if (q == 16) { q = 8; ++ee; }
    return sgn | (unsigned)(((ee + 7) << 3) | (q - 8));
}
__device__ __forceinline__ unsigned pk4_fp8(float a, float b, float c, float d) { return f2e4m3(a) | (f2e4m3(b) << 8) | (f2e4m3(c) << 16) | (f2e4m3(d) << 24); }
#else
__device__ __forceinline__ unsigned pk4_fp8(float a, float b, float c, float d) {
    a = __builtin_amdgcn_fmed3f(a, -448.f, 448.f); b = __builtin_amdgcn_fmed3f(b, -448.f, 448.f); c = __builtin_amdgcn_fmed3f(c, -448.f, 448.f); d = __builtin_amdgcn_fmed3f(d, -448.f, 448.f);
    int w = __builtin_amdgcn_cvt_pk_fp8_f32(a, b, 0, false); w = __builtin_amdgcn_cvt_pk_fp8_f32(c, d, w, true); return (unsigned)w;
}
#endif
__device__ __forceinline__ float bf_lo(unsigned w) { return __uint_as_float(w << 16); }
__device__ __forceinline__ float bf_hi(unsigned w) { return __uint_as_float(w & 0xffff0000u); }
__device__ __forceinline__ float ldbf(const bf16_t* p) { return __uint_as_float(((unsigned)*p) << 16); }
__device__ __forceinline__ f32x4 ldbf4(const bf16_t* p) { const u32x2 w = *(const u32x2*)p; return (f32x4){bf_lo(w.x), bf_hi(w.x), bf_lo(w.y), bf_hi(w.y)}; }
__device__ __forceinline__ void stbf(bf16_t* p, float v) { *p = (bf16_t)f2bf(v); }
__device__ __forceinline__ float wave_sum(float v) {
#pragma unroll
    for (int o = 1; o < 64; o <<= 1) v += __shfl_xor(v, o);
    return v;
}
__device__ __forceinline__ float sum8(float v) { v += __shfl_xor(v, 1); v += __shfl_xor(v, 2); v += __shfl_xor(v, 4); return v; }
__device__ __forceinline__ float fexp(float x) { return __builtin_amdgcn_exp2f(x * 1.4426950408889634f); }
__device__ __forceinline__ float frcp(float x) { return __builtin_amdgcn_rcpf(x); }
__device__ __forceinline__ float frsq(float x) { return __builtin_amdgcn_rsqf(x); }
__device__ __forceinline__ float flog(float x) { return __builtin_amdgcn_logf(x) * 0.6931471805599453f; }
__device__ __forceinline__ float sigmoidf_(float x) { return frcp(1.0f + fexp(-x)); }
__device__ __forceinline__ float siluf_(float x) { return x * frcp(1.0f + fexp(-x)); }
__device__ __forceinline__ float ftanh(float x) { return 1.0f - 2.0f * frcp(fexp(2.0f * x) + 1.0f); }
__device__ __forceinline__ float softplusf_(float x) { return fmaxf(x, 0.f) + flog(1.0f + fexp(-fabsf(x))); }
__device__ __forceinline__ float logsigmoidf_(float x) { return -softplusf_(-x); }

#define XB_TMO      128
#define XB_XCNT(j)  (256  + 64 * (j))
#define XB_XSUB(j)  (1280 + 64 * (j))
#define XB_XGEN(j)  (2304 + 64 * (j))
#define XB_TOP      3328
#define XB_TOPGEN   3392
#define XCD_BAR_WORDS 3456
#ifdef EMU
#define XB_SPIN_CAP (0xffffffffu)
#else
#define XB_SPIN_CAP (1u << 22)
#endif
__device__ __forceinline__ unsigned xb_ld(unsigned* p)              { return __hip_atomic_load(p, __ATOMIC_RELAXED, __HIP_MEMORY_SCOPE_AGENT); }
__device__ __forceinline__ unsigned xb_add(unsigned* p, unsigned v) { return __hip_atomic_fetch_add(p, v, __ATOMIC_RELAXED, __HIP_MEMORY_SCOPE_AGENT); }
__device__ __forceinline__ unsigned xb_xcc_id() { return (unsigned)__builtin_amdgcn_s_getreg((3 << 11) | 20) & 0xFu; }
#define XB_SPIN(cond, bar) do { unsigned _sp = 0; while (cond) { __builtin_amdgcn_s_sleep(1); \
    if ((++_sp & 255u) == 0u) { if (xb_ld(&(bar)[XB_TMO])) break; if (_sp > XB_SPIN_CAP) { atomicAdd(&(bar)[XB_TMO], 1u); break; } } } } while (0)
struct XcdBarrier { unsigned* bar; unsigned x; volatile LAS unsigned* st; };
__device__ __forceinline__ XcdBarrier xcd_barrier_post(unsigned* bar, volatile LAS unsigned* st) {
    XcdBarrier b; b.bar = bar; b.x = xb_xcc_id(); b.st = st;
    if (threadIdx.x == 0) (void)xb_add(&bar[XB_XCNT(b.x)], 1u);
    return b;
}
__device__ __forceinline__ void xcd_barrier_complete(unsigned* bar, unsigned x, unsigned& nloc, unsigned& nx) {
    const unsigned G = gridDim.x * gridDim.y * gridDim.z;
    unsigned sum, cnt, mine, sp = 0u;
    for (;;) {
        sum = 0u; cnt = 0u; mine = 0u;
#pragma unroll
        for (unsigned j = 0; j < 16; ++j) { const unsigned c = xb_ld(&bar[XB_XCNT(j)]); sum += c; cnt += (c > 0u) ? 1u : 0u; mine = (j == x) ? c : mine; }
        if (sum == G) break;
        __builtin_amdgcn_s_sleep(1);
        if ((++sp & 255u) == 0u) { if (xb_ld(&bar[XB_TMO])) break; if (sp > XB_SPIN_CAP) { atomicAdd(&bar[XB_TMO], 1u); break; } }
    }
    nloc = mine > 0u ? mine : 1u; nx = cnt > 0u ? cnt : 1u;
}
__device__ __forceinline__ void xcd_barrier(const XcdBarrier& b) {
    ASM_VM0();
    __syncthreads();
    if (threadIdx.x == 0) {
        unsigned* bar = b.bar;
        __builtin_amdgcn_s_waitcnt(0);
        unsigned nloc = b.st[0], nx = b.st[1];
        if (nloc == 0u) { xcd_barrier_complete(bar, b.x, nloc, nx); b.st[0] = nloc; b.st[1] = nx; }
        const unsigned old = xb_add(&bar[XB_XSUB(b.x)], 1u);
        const unsigned gen = old / nloc;
        if (old + 1u == (gen + 1u) * nloc) {
            __builtin_amdgcn_fence(__ATOMIC_RELEASE, "agent");
            ASM_VM0();
            const unsigned og = xb_add(&bar[XB_TOP], 1u);
            const unsigned tg = og / nx;
            if (og + 1u == (tg + 1u) * nx) xb_add(&bar[XB_TOPGEN], 1u);
            else XB_SPIN(xb_ld(&bar[XB_TOPGEN]) == tg, bar);
            __builtin_amdgcn_fence(__ATOMIC_ACQUIRE, "agent");
            xb_add(&bar[XB_XGEN(b.x)], 1u);
            ASM_VM0();
        } else {
            XB_SPIN(xb_ld(&bar[XB_XGEN(b.x)]) == gen, bar);
            __builtin_amdgcn_fence(__ATOMIC_ACQUIRE, "agent");
            ASM_VM0();
        }
    }
    __syncthreads();
}

__device__ __forceinline__ void sub_barrier(unsigned* cnt, unsigned n) {
    ASM_VM0();
    __syncthreads();
    if (threadIdx.x == 0) {
        __builtin_amdgcn_fence(__ATOMIC_RELEASE, "agent");
        ASM_VM0();
        (void)xb_add(cnt, 1u);
        unsigned sp = 0u;
        while (xb_ld(cnt) < n) { __builtin_amdgcn_s_sleep(1); if (++sp > XB_SPIN_CAP) break; }
        __builtin_amdgcn_fence(__ATOMIC_ACQUIRE, "agent");
        ASM_VM0();
    }
    __syncthreads();
}

namespace pg8 {
constexpr int BM = 256, BK = 64, HALF = 128, HTB = HALF * BK * 2, STAGE_BYTES = 8 * HTB, NXCD = 8, WGM = 8;
__host__ __device__ __forceinline__ int lds_byte(int r, int c) { const int st = (r >> 4) * 2 + (c >> 5), rr = r & 15, cc = c & 31, ob = rr * 64 + cc * 2; return st * 1024 + (ob ^ (((ob >> 9) & 1) << 5)); }
__host__ __device__ __forceinline__ void stage_rc(int b, int& R, int& C) { const int st = b / 1024, sb = b % 1024, swz = sb ^ (((sb >> 9) & 1) << 5); R = (st >> 1) * 16 + swz / 64; C = (st & 1) * 32 + (swz % 64) / 2; }
__host__ __device__ __forceinline__ int perm32(int rho) { const int n = rho >> 4, i = rho & 15; return 8 * (i >> 2) + 4 * n + (i & 3); }
struct Unit { int pm, pn, pb; };
struct Gemm { const bf16_t* A; const bf16_t* Bt; int K; const int* rowidx; };
struct Order {
    int nM, nN, nwg, G, c;
    __device__ __forceinline__ void init(int nM_, int nN_, int G_, int c_) { nM = nM_; nN = nN_; nwg = nM * nN; G = G_; c = c_; }
    __device__ __forceinline__ bool tile(int i, int& pm, int& pn) const {
        const long L = (long)i * G + c; if (L >= nwg) return false;
        int wgid = (int)L; { const int q = nwg / NXCD, r = nwg % NXCD, xcd = wgid % NXCD, off = wgid / NXCD; wgid = (xcd < r ? xcd * (q + 1) : r * (q + 1) + (xcd - r) * q) + off; }
        const int nig = WGM * nN, gid = wgid / nig, fm = gid * WGM, gsz = (nM - fm) < WGM ? (nM - fm) : WGM;
        pm = fm + ((wgid % nig) % gsz); pn = (wgid % nig) / gsz; return true;
    }
};
struct DenseSched { Order o; __device__ __forceinline__ bool next(int i, Unit& u) const { if (!o.tile(i, u.pm, u.pn)) return false; u.pb = u.pn; return true; } };
struct MoeSched { Order o; const LAS int* tile_e; int nct;
    __device__ __forceinline__ bool next(int i, Unit& u) const { if (!o.tile(i, u.pm, u.pn)) return false; u.pb = tile_e[u.pm] * nct + u.pn; return true; } };

__device__ __forceinline__ unsigned cvt_pk_bf16(float lo, float hi) {
#ifdef EMU
    return pk2(lo, hi);
#else
    return pk2(lo, hi);
#endif
}
struct EpiF32 {
    static constexpr bool PERM = false;
    float* C; int ldc;
    __device__ __forceinline__ void operator()(const f32x4 (&acc)[2][2][4][2], const Unit& u, int wr, int wc, int fr, int fq) const {
        const int row0 = u.pm * BM + wr * 64 + fr, col0 = u.pn * BM + wc * 32 + 4 * fq;
#pragma unroll
        for (int ai = 0; ai < 2; ++ai)
#pragma unroll
            for (int m = 0; m < 4; ++m) { float* rowp = C + (size_t)(row0 + ai * HALF + m * 16) * ldc + col0;
#pragma unroll
                for (int bj = 0; bj < 2; ++bj)
#pragma unroll
                    for (int n = 0; n < 2; ++n) *(f32x4*)(rowp + bj * HALF + n * 16) = acc[ai][bj][m][n]; }
    }
};
struct EpiBf16 {
    static constexpr bool PERM = true;
    bf16_t* C; int ldc;
    __device__ __forceinline__ void operator()(const f32x4 (&acc)[2][2][4][2], const Unit& u, int wr, int wc, int fr, int fq) const {
        const int row0 = u.pm * BM + wr * 64 + fr, col0 = u.pn * BM + wc * 32 + 8 * fq;
#pragma unroll
        for (int ai = 0; ai < 2; ++ai)
#pragma unroll
            for (int m = 0; m < 4; ++m) { bf16_t* rowp = C + (size_t)(row0 + ai * HALF + m * 16) * ldc + col0;
#pragma unroll
                for (int bj = 0; bj < 2; ++bj) { const f32x4 v0 = acc[ai][bj][m][0], v1 = acc[ai][bj][m][1];
                    u32x4 w; w.x = cvt_pk_bf16(v0[0], v0[1]); w.y = cvt_pk_bf16(v0[2], v0[3]); w.z = cvt_pk_bf16(v1[0], v1[1]); w.w = cvt_pk_bf16(v1[2], v1[3]);
                    *(u32x4*)(rowp + bj * HALF) = w; } }
    }
};
struct EpiResid {
    static constexpr bool PERM = true;
    bf16_t* X; const float* mods;
    __device__ __forceinline__ void operator()(const f32x4 (&acc)[2][2][4][2], const Unit& u, int wr, int wc, int fr, int fq) const {
        const int row0 = u.pm * BM + wr * 64 + fr, col0 = u.pn * BM + wc * 32 + 8 * fq;
        const int rbase = u.pm * BM; const int mrow = rbase < ML ? rbase / SEQ : BATCH;
        const float* g = mods + (size_t)mrow * 6144 + 2 * 1024 + col0;
        f32x4 gv[2][2];
#pragma unroll
        for (int bj = 0; bj < 2; ++bj)
#pragma unroll
            for (int n = 0; n < 2; ++n) gv[bj][n] = *(const f32x4*)(g + bj * HALF + 4 * n);
#pragma unroll
        for (int ai = 0; ai < 2; ++ai)
#pragma unroll
            for (int m = 0; m < 4; ++m) { bf16_t* rowp = X + (size_t)(row0 + ai * HALF + m * 16) * D + col0;
#pragma unroll
                for (int bj = 0; bj < 2; ++bj) { u32x4* p = (u32x4*)(rowp + bj * HALF); const u32x4 xo = *p;
                    const f32x4 v0 = (f32x4){bf_lo(xo.x), bf_hi(xo.x), bf_lo(xo.y), bf_hi(xo.y)} + gv[bj][0] * acc[ai][bj][m][0];
                    const f32x4 v1 = (f32x4){bf_lo(xo.z), bf_hi(xo.z), bf_lo(xo.w), bf_hi(xo.w)} + gv[bj][1] * acc[ai][bj][m][1];
                    u32x4 w; w.x = cvt_pk_bf16(v0[0], v0[1]); w.y = cvt_pk_bf16(v0[2], v0[3]); w.z = cvt_pk_bf16(v1[0], v1[1]); w.w = cvt_pk_bf16(v1[2], v1[3]);
                    *p = w; } }
    }
};
constexpr float F8_WSCALE = 64.0f, F8_ASCALE = 4.0f;
struct EpiSwiglu {
    static constexpr bool PERM = true;
    unsigned char* ACT; const float* bgu;
    __device__ __forceinline__ void operator()(const f32x4 (&acc)[2][2][4][2], const Unit& u, int wr, int wc, int fr, int fq) const {
        const int e = u.pb >> 3;
        const int row0 = u.pm * BM + wr * 64 + fr, j0 = u.pn * 128 + wc * 32 + 8 * fq;
        const float* bg = bgu + (size_t)e * 2048 + j0;
        f32x4 bgl[2], bln[2];
#pragma unroll
        for (int n = 0; n < 2; ++n) { bgl[n] = *(const f32x4*)(bg + 4 * n); bln[n] = *(const f32x4*)(bg + 1024 + 4 * n); }
#pragma unroll
        for (int ai = 0; ai < 2; ++ai)
#pragma unroll
            for (int m = 0; m < 4; ++m) { unsigned char* rowp = ACT + (size_t)(row0 + ai * HALF + m * 16) * DFF + j0;
                float o[8];
#pragma unroll
                for (int n = 0; n < 2; ++n)
#pragma unroll
                    for (int j = 0; j < 4; ++j) { float gl = acc[ai][0][m][n][j] * (1.0f / F8_WSCALE) + bgl[n][j], ln = acc[ai][1][m][n][j] * (1.0f / F8_WSCALE) + bln[n][j];
                        gl = fminf(gl, 7.0f); ln = fminf(fmaxf(ln, -7.0f), 7.0f);
                        o[n * 4 + j] = gl * __builtin_amdgcn_rcpf(1.0f + __builtin_amdgcn_exp2f(-1.702f * 1.4426950408889634f * gl)) * (ln * F8_ASCALE + F8_ASCALE); }
                u32x2 w; w.x = pk4_fp8(o[0], o[1], o[2], o[3]); w.y = pk4_fp8(o[4], o[5], o[6], o[7]);
                *(u32x2*)rowp = w; }
    }
};
struct EpiDown {
    static constexpr bool PERM = true;
    bf16_t* Y; const float* bd; const float* rowgate;
    __device__ __forceinline__ void operator()(const f32x4 (&acc)[2][2][4][2], const Unit& u, int wr, int wc, int fr, int fq) const {
        const int e = u.pb >> 2;
        const int row0 = u.pm * BM + wr * 64 + fr, col0 = u.pn * BM + wc * 32 + 8 * fq;
        const float* b = bd + (size_t)e * 1024 + col0;
        f32x4 bv[2][2];
#pragma unroll
        for (int bj = 0; bj < 2; ++bj)
#pragma unroll
            for (int n = 0; n < 2; ++n) bv[bj][n] = *(const f32x4*)(b + bj * HALF + 4 * n);
#pragma unroll
        for (int ai = 0; ai < 2; ++ai)
#pragma unroll
            for (int m = 0; m < 4; ++m) { const int row = row0 + ai * HALF + m * 16; const float gt = rowgate[row]; bf16_t* rowp = Y + (size_t)row * D + col0;
#pragma unroll
                for (int bj = 0; bj < 2; ++bj) { const f32x4 v0 = (acc[ai][bj][m][0] * (1.0f / (F8_WSCALE * F8_ASCALE)) + bv[bj][0]) * gt, v1 = (acc[ai][bj][m][1] * (1.0f / (F8_WSCALE * F8_ASCALE)) + bv[bj][1]) * gt;
                    u32x4 w; w.x = cvt_pk_bf16(v0[0], v0[1]); w.y = cvt_pk_bf16(v0[2], v0[3]); w.z = cvt_pk_bf16(v1[0], v1[1]); w.w = cvt_pk_bf16(v1[2], v1[3]);
                    *(u32x4*)(rowp + bj * HALF) = w; } }
    }
};

__device__ __forceinline__ f32x4 mma_f8(bf16x8 a0, bf16x8 a1, bf16x8 b0, bf16x8 b1, f32x4 c) {
#ifdef EMU
    return emu_mfma16_f8(a0, a1, b0, b1, c);
#else
    const i32x4 a0i = __builtin_bit_cast(i32x4, a0), a1i = __builtin_bit_cast(i32x4, a1), b0i = __builtin_bit_cast(i32x4, b0), b1i = __builtin_bit_cast(i32x4, b1);
    const i32x8 A = __builtin_shufflevector(a0i, a1i, 0, 1, 2, 3, 4, 5, 6, 7), B = __builtin_shufflevector(b0i, b1i, 0, 1, 2, 3, 4, 5, 6, 7);
    asm volatile("v_mfma_f32_16x16x128_f8f6f4 %0, %1, %2, %0" : "+v"(c) : "v"(A), "v"(B));
    return c;
#endif
}
template <class Epi, class Sched, bool GATHER, bool F8 = false>
__device__ __forceinline__ void gemm_phase(LAS unsigned char* lds, const int tid, const Gemm g, const Sched& S, const Epi& E) {
    const int wid = __builtin_amdgcn_readfirstlane(tid >> 6), lane = tid & 63, wr = wid >> 2, wc = wid & 3, fr = lane & 15, fq = lane >> 4;
    const int K = g.K, nt = K / BK;
    unsigned voffB[2]; int RA[2], CA[2];
#pragma unroll
    for (int i = 0; i < 2; ++i) { int R, C; stage_rc(tid * 16 + i * 8192, R, C); const int Rb = Epi::PERM ? ((R & ~31) + perm32(R & 31)) : R;
        RA[i] = R; CA[i] = C; voffB[i] = (unsigned)(Rb * K + C) * 2u; }
    const size_t kstep = (size_t)(BK * 2);
    const size_t hstep = (size_t)HALF * K * 2;
    const size_t tstep = 2 * hstep;
    const unsigned ldsw = (unsigned)wid * 1024u;
    const int aoff = lds_byte(wr * 64 + fr, fq * 8), boff = lds_byte(wc * 32 + fr, fq * 8);
#define PG8_SA(b, h) (((b) * 2 + (h)) * HTB)
#define PG8_SB(b, h) ((4 + (b) * 2 + (h)) * HTB)
#define PG8_STAGE(bufoff, gbase, voff) do { _Pragma("unroll") for (int _i = 0; _i < 2; ++_i) \
        __builtin_amdgcn_global_load_lds((const unsigned*)((const char*)(gbase) + (voff)[_i]), (LAS unsigned*)(lds + (bufoff) + ldsw + _i * 8192), 16, 0, 0); } while (0)
#define PG8_LDA(dst, b, h) do { _Pragma("unroll") for (int m = 0; m < 4; ++m) _Pragma("unroll") for (int k = 0; k < 2; ++k) dst[m][k] = *(const LAS bf16x8*)(lds + PG8_SA(b, h) + aoff + m * 2048 + k * 1024); } while (0)
#define PG8_LDB(dst, b, h) do { _Pragma("unroll") for (int n = 0; n < 2; ++n) _Pragma("unroll") for (int k = 0; k < 2; ++k) dst[n][k] = *(const LAS bf16x8*)(lds + PG8_SB(b, h) + boff + n * 2048 + k * 1024); } while (0)
#define PG8_MMA(ai, bj, At, Bt) do { __builtin_amdgcn_s_setprio(1); _Pragma("unroll") for (int m = 0; m < 4; ++m) _Pragma("unroll") for (int n = 0; n < 2; ++n) { \
        if constexpr (F8) acc[ai][bj][m][n] = mma_f8(Bt[n][0], Bt[n][1], At[m][0], At[m][1], acc[ai][bj][m][n]); \
        else { _Pragma("unroll") for (int k = 0; k < 2; ++k) acc[ai][bj][m][n] = __builtin_amdgcn_mfma_f32_16x16x32_bf16(Bt[n][k], At[m][k], acc[ai][bj][m][n], 0, 0, 0); } } __builtin_amdgcn_s_setprio(0); } while (0)
#define PG8_BAR __builtin_amdgcn_s_barrier()
#define PG8_SCHED __builtin_amdgcn_sched_barrier(0)
#define PG8_AOFF(dst, unit) do { _Pragma("unroll") for (int _h = 0; _h < 2; ++_h) _Pragma("unroll") for (int _i = 0; _i < 2; ++_i) { \
        const int _r = (unit).pm * BM + _h * HALF + RA[_i]; const int _src = GATHER ? g.rowidx[_r] : _r; dst[_h][_i] = (unsigned)(_src * K + CA[_i]) * 2u; } } while (0)
    Unit cur, nxt; int ui = 0;
    if (!S.next(0, cur)) return;
    f32x4 acc[2][2][4][2];
#pragma unroll
    for (int a = 0; a < 2; ++a)
#pragma unroll
        for (int b = 0; b < 2; ++b)
#pragma unroll
            for (int m = 0; m < 4; ++m)
#pragma unroll
                for (int n = 0; n < 2; ++n) acc[a][b][m][n] = (f32x4){0.f, 0.f, 0.f, 0.f};
    bf16x8 At[4][2], B0[2][2], B1[2][2];
    unsigned cvA[2][2], nvA[2][2];
    PG8_AOFF(cvA, cur);
    const char* const gA = (const char*)g.A;
    const char* cB = (const char*)g.Bt + (size_t)cur.pb * tstep;
    PG8_STAGE(PG8_SB(0, 0), cB, voffB); PG8_STAGE(PG8_SA(0, 0), gA, cvA[0]); PG8_STAGE(PG8_SB(0, 1), cB + hstep, voffB); PG8_STAGE(PG8_SA(0, 1), gA, cvA[1]);
    if (wr == 1) PG8_BAR;
    WAIT_V(4); PG8_BAR;
    PG8_STAGE(PG8_SB(1, 0), cB + kstep, voffB); PG8_STAGE(PG8_SA(1, 0), gA + kstep, cvA[0]); PG8_STAGE(PG8_SB(1, 1), cB + hstep + kstep, voffB);
    WAIT_V(6); PG8_BAR;
    for (;;) {
        const bool has_next = S.next(ui + 1, nxt);
        if (has_next) { PG8_AOFF(nvA, nxt); } else {
#pragma unroll
            for (int h = 0; h < 2; ++h)
#pragma unroll
                for (int i = 0; i < 2; ++i) nvA[h][i] = cvA[h][i]; }
        const char* nB = has_next ? (const char*)g.Bt + (size_t)nxt.pb * tstep : cB;
        for (int t = 0; t < nt; t += 2) {
            const bool last = (t == nt - 2);
            const char* a1 = gA + (size_t)(t + 1) * kstep;
            const char* a2 = last ? gA : gA + (size_t)(t + 2) * kstep; const char* b2 = last ? nB : cB + (size_t)(t + 2) * kstep;
            const char* a3 = a2 + kstep; const char* b3 = b2 + kstep;
            unsigned xA0[2], xA1[2];
#pragma unroll
            for (int i = 0; i < 2; ++i) { xA0[i] = last ? nvA[0][i] : cvA[0][i]; xA1[i] = last ? nvA[1][i] : cvA[1][i]; }
            PG8_LDB(B0, 0, 0); PG8_SCHED; PG8_LDA(At, 0, 0); PG8_STAGE(PG8_SA(1, 1), a1, cvA[1]);
            WAIT_L(8); PG8_BAR; WAIT_L(0); PG8_MMA(0, 0, At, B0); PG8_BAR; PG8_SCHED;
            PG8_LDB(B1, 0, 1); PG8_STAGE(PG8_SB(0, 0), b2, voffB);
            PG8_BAR; WAIT_L(0); PG8_MMA(0, 1, At, B1); PG8_BAR;
            PG8_LDA(At, 0, 1); PG8_STAGE(PG8_SA(0, 0), a2, xA0);
            PG8_BAR; WAIT_L(0); PG8_MMA(1, 0, At, B0); PG8_BAR; PG8_SCHED;
            PG8_STAGE(PG8_SB(0, 1), b2 + hstep, voffB);
            WAIT_V(6); PG8_BAR; PG8_MMA(1, 1, At, B1); PG8_BAR;
            PG8_LDB(B0, 1, 0); PG8_SCHED; PG8_LDA(At, 1, 0); PG8_STAGE(PG8_SA(0, 1), a2, xA1);
            WAIT_L(8); PG8_BAR; WAIT_L(0); PG8_MMA(0, 0, At, B0); PG8_BAR; PG8_SCHED;
            PG8_LDB(B1, 1, 1); PG8_STAGE(PG8_SB(1, 0), b3, voffB);
            PG8_BAR; WAIT_L(0); PG8_MMA(0, 1, At, B1); PG8_BAR;
            PG8_LDA(At, 1, 1); PG8_STAGE(PG8_SA(1, 0), a3, xA0);
            PG8_BAR; WAIT_L(0); PG8_MMA(1, 0, At, B0); PG8_BAR; PG8_SCHED;
            PG8_STAGE(PG8_SB(1, 1), b3 + hstep, voffB);
            WAIT_V(6); PG8_BAR; PG8_MMA(1, 1, At, B1); PG8_BAR;
        }
#ifndef EMU
        if constexpr (F8) asm volatile("s_nop 15\n\ts_nop 15" ::: "memory");
#endif
        E(acc, cur, wr, wc, fr, fq);
        if (!has_next) break;
#pragma unroll
        for (int a = 0; a < 2; ++a)
#pragma unroll
            for (int b = 0; b < 2; ++b)
#pragma unroll
                for (int m = 0; m < 4; ++m)
#pragma unroll
                    for (int n = 0; n < 2; ++n) acc[a][b][m][n] = (f32x4){0.f, 0.f, 0.f, 0.f};
        cur = nxt; cB = nB; ++ui;
#pragma unroll
        for (int h = 0; h < 2; ++h)
#pragma unroll
            for (int i = 0; i < 2; ++i) cvA[h][i] = nvA[h][i];
    }
    WAIT_V(0);
    if (wr == 0) PG8_BAR;
    PG8_BAR;
#undef PG8_SA
#undef PG8_SB
#undef PG8_STAGE
#undef PG8_LDA
#undef PG8_LDB
#undef PG8_MMA
#undef PG8_BAR
#undef PG8_SCHED
#undef PG8_AOFF
}
}

struct Args { const float* in[37]; float* out; unsigned char* ws; int ph_lo, ph_hi; };
enum { I_X = 0, I_C, I_CTX, I_CCTX, I_WADA, I_BADA, I_N1G, I_N2G, I_WIN, I_GGW, I_GGB, I_GNG, I_RMU, I_RW0, I_RW2, I_RA0, I_RA2, I_RG2, I_RKK, I_RKA, I_RRK,
       I_RLG, I_RLB, I_SCW, I_SCB, I_SDTB, I_SALOG, I_SD, I_SNG, I_WOUT, I_ROUTW, I_ROUTB, I_WGU, I_BGU, I_WDN, I_BDN, I_FNG };

struct Tc { LAS unsigned char* lds; int tid, lane, wave, G, bid; };
__device__ __forceinline__ const float* inp(const Tc& t, int i) {
    const unsigned long long v = ((const LAS unsigned long long*)(t.lds + LDS_PTRS))[i];
    const unsigned lo = __builtin_amdgcn_readfirstlane((unsigned)v), hi = __builtin_amdgcn_readfirstlane((unsigned)(v >> 32));
    return (const float*)(((unsigned long long)hi << 32) | lo);
}

struct CvItem { const float* W; bf16_t* dst; int ldw, k0, n0, nv, K; };
__device__ __forceinline__ void cv_load(const CvItem& it, float (&ld)[32], int lane) {
    const int c = lane & 31; const float* wp = it.W + (size_t)(it.k0 + (lane >> 5)) * it.ldw + it.n0 + (c < it.nv ? c : 0);
#pragma unroll
    for (int i = 0; i < 32; ++i) ld[i] = wp[(size_t)(2 * i) * it.ldw];
}
__device__ __forceinline__ void cv_store(const CvItem& it, const float (&ld)[32], LAS float* scr, int lane) {
    { const int c = lane & 31;
#pragma unroll
      for (int i = 0; i < 32; ++i) scr[(2 * i + (lane >> 5)) * 33 + c] = (c < it.nv) ? ld[i] : 0.f; }
    WAVE_LDS_FENCE();
    const int c = lane & 7;
#pragma unroll
    for (int j = 0; j < 4; ++j) { const int n = (lane >> 3) + 8 * j; const LAS float* s = scr + (8 * c) * 33 + n;
        u32x4 o; o.x = pk2(s[0 * 33], s[1 * 33]); o.y = pk2(s[2 * 33], s[3 * 33]); o.z = pk2(s[4 * 33], s[5 * 33]); o.w = pk2(s[6 * 33], s[7 * 33]);
        *(u32x4*)(it.dst + (size_t)n * it.K + it.k0 + 8 * c) = o; }
    WAVE_LDS_FENCE();
}
__device__ __forceinline__ void cv_store8(const CvItem& it, const float (&ld)[32], LAS float* scr, int lane) {
    { const int c = lane & 31;
#pragma unroll
      for (int i = 0; i < 32; ++i) scr[(2 * i + (lane >> 5)) * 33 + c] = ld[i] * pg8::F8_WSCALE; }
    WAVE_LDS_FENCE();
    const int c = lane & 7; unsigned char* d8 = (unsigned char*)it.dst;
#pragma unroll
    for (int j = 0; j < 4; ++j) { const int n = (lane >> 3) + 8 * j; const LAS float* s = scr + (8 * c) * 33 + n;
        u32x2 o; o.x = pk4_fp8(s[0 * 33], s[1 * 33], s[2 * 33], s[3 * 33]); o.y = pk4_fp8(s[4 * 33], s[5 * 33], s[6 * 33], s[7 * 33]);
        *(u32x2*)(d8 + (size_t)n * it.K + it.k0 + 8 * c) = o; }
    WAVE_LDS_FENCE();
}
constexpr int CV_KB = D / 64, CV_I_IN = CV_KB * (NU / 32), CV_I_OUT = CV_KB * (D / 32), CV_I_GU = CV_KB * (2048 / 32), CV_I_DN = CV_KB * (D / 32);
constexpr int CV_MOE_ITEMS = NEXP * (CV_I_GU + CV_I_DN);
constexpr int CV_E_IN = CV_MOE_ITEMS / 6, CV_E_B = CV_MOE_ITEMS / 2;
__device__ __forceinline__ CvItem cv_moe_item(const Args& a, int l, int it) {
    unsigned char* WGU = a.ws + WS_WGU; unsigned char* WDN = a.ws + WS_WD;
    const int e = it / (CV_I_GU + CV_I_DN); int r = it % (CV_I_GU + CV_I_DN); CvItem ci;
    if (r < CV_I_GU) { const int kb = r / 64, nb = r % 64, n0 = nb * 32; const int half = n0 >> 10, rem = n0 & 1023, pn = rem >> 7, jj = rem & 127;
        ci.W = a.in[I_WGU] + ((size_t)l * NEXP + e) * D * 2048; ci.ldw = 2048; ci.k0 = kb * 64; ci.n0 = n0; ci.nv = 32; ci.dst = (bf16_t*)(WGU + (((size_t)l * NEXP + e) * 2048 + pn * 256 + half * 128 + jj) * D); ci.K = D; }
    else { r -= CV_I_GU; const int kb = r / (D / 32), nb = r % (D / 32);
        ci.W = a.in[I_WDN] + ((size_t)l * NEXP + e) * DFF * D; ci.ldw = D; ci.k0 = kb * 64; ci.n0 = nb * 32; ci.nv = 32; ci.dst = (bf16_t*)(WDN + (((size_t)l * NEXP + e) * D + nb * 32) * DFF); ci.K = DFF; }
    return ci;
}
__device__ __forceinline__ CvItem cv_dense_item(const Args& a, int it) {
    bf16_t* WIN = (bf16_t*)(a.ws + WS_WIN); bf16_t* WOUT = (bf16_t*)(a.ws + WS_WOUT);
    const int l = it / (CV_I_IN + CV_I_OUT); int r = it % (CV_I_IN + CV_I_OUT); CvItem ci;
    if (r < CV_I_IN) { const int kb = r / (NU / 32), nb = r % (NU / 32), n0 = nb * 32; int nv = IN_COLS - n0; nv = nv < 0 ? 0 : (nv > 32 ? 32 : nv);
        ci.W = a.in[I_WIN] + (size_t)l * D * IN_COLS; ci.ldw = IN_COLS; ci.k0 = kb * 64; ci.n0 = n0; ci.nv = nv; ci.dst = WIN + ((size_t)l * NU + n0) * D; ci.K = D; }
    else { r -= CV_I_IN; const int kb = r / (D / 32), nb = r % (D / 32);
        ci.W = a.in[I_WOUT] + (size_t)l * D * D; ci.ldw = D; ci.k0 = kb * 64; ci.n0 = nb * 32; ci.nv = 32; ci.dst = WOUT + ((size_t)l * D + nb * 32) * D; ci.K = D; }
    return ci;
}
__device__ __forceinline__ void convert_moe(const Args& a, const Tc& t, int l, int i0, int i1, int gw, int ngw) {
    LAS float* scr = (LAS float*)(t.lds + t.wave * 16384);
    float ld[32], ln[32];
    if (i0 + gw < i1) { const CvItem c0 = cv_moe_item(a, l, i0 + gw); cv_load(c0, ld, t.lane); }
    for (int it = i0 + gw; it < i1; it += ngw) {
        const CvItem cur = cv_moe_item(a, l, it);
        const bool more = it + ngw < i1;
        if (more) { const CvItem nx = cv_moe_item(a, l, it + ngw); cv_load(nx, ln, t.lane); }
        cv_store8(cur, ld, scr, t.lane);
        if (more) {
#pragma unroll
            for (int i = 0; i < 32; ++i) ld[i] = ln[i]; }
    }
}
__device__ __forceinline__ void convert_in_slack(const Args& a, const Tc& t, int l, int i0, int i1, int nunits) {
    const int rem = nunits % t.G;
    if (t.bid >= rem) convert_moe(a, t, l, i0, i1, (t.bid - rem) * NWAVES + t.wave, (t.G - rem) * NWAVES);
}
__device__ __forceinline__ void phase_pro0(const Args& a, const Tc& t) {
    LAS float* scr = (LAS float*)(t.lds + t.wave * 16384);
    const int gw = t.bid * NWAVES + t.wave, NGW = t.G * NWAVES;
    { float ld[32];
      for (int it = gw; it < DEPTH * (CV_I_IN + CV_I_OUT); it += NGW) { const CvItem ci = cv_dense_item(a, it); cv_load(ci, ld, t.lane); cv_store(ci, ld, scr, t.lane); } }
    __syncthreads();
    LAS float* sc = (LAS float*)t.lds;
    LAS float* red = (LAS float*)(t.lds + 32768);
    for (int i = t.tid; i < NR * D; i += NTHREADS) { const int r = i / D, k = i % D; const float v = r < BATCH ? a.in[I_C][r * D + k] : a.in[I_CCTX][k]; sc[i] = siluf_(v); }
    __syncthreads();
    float* MODS = (float*)(a.ws + WS_MODS);
    const int jl = t.tid & 127, kq = t.tid >> 7;
    for (int cb = t.bid; cb < DEPTH * 48; cb += t.G) {
        const int l = cb / 48, j = (cb % 48) * 128 + jl;
        const float* w = a.in[I_WADA] + (size_t)l * D * 6144 + j;
        float acc[NR];
#pragma unroll
        for (int r = 0; r < NR; ++r) acc[r] = 0.f;
        for (int k = kq * 256; k < kq * 256 + 256; ++k) { const float wv = w[(size_t)k * 6144];
#pragma unroll
            for (int r = 0; r < NR; ++r) acc[r] += sc[r * D + k] * wv; }
#pragma unroll
        for (int r = 0; r < NR; ++r) red[(kq * NR + r) * 128 + jl] = acc[r];
        __syncthreads();
        if (kq == 0) {
            const float bb = a.in[I_BADA][(size_t)l * 6144 + j];
#pragma unroll
            for (int r = 0; r < NR; ++r) MODS[((size_t)l * NR + r) * 6144 + j] = red[(0 * NR + r) * 128 + jl] + red[(1 * NR + r) * 128 + jl] + red[(2 * NR + r) * 128 + jl] + red[(3 * NR + r) * 128 + jl] + bb;
        }
        __syncthreads();
    }
}

__device__ __forceinline__ int mod_row(int row) { return row < ML ? row / SEQ : BATCH; }
template <bool F8 = false>
__device__ __forceinline__ void norm_mod_store(const f32x4 (&v)[4], const float* g, const float* shift, const float* scale, bf16_t* hrow, int lane, f32x4 (&hout)[4]) {
    float ss = 0.f;
#pragma unroll
    for (int j = 0; j < 4; ++j) ss += (v[j][0] * v[j][0] + v[j][1] * v[j][1]) + (v[j][2] * v[j][2] + v[j][3] * v[j][3]);
    const float rstd = frsq(wave_sum(ss) * (1.0f / D) + 1e-6f);
#pragma unroll
    for (int j = 0; j < 4; ++j) { const int c = 4 * lane + 256 * j;
        const f32x4 gg = *(const f32x4*)(g + c), sh = *(const f32x4*)(shift + c), sc = *(const f32x4*)(scale + c);
        const f32x4 h = (v[j] * rstd * gg) * (sc + 1.0f) + sh; hout[j] = h;
        if constexpr (F8) { *(unsigned*)((unsigned char*)hrow + c) = pk4_fp8(h[0], h[1], h[2], h[3]); }
        else { u32x2 w; w.x = pk2(h[0], h[1]); w.y = pk2(h[2], h[3]); *(u32x2*)(hrow + c) = w; } }
}
__device__ __forceinline__ void phase_pro1(const Args& a, const Tc& t) {
    const int gw = t.bid * NWAVES + t.wave, NGW = t.G * NWAVES;
    bf16_t* X = (bf16_t*)(a.ws + WS_X); bf16_t* H = (bf16_t*)(a.ws + WS_H); const float* MODS = (const float*)(a.ws + WS_MODS);
    for (int row = gw; row < M; row += NGW) {
        const float* src = row < ML ? a.in[I_X] + (size_t)row * D : a.in[I_CTX] + (size_t)(row - ML) * D;
        f32x4 v[4], h[4];
#pragma unroll
        for (int j = 0; j < 4; ++j) { v[j] = *(const f32x4*)(src + 4 * t.lane + 256 * j); u32x2 w; w.x = pk2(v[j][0], v[j][1]); w.y = pk2(v[j][2], v[j][3]); *(u32x2*)(X + (size_t)row * D + 4 * t.lane + 256 * j) = w; }
        const float* md = MODS + (size_t)mod_row(row) * 6144;
        norm_mod_store(v, a.in[I_N1G], md, md + 1024, H + (size_t)row * D, t.lane, h);
    }
}

__device__ __forceinline__ float ld_or0(const float* p, const float* safe, bool ok) { const float v = *(ok ? p : safe); return ok ? v : 0.f; }
__device__ __forceinline__ float ld_or0(const bf16_t* p, const bf16_t* safe, bool ok) { const float v = ldbf(ok ? p : safe); return ok ? v : 0.f; }
__device__ __forceinline__ void seg_bounds(int row, int& lo, int& hi) {
    if (row < ML) { lo = row & ~63; hi = lo + 64; } else { lo = ML + ((row - ML) / CTX) * CTX; hi = lo + CTX; }
}
__device__ __forceinline__ void phase_prep(const Args& a, const Tc& t, int l) {
    const bf16_t* U = (const bf16_t*)(a.ws + WS_U);
    float* GG = (float*)(a.ws + WS_GG); bf16_t* RW7 = (bf16_t*)(a.ws + WS_RW7); bf16_t* SXBC = (bf16_t*)(a.ws + WS_SXBC); float* SDT = (float*)(a.ws + WS_SDT);
    const float* mu = a.in[I_RMU] + (size_t)l * 2 * 928;
    const float* w0 = a.in[I_RW0] + (size_t)l * 2 * 256; const float* w2 = a.in[I_RW2] + (size_t)l * 2 * 32 * 256;
    const float* a0 = a.in[I_RA0] + (size_t)l * 256; const float* a2 = a.in[I_RA2] + (size_t)l * 32 * 256;
    const float* rkk = a.in[I_RKK] + (size_t)l * 256; const float* rka = a.in[I_RKA] + (size_t)l * 256;
    const float* ggw = a.in[I_GGW] + (size_t)l * 2 * 16 * 128; const float* ggb = a.in[I_GGB] + (size_t)l * 2 * 128;
    const float* cw = a.in[I_SCW] + (size_t)l * 4 * 1024; const float* cb = a.in[I_SCB] + (size_t)l * 1024;
    const float* dtb = a.in[I_SDTB] + (size_t)l * 16;
    LAS float* LOW = (LAS float*)t.lds;
    LAS float* A2S = LOW + 16 * 128; LAS float* W2S = A2S + 32 * 256; LAS float* GWS = W2S + 64 * 256;
    for (int e = t.tid; e < 32 * 256 / 4; e += NTHREADS) *(LAS f32x4*)(A2S + 4 * e) = *(const f32x4*)(a2 + 4 * e);
    for (int e = t.tid; e < 64 * 256 / 4; e += NTHREADS) *(LAS f32x4*)(W2S + 4 * e) = *(const f32x4*)(w2 + 4 * e);
    for (int e = t.tid; e < 32 * 128 / 4; e += NTHREADS) *(LAS f32x4*)(GWS + 4 * e) = *(const f32x4*)(ggw + 4 * e);
    LDS_BARRIER();
    for (int tile = t.bid; tile < M / 16; tile += t.G) {
        const int r0 = tile * 16; int slo, shi; seg_bounds(r0, slo, shi);
        {
            const int tt = t.tid >> 5, r = t.tid & 31, row = r0 + tt;
            const bf16_t* up = U + (size_t)row * NU; const bool hp = row - 1 >= slo, hn = row + 1 < shi;
#pragma unroll
            for (int q = 0; q < 3; ++q) { const int col = U_RLWF + q * 32 + r, mi = col - U_RW;
                const float u = ldbf(up + col), pv = ld_or0(up + col - NU, up + col, hp), nv = ld_or0(up + col + NU, up + col, hn);
                const float s = u + mu[mi] * (pv - u) + mu[928 + mi] * (nv - u);
                LOW[tt * 128 + q * 32 + r] = q < 2 ? ftanh(s) : s; }
            LOW[tt * 128 + 96 + r] = ldbf(up + U_GLF + r);
        }
        LDS_BARRIER();
        {
            const int c = t.tid & 255, tt0 = (t.tid >> 8) * 8;
            float lu[10][3];
#pragma unroll
            for (int jj = 0; jj < 10; ++jj) { const int row = r0 + tt0 + jj - 1; const bool ok = row >= slo && row < shi; const bf16_t* up = U + (size_t)(ok ? row : r0) * NU;
                const float x0 = ldbf(up + U_RR + c), x1 = ldbf(up + U_RK + c), x2 = ldbf(up + U_RV + c); lu[jj][0] = ok ? x0 : 0.f; lu[jj][1] = ok ? x1 : 0.f; lu[jj][2] = ok ? x2 : 0.f; }
            float aa[8], af[8], ab[8];
#pragma unroll
            for (int j = 0; j < 8; ++j) { aa[j] = a0[c]; af[j] = w0[c]; ab[j] = w0[256 + c]; }
#pragma unroll 2
            for (int r4 = 0; r4 < 8; ++r4) { float wa[4], wf[4], wb[4];
#pragma unroll
                for (int q = 0; q < 4; ++q) { wa[q] = A2S[(4 * r4 + q) * 256 + c]; wf[q] = W2S[(4 * r4 + q) * 256 + c]; wb[q] = W2S[(32 + 4 * r4 + q) * 256 + c]; }
#pragma unroll
                for (int j = 0; j < 8; ++j) { const LAS float* lw = LOW + (tt0 + j) * 128;
                    const f32x4 la = *(const LAS f32x4*)(lw + 64 + 4 * r4), lf = *(const LAS f32x4*)(lw + 4 * r4), lb = *(const LAS f32x4*)(lw + 32 + 4 * r4);
#pragma unroll
                    for (int q = 0; q < 4; ++q) { aa[j] += la[q] * wa[q]; af[j] += lf[q] * wf[q]; ab[j] += lb[q] * wb[q]; } } }
            const float m0r = mu[c], m1r = mu[928 + c], m0k = mu[256 + c], m1k = mu[928 + 256 + c], m0v = mu[512 + c], m1v = mu[928 + 512 + c];
            const float kkg = rkk[c], kag = rka[c];
#pragma unroll
            for (int j = 0; j < 8; ++j) { const int row = r0 + tt0 + j;
                float u, pv, nv;
                u = lu[j + 1][0]; pv = lu[j][0]; nv = lu[j + 2][0]; const float rs = u + m0r * (pv - u) + m1r * (nv - u);
                u = lu[j + 1][1]; pv = lu[j][1]; nv = lu[j + 2][1]; const float ks = u + m0k * (pv - u) + m1k * (nv - u);
                u = lu[j + 1][2]; pv = lu[j][2]; nv = lu[j + 2][2]; const float vs = u + m0v * (pv - u) + m1v * (nv - u);
                const float av = sigmoidf_(aa[j]);
                const float wfv = fexp(-0.606531f * sigmoidf_(af[j])), wbv = fexp(-0.606531f * sigmoidf_(ab[j]));
                const float kr = ks * kkg; const float ssq = wave_sum(kr * kr); const float kk = kr * (frsq(ssq + 1e-12f));
                const float kf = ks * (1.0f + (av - 1.0f) * kag);
                const size_t o = (size_t)row * 256 + c, P = (size_t)M * 256;
                stbf(RW7 + o, rs); stbf(RW7 + P + o, kf); stbf(RW7 + 2 * P + o, vs); stbf(RW7 + 3 * P + o, kk); stbf(RW7 + 4 * P + o, kk * av); stbf(RW7 + 5 * P + o, wfv); stbf(RW7 + 6 * P + o, wbv); }
        }
        {
            const int j = t.tid & 127, dq = t.tid >> 7, dir = dq & 1, tt0 = (dq >> 1) * 8;
            float acc[8];
#pragma unroll
            for (int q = 0; q < 8; ++q) acc[q] = ggb[dir * 128 + j];
#pragma unroll
            for (int r4 = 0; r4 < 4; ++r4) { float w[4];
#pragma unroll
                for (int q2 = 0; q2 < 4; ++q2) w[q2] = GWS[(dir * 16 + 4 * r4 + q2) * 128 + j];
#pragma unroll
                for (int q = 0; q < 8; ++q) { const f32x4 lv = *(const LAS f32x4*)(LOW + (tt0 + q) * 128 + 96 + dir * 16 + 4 * r4);
                    acc[q] += (lv[0] * w[0] + lv[1] * w[1]) + (lv[2] * w[2] + lv[3] * w[3]); } }
#pragma unroll
            for (int q = 0; q < 8; ++q) GG[((size_t)dir * M + r0 + tt0 + q) * 128 + j] = logsigmoidf_(acc[q]) * (1.0f / 16.0f);
        }
        {
#pragma unroll
            for (int cc = 0; cc < 2; ++cc) { const int col = t.tid + cc * 512; const bf16_t* up = U + U_SXBC + col;
                const float c0 = cw[col], c1 = cw[1024 + col], c2 = cw[2048 + col], c3 = cw[3072 + col], bb = cb[col];
                const bf16_t* uc = up + (size_t)r0 * NU;
                float lc_[19];
#pragma unroll
                for (int q = 0; q < 19; ++q) lc_[q] = ld_or0(uc + (ptrdiff_t)(q - 2) * NU, uc, (r0 + q - 2 >= slo) && (r0 + q - 2 < shi));
                float um2 = lc_[0], um1 = lc_[1], u0 = lc_[2];
#pragma unroll
                for (int q = 0; q < 16; ++q) { const int row = r0 + q; const float up1 = lc_[q + 3];
                    const float y = c0 * um2 + c1 * um1 + c2 * u0 + c3 * up1 + bb;
                    stbf(SXBC + (size_t)row * 1024 + col, siluf_(y)); um2 = um1; um1 = u0; u0 = up1; } }
        }
        if (t.tid < 256) { const int tt = t.tid >> 4, j = t.tid & 15, row = r0 + tt; SDT[(size_t)row * 16 + j] = softplusf_(ldbf(U + (size_t)row * NU + U_SDT + j) + dtb[j]); }
        LDS_BARRIER();
    }
}

__device__ __forceinline__ int chain_row(int b, int dir, int s) {
    if (s < CTX) return ML + b * CTX + (dir ? CTX - 1 - s : s);
    const int tt = s - CTX; return b * SEQ + (dir ? SEQ - 1 - tt : tt);
}

__device__ __forceinline__ f32x4 mma16(f32x4 acc, const LAS bf16_t* A, int lda, const LAS bf16_t* Bt, int ldb, int K, int lane) {
    const int r = lane & 15, kq = (lane >> 4) * 8;
    for (int k0 = 0; k0 < K; k0 += 32) {
        const bf16x8 av = *(const LAS bf16x8*)(A + r * lda + k0 + kq), bv = *(const LAS bf16x8*)(Bt + r * ldb + k0 + kq);
        acc = __builtin_amdgcn_mfma_f32_16x16x32_bf16(av, bv, acc, 0, 0, 0);
    }
    return acc;
}
__device__ __forceinline__ float wave_incl_scan(float v, int lane) {
#pragma unroll
    for (int o = 1; o < 64; o <<= 1) { const float u = __shfl_up(v, o); if (lane >= o) v += u; }
    return v;
}
__device__ __forceinline__ int rc_row0(int b, int c) { return c < CTXC ? ML + b * CTX + 64 * c : b * SEQ + 64 * (c - CTXC); }
__device__ __forceinline__ int rc_chain_pos(int c, int dir) { return dir == 0 ? c : (c < CTXC ? CTXC - 1 - c : CTXC + (LATC - 1 - (c - CTXC))); }

constexpr int SSD_UNITS = BATCH * 2 * NRC;
__device__ __forceinline__ void ssd_a1_unit(const Args& a, const Tc& t, int l, int u) {
    const bf16_t* SXBC = (const bf16_t*)(a.ws + WS_SXBC); const float* SDT = (const float*)(a.ws + WS_SDT);
    bf16_t* SZ = (bf16_t*)(a.ws + WS_SZ); float* SDEC = (float*)(a.ws + WS_SDEC);
    const int c = u % NRC, g = (u / NRC) & 1, b = u / (2 * NRC), row0 = rc_row0(b, c);
    LAS bf16_t* BT = (LAS bf16_t*)t.lds;
    LAS bf16_t* XT = BT + 128 * 72 + t.wave * 64 * 72;
    for (int e = t.tid; e < 64 * 32; e += NTHREADS) { const int rho = e >> 5, n4 = (e & 31) * 4;
        const f32x4 v = ldbf4(SXBC + (size_t)(row0 + rho) * 1024 + 512 + g * 128 + n4);
#pragma unroll
        for (int q = 0; q < 4; ++q) BT[(n4 + q) * 72 + rho] = (bf16_t)f2bf(v[q]); }
    const int hh = t.wave & 3, dir = t.wave >> 2, h = 4 * g + hh, chain = (b * 8 + h) * 2 + dir, cc = rc_chain_pos(c, dir);
    const float a_neg = -fexp(a.in[I_SALOG][(size_t)l * 16 + dir * 8 + h]);
    const float dtv = SDT[(size_t)(row0 + t.lane) * 16 + dir * 8 + h], av = dtv * a_neg;
    const float pre = wave_incl_scan(av, t.lane), tot = __shfl(pre, 63);
    const float wgt = dir == 0 ? fexp(tot - pre) : fexp(pre - av);
    const float sc = dtv * wgt;
#pragma unroll
    for (int p4 = 0; p4 < 16; ++p4) { const f32x4 x = ldbf4(SXBC + (size_t)(row0 + t.lane) * 1024 + h * 64 + p4 * 4);
#pragma unroll
        for (int q = 0; q < 4; ++q) XT[(p4 * 4 + q) * 72 + t.lane] = (bf16_t)f2bf(x[q] * sc); }
    if (t.lane == 0) SDEC[(size_t)chain * NRC + cc] = fexp(tot);
    LDS_BARRIER();
    bf16_t* zb = SZ + ((size_t)chain * NRC + cc) * 64 * 128;
#pragma unroll 1
    for (int pt = 0; pt < 4; ++pt)
#pragma unroll 2
        for (int nt = 0; nt < 8; ++nt) { f32x4 acc = {0.f, 0.f, 0.f, 0.f};
            acc = mma16(acc, XT + pt * 16 * 72, 72, BT + nt * 16 * 72, 72, 64, t.lane);
#pragma unroll
            for (int r = 0; r < 4; ++r) zb[(size_t)(16 * pt + 4 * (t.lane >> 4) + r) * 128 + 16 * nt + (t.lane & 15)] = (bf16_t)f2bf(acc[r]); }
    LDS_BARRIER();
}
constexpr int CAR_DEP = 4;
__device__ __forceinline__ void ssd_b_carry(const Args& a, const Tc& t, int wg, int nwg) {
    const bf16_t* SZ = (const bf16_t*)(a.ws + WS_SZ); const float* SDEC = (const float*)(a.ws + WS_SDEC); bf16_t* SST = (bf16_t*)(a.ws + WS_SST);
    static_assert(NRC % 4 == 0, "carry unroll");
    constexpr int NG = NRC / 4;
    for (int idx = wg * NTHREADS + t.tid; idx < BATCH * 16 * 2048; idx += nwg * NTHREADS) {
        const int chain = idx >> 11, e4 = (idx & 2047) * 4;
        const bf16_t* zc = SZ + (size_t)chain * NRC * 8192 + e4; bf16_t* sc = SST + (size_t)chain * NRC * 8192 + e4; const float* dc = SDEC + (size_t)chain * NRC;
        f32x4 s = {0.f, 0.f, 0.f, 0.f};
        u32x2 z[CAR_DEP][4]; float d[CAR_DEP][4];
#pragma unroll
        for (int g = 0; g < CAR_DEP - 1 && g < NG; ++g)
#pragma unroll
            for (int q = 0; q < 4; ++q) { z[g][q] = *(const u32x2*)(zc + (size_t)(4 * g + q) * 8192); d[g][q] = dc[4 * g + q]; }
#pragma unroll
        for (int g = 0; g < NG; ++g) {
            if (g + CAR_DEP - 1 < NG) {
#pragma unroll
                for (int q = 0; q < 4; ++q) { z[(g + CAR_DEP - 1) % CAR_DEP][q] = *(const u32x2*)(zc + (size_t)(4 * (g + CAR_DEP - 1) + q) * 8192); d[(g + CAR_DEP - 1) % CAR_DEP][q] = dc[4 * (g + CAR_DEP - 1) + q]; } }
#pragma unroll
            for (int q = 0; q < 4; ++q) { u32x2 w; w.x = pk2(s[0], s[1]); w.y = pk2(s[2], s[3]); *(u32x2*)(sc + (size_t)(4 * g + q) * 8192) = w;
                const u32x2 zw = z[g % CAR_DEP][q]; s = s * d[g % CAR_DEP][q] + (f32x4){bf_lo(zw.x), bf_hi(zw.x), bf_lo(zw.y), bf_hi(zw.y)}; }
        }
    }
}
__device__ __forceinline__ void ssd_c_unit(const Args& a, const Tc& t, int l, int u) {
    const bf16_t* SXBC = (const bf16_t*)(a.ws + WS_SXBC); const float* SDT = (const float*)(a.ws + WS_SDT);
    const bf16_t* SST = (const bf16_t*)(a.ws + WS_SST); bf16_t* OS = (bf16_t*)(a.ws + WS_OS);
    const int c = u % NRC, g = (u / NRC) & 1, b = u / (2 * NRC), row0 = rc_row0(b, c);
    LAS bf16_t* CM = (LAS bf16_t*)t.lds;
    LAS bf16_t* BM = CM + 64 * 136;
    LAS bf16_t* GS = BM + 64 * 136;
    LAS bf16_t* XT = GS + 64 * 72 + t.wave * 64 * 72;
    LAS float* PRE = (LAS float*)(GS + 64 * 72 + 8 * 64 * 72) + t.wave * 128;
    for (int e = t.tid; e < 64 * 32; e += NTHREADS) { const int rho = e >> 5, n4 = (e & 31) * 4;
        const f32x4 bv = ldbf4(SXBC + (size_t)(row0 + rho) * 1024 + 512 + g * 128 + n4), cv = ldbf4(SXBC + (size_t)(row0 + rho) * 1024 + 768 + g * 128 + n4);
        u32x2 wb, wc; wb.x = pk2(bv[0], bv[1]); wb.y = pk2(bv[2], bv[3]); wc.x = pk2(cv[0], cv[1]); wc.y = pk2(cv[2], cv[3]);
        *(LAS u32x2*)(BM + rho * 136 + n4) = wb; *(LAS u32x2*)(CM + rho * 136 + n4) = wc; }
    const int hh = t.wave & 3, dir = t.wave >> 2, h = 4 * g + hh, chain = (b * 8 + h) * 2 + dir, cc = rc_chain_pos(c, dir);
    const bf16_t* sb = SST + ((size_t)chain * NRC + cc) * 8192;
    bf16x8 sf[4][4];
#pragma unroll
    for (int pt = 0; pt < 4; ++pt)
#pragma unroll
        for (int ks = 0; ks < 4; ++ks) sf[pt][ks] = *(const bf16x8*)(sb + (size_t)(16 * pt + (t.lane & 15)) * 128 + 32 * ks + 8 * (t.lane >> 4));
    const float a_neg = -fexp(a.in[I_SALOG][(size_t)l * 16 + dir * 8 + h]);
    const float dtv = SDT[(size_t)(row0 + t.lane) * 16 + dir * 8 + h], av = dtv * a_neg;
    const float pre = wave_incl_scan(av, t.lane), tot = __shfl(pre, 63);
    PRE[t.lane] = pre; PRE[64 + t.lane] = pre - av;
#pragma unroll
    for (int p4 = 0; p4 < 16; ++p4) { const f32x4 x = ldbf4(SXBC + (size_t)(row0 + t.lane) * 1024 + h * 64 + p4 * 4);
#pragma unroll
        for (int q = 0; q < 4; ++q) XT[(p4 * 4 + q) * 72 + t.lane] = (bf16_t)f2bf(x[q] * dtv); }
    LDS_BARRIER();
#pragma unroll
    for (int q = 0; q < 2; ++q) { const int ti = t.wave * 2 + q, it = ti >> 2, jt = ti & 3; f32x4 acc = {0.f, 0.f, 0.f, 0.f};
        acc = mma16(acc, CM + it * 16 * 136, 136, BM + jt * 16 * 136, 136, 128, t.lane);
#pragma unroll
        for (int r = 0; r < 4; ++r) GS[(16 * it + 4 * (t.lane >> 4) + r) * 72 + 16 * jt + (t.lane & 15)] = (bf16_t)f2bf(acc[r]); }
    LDS_BARRIER();
#pragma unroll 1
    for (int it = 0; it < 4; ++it) {
        f32x4 acc[4], acc2[4];
#pragma unroll
        for (int pt = 0; pt < 4; ++pt) { acc[pt] = (f32x4){0.f, 0.f, 0.f, 0.f}; acc2[pt] = (f32x4){0.f, 0.f, 0.f, 0.f}; }
        const int rho = 16 * it + (t.lane & 15);
        const float prer = PRE[rho], exr = PRE[64 + rho];
#pragma unroll
        for (int ks = 0; ks < 2; ++ks) {
            const int rp0 = 32 * ks + 8 * (t.lane >> 4);
            const bf16x8 g8 = *(const LAS bf16x8*)(GS + rho * 72 + rp0);
            bf16x8 af;
#pragma unroll
            for (int e = 0; e < 8; ++e) { const int rp = rp0 + e; const float gv = __uint_as_float(((unsigned)(unsigned short)g8[e]) << 16);
                float f;
                if (dir == 0) f = rp <= rho ? fexp(prer - PRE[rp]) : 0.f; else f = rp >= rho ? fexp(PRE[64 + rp] - exr) : 0.f;
                af[e] = (short)f2bf(gv * f); }
#pragma unroll
            for (int pt = 0; pt < 4; ++pt) { const bf16x8 bfr = *(const LAS bf16x8*)(XT + (16 * pt + (t.lane & 15)) * 72 + rp0); acc[pt] = __builtin_amdgcn_mfma_f32_16x16x32_bf16(af, bfr, acc[pt], 0, 0, 0); }
        }
#pragma unroll
        for (int ks = 0; ks < 4; ++ks) {
            const bf16x8 cf = *(const LAS bf16x8*)(CM + rho * 136 + 32 * ks + 8 * (t.lane >> 4));
#pragma unroll
            for (int pt = 0; pt < 4; ++pt) acc2[pt] = __builtin_amdgcn_mfma_f32_16x16x32_bf16(cf, sf[pt][ks], acc2[pt], 0, 0, 0);
        }
#pragma unroll
        for (int r = 0; r < 4; ++r) { const int ro = 16 * it + 4 * (t.lane >> 4) + r; const float f = dir == 0 ? fexp(PRE[ro]) : fexp(tot - PRE[64 + ro]);
#pragma unroll
            for (int pt = 0; pt < 4; ++pt) stbf(OS + ((size_t)dir * M + row0 + ro) * 512 + h * 64 + 16 * pt + (t.lane & 15), acc[pt][r] + f * acc2[pt][r]); }
    }
    LDS_BARRIER();
}


constexpr int RW_UNITS = BATCH * 8 * NCK, RW_PAIRS = RW_UNITS / 2, RWA_HALF = 57344;
static_assert(RW_UNITS % 2 == 0, "unit pairs");
__device__ __forceinline__ void rwkv_a_all(const Args& a, const Tc& t) {
    const bf16_t* RW7 = (const bf16_t*)(a.ws + WS_RW7);
    const size_t P7 = (size_t)M * 256;
    const int half = t.tid >> 8, ht = t.tid & 255, hw = t.wave & 3, hq = t.lane >> 4, lc = t.lane & 15;
    LAS unsigned char* hb = t.lds + half * RWA_HALF;
    LAS float* RAW = (LAS float*)hb;
    LAS float* RtF = RAW;
    LAS float* KhF = RAW + 1024;
    LAS float* AtF = RAW + 3 * 1024;
    LAS float* Uf = RAW + 6 * 1024;
    LAS float* Qkf = Uf + 256;
    LAS float* Nuf = Qkf + 256;
    LAS float* WTs = Nuf + 256;
    LAS bf16_t* BtN = (LAS bf16_t*)(WTs + 64);
    LAS bf16_t* KtN = BtN + 16 * 72; LAS bf16_t* AtN = KtN + 16 * 72; LAS bf16_t* RtN = AtN + 16 * 72;
    LAS bf16_t* KpT = BtN;
    LAS bf16_t* BhT = RtN + 16 * 72;
    LAS bf16_t* VT = BhT + 64 * 40; LAS bf16_t* ApS = VT + 64 * 40;
    LAS bf16_t* NpS = ApS + 64 * 40;
    LAS bf16_t* QbT = NpS + 16 * 40;
    f32x4 pf[6];
#define RWA_LOAD(pair) do { const int u_ = 2 * (pair) + half, ck_ = u_ % NCK, ch_ = u_ / NCK, dir_ = ch_ & 1, h_ = (ch_ >> 1) & 3, b_ = ch_ >> 3; \
        _Pragma("unroll") for (int q = 0; q < 6; ++q) { const int e = ht + 256 * q, vec = e >> 8, rem = e & 255, i = rem >> 4, c4 = rem & 15; \
            const int row = chain_row(b_, dir_, ck_ * RKT + i); const int vs = vec < 5 ? vec : 5 + dir_; \
            pf[q] = ldbf4(RW7 + (size_t)vs * P7 + (size_t)row * 256 + h_ * 64 + c4 * 4); } } while (0)
    if (t.bid < RW_PAIRS) RWA_LOAD(t.bid);
    for (int pair = t.bid; pair < RW_PAIRS; pair += t.G) {
        const int u = 2 * pair + half, ck = u % NCK, chain = u / NCK;
        unsigned char* rec = a.ws + WS_RK + ((size_t)chain * NCK + ck) * RK_BYTES;
#pragma unroll
        for (int q = 0; q < 6; ++q) *(LAS f32x4*)(RAW + (ht + 256 * q) * 4) = pf[q];
        for (int e = ht; e < 3 * 64 * 8; e += 256) { const int arr = e >> 9, rem = e & 511, r = rem >> 3, c2 = rem & 7; *(LAS unsigned*)(BhT + arr * 64 * 40 + r * 40 + 16 + 2 * c2) = 0u; }
        { const int arr = ht >> 7, rem = ht & 127, r = rem >> 3, c2 = rem & 7; *(LAS unsigned*)(NpS + arr * 16 * 40 + r * 40 + 16 + 2 * c2) = 0u; }
        LDS_BARRIER();
        if (pair + t.G < RW_PAIRS) RWA_LOAD(pair + t.G);
        { const int j = ht & 63, ig = ht >> 6; float wc = 1.f, wT = 1.f;
#pragma unroll
            for (int i = 0; i < 16; ++i) { const float wv = RAW[5 * 1024 + i * 64 + j]; wT *= wv; if (i < 4 * ig) wc *= wv; }
            if (ig == 0) WTs[j] = wT;
            float bh4[4], v4[4];
#pragma unroll
            for (int q = 0; q < 4; ++q) { const int i = 4 * ig + q; const float wp = wc; wc *= RAW[5 * 1024 + i * 64 + j]; const float iw = frcp(wc);
                const float at = RAW[3 * 1024 + i * 64 + j] * wp, rt = RAW[i * 64 + j] * wc, bt = RAW[4 * 1024 + i * 64 + j] * iw, kt = RAW[1024 + i * 64 + j] * iw;
                AtN[i * 72 + j] = (bf16_t)f2bf(at); RtN[i * 72 + j] = (bf16_t)f2bf(rt); BtN[i * 72 + j] = (bf16_t)f2bf(bt); KtN[i * 72 + j] = (bf16_t)f2bf(kt);
                bh4[q] = bt * wT; v4[q] = RAW[2 * 1024 + i * 64 + j];
                KhF[i * 64 + j] = kt * wT; RtF[i * 64 + j] = rt; AtF[i * 64 + j] = at; }
            { u32x2 wb, wv; wb.x = pk2(bh4[0], bh4[1]); wb.y = pk2(bh4[2], bh4[3]); wv.x = pk2(v4[0], v4[1]); wv.y = pk2(v4[2], v4[3]);
              *(LAS u32x2*)(BhT + j * 40 + 4 * ig) = wb; *(LAS u32x2*)(VT + j * 40 + 4 * ig) = wv; } }
        LDS_BARRIER();
        { f32x4 acc = {0.f, 0.f, 0.f, 0.f};
            acc = mma16(acc, (hw == 0 || hw == 3) ? BtN : KtN, 72, hw < 2 ? AtN : RtN, 72, 64, t.lane);
            f32x4 mv;
#pragma unroll
            for (int r = 0; r < 4; ++r) { const int s_ = 4 * hq + r, t_ = lc; const bool keep = hw < 2 ? (s_ < t_) : (s_ <= t_); mv[r] = keep ? acc[r] : 0.f; }
            if (hw == 0) *(LAS f32x4*)(Uf + lc * 16 + 4 * hq) = mv;
            else if (hw == 3) { u32x2 w; w.x = pk2(mv[0], mv[1]); w.y = pk2(mv[2], mv[3]); *(LAS u32x2*)(QbT + lc * 40 + 4 * hq) = w; }
            else {
#pragma unroll
                for (int r = 0; r < 4; ++r) { const int s_ = 4 * hq + r; if (hw == 1) Nuf[s_ * 16 + lc] = mv[r]; else Qkf[s_ * 16 + lc] = mv[r]; } } }
        LDS_BARRIER();
        if (ht < 80) { float x[16]; const bool isA = ht < 64; const int rr = isA ? ht : ht - 64;
#pragma unroll
            for (int tt = 0; tt < 16; ++tt) { float acc = isA ? AtF[tt * 64 + rr] : Nuf[rr * 16 + tt];
                f32x4 uc[4];
#pragma unroll
                for (int q = 0; q < 4; ++q) uc[q] = *(const LAS f32x4*)(Uf + tt * 16 + 4 * q);
#pragma unroll
                for (int s_ = 0; s_ < 16; ++s_) if (s_ < tt) acc -= x[s_] * uc[s_ >> 2][s_ & 3];
                x[tt] = acc; }
            u32x4 w0, w1; w0.x = pk2(x[0], x[1]); w0.y = pk2(x[2], x[3]); w0.z = pk2(x[4], x[5]); w0.w = pk2(x[6], x[7]); w1.x = pk2(x[8], x[9]); w1.y = pk2(x[10], x[11]); w1.z = pk2(x[12], x[13]); w1.w = pk2(x[14], x[15]);
            LAS bf16_t* xr = (isA ? ApS : NpS) + rr * 40; *(LAS u32x4*)xr = w0; *(LAS u32x4*)(xr + 8) = w1; }
        else if (ht >= 128) { for (int e = ht - 128; e < 64 * 8; e += 128) { const int r = e >> 3, c2 = e & 7; *(LAS unsigned*)(KpT + r * 40 + 16 + 2 * c2) = 0u; } }
        LDS_BARRIER();
        for (int ti = hw; ti < 25; ti += 4) {
            f32x4 acc = {0.f, 0.f, 0.f, 0.f};
            if (ti < 16) { const int jt = ti >> 2, jt2 = ti & 3;
                acc = mma16(acc, ApS + jt * 16 * 40, 40, BhT + jt2 * 16 * 40, 40, 32, t.lane);
                unsigned short o[4];
#pragma unroll
                for (int r = 0; r < 4; ++r) { const int j = 16 * jt + 4 * hq + r, j2 = 16 * jt2 + lc; const float dg = (j == j2) ? WTs[j] : 0.f; o[r] = (unsigned short)f2bf(dg - acc[r]); }
                u32x2 w; w.x = o[0] | ((unsigned)o[1] << 16); w.y = o[2] | ((unsigned)o[3] << 16);
                *(u32x2*)(rec + RK_PA + ((size_t)((jt2 * 2 + (jt >> 1)) * 64 + t.lane) * 8 + 4 * (jt & 1)) * 2) = w;
            } else if (ti < 20) { const int jt = ti - 16;
                acc = mma16(acc, ApS + jt * 16 * 40, 40, QbT, 40, 32, t.lane);
                unsigned short o[4];
                const f32x4 rt4 = *(const LAS f32x4*)(RtF + lc * 64 + 16 * jt + 4 * hq);
#pragma unroll
                for (int r = 0; r < 4; ++r) o[r] = (unsigned short)f2bf(rt4[r] - acc[r]);
                u32x2 w; w.x = o[0] | ((unsigned)o[1] << 16); w.y = o[2] | ((unsigned)o[3] << 16);
                *(u32x2*)(rec + RK_RA + ((size_t)(((jt >> 1) * 64 + t.lane) * 8 + 4 * (jt & 1))) * 2) = w;
            } else if (ti == 20) {
                acc = mma16(acc, NpS, 40, QbT, 40, 32, t.lane);
                unsigned short o[4];
#pragma unroll
                for (int r = 0; r < 4; ++r) o[r] = (unsigned short)f2bf(Qkf[(4 * hq + r) * 16 + lc] - acc[r]);
                u32x2 w; w.x = o[0] | ((unsigned)o[1] << 16); w.y = o[2] | ((unsigned)o[3] << 16);
                *(u32x2*)(rec + RK_QA + ((size_t)((lc + 16 * (hq >> 1)) * 8 + 4 * (hq & 1))) * 2) = w;
                u32x2 z; z.x = 0u; z.y = 0u; *(u32x2*)(rec + RK_QA + ((size_t)((32 + lc + 16 * (hq >> 1)) * 8 + 4 * (hq & 1))) * 2) = z;
            } else { const int jt2 = ti - 21;
                acc = mma16(acc, NpS, 40, BhT + jt2 * 16 * 40, 40, 32, t.lane);
                float kp[4];
#pragma unroll
                for (int r = 0; r < 4; ++r) { const int s_ = 4 * hq + r, j2 = 16 * jt2 + lc; kp[r] = KhF[s_ * 64 + j2] - acc[r]; }
                u32x2 w; w.x = pk2(kp[0], kp[1]); w.y = pk2(kp[2], kp[3]); *(LAS u32x2*)(KpT + (16 * jt2 + lc) * 40 + 4 * hq) = w;
            }
        }
        for (int e = ht; e < 4 * 64 * 4; e += 256) { const int it = e >> 8, rem = e & 255, ln = rem >> 2, e2 = (rem & 3) * 2, hp = ln >> 4, i2 = 16 * it + (ln & 15);
            unsigned w = 0u; if (hp < 2) { const int s0 = 8 * hp + e2; w = f2bf(RAW[2 * 1024 + s0 * 64 + i2]) | (f2bf(RAW[2 * 1024 + (s0 + 1) * 64 + i2]) << 16); }
            *(unsigned*)(rec + RK_VB + ((size_t)((it * 64 + ln) * 8 + e2)) * 2) = w; }
        LDS_BARRIER();
#pragma unroll
        for (int q = 0; q < 4; ++q) { const int ti = hw * 4 + q, rt = ti >> 2, it = ti & 3; f32x4 acc = {0.f, 0.f, 0.f, 0.f};
            acc = mma16(acc, KpT + rt * 16 * 40, 40, VT + it * 16 * 40, 40, 32, t.lane);
            u32x2 zw; zw.x = pk2(acc[0], acc[1]); zw.y = pk2(acc[2], acc[3]);
            *(u32x2*)(rec + RK_ZC + ((size_t)((rt * 4 + it) * 64 + t.lane)) * 8) = zw; }
        LDS_BARRIER();
    }
#undef RWA_LOAD
}
constexpr int RKB_TASKS = BATCH * 8 * 2, RKB_NS = 7, RKB_D = 5, RKB_SLOT = 17408;
__device__ __forceinline__ void rkb_piece(const unsigned char* rp, int p, int w0, int lane, LAS unsigned char* slot) {
    const unsigned char* src;
    if (p < 8) src = rp + RK_PA + (size_t)(p * 64 + lane) * 16; else if (p < 10) src = rp + RK_RA + (size_t)((p - 8) * 64 + lane) * 16; else if (p == 10) src = rp + RK_QA + (size_t)lane * 16;
    else if (p < 15) src = rp + RK_ZC + (size_t)(((p - 11) * 4 + w0 + (lane >> 5)) * 64) * 8 + (size_t)(lane & 31) * 16;
    else src = rp + RK_VB + (size_t)((w0 + (p - 15)) * 64 + lane) * 16;
    __builtin_amdgcn_global_load_lds((const unsigned*)src, (LAS unsigned*)(slot + p * 1024), 16, 0, 0);
}
__device__ __forceinline__ void rkb_issue(const unsigned char* rec, int ck, int w0, int lw, int lane, LAS unsigned char* ring) {
    const unsigned char* rp = rec + (size_t)ck * RK_BYTES; LAS unsigned char* slot = ring + (ck % RKB_NS) * RKB_SLOT;
#pragma unroll
    for (int q = 0; q < 4; ++q) rkb_piece(rp, 4 * lw + q, w0, lane, slot);
    if (lw == 0) rkb_piece(rp, 16, w0, lane, slot);
}
__device__ __forceinline__ void rwkv_b_task(const Args& a, const Tc& t, int task) {
    bf16_t* OR = (bf16_t*)(a.ws + WS_OR);
    const int hb = task & 1, chain = task >> 1, dir = chain & 1, h = (chain >> 1) & 3, b = chain >> 3, hq = t.lane >> 4, lc = t.lane & 15;
    const int w0 = 2 * hb, w = w0 + (t.wave & 1);
    const unsigned char* rec = a.ws + WS_RK + (size_t)chain * NCK * RK_BYTES;
    LAS unsigned char* ring = t.lds;
    const bool loader = (t.wave >= 2 && t.wave <= 5); const int lw = t.wave - 2;
    if (loader) {
#pragma unroll 1
        for (int ck = 0; ck < RKB_D; ++ck) rkb_issue(rec, ck, w0, lw, t.lane, ring);
    }
    f32x4 T[4];
#pragma unroll
    for (int rt = 0; rt < 4; ++rt) T[rt] = (f32x4){0.f, 0.f, 0.f, 0.f};
#pragma unroll 1
    for (int ck = 0; ck < NCK; ++ck) {
        if (loader) {
            if (ck + RKB_D <= NCK) { if (lw == 0) WAIT_V(20); else WAIT_V(16); } else WAIT_V(0);
        }
        __builtin_amdgcn_s_barrier();
        if (loader) { if (ck + RKB_D < NCK) rkb_issue(rec, ck + RKB_D, w0, lw, t.lane, ring); }
        else if (t.wave < 2) {
            const LAS unsigned char* slot = ring + (ck % RKB_NS) * RKB_SLOT;
            bf16x8 pa[4][2], ra[2], qa, vb; f32x4 zc[4]; u32x2 zraw[4];
#pragma unroll
            for (int rt = 0; rt < 4; ++rt) {
#pragma unroll
                for (int ks = 0; ks < 2; ++ks) pa[rt][ks] = *(const LAS bf16x8*)(slot + ((rt * 2 + ks) * 64 + t.lane) * 16);
                zraw[rt] = *(const LAS u32x2*)(slot + (11 + rt) * 1024 + t.wave * 512 + t.lane * 8); }
#pragma unroll
            for (int ks = 0; ks < 2; ++ks) ra[ks] = *(const LAS bf16x8*)(slot + ((8 + ks) * 64 + t.lane) * 16);
            qa = *(const LAS bf16x8*)(slot + (10 * 64 + t.lane) * 16); vb = *(const LAS bf16x8*)(slot + ((15 + t.wave) * 64 + t.lane) * 16);
            WAIT_L(0); __builtin_amdgcn_sched_barrier(0);
#pragma unroll
            for (int rt = 0; rt < 4; ++rt) { const u32x2 zw = zraw[rt]; zc[rt] = (f32x4){bf_lo(zw.x), bf_hi(zw.x), bf_lo(zw.y), bf_hi(zw.y)}; }
            bf16x8 bfr[2];
#pragma unroll
            for (int ks = 0; ks < 2; ++ks) { u32x4 wv; wv.x = pk2(T[2 * ks][0], T[2 * ks][1]); wv.y = pk2(T[2 * ks][2], T[2 * ks][3]); wv.z = pk2(T[2 * ks + 1][0], T[2 * ks + 1][1]); wv.w = pk2(T[2 * ks + 1][2], T[2 * ks + 1][3]);
                bfr[ks] = __builtin_bit_cast(bf16x8, wv); }
            f32x4 o = {0.f, 0.f, 0.f, 0.f};
            o = __builtin_amdgcn_mfma_f32_16x16x32_bf16(bfr[0], ra[0], o, 0, 0, 0);
            o = __builtin_amdgcn_mfma_f32_16x16x32_bf16(bfr[1], ra[1], o, 0, 0, 0);
            o = __builtin_amdgcn_mfma_f32_16x16x32_bf16(vb, qa, o, 0, 0, 0);
#pragma unroll
            for (int rt = 0; rt < 4; ++rt) { f32x4 n = __builtin_amdgcn_mfma_f32_16x16x32_bf16(pa[rt][0], bfr[0], zc[rt], 0, 0, 0); T[rt] = __builtin_amdgcn_mfma_f32_16x16x32_bf16(pa[rt][1], bfr[1], n, 0, 0, 0); }
            { const int row = chain_row(b, dir, ck * RKT + lc); u32x2 ow; ow.x = pk2(o[0], o[1]); ow.y = pk2(o[2], o[3]);
              *(u32x2*)(OR + ((size_t)dir * M + row) * 256 + h * 64 + 16 * w + 4 * hq) = ow; }
        }
    }
    __builtin_amdgcn_s_barrier();
}

constexpr int GLA_UNITS = BATCH * GNC;
__device__ __forceinline__ int gc_row0(int b, int c) { return c < GC_CTX ? ML + b * CTX + 32 * c : b * SEQ + 32 * (c - GC_CTX); }
__device__ __forceinline__ int gc_chain_pos(int c, int dir) { return dir == 0 ? c : (c < GC_CTX ? GC_CTX - 1 - c : GC_CTX + (GC_LAT - 1 - (c - GC_CTX))); }
__device__ __forceinline__ void gla_prefix(LAS float* PRE, int lane) {
    const int d = lane & 31, r0 = (lane >> 5) * 16; float run = 0.f;
#pragma unroll
    for (int i = 0; i < 16; ++i) { run += PRE[(r0 + i) * 33 + d]; PRE[(r0 + i) * 33 + d] = run; }
    WAVE_LDS_FENCE();
    if (lane >= 32) { const float add = PRE[15 * 33 + d];
#pragma unroll
        for (int i = 0; i < 16; ++i) PRE[(16 + i) * 33 + d] += add; }
    WAVE_LDS_FENCE();
}
__device__ __forceinline__ void gla_a1_unit(const Args& a, const Tc& t, int u) {
    const bf16_t* U = (const bf16_t*)(a.ws + WS_U); const float* GG = (const float*)(a.ws + WS_GG);
    float* GZ = (float*)(a.ws + WS_GZ); float* GDEC = (float*)(a.ws + WS_GDEC);
    const int c = u % GNC, b = u / GNC, row0 = gc_row0(b, c);
    const int h = t.wave & 3, dir = t.wave >> 2, chain = (b * 4 + h) * 2 + dir, cc = gc_chain_pos(c, dir);
    LAS float* PRE = (LAS float*)(t.lds + t.wave * 12288);
    LAS bf16_t* KT = (LAS bf16_t*)(PRE + 32 * 33 + 8);
    LAS bf16_t* VT = KT + 32 * 40;
    const int rho = t.lane & 31, hf = t.lane >> 5;
#pragma unroll
    for (int q = 0; q < 4; ++q) { const f32x4 g = *(const f32x4*)(GG + ((size_t)dir * M + row0 + rho) * 128 + h * 32 + hf * 16 + 4 * q);
#pragma unroll
        for (int e = 0; e < 4; ++e) PRE[rho * 33 + hf * 16 + 4 * q + e] = g[e]; }
    WAVE_LDS_FENCE();
    f32x4 graw[4];
#pragma unroll
    for (int q = 0; q < 4; ++q)
#pragma unroll
        for (int e = 0; e < 4; ++e) graw[q][e] = PRE[rho * 33 + hf * 16 + 4 * q + e];
    WAVE_LDS_FENCE();
    gla_prefix(PRE, t.lane);
#pragma unroll
    for (int q = 0; q < 4; ++q) { const f32x4 k = ldbf4(U + (size_t)(row0 + rho) * NU + U_GK + h * 32 + hf * 16 + 4 * q);
#pragma unroll
        for (int e = 0; e < 4; ++e) { const int d = hf * 16 + 4 * q + e; const float pre = PRE[rho * 33 + d], tot = PRE[31 * 33 + d];
            const float w = dir == 0 ? fexp(tot - pre) : fexp(pre - graw[q][e]);
            KT[d * 40 + rho] = (bf16_t)f2bf(k[e] * w); } }
#pragma unroll
    for (int q = 0; q < 8; ++q) { const f32x4 v = ldbf4(U + (size_t)(row0 + rho) * NU + U_GV + h * 64 + hf * 32 + 4 * q);
#pragma unroll
        for (int e = 0; e < 4; ++e) VT[(hf * 32 + 4 * q + e) * 40 + rho] = (bf16_t)f2bf(v[e]); }
    if (t.lane < 32) GDEC[((size_t)chain * GNC + cc) * 32 + t.lane] = fexp(PRE[31 * 33 + t.lane]);
    WAVE_LDS_FENCE();
    float* zb = GZ + ((size_t)chain * GNC + cc) * 2048;
#pragma unroll
    for (int vt = 0; vt < 4; ++vt)
#pragma unroll
        for (int dt = 0; dt < 2; ++dt) { f32x4 acc = {0.f, 0.f, 0.f, 0.f};
            acc = mma16(acc, VT + vt * 16 * 40, 40, KT + dt * 16 * 40, 40, 32, t.lane);
#pragma unroll
            for (int r = 0; r < 4; ++r) zb[(16 * vt + 4 * (t.lane >> 4) + r) * 32 + 16 * dt + (t.lane & 15)] = acc[r]; }
    WAVE_LDS_FENCE();
}
__device__ __forceinline__ void gla_b_carry(const Args& a, const Tc& t, int wg, int nwg) {
    const float* GZ = (const float*)(a.ws + WS_GZ); const float* GDEC = (const float*)(a.ws + WS_GDEC); bf16_t* GST = (bf16_t*)(a.ws + WS_GST);
    static_assert(GNC % 4 == 0, "carry unroll");
    constexpr int NG = GNC / 4, DEP = 3;
    for (int idx = (nwg - 1 - wg) * NTHREADS + t.tid; idx < BATCH * 8 * 512; idx += nwg * NTHREADS) {
        const int chain = idx >> 9, e4 = (idx & 511) * 4, d0 = e4 & 31;
        const float* zc = GZ + (size_t)chain * GNC * 2048 + e4; bf16_t* sc = GST + (size_t)chain * GNC * 2048 + e4; const float* dc = GDEC + (size_t)chain * GNC * 32 + d0;
        f32x4 s = {0.f, 0.f, 0.f, 0.f};
        f32x4 z[DEP][4], d[DEP][4];
#pragma unroll
        for (int g = 0; g < DEP - 1 && g < NG; ++g)
#pragma unroll
            for (int q = 0; q < 4; ++q) { z[g][q] = *(const f32x4*)(zc + (size_t)(4 * g + q) * 2048); d[g][q] = *(const f32x4*)(dc + (size_t)(4 * g + q) * 32); }
#pragma unroll
        for (int g = 0; g < NG; ++g) {
            if (g + DEP - 1 < NG) {
#pragma unroll
                for (int q = 0; q < 4; ++q) { z[(g + DEP - 1) % DEP][q] = *(const f32x4*)(zc + (size_t)(4 * (g + DEP - 1) + q) * 2048); d[(g + DEP - 1) % DEP][q] = *(const f32x4*)(dc + (size_t)(4 * (g + DEP - 1) + q) * 32); } }
#pragma unroll
            for (int q = 0; q < 4; ++q) { u32x2 w; w.x = pk2(s[0], s[1]); w.y = pk2(s[2], s[3]); *(u32x2*)(sc + (size_t)(4 * g + q) * 2048) = w; s = s * d[g % DEP][q] + z[g % DEP][q]; }
        }
    }
}
__device__ __forceinline__ void gla_c_unit(const Args& a, const Tc& t, int u) {
    const bf16_t* U = (const bf16_t*)(a.ws + WS_U); const float* GG = (const float*)(a.ws + WS_GG);
    const bf16_t* GST = (const bf16_t*)(a.ws + WS_GST); bf16_t* OG = (bf16_t*)(a.ws + WS_OG);
    const int c = u % GNC, b = u / GNC, row0 = gc_row0(b, c);
    const int h = t.wave & 3, dir = t.wave >> 2, chain = (b * 4 + h) * 2 + dir, cc = gc_chain_pos(c, dir);
    LAS float* PRE = (LAS float*)(t.lds + t.wave * 14592);
    LAS bf16_t* QN = (LAS bf16_t*)(PRE + 32 * 33 + 8);
    LAS bf16_t* KN = QN + 32 * 40;
    LAS bf16_t* VT = KN + 32 * 40;
    const int rho = t.lane & 31, hf = t.lane >> 5, hq = t.lane >> 4, lc = t.lane & 15;
#pragma unroll
    for (int q = 0; q < 4; ++q) { const f32x4 g = *(const f32x4*)(GG + ((size_t)dir * M + row0 + rho) * 128 + h * 32 + hf * 16 + 4 * q);
#pragma unroll
        for (int e = 0; e < 4; ++e) PRE[rho * 33 + hf * 16 + 4 * q + e] = g[e]; }
    WAVE_LDS_FENCE();
    f32x4 graw[4];
#pragma unroll
    for (int q = 0; q < 4; ++q)
#pragma unroll
        for (int e = 0; e < 4; ++e) graw[q][e] = PRE[rho * 33 + hf * 16 + 4 * q + e];
    WAVE_LDS_FENCE();
    gla_prefix(PRE, t.lane);
#pragma unroll
    for (int q = 0; q < 4; ++q) { const f32x4 qv = ldbf4(U + (size_t)(row0 + rho) * NU + U_GQ + h * 32 + hf * 16 + 4 * q), kv = ldbf4(U + (size_t)(row0 + rho) * NU + U_GK + h * 32 + hf * 16 + 4 * q);
#pragma unroll
        for (int e = 0; e < 4; ++e) { const int d = hf * 16 + 4 * q + e; const float pre = PRE[rho * 33 + d], tot = PRE[31 * 33 + d], ref = PRE[15 * 33 + d];
            const float ex = pre - graw[q][e], qs = qv[e] * 0.17677669529663687f;
            float fq, fk;
            if (dir == 0) { fq = fexp(pre - ref); fk = fexp(ref - pre); } else { fq = fexp(ref - ex); fk = fexp(ex - ref); }
            (void)tot;
            QN[rho * 40 + d] = (bf16_t)f2bf(qs * fq); KN[rho * 40 + d] = (bf16_t)f2bf(kv[e] * fk); } }
    bf16x8 q2f[2];
#pragma unroll
    for (int it = 0; it < 2; ++it) { const int ro = 16 * it + lc; const bf16_t* qp = U + (size_t)(row0 + ro) * NU + U_GQ + h * 32 + 8 * hq; const float* gp = GG + ((size_t)dir * M + row0 + ro) * 128 + h * 32 + 8 * hq;
        const f32x4 qa = ldbf4(qp), qb = ldbf4(qp + 4), ga = *(const f32x4*)gp, gb = *(const f32x4*)(gp + 4);
#pragma unroll
        for (int e = 0; e < 8; ++e) { const int d = 8 * hq + e; const float pre = PRE[ro * 33 + d], tot = PRE[31 * 33 + d]; const float qv = e < 4 ? qa[e & 3] : qb[e & 3], gv = e < 4 ? ga[e & 3] : gb[e & 3];
            const float f2 = dir == 0 ? fexp(pre) : fexp(tot - (pre - gv));
            q2f[it][e] = (short)f2bf(qv * 0.17677669529663687f * f2); } }
#pragma unroll
    for (int q = 0; q < 8; ++q) { const f32x4 v = ldbf4(U + (size_t)(row0 + rho) * NU + U_GV + h * 64 + hf * 32 + 4 * q);
#pragma unroll
        for (int e = 0; e < 4; ++e) VT[(hf * 32 + 4 * q + e) * 40 + rho] = (bf16_t)f2bf(v[e]); }
    WAVE_LDS_FENCE();
    f32x4 att[2][2];
#pragma unroll
    for (int it = 0; it < 2; ++it)
#pragma unroll
        for (int jt = 0; jt < 2; ++jt) { att[it][jt] = (f32x4){0.f, 0.f, 0.f, 0.f}; att[it][jt] = mma16(att[it][jt], QN + it * 16 * 40, 40, KN + jt * 16 * 40, 40, 32, t.lane); }
    WAVE_LDS_FENCE();
#pragma unroll
    for (int it = 0; it < 2; ++it)
#pragma unroll
        for (int jt = 0; jt < 2; ++jt)
#pragma unroll
            for (int r = 0; r < 4; ++r) { const int ro = 16 * it + 4 * hq + r, rp = 16 * jt + lc; const bool keep = dir == 0 ? (rp <= ro) : (rp >= ro);
                QN[ro * 40 + rp] = (bf16_t)f2bf(keep ? att[it][jt][r] : 0.f); }
    WAVE_LDS_FENCE();
    const bf16_t* sb = GST + ((size_t)chain * GNC + cc) * 2048;
#pragma unroll
    for (int it = 0; it < 2; ++it)
#pragma unroll
        for (int vt = 0; vt < 4; ++vt) { f32x4 acc = {0.f, 0.f, 0.f, 0.f};
            acc = mma16(acc, QN + it * 16 * 40, 40, VT + vt * 16 * 40, 40, 32, t.lane);
            const bf16x8 sf = *(const bf16x8*)(sb + (size_t)(16 * vt + lc) * 32 + 8 * hq);
            acc = __builtin_amdgcn_mfma_f32_16x16x32_bf16(q2f[it], sf, acc, 0, 0, 0);
#pragma unroll
            for (int r = 0; r < 4; ++r) stbf(OG + ((size_t)dir * M + row0 + 16 * it + 4 * hq + r) * 256 + h * 64 + 16 * vt + lc, acc[r]); }
    WAVE_LDS_FENCE();
}

__device__ __forceinline__ void phase_mixout(const Args& a, const Tc& t, int l, int Mtok) {
    const bf16_t* U = (const bf16_t*)(a.ws + WS_U); const bf16_t* RW7 = (const bf16_t*)(a.ws + WS_RW7); const bf16_t* SXBC = (const bf16_t*)(a.ws + WS_SXBC);
    const bf16_t* OG = (const bf16_t*)(a.ws + WS_OG); const bf16_t* OR = (const bf16_t*)(a.ws + WS_OR); const bf16_t* OS = (const bf16_t*)(a.ws + WS_OS);
    bf16_t* MIX = (bf16_t*)(a.ws + WS_MIX);
    const float* mu = a.in[I_RMU] + (size_t)l * 2 * 928; const float* g2 = a.in[I_RG2] + (size_t)l * 64 * 256;
    const float* gng = a.in[I_GNG] + (size_t)l * 256; const float* lng = a.in[I_RLG] + (size_t)l * 256; const float* lnb = a.in[I_RLB] + (size_t)l * 256;
    const float* rrk = a.in[I_RRK] + (size_t)l * 256; const float* sd = a.in[I_SD] + (size_t)l * 8; const float* sng = a.in[I_SNG] + (size_t)l * 512;
    LAS float* SG = (LAS float*)t.lds;
    LAS float* RED = (LAS float*)(t.lds + 4096);
    const size_t P = (size_t)M * 256;
    LAS float* G2S = (LAS float*)(t.lds + 8192);
    for (int e = t.tid; e < 64 * 256 / 4; e += NTHREADS) *(LAS f32x4*)(G2S + 4 * e) = *(const f32x4*)(g2 + 4 * e);
    LDS_BARRIER();
    for (int tile = t.bid; tile < Mtok / 16; tile += t.G) {
        const int r0 = tile * 16; int slo, shi; seg_bounds(r0, slo, shi);
        unsigned lgr[8][4], lsd[16][2];
        {   const int c = t.tid & 255, tt0 = (t.tid >> 8) * 8;
#pragma unroll
            for (int j = 0; j < 8; ++j) { const size_t row = (size_t)(r0 + tt0 + j);
                lgr[j][0] = (unsigned)OG[row * 256 + c] | ((unsigned)OG[P + row * 256 + c] << 16);
                lgr[j][1] = (unsigned)OR[row * 256 + c] | ((unsigned)OR[P + row * 256 + c] << 16);
                lgr[j][2] = (unsigned)U[row * NU + U_GOG + c] | ((unsigned)RW7[row * 256 + c] << 16);
                lgr[j][3] = (unsigned)RW7[P + row * 256 + c] | ((unsigned)RW7[2 * P + row * 256 + c] << 16); }
            const int cs = t.tid;
#pragma unroll
            for (int q = 0; q < 16; ++q) { const size_t row = (size_t)(r0 + q);
                lsd[q][0] = (unsigned)OS[row * 512 + cs] | ((unsigned)OS[(size_t)M * 512 + row * 512 + cs] << 16);
                lsd[q][1] = (unsigned)SXBC[row * 1024 + cs] | ((unsigned)U[row * NU + U_SZ + cs] << 16); } }
        {   const int tt = t.tid >> 5, r = t.tid & 31, row = r0 + tt; const bf16_t* up = U + (size_t)row * NU; const bool hp = row - 1 >= slo, hn = row + 1 < shi;
#pragma unroll
            for (int q = 0; q < 2; ++q) { const int col = U_RLGT + q * 32 + r, mi = col - U_RW; const float u = ldbf(up + col), pv = ld_or0(up + col - NU, up + col, hp), nv = ld_or0(up + col + NU, up + col, hn);
                SG[tt * 64 + q * 32 + r] = sigmoidf_(u + mu[mi] * (pv - u) + mu[928 + mi] * (nv - u)); } }
        LDS_BARRIER();
        {
            const int c = t.tid & 255, tt0 = (t.tid >> 8) * 8;
            float ag[8];
#pragma unroll
            for (int j = 0; j < 8; ++j) ag[j] = 0.f;
#pragma unroll 2
            for (int r4 = 0; r4 < 16; ++r4) { float w[4];
#pragma unroll
                for (int q = 0; q < 4; ++q) w[q] = G2S[(4 * r4 + q) * 256 + c];
#pragma unroll
                for (int j = 0; j < 8; ++j) { const f32x4 sv = *(const LAS f32x4*)(SG + (tt0 + j) * 64 + 4 * r4); ag[j] += (sv[0] * w[0] + sv[1] * w[1]) + (sv[2] * w[2] + sv[3] * w[3]); } }
            const float gn = gng[c], lg = lng[c], lb = lnb[c], rk = rrk[c];
#pragma unroll
            for (int j = 0; j < 8; ++j) { const int row = r0 + tt0 + j;
                const float og_ = bf_lo(lgr[j][0]) + bf_hi(lgr[j][0]);
                const float ms = wave_sum(og_ * og_) * (1.0f / 64.0f);
                const float o1 = og_ * (frsq(ms + 1e-6f)) * gn * siluf_(bf_lo(lgr[j][2]));
                const float orr = bf_lo(lgr[j][1]) + bf_hi(lgr[j][1]);
                const float mean = wave_sum(orr) * (1.0f / 64.0f); const float dd = orr - mean; const float var = wave_sum(dd * dd) * (1.0f / 64.0f);
                const float on = dd * (frsq(var + 64e-5f)) * lg + lb;
                const float bon = wave_sum(bf_hi(lgr[j][2]) * bf_lo(lgr[j][3]) * rk) * bf_hi(lgr[j][3]);
                const float o2 = (on + bon) * ag[j];
                MIX[(size_t)row * D + c] = (bf16_t)f2bf(o1); MIX[(size_t)row * D + 256 + c] = (bf16_t)f2bf(o2); }
        }
        {
            const int c = t.tid; const float dh = sd[c >> 6], ng = sng[c];
            float y[16];
#pragma unroll
            for (int q = 0; q < 16; ++q) {
                float v = bf_lo(lsd[q][0]) + bf_hi(lsd[q][0]) + dh * bf_lo(lsd[q][1]);
                v *= siluf_(bf_hi(lsd[q][1])); y[q] = v;
                const float ss = wave_sum(v * v); if (t.lane == 0) RED[q * 8 + t.wave] = ss; }
            LDS_BARRIER();
            const int gb = (t.wave >> 2) * 4;
#pragma unroll
            for (int q = 0; q < 16; ++q) { const float ms = (RED[q * 8 + gb] + RED[q * 8 + gb + 1] + RED[q * 8 + gb + 2] + RED[q * 8 + gb + 3]) * (1.0f / 256.0f);
                MIX[(size_t)(r0 + q) * D + 512 + c] = (bf16_t)f2bf(y[q] * (frsq(ms + 1e-6f)) * ng); }
        }
        LDS_BARRIER();
    }
}

static_assert(NEXP <= 32, "router lanes");
__device__ __forceinline__ unsigned long long router_key(float v, int e) { unsigned u = __float_as_uint(v); u = (u & 0x80000000u) ? ~u : (u | 0x80000000u); return ((unsigned long long)u << 32) | (unsigned)(31 - e); }
__device__ __forceinline__ float router_unkey(unsigned long long k) { unsigned u = (unsigned)(k >> 32); u = (u & 0x80000000u) ? (u & 0x7fffffffu) : ~u; return __uint_as_float(u); }
__device__ __forceinline__ void phase_router(const Args& a, const Tc& t, int l, int Mtok) {
    const bf16_t* X = (const bf16_t*)(a.ws + WS_X); bf16_t* H = (bf16_t*)(a.ws + WS_H); const float* MODS = (const float*)(a.ws + WS_MODS) + (size_t)l * NR * 6144;
    const float* rw = a.in[I_ROUTW] + (size_t)l * D * NEXP; const float* rb = a.in[I_ROUTB] + (size_t)l * NEXP;
    int* TOPI = (int*)(a.ws + WS_TOPI); float* TOPP = (float*)(a.ws + WS_TOPP);
    unsigned* CNT = (unsigned*)(a.ws + WS_CTL) + CW_CNT + l * 64;
    LAS int* hist = (LAS int*)(t.lds + LDS_MISC + 64);
    LAS float* HT = (LAS float*)t.lds;
    LAS float* PART = HT + 16 * 1028;
    if (t.tid < NEXP) hist[t.tid] = 0;
    __syncthreads();
    const int hq = t.lane >> 4, lc = t.lane & 15, e = t.lane & 31, rh = t.lane >> 5; const bool ev = e < NEXP;
    const float bias = ev ? rb[e] : 0.f;
    constexpr int NT = NEXP > 16 ? 2 : 1;
    float wreg[NT][32];
#pragma unroll
    for (int nt = 0; nt < NT; ++nt)
#pragma unroll
        for (int ks = 0; ks < 32; ++ks) { const int k = 128 * t.wave + 4 * ks + hq, col = 16 * nt + lc; wreg[nt][ks] = col < NEXP ? rw[(size_t)k * NEXP + col] : 0.f; }
    for (int tile = t.bid; tile < Mtok / 16; tile += t.G) {
        const int r0 = tile * 16;
#pragma unroll
        for (int rr = 0; rr < 2; ++rr) { const int lr = 2 * t.wave + rr, row = r0 + lr;
            f32x4 v[4], h[4];
#pragma unroll
            for (int j = 0; j < 4; ++j) v[j] = ldbf4(X + (size_t)row * D + 4 * t.lane + 256 * j);
            const float* md = MODS + (size_t)mod_row(row) * 6144;
            norm_mod_store<true>(v, a.in[I_N2G] + (size_t)l * D, md + 3 * 1024, md + 4 * 1024, (bf16_t*)((unsigned char*)H + (size_t)row * D), t.lane, h);
#pragma unroll
            for (int j = 0; j < 4; ++j) *(LAS f32x4*)(HT + lr * 1028 + 4 * t.lane + 256 * j) = h[j]; }
        LDS_BARRIER();
        f32x4 acc[NT];
#pragma unroll
        for (int nt = 0; nt < NT; ++nt) acc[nt] = (f32x4){0.f, 0.f, 0.f, 0.f};
#pragma unroll
        for (int ks = 0; ks < 32; ++ks) { const float av = HT[lc * 1028 + 128 * t.wave + 4 * ks + hq];
#pragma unroll
            for (int nt = 0; nt < NT; ++nt) acc[nt] = __builtin_amdgcn_mfma_f32_16x16x4f32(av, wreg[nt][ks], acc[nt], 0, 0, 0); }
#pragma unroll
        for (int nt = 0; nt < NT; ++nt)
#pragma unroll
            for (int r = 0; r < 4; ++r) PART[(t.wave * 16 + 4 * hq + r) * 33 + 16 * nt + lc] = acc[nt][r];
        LDS_BARRIER();
        {   const int lr = 2 * t.wave + rh, row = r0 + lr;
            float lg = bias;
#pragma unroll
            for (int w2 = 0; w2 < 8; ++w2) lg += PART[(w2 * 16 + lr) * 33 + (ev ? e : 0)];
            if (!ev) lg = -3.0e38f;
            unsigned long long key = router_key(lg, e);
            int ti[4]; float tv[4];
#pragma unroll
            for (int k = 0; k < 4; ++k) { unsigned long long m = key;
#pragma unroll
                for (int o = 1; o < 32; o <<= 1) { const unsigned long long other = __shfl_xor(m, o); m = other > m ? other : m; }
                ti[k] = 31 - (int)(unsigned)(m & 0xffffffffu); tv[k] = router_unkey(m);
                if (ti[k] == e) key = 0ull; }
            const float e0 = 1.0f, e1 = fexp(tv[1] - tv[0]), e2 = fexp(tv[2] - tv[0]), e3 = fexp(tv[3] - tv[0]); const float inv = frcp(e0 + e1 + e2 + e3);
            if (e == 0) {
                TOPI[row * 4 + 0] = ti[0]; TOPI[row * 4 + 1] = ti[1]; TOPI[row * 4 + 2] = ti[2]; TOPI[row * 4 + 3] = ti[3];
                TOPP[row * 4 + 0] = e0 * inv; TOPP[row * 4 + 1] = e1 * inv; TOPP[row * 4 + 2] = e2 * inv; TOPP[row * 4 + 3] = e3 * inv;
#pragma unroll
                for (int k = 0; k < 4; ++k) atomicAdd((int*)&hist[ti[k]], 1);
            } }
        LDS_BARRIER();
    }
    __syncthreads();
    if (t.tid < NEXP && hist[t.tid] != 0) atomicAdd(&CNT[t.tid], (unsigned)hist[t.tid]);
}

__device__ __forceinline__ int moe_offsets(const unsigned* CNT, LAS int* off, LAS int* cnt, int tid) {
    if (tid < NEXP) { int o = 0; for (int e = 0; e < tid; ++e) o += ((int)CNT[e] + 255) & ~255; off[tid] = o; cnt[tid] = (int)CNT[tid]; }
    __syncthreads();
    return (off[NEXP - 1] + ((cnt[NEXP - 1] + 255) & ~255)) >> 8;
}
__device__ __forceinline__ void phase_lists(const Args& a, const Tc& t, int l, int Mtok) {
    const int* TOPI = (const int*)(a.ws + WS_TOPI); const float* TOPP = (const float*)(a.ws + WS_TOPP);
    int* POS = (int*)(a.ws + WS_POS); int* ROWIDX = (int*)(a.ws + WS_ROWIDX); float* ROWGATE = (float*)(a.ws + WS_ROWGATE);
    unsigned* CNT = (unsigned*)(a.ws + WS_CTL) + CW_CNT + l * 64; unsigned* CUR = (unsigned*)(a.ws + WS_CTL) + CW_CUR + l * 64;
    LAS int* off = (LAS int*)(t.lds + LDS_MISC + 64); LAS int* cnt = off + 64; LAS int* hist = off + 128; LAS int* base = off + 192; LAS int* cur = off + 256;
    if (t.tid < NEXP) { hist[t.tid] = 0; cur[t.tid] = 0; }
    moe_offsets(CNT, off, cnt, t.tid);
    const int rpb = (Mtok + t.G - 1) / t.G, s0 = t.bid * rpb * 4; int s1 = (t.bid + 1) * rpb * 4; if (s1 > Mtok * 4) s1 = Mtok * 4;
    for (int s = s0 + t.tid; s < s1; s += NTHREADS) atomicAdd((int*)&hist[TOPI[s]], 1);
    __syncthreads();
    if (t.tid < NEXP) base[t.tid] = hist[t.tid] ? (int)atomicAdd(&CUR[t.tid], (unsigned)hist[t.tid]) : 0;
    __syncthreads();
    for (int s = s0 + t.tid; s < s1; s += NTHREADS) { const int e = TOPI[s]; const int p = off[e] + base[e] + atomicAdd((int*)&cur[e], 1);
        POS[s] = p; ROWIDX[p] = s >> 2; ROWGATE[p] = TOPP[s]; }
    for (int e = t.bid; e < NEXP; e += t.G) { const int lo = off[e] + cnt[e], hi = off[e] + ((cnt[e] + 255) & ~255);
        for (int p = lo + t.tid; p < hi; p += NTHREADS) { ROWIDX[p] = 0; ROWGATE[p] = 0.f; } }
    __syncthreads();
}
__device__ __forceinline__ int moe_tile_table(const Args& a, const Tc& t, int l) {
    unsigned* CNT = (unsigned*)(a.ws + WS_CTL) + CW_CNT + l * 64;
    LAS int* off = (LAS int*)(t.lds + LDS_MISC + 64); LAS int* cnt = off + 64; LAS int* tile_e = (LAS int*)(t.lds + LDS_TILE_E);
    const int ntiles = moe_offsets(CNT, off, cnt, t.tid);
    for (int tt = t.tid; tt < ntiles; tt += NTHREADS) { int e = 0;
        for (int q = 1; q < NEXP; ++q) if ((off[q] >> 8) <= tt) e = q;
        tile_e[tt] = e; }
    __syncthreads();
    return ntiles;
}

__device__ __forceinline__ void phase_combine(const Args& a, const Tc& t, int l, int Mtok) {
    const int gw = t.bid * NWAVES + t.wave, NGW = t.G * NWAVES;
    bf16_t* X = (bf16_t*)(a.ws + WS_X); bf16_t* H = (bf16_t*)(a.ws + WS_H); const bf16_t* Y = (const bf16_t*)(a.ws + WS_Y); const int* POS = (const int*)(a.ws + WS_POS);
    const float* MODS = (const float*)(a.ws + WS_MODS) + (size_t)l * NR * 6144;
    for (int rp = gw * 2; rp < Mtok; rp += NGW * 2) {
        int ps[2][4];
#pragma unroll
        for (int q = 0; q < 2; ++q) { const u32x4 pv = *(const u32x4*)(POS + (size_t)(rp + q) * 4); ps[q][0] = (int)pv.x; ps[q][1] = (int)pv.y; ps[q][2] = (int)pv.z; ps[q][3] = (int)pv.w; }
        u32x2 yv[2][4][4]; f32x4 xv[2][4];
#pragma unroll
        for (int q = 0; q < 2; ++q)
#pragma unroll
            for (int j = 0; j < 4; ++j) { const int c = 4 * t.lane + 256 * j; xv[q][j] = ldbf4(X + (size_t)(rp + q) * D + c);
#pragma unroll
                for (int k = 0; k < 4; ++k) yv[q][k][j] = *(const u32x2*)(Y + (size_t)ps[q][k] * D + c); }
#pragma unroll
        for (int q = 0; q < 2; ++q) { const int row = rp + q;
            const float* md = MODS + (size_t)mod_row(row) * 6144 + 5 * 1024;
            f32x4 v[4], h[4];
#pragma unroll
            for (int j = 0; j < 4; ++j) { const int c = 4 * t.lane + 256 * j;
                const u32x2 y0 = yv[q][0][j], y1 = yv[q][1][j], y2 = yv[q][2][j], y3 = yv[q][3][j];
                f32x4 s_; s_[0] = (bf_lo(y0.x) + bf_lo(y1.x)) + (bf_lo(y2.x) + bf_lo(y3.x)); s_[1] = (bf_hi(y0.x) + bf_hi(y1.x)) + (bf_hi(y2.x) + bf_hi(y3.x));
                s_[2] = (bf_lo(y0.y) + bf_lo(y1.y)) + (bf_lo(y2.y) + bf_lo(y3.y)); s_[3] = (bf_hi(y0.y) + bf_hi(y1.y)) + (bf_hi(y2.y) + bf_hi(y3.y));
                const f32x4 g = *(const f32x4*)(md + c);
                v[j] = xv[q][j] + g * s_; }
            if (l + 1 < DEPTH) {
#pragma unroll
                for (int j = 0; j < 4; ++j) { u32x2 w; w.x = pk2(v[j][0], v[j][1]); w.y = pk2(v[j][2], v[j][3]); *(u32x2*)(X + (size_t)row * D + 4 * t.lane + 256 * j) = w; }
                const float* md2 = MODS + (size_t)NR * 6144 + (size_t)mod_row(row) * 6144;
                norm_mod_store(v, a.in[I_N1G] + (size_t)(l + 1) * D, md2, md2 + 1024, H + (size_t)row * D, t.lane, h);
            } else {
                float ss = 0.f;
#pragma unroll
                for (int j = 0; j < 4; ++j) ss += (v[j][0] * v[j][0] + v[j][1] * v[j][1]) + (v[j][2] * v[j][2] + v[j][3] * v[j][3]);
                const float rstd = frsq(wave_sum(ss) * (1.0f / D) + 1e-6f);
#pragma unroll
                for (int j = 0; j < 4; ++j) { const int c = 4 * t.lane + 256 * j; const f32x4 g = *(const f32x4*)(a.in[I_FNG] + c); *(f32x4*)(a.out + (size_t)row * D + c) = v[j] * rstd * g; }
            } }
    }
}

#ifndef EMU
__device__ __forceinline__ void launder_ws(Args& al) {
    __attribute__((address_space(1))) unsigned char* p = (__attribute__((address_space(1))) unsigned char*)al.ws; asm volatile("" : "+s"(p)); al.ws = (unsigned char*)p; }
__device__ __forceinline__ void launder_tid(Tc& t) { int x = threadIdx.x; asm volatile("" : "+v"(x)); t.tid = x; t.lane = x & 63; t.wave = __builtin_amdgcn_readfirstlane(x >> 6); }
#endif
constexpr int PH_PER_LAYER = 12, N_PHASES = 2 + DEPTH * PH_PER_LAYER;
__global__ void __launch_bounds__(NTHREADS, 2) fwd(Args a) {
#ifdef EMU
    unsigned char* lds_raw = EMU_DYN_LDS();
#else
    extern __shared__ __attribute__((aligned(16))) unsigned char lds_raw[];
#endif
    Tc t; t.lds = (LAS unsigned char*)lds_raw; t.tid = threadIdx.x; t.lane = t.tid & 63; t.wave = __builtin_amdgcn_readfirstlane(t.tid >> 6); t.G = gridDim.x; t.bid = blockIdx.x;
    const int lo = a.ph_lo, hi = a.ph_hi;
    Args al = a;
    volatile LAS unsigned* misc = (volatile LAS unsigned*)(t.lds + LDS_MISC);
    if (t.tid < 16) misc[t.tid] = 0u;
    if (t.tid == 0) { LAS unsigned long long* tb = (LAS unsigned long long*)(t.lds + LDS_PTRS);
#pragma unroll
        for (int i = 0; i < 37; ++i) tb[i] = (unsigned long long)a.in[i]; }
    __syncthreads();
    XcdBarrier bar; bar.bar = (unsigned*)(a.ws + WS_CTL) + CW_BAR; bar.x = 0; bar.st = misc;
    if (hi - lo > 1) bar = xcd_barrier_post((unsigned*)(a.ws + WS_CTL) + CW_BAR, misc);
#ifdef EMU
#define LAUNDER_TID() ((void)0)
#else
#define LAUNDER_TID() launder_tid(t)
#endif
#if PROBE_SPIN >= 0 && !defined(EMU)
    unsigned long long pt_acc = 0ull, pt_t0 = 0ull;
#define PT_MATCH(k) ((PROBE_SPIN >= 100) ? ((k) == PROBE_SPIN - 100) : ((k) >= 2 && ((k) - 2) % PH_PER_LAYER == PROBE_SPIN))
#define PT_BEGIN(k) (PT_MATCH(k) ? (pt_t0 = wall_clock64(), true) : true)
#define PT_END(k) do { if (PT_MATCH(k)) pt_acc += wall_clock64() - pt_t0; } while (0)
#else
#define PT_BEGIN(k) true
#define PT_END(k) ((void)0)
#endif
#ifdef EMU
#define LAUNDER_WS() ((void)0)
#else
#define LAUNDER_WS() launder_ws(al)
#endif
#define IN_PH(k) (lo <= (k) && (k) < hi && (LAUNDER_TID(), LAUNDER_WS(), true) && PT_BEGIN(k))
#define REPS(bit) (((PROBE_DOUBLE >> (bit)) & 1) ? 2 : 1)
#ifdef EMU
#define SEAM(k) do { if ((k) + 1 < hi) xcd_barrier(bar); PT_END(k); } while (0)
#else
#define SEAM(k) do { if ((k) + 1 < hi) { XcdBarrier b2_ = bar; __attribute__((address_space(1))) unsigned* bp_ = (__attribute__((address_space(1))) unsigned*)b2_.bar; asm volatile("" : "+s"(bp_)); b2_.bar = (unsigned*)bp_; xcd_barrier(b2_); } PT_END(k); } while (0)
#endif
    if (IN_PH(0)) { for (int rep = 0; rep < REPS(15); ++rep) phase_pro0(al, t); SEAM(0); }
    if (IN_PH(1)) { phase_pro1(al, t); SEAM(1); }
    for (int l = 0; l < DEPTH; ++l) {
        const int pb = 2 + l * PH_PER_LAYER;
        const bool lastl = (l == DEPTH - 1);
        const int Mtok = lastl ? ML : M;
        const float* MODSL = (const float*)(al.ws + WS_MODS) + (size_t)l * NR * 6144;
        if (IN_PH(pb + 0)) {
            pg8::Gemm g{(const bf16_t*)(al.ws + WS_H), (const bf16_t*)(al.ws + WS_WIN) + (size_t)l * NU * D, D, nullptr};
            pg8::DenseSched S; S.o.init(M / 256, NU / 256, t.G, t.bid);
            pg8::EpiBf16 E{(bf16_t*)(al.ws + WS_U), NU};
            for (int rep = 0; rep < REPS(0); ++rep) pg8::gemm_phase<pg8::EpiBf16, pg8::DenseSched, false>(t.lds, t.tid, g, S, E);
            convert_in_slack(al, t, l, 0, CV_E_IN, (M / 256) * (NU / 256));
            SEAM(pb + 0);
        }
        if (IN_PH(pb + 1)) { for (int rep = 0; rep < REPS(1); ++rep) phase_prep(al, t, l); SEAM(pb + 1); }
        const bool a1_in_b = t.G >= 2 * RKB_TASKS;
        if (IN_PH(pb + 2)) {
            for (int rep = 0; rep < REPS(4); ++rep) rwkv_a_all(al, t);
            if (!a1_in_b) for (int u = t.bid; u < SSD_UNITS + GLA_UNITS; u += t.G) { if (u < SSD_UNITS) ssd_a1_unit(al, t, l, u); else gla_a1_unit(al, t, u - SSD_UNITS); }
            SEAM(pb + 2);
        }
        if (IN_PH(pb + 3)) {
            if (a1_in_b) {
                if (t.bid < RKB_TASKS) { for (int rep = 0; rep < REPS(5); ++rep) rwkv_b_task(al, t, t.bid); }
                else { const int wg = t.bid - RKB_TASKS, nwg = t.G - RKB_TASKS;
                    for (int u = wg; u < SSD_UNITS + GLA_UNITS; u += nwg) { if (u < SSD_UNITS) ssd_a1_unit(al, t, l, u); else gla_a1_unit(al, t, u - SSD_UNITS); }
                    sub_barrier((unsigned*)(al.ws + WS_CTL) + CW_SUB + l * 64, (unsigned)nwg);
                    ssd_b_carry(al, t, wg, nwg); gla_b_carry(al, t, wg, nwg);
                    __syncthreads(); convert_moe(al, t, l, CV_E_IN, lastl ? CV_MOE_ITEMS : CV_E_B, wg * NWAVES + t.wave, nwg * NWAVES); }
            } else {
                for (int task = t.bid; task < RKB_TASKS; task += t.G) rwkv_b_task(al, t, task);
                ssd_b_carry(al, t, t.bid, t.G); gla_b_carry(al, t, t.bid, t.G); __syncthreads(); convert_moe(al, t, l, CV_E_IN, lastl ? CV_MOE_ITEMS : CV_E_B, t.bid * NWAVES + t.wave, t.G * NWAVES);
            }
            SEAM(pb + 3);
        }
        if (IN_PH(pb + 4)) {
            for (int rep = 0; rep < REPS(6); ++rep) for (int u = t.bid; u < SSD_UNITS + GLA_UNITS; u += t.G) { if (u < SSD_UNITS) ssd_c_unit(al, t, l, u); else gla_c_unit(al, t, u - SSD_UNITS); }
            SEAM(pb + 4);
        }
        if (IN_PH(pb + 5)) { for (int rep = 0; rep < REPS(3); ++rep) phase_mixout(al, t, l, Mtok); SEAM(pb + 5); }
        if (IN_PH(pb + 6)) {
            pg8::Gemm g{(const bf16_t*)(al.ws + WS_MIX), (const bf16_t*)(al.ws + WS_WOUT) + (size_t)l * D * D, D, nullptr};
            pg8::DenseSched S; S.o.init(Mtok / 256, D / 256, t.G, t.bid);
            pg8::EpiResid E{(bf16_t*)(al.ws + WS_X), MODSL};
            pg8::gemm_phase<pg8::EpiResid, pg8::DenseSched, false>(t.lds, t.tid, g, S, E);
            if (!lastl) convert_in_slack(al, t, l, CV_E_B, CV_MOE_ITEMS, (Mtok / 256) * (D / 256));
            SEAM(pb + 6);
        }
        if (IN_PH(pb + 7)) { phase_router(al, t, l, Mtok); SEAM(pb + 7); }
        if (IN_PH(pb + 8)) { phase_lists(al, t, l, Mtok); SEAM(pb + 8); }
        if (IN_PH(pb + 9)) {
            const int ntiles = moe_tile_table(al, t, l);
            pg8::Gemm g{(const bf16_t*)(al.ws + WS_H), (const bf16_t*)(al.ws + WS_WGU + (size_t)l * NEXP * 2048 * D), D / 2, (const int*)(al.ws + WS_ROWIDX)};
            pg8::MoeSched S; S.o.init(ntiles, 8, t.G, t.bid); S.tile_e = (const LAS int*)(t.lds + LDS_TILE_E); S.nct = 8;
            pg8::EpiSwiglu E{al.ws + WS_ACT, al.in[I_BGU] + (size_t)l * NEXP * 2048};
            for (int rep = 0; rep < REPS(7); ++rep) pg8::gemm_phase<pg8::EpiSwiglu, pg8::MoeSched, true, true>(t.lds, t.tid, g, S, E);
            SEAM(pb + 9);
        }
        if (IN_PH(pb + 10)) {
            const int ntiles = moe_tile_table(al, t, l);
            pg8::Gemm g{(const bf16_t*)(al.ws + WS_ACT), (const bf16_t*)(al.ws + WS_WD + (size_t)l * NEXP * D * DFF), DFF / 2, nullptr};
            pg8::MoeSched S; S.o.init(ntiles, 4, t.G, t.bid); S.tile_e = (const LAS int*)(t.lds + LDS_TILE_E); S.nct = 4;
            pg8::EpiDown E{(bf16_t*)(al.ws + WS_Y), al.in[I_BDN] + (size_t)l * NEXP * D, (const float*)(al.ws + WS_ROWGATE)};
            for (int rep = 0; rep < REPS(8); ++rep) pg8::gemm_phase<pg8::EpiDown, pg8::MoeSched, false, true>(t.lds, t.tid, g, S, E);
            SEAM(pb + 10);
        }
        if (IN_PH(pb + 11)) { phase_combine(al, t, l, Mtok); SEAM(pb + 11); }
    }
#if PROBE_SPIN >= 0 && !defined(EMU)
    if (t.bid == 0) { const unsigned long long te = wall_clock64(); while (wall_clock64() - te < 4ull * pt_acc) __builtin_amdgcn_s_sleep(8); }
#endif
#undef IN_PH
#undef SEAM
}

}

extern "C" void kernel_launch(void* const* d_in, const int* in_sizes, int n_in, void* d_out, int out_size, void* d_ws, size_t ws_size, hipStream_t stream) {
    using namespace mk;
    static int grid = 0;
    if (grid == 0) {
        if (n_in != 37 || out_size != ML * D || ws_size < WS_END) { fprintf(stderr, "kernel_launch: unexpected shapes (n_in %d out %d ws %zu need %zu)\n", n_in, out_size, ws_size, (size_t)WS_END); grid = -1; return; }
#ifdef EMU
        { const char* e = getenv("EMU_GRID"); grid = e ? atoi(e) : 8; }
#else
        int dev = 0, cus = 0, per_cu = 0;
        if (hipGetDevice(&dev) != hipSuccess || hipDeviceGetAttribute(&cus, hipDeviceAttributeMultiprocessorCount, dev) != hipSuccess) { grid = -1; return; }
        if (hipFuncSetAttribute((const void*)fwd, hipFuncAttributeMaxDynamicSharedMemorySize, LDS_BYTES) != hipSuccess) { fprintf(stderr, "kernel_launch: hipFuncSetAttribute failed\n"); grid = -1; return; }
        if (hipOccupancyMaxActiveBlocksPerMultiprocessor(&per_cu, (const void*)fwd, NTHREADS, LDS_BYTES) != hipSuccess || per_cu < 1) fprintf(stderr, "kernel_launch: occupancy query reports %d\n", per_cu);
        (void)hipGetLastError();
        grid = cus;
#endif
    }
    if (grid < 0) return;
    (void)hipMemsetAsync((char*)d_ws + WS_CTL, 0, CTL_BYTES, stream);
    Args a{};
    for (int i = 0; i < 37; ++i) a.in[i] = (const float*)d_in[i];
    a.out = (float*)d_out; a.ws = (unsigned char*)d_ws;
#if N_LAUNCH_MODE == 1
    a.ph_lo = 0; a.ph_hi = N_PHASES;
    hipLaunchKernelGGL(fwd, dim3(grid), dim3(NTHREADS), LDS_BYTES, stream, a);
#else
    for (int p = 0; p < N_PHASES; ++p) { a.ph_lo = p; a.ph_hi = p + 1; hipLaunchKernelGGL(fwd, dim3(grid), dim3(NTHREADS), LDS_BYTES, stream, a); }
#endif
}
```

```cpp
#ifndef EMU
#include <hip/hip_runtime.h>
#endif
#include <cstdio>
#include <cstdint>
#include <cmath>

#ifndef CFG_BATCH
#define CFG_BATCH 4
#define CFG_SEQ 4096
#define CFG_CTX 256
#define CFG_DEPTH 4
#define CFG_NEXP 32
#endif
#ifndef PROBE_DOUBLE
#define PROBE_DOUBLE 0
#endif
#ifndef PROBE_SPIN
#define PROBE_SPIN (-1)
#endif
#ifndef N_LAUNCH_MODE
#define N_LAUNCH_MODE 1
#endif

namespace mk {
constexpr int BATCH = CFG_BATCH, SEQ = CFG_SEQ, CTX = CFG_CTX, DEPTH = CFG_DEPTH, NEXP = CFG_NEXP;
constexpr int D = 1024, ML = BATCH * SEQ, MC = BATCH * CTX, M = ML + MC, NR = BATCH + 1;
constexpr int IN_COLS = 3280, NU = 3328;
constexpr int TOPK = 4, DFF = 1024;
constexpr int MAXROWS = M * TOPK + NEXP * 256;
constexpr int NTHREADS = 512, NWAVES = 8;
constexpr int U_GQ = 0, U_GK = 128, U_GV = 256, U_GOG = 512, U_GLF = 768, U_GLB = 784;
constexpr int U_RW = 800, U_RR = 800, U_RK = 1056, U_RV = 1312, U_RLWF = 1568, U_RLWB = 1600, U_RLA = 1632, U_RLGT = 1664;
constexpr int U_SZ = 1728, U_SXBC = 2240, U_SDT = 3264;
static_assert(SEQ % 256 == 0 && CTX % 256 == 0 && M % 256 == 0, "row tiles");

constexpr size_t al256(size_t x) { return (x + 255) & ~(size_t)255; }
constexpr size_t WS_CTL = 0, CTL_BYTES = 1u << 20;
constexpr size_t WS_MODS = WS_CTL + CTL_BYTES;
constexpr size_t WS_X = WS_MODS + al256((size_t)DEPTH * NR * 6144 * 4);
constexpr size_t WS_H = WS_X + al256((size_t)M * D * 4);
constexpr size_t WS_U = WS_H + al256((size_t)M * D * 2);
constexpr size_t WS_GG = WS_U + al256((size_t)M * NU * 4);
constexpr size_t WS_RW7 = WS_GG + al256((size_t)2 * M * 128 * 4);
constexpr size_t WS_SXBC = WS_RW7 + al256((size_t)7 * M * 256 * 4);
constexpr size_t WS_SDT = WS_SXBC + al256((size_t)M * 1024 * 4);
constexpr size_t WS_OG = WS_SDT + al256((size_t)M * 16 * 4);
constexpr size_t WS_OR = WS_OG + al256((size_t)2 * M * 256 * 4);
constexpr size_t WS_OS = WS_OR + al256((size_t)2 * M * 256 * 4);
constexpr size_t WS_MIX = WS_OS + al256((size_t)2 * M * 512 * 4);
constexpr size_t WS_TOPI = WS_MIX + al256((size_t)M * D * 2);
constexpr size_t WS_TOPP = WS_TOPI + al256((size_t)M * 4 * 4);
constexpr size_t WS_POS = WS_TOPP + al256((size_t)M * 4 * 4);
constexpr size_t WS_ROWIDX = WS_POS + al256((size_t)M * 4 * 4);
constexpr size_t WS_ROWGATE = WS_ROWIDX + al256((size_t)MAXROWS * 4);
constexpr size_t WS_ACT = WS_ROWGATE + al256((size_t)MAXROWS * 4);
constexpr size_t WS_Y = WS_ACT + al256((size_t)MAXROWS * DFF * 2);
constexpr size_t WS_WIN = WS_Y + al256((size_t)MAXROWS * D * 2);
constexpr size_t WS_WOUT = WS_WIN + al256((size_t)DEPTH * NU * D * 2);
constexpr size_t WS_WGU = WS_WOUT + al256((size_t)DEPTH * D * D * 2);
constexpr size_t WS_WD = WS_WGU + al256((size_t)DEPTH * NEXP * 2048 * D * 2);
constexpr int CTXC = CTX / 64, LATC = SEQ / 64, NRC = CTXC + LATC;
constexpr size_t WS_SZ = WS_WD + al256((size_t)DEPTH * NEXP * D * DFF * 2);
constexpr size_t WS_SDEC = WS_SZ + al256((size_t)BATCH * 16 * NRC * 64 * 128 * 2);
constexpr size_t WS_SST = WS_SDEC + al256((size_t)BATCH * 16 * NRC * 4);
constexpr int RKT = 16, NCK = (CTX + SEQ) / RKT;
constexpr int RK_PA = 0, RK_RA = 8192, RK_QA = 10240, RK_VB = 11264, RK_ZC = 15360, RK_BYTES = 23552;
constexpr size_t WS_RK = WS_SST + al256((size_t)BATCH * 16 * NRC * 64 * 128 * 2);
constexpr int GC_CTX = CTX / 32, GC_LAT = SEQ / 32, GNC = GC_CTX + GC_LAT;
constexpr size_t WS_GZ = WS_RK + al256((size_t)BATCH * 8 * NCK * RK_BYTES);
constexpr size_t WS_GDEC = WS_GZ + al256((size_t)BATCH * 8 * GNC * 2048 * 4);
constexpr size_t WS_GST = WS_GDEC + al256((size_t)BATCH * 8 * GNC * 32 * 4);
constexpr size_t WS_END = WS_GST + al256((size_t)BATCH * 8 * GNC * 2048 * 2);
constexpr int CW_BAR = 4096;
constexpr int CW_CNT = 16384;
constexpr int CW_SUB = 32768;
constexpr int CW_CUR = 16384 + 64 * 8;
constexpr int LDS_STAGE = 131072;
constexpr int LDS_TILE_E = LDS_STAGE;
constexpr int LDS_MISC = LDS_STAGE + 2048;
constexpr int LDS_PTRS = LDS_MISC + 2048;
constexpr int LDS_BYTES = 147456;

#ifdef EMU
#define LAS
#define ASM_VM0() ((void)0)
#define ASM_LGKM0() ((void)0)
#define ASM_MEMFENCE() ((void)0)
#define WAIT_V(n) ((void)0)
#define WAIT_L(n) ((void)0)
#define WAVE_LDS_FENCE() emu_wave_sync()
#define LAUNDER_V(x) ((void)0)
#define LDS_BARRIER() emu_block_sync()
#else
#define LAS __attribute__((address_space(3)))
#define ASM_VM0() asm volatile("s_waitcnt vmcnt(0)" ::: "memory")
#define ASM_LGKM0() asm volatile("s_waitcnt lgkmcnt(0)" ::: "memory")
#define ASM_MEMFENCE() asm volatile("" ::: "memory")
#define WAIT_V(n) asm volatile("s_waitcnt vmcnt(" #n ")" ::: "memory")
#define WAIT_L(n) asm volatile("s_waitcnt lgkmcnt(" #n ")" ::: "memory")
#define LDS_BARRIER() do { asm volatile("s_waitcnt lgkmcnt(0)" ::: "memory"); __builtin_amdgcn_s_barrier(); asm volatile("" ::: "memory"); } while (0)
#define LAUNDER_V(x) asm volatile("" : "+v"(x))
#define WAVE_LDS_FENCE() do { asm volatile("s_waitcnt lgkmcnt(0)" ::: "memory"); } while (0)
#endif

typedef unsigned short bf16_t;
typedef short bf16x8 __attribute__((ext_vector_type(8)));
typedef float f32x4 __attribute__((ext_vector_type(4)));
typedef float f32x2 __attribute__((ext_vector_type(2)));
typedef unsigned u32x4 __attribute__((ext_vector_type(4)));
typedef unsigned u32x2 __attribute__((ext_vector_type(2)));

#ifdef EMU
__device__ __forceinline__ unsigned f2bf(float f) { unsigned u = __float_as_uint(f); return (u + 0x7fffu + ((u >> 16) & 1u)) >> 16; }
__device__ __forceinline__ unsigned pk2(float lo, float hi) { return f2bf(lo) | (f2bf(hi) << 16); }
#else
typedef __bf16 hw_bf16x2 __attribute__((ext_vector_type(2)));
__device__ __forceinline__ unsigned pk2(float lo, float hi) { const f32x2 v = {lo, hi}; return __builtin_bit_cast(unsigned, __builtin_convertvector(v, hw_bf16x2)); }
__device__ __forceinline__ unsigned f2bf(float f) { return pk2(f, f) & 0xffffu; }
#endif
typedef int i32x4 __attribute__((ext_vector_type(4)));
typedef int i32x8 __attribute__((ext_vector_type(8)));
#ifdef EMU
__device__ __forceinline__ unsigned f2e4m3(float f) {
    const unsigned sgn = (__float_as_uint(f) >> 24) & 0x80u; float a = fabsf(f); if (!(a < 448.f)) a = 448.f;
    if (a < 0.015625f) { const int q = (int)nearbyintf(a * 512.f); return sgn | (unsigned)q; }
    int e; const float m = frexpf(a, &e); int q = (int)nearbyintf(m * 16.f); int ee = e - 1;
    if (q == 16) { q = 8; ++ee; }
    return sgn | (unsigned)(((ee + 7) << 3) | (q - 8));
}
__device__ __forceinline__ unsigned pk4_fp8(float a, float b, float c, float d) { return f2e4m3(a) | (f2e4m3(b) << 8) | (f2e4m3(c) << 16) | (f2e4m3(d) << 24); }
#else
__device__ __forceinline__ unsigned pk4_fp8(float a, float b, float c, float d) {
    a = __builtin_amdgcn_fmed3f(a, -448.f, 448.f); b = __builtin_amdgcn_fmed3f(b, -448.f, 448.f); c = __builtin_amdgcn_fmed3f(c, -448.f, 448.f); d = __builtin_amdgcn_fmed3f(d, -448.f, 448.f);
    int w = __builtin_amdgcn_cvt_pk_fp8_f32(a, b, 0, false); w = __builtin_amdgcn_cvt_pk_fp8_f32(c, d, w, true); return (unsigned)w;
}
#endif
__device__ __forceinline__ float bf_lo(unsigned w) { return __uint_as_float(w << 16); }
__device__ __forceinline__ float bf_hi(unsigned w) { return __uint_as_float(w & 0xffff0000u); }
__device__ __forceinline__ float ldbf(const bf16_t* p) { return __uint_as_float(((unsigned)*p) << 16); }
__device__ __forceinline__ f32x4 ldbf4(const bf16_t* p) { const u32x2 w = *(const u32x2*)p; return (f32x4){bf_lo(w.x), bf_hi(w.x), bf_lo(w.y), bf_hi(w.y)}; }
__device__ __forceinline__ void stbf(bf16_t* p, float v) { *p = (bf16_t)f2bf(v); }
__device__ __forceinline__ float wave_sum(float v) {
#pragma unroll
    for (int o = 1; o < 64; o <<= 1) v += __shfl_xor(v, o);
    return v;
}
__device__ __forceinline__ float sum8(float v) { v += __shfl_xor(v, 1); v += __shfl_xor(v, 2); v += __shfl_xor(v, 4); return v; }
__device__ __forceinline__ float fexp(float x) { return __builtin_amdgcn_exp2f(x * 1.4426950408889634f); }
__device__ __forceinline__ float frcp(float x) { return __builtin_amdgcn_rcpf(x); }
__device__ __forceinline__ float frsq(float x) { return __builtin_amdgcn_rsqf(x); }
__device__ __forceinline__ float flog(float x) { return __builtin_amdgcn_logf(x) * 0.6931471805599453f; }
__device__ __forceinline__ float sigmoidf_(float x) { return frcp(1.0f + fexp(-x)); }
__device__ __forceinline__ float siluf_(float x) { return x * frcp(1.0f + fexp(-x)); }
__device__ __forceinline__ float ftanh(float x) { return 1.0f - 2.0f * frcp(fexp(2.0f * x) + 1.0f); }
__device__ __forceinline__ float softplusf_(float x) { return fmaxf(x, 0.f) + flog(1.0f + fexp(-fabsf(x))); }
__device__ __forceinline__ float logsigmoidf_(float x) { return -softplusf_(-x); }

#define XB_TMO      128
#define XB_XCNT(j)  (256  + 64 * (j))
#define XB_XSUB(j)  (1280 + 64 * (j))
#define XB_XGEN(j)  (2304 + 64 * (j))
#define XB_TOP      3328
#define XB_TOPGEN   3392
#define XCD_BAR_WORDS 3456
#ifdef EMU
#define XB_SPIN_CAP (0xffffffffu)
#else
#define XB_SPIN_CAP (1u << 22)
#endif
__device__ __forceinline__ unsigned xb_ld(unsigned* p)              { return __hip_atomic_load(p, __ATOMIC_RELAXED, __HIP_MEMORY_SCOPE_AGENT); }
__device__ __forceinline__ unsigned xb_add(unsigned* p, unsigned v) { return __hip_atomic_fetch_add(p, v, __ATOMIC_RELAXED, __HIP_MEMORY_SCOPE_AGENT); }
__device__ __forceinline__ unsigned xb_xcc_id() { return (unsigned)__builtin_amdgcn_s_getreg((3 << 11) | 20) & 0xFu; }
#define XB_SPIN(cond, bar) do { unsigned _sp = 0; while (cond) { __builtin_amdgcn_s_sleep(1); \
    if ((++_sp & 255u) == 0u) { if (xb_ld(&(bar)[XB_TMO])) break; if (_sp > XB_SPIN_CAP) { atomicAdd(&(bar)[XB_TMO], 1u); break; } } } } while (0)
struct XcdBarrier { unsigned* bar; unsigned x; volatile LAS unsigned* st; };
__device__ __forceinline__ XcdBarrier xcd_barrier_post(unsigned* bar, volatile LAS unsigned* st) {
    XcdBarrier b; b.bar = bar; b.x = xb_xcc_id(); b.st = st;
    if (threadIdx.x == 0) (void)xb_add(&bar[XB_XCNT(b.x)], 1u);
    return b;
}
__device__ __forceinline__ void xcd_barrier_complete(unsigned* bar, unsigned x, unsigned& nloc, unsigned& nx) {
    const unsigned G = gridDim.x * gridDim.y * gridDim.z;
    unsigned sum, cnt, mine, sp = 0u;
    for (;;) {
        sum = 0u; cnt = 0u; mine = 0u;
#pragma unroll
        for (unsigned j = 0; j < 16; ++j) { const unsigned c = xb_ld(&bar[XB_XCNT(j)]); sum += c; cnt += (c > 0u) ? 1u : 0u; mine = (j == x) ? c : mine; }
        if (sum == G) break;
        __builtin_amdgcn_s_sleep(1);
        if ((++sp & 255u) == 0u) { if (xb_ld(&bar[XB_TMO])) break; if (sp > XB_SPIN_CAP) { atomicAdd(&bar[XB_TMO], 1u); break; } }
    }
    nloc = mine > 0u ? mine : 1u; nx = cnt > 0u ? cnt : 1u;
}
__device__ __forceinline__ void xcd_barrier(const XcdBarrier& b) {
    ASM_VM0();
    __syncthreads();
    if (threadIdx.x == 0) {
        unsigned* bar = b.bar;
        __builtin_amdgcn_s_waitcnt(0);
        unsigned nloc = b.st[0], nx = b.st[1];
        if (nloc == 0u) { xcd_barrier_complete(bar, b.x, nloc, nx); b.st[0] = nloc; b.st[1] = nx; }
        const unsigned old = xb_add(&bar[XB_XSUB(b.x)], 1u);
        const unsigned gen = old / nloc;
        if (old + 1u == (gen + 1u) * nloc) {
            __builtin_amdgcn_fence(__ATOMIC_RELEASE, "agent");
            ASM_VM0();
            const unsigned og = xb_add(&bar[XB_TOP], 1u);
            const unsigned tg = og / nx;
            if (og + 1u == (tg + 1u) * nx) xb_add(&bar[XB_TOPGEN], 1u);
            else XB_SPIN(xb_ld(&bar[XB_TOPGEN]) == tg, bar);
            __builtin_amdgcn_fence(__ATOMIC_ACQUIRE, "agent");
            xb_add(&bar[XB_XGEN(b.x)], 1u);
            ASM_VM0();
        } else {
            XB_SPIN(xb_ld(&bar[XB_XGEN(b.x)]) == gen, bar);
            __builtin_amdgcn_fence(__ATOMIC_ACQUIRE, "agent");
            ASM_VM0();
        }
    }
    __syncthreads();
}

__device__ __forceinline__ void sub_barrier(unsigned* cnt, unsigned n) {
    ASM_VM0();
    __syncthreads();
    if (threadIdx.x == 0) {
        __builtin_amdgcn_fence(__ATOMIC_RELEASE, "agent");
        ASM_VM0();
        (void)xb_add(cnt, 1u);
        unsigned sp = 0u;
        while (xb_ld(cnt) < n) { __builtin_amdgcn_s_sleep(1); if (++sp > XB_SPIN_CAP) break; }
        __builtin_amdgcn_fence(__ATOMIC_ACQUIRE, "agent");
        ASM_VM0();
    }
    __syncthreads();
}

namespace pg8 {
constexpr int BM = 256, BK = 64, HALF = 128, HTB = HALF * BK * 2, STAGE_BYTES = 8 * HTB, NXCD = 8, WGM = 8;
__host__ __device__ __forceinline__ int lds_byte(int r, int c) { const int st = (r >> 4) * 2 + (c >> 5), rr = r & 15, cc = c & 31, ob = rr * 64 + cc * 2; return st * 1024 + (ob ^ (((ob >> 9) & 1) << 5)); }
__host__ __device__ __forceinline__ void stage_rc(int b, int& R, int& C) { const int st = b / 1024, sb = b % 1024, swz = sb ^ (((sb >> 9) & 1) << 5); R = (st >> 1) * 16 + swz / 64; C = (st & 1) * 32 + (swz % 64) / 2; }
__host__ __device__ __forceinline__ int perm32(int rho) { const int n = rho >> 4, i = rho & 15; return 8 * (i >> 2) + 4 * n + (i & 3); }
struct Unit { int pm, pn, pb; };
struct Gemm { const bf16_t* A; const bf16_t* Bt; int K; const int* rowidx; };
struct Order {
    int nM, nN, nwg, G, c;
    __device__ __forceinline__ void init(int nM_, int nN_, int G_, int c_) { nM = nM_; nN = nN_; nwg = nM * nN; G = G_; c = c_; }
    __device__ __forceinline__ bool tile(int i, int& pm, int& pn) const {
        const long L = (long)i * G + c; if (L >= nwg) return false;
        int wgid = (int)L; { const int q = nwg / NXCD, r = nwg % NXCD, xcd = wgid % NXCD, off = wgid / NXCD; wgid = (xcd < r ? xcd * (q + 1) : r * (q + 1) + (xcd - r) * q) + off; }
        const int nig = WGM * nN, gid = wgid / nig, fm = gid * WGM, gsz = (nM - fm) < WGM ? (nM - fm) : WGM;
        pm = fm + ((wgid % nig) % gsz); pn = (wgid % nig) / gsz; return true;
    }
};
struct DenseSched { Order o; __device__ __forceinline__ bool next(int i, Unit& u) const { if (!o.tile(i, u.pm, u.pn)) return false; u.pb = u.pn; return true; } };
struct MoeSched { Order o; const LAS int* tile_e; int nct;
    __device__ __forceinline__ bool next(int i, Unit& u) const { if (!o.tile(i, u.pm, u.pn)) return false; u.pb = tile_e[u.pm] * nct + u.pn; return true; } };

__device__ __forceinline__ unsigned cvt_pk_bf16(float lo, float hi) {
#ifdef EMU
    return pk2(lo, hi);
#else
    return pk2(lo, hi);
#endif
}
struct EpiF32 {
    static constexpr bool PERM = false;
    float* C; int ldc;
    __device__ __forceinline__ void operator()(const f32x4 (&acc)[2][2][4][2], const Unit& u, int wr, int wc, int fr, int fq) const {
        const int row0 = u.pm * BM + wr * 64 + fr, col0 = u.pn * BM + wc * 32 + 4 * fq;
#pragma unroll
        for (int ai = 0; ai < 2; ++ai)
#pragma unroll
            for (int m = 0; m < 4; ++m) { float* rowp = C + (size_t)(row0 + ai * HALF + m * 16) * ldc + col0;
#pragma unroll
                for (int bj = 0; bj < 2; ++bj)
#pragma unroll
                    for (int n = 0; n < 2; ++n) *(f32x4*)(rowp + bj * HALF + n * 16) = acc[ai][bj][m][n]; }
    }
};
struct EpiBf16 {
    static constexpr bool PERM = true;
    bf16_t* C; int ldc;
    __device__ __forceinline__ void operator()(const f32x4 (&acc)[2][2][4][2], const Unit& u, int wr, int wc, int fr, int fq) const {
        const int row0 = u.pm * BM + wr * 64 + fr, col0 = u.pn * BM + wc * 32 + 8 * fq;
#pragma unroll
        for (int ai = 0; ai < 2; ++ai)
#pragma unroll
            for (int m = 0; m < 4; ++m) { bf16_t* rowp = C + (size_t)(row0 + ai * HALF + m * 16) * ldc + col0;
#pragma unroll
                for (int bj = 0; bj < 2; ++bj) { const f32x4 v0 = acc[ai][bj][m][0], v1 = acc[ai][bj][m][1];
                    u32x4 w; w.x = cvt_pk_bf16(v0[0], v0[1]); w.y = cvt_pk_bf16(v0[2], v0[3]); w.z = cvt_pk_bf16(v1[0], v1[1]); w.w = cvt_pk_bf16(v1[2], v1[3]);
                    *(u32x4*)(rowp + bj * HALF) = w; } }
    }
};
struct EpiResid {
    static constexpr bool PERM = true;
    bf16_t* X; const float* mods;
    __device__ __forceinline__ void operator()(const f32x4 (&acc)[2][2][4][2], const Unit& u, int wr, int wc, int fr, int fq) const {
        const int row0 = u.pm * BM + wr * 64 + fr, col0 = u.pn * BM + wc * 32 + 8 * fq;
        const int rbase = u.pm * BM; const int mrow = rbase < ML ? rbase / SEQ : BATCH;
        const float* g = mods + (size_t)mrow * 6144 + 2 * 1024 + col0;
        f32x4 gv[2][2];
#pragma unroll
        for (int bj = 0; bj < 2; ++bj)
#pragma unroll
            for (int n = 0; n < 2; ++n) gv[bj][n] = *(const f32x4*)(g + bj * HALF + 4 * n);
#pragma unroll
        for (int ai = 0; ai < 2; ++ai)
#pragma unroll
            for (int m = 0; m < 4; ++m) { bf16_t* rowp = X + (size_t)(row0 + ai * HALF + m * 16) * D + col0;
#pragma unroll
                for (int bj = 0; bj < 2; ++bj) { u32x4* p = (u32x4*)(rowp + bj * HALF); const u32x4 xo = *p;
                    const f32x4 v0 = (f32x4){bf_lo(xo.x), bf_hi(xo.x), bf_lo(xo.y), bf_hi(xo.y)} + gv[bj][0] * acc[ai][bj][m][0];
                    const f32x4 v1 = (f32x4){bf_lo(xo.z), bf_hi(xo.z), bf_lo(xo.w), bf_hi(xo.w)} + gv[bj][1] * acc[ai][bj][m][1];
                    u32x4 w; w.x = cvt_pk_bf16(v0[0], v0[1]); w.y = cvt_pk_bf16(v0[2], v0[3]); w.z = cvt_pk_bf16(v1[0], v1[1]); w.w = cvt_pk_bf16(v1[2], v1[3]);
                    *p = w; } }
    }
};
constexpr float F8_WSCALE = 64.0f, F8_ASCALE = 4.0f;
struct EpiSwiglu {
    static constexpr bool PERM = true;
    unsigned char* ACT; const float* bgu;
    __device__ __forceinline__ void operator()(const f32x4 (&acc)[2][2][4][2], const Unit& u, int wr, int wc, int fr, int fq) const {
        const int e = u.pb >> 3;
        const int row0 = u.pm * BM + wr * 64 + fr, j0 = u.pn * 128 + wc * 32 + 8 * fq;
        const float* bg = bgu + (size_t)e * 2048 + j0;
        f32x4 bgl[2], bln[2];
#pragma unroll
        for (int n = 0; n < 2; ++n) { bgl[n] = *(const f32x4*)(bg + 4 * n); bln[n] = *(const f32x4*)(bg + 1024 + 4 * n); }
#pragma unroll
        for (int ai = 0; ai < 2; ++ai)
#pragma unroll
            for (int m = 0; m < 4; ++m) { unsigned char* rowp = ACT + (size_t)(row0 + ai * HALF + m * 16) * DFF + j0;
                float o[8];
#pragma unroll
                for (int n = 0; n < 2; ++n)
#pragma unroll
                    for (int j = 0; j < 4; ++j) { float gl = acc[ai][0][m][n][j] * (1.0f / F8_WSCALE) + bgl[n][j], ln = acc[ai][1][m][n][j] * (1.0f / F8_WSCALE) + bln[n][j];
                        gl = fminf(gl, 7.0f); ln = fminf(fmaxf(ln, -7.0f), 7.0f);
                        o[n * 4 + j] = gl * __builtin_amdgcn_rcpf(1.0f + __builtin_amdgcn_exp2f(-1.702f * 1.4426950408889634f * gl)) * (ln * F8_ASCALE + F8_ASCALE); }
                u32x2 w; w.x = pk4_fp8(o[0], o[1], o[2], o[3]); w.y = pk4_fp8(o[4], o[5], o[6], o[7]);
                *(u32x2*)rowp = w; }
    }
};
struct EpiDown {
    static constexpr bool PERM = true;
    bf16_t* Y; const float* bd; const float* rowgate;
    __device__ __forceinline__ void operator()(const f32x4 (&acc)[2][2][4][2], const Unit& u, int wr, int wc, int fr, int fq) const {
        const int e = u.pb >> 2;
        const int row0 = u.pm * BM + wr * 64 + fr, col0 = u.pn * BM + wc * 32 + 8 * fq;
        const float* b = bd + (size_t)e * 1024 + col0;
        f32x4 bv[2][2];
#pragma unroll
        for (int bj = 0; bj < 2; ++bj)
#pragma unroll
            for (int n = 0; n < 2; ++n) bv[bj][n] = *(const f32x4*)(b + bj * HALF + 4 * n);
#pragma unroll
        for (int ai = 0; ai < 2; ++ai)
#pragma unroll
            for (int m = 0; m < 4; ++m) { const int row = row0 + ai * HALF + m * 16; const float gt = rowgate[row]; bf16_t* rowp = Y + (size_t)row * D + col0;
#pragma unroll
                for (int bj = 0; bj < 2; ++bj) { const f32x4 v0 = (acc[ai][bj][m][0] * (1.0f / (F8_WSCALE * F8_ASCALE)) + bv[bj][0]) * gt, v1 = (acc[ai][bj][m][1] * (1.0f / (F8_WSCALE * F8_ASCALE)) + bv[bj][1]) * gt;
                    u32x4 w; w.x = cvt_pk_bf16(v0[0], v0[1]); w.y = cvt_pk_bf16(v0[2], v0[3]); w.z = cvt_pk_bf16(v1[0], v1[1]); w.w = cvt_pk_bf16(v1[2], v1[3]);
                    *(u32x4*)(rowp + bj * HALF) = w; } }
    }
};

__device__ __forceinline__ f32x4 mma_f8(bf16x8 a0, bf16x8 a1, bf16x8 b0, bf16x8 b1, f32x4 c) {
#ifdef EMU
    return emu_mfma16_f8(a0, a1, b0, b1, c);
#else
    const i32x4 a0i = __builtin_bit_cast(i32x4, a0), a1i = __builtin_bit_cast(i32x4, a1), b0i = __builtin_bit_cast(i32x4, b0), b1i = __builtin_bit_cast(i32x4, b1);
    const i32x8 A = __builtin_shufflevector(a0i, a1i, 0, 1, 2, 3, 4, 5, 6, 7), B = __builtin_shufflevector(b0i, b1i, 0, 1, 2, 3, 4, 5, 6, 7);
    asm volatile("v_mfma_f32_16x16x128_f8f6f4 %0, %1, %2, %0" : "+v"(c) : "v"(A), "v"(B));
    return c;
#endif
}
template <class Epi, class Sched, bool GATHER, bool F8 = false>
__device__ __forceinline__ void gemm_phase(LAS unsigned char* lds, const int tid, const Gemm g, const Sched& S, const Epi& E) {
    const int wid = __builtin_amdgcn_readfirstlane(tid >> 6), lane = tid & 63, wr = wid >> 2, wc = wid & 3, fr = lane & 15, fq = lane >> 4;
    const int K = g.K, nt = K / BK;
    unsigned voffB[2]; int RA[2], CA[2];
#pragma unroll
    for (int i = 0; i < 2; ++i) { int R, C; stage_rc(tid * 16 + i * 8192, R, C); const int Rb = Epi::PERM ? ((R & ~31) + perm32(R & 31)) : R;
        RA[i] = R; CA[i] = C; voffB[i] = (unsigned)(Rb * K + C) * 2u; }
    const size_t kstep = (size_t)(BK * 2);
    const size_t hstep = (size_t)HALF * K * 2;
    const size_t tstep = 2 * hstep;
    const unsigned ldsw = (unsigned)wid * 1024u;
    const int aoff = lds_byte(wr * 64 + fr, fq * 8), boff = lds_byte(wc * 32 + fr, fq * 8);
#define PG8_SA(b, h) (((b) * 2 + (h)) * HTB)
#define PG8_SB(b, h) ((4 + (b) * 2 + (h)) * HTB)
#define PG8_STAGE(bufoff, gbase, voff) do { _Pragma("unroll") for (int _i = 0; _i < 2; ++_i) \
        __builtin_amdgcn_global_load_lds((const unsigned*)((const char*)(gbase) + (voff)[_i]), (LAS unsigned*)(lds + (bufoff) + ldsw + _i * 8192), 16, 0, 0); } while (0)
#define PG8_LDA(dst, b, h) do { _Pragma("unroll") for (int m = 0; m < 4; ++m) _Pragma("unroll") for (int k = 0; k < 2; ++k) dst[m][k] = *(const LAS bf16x8*)(lds + PG8_SA(b, h) + aoff + m * 2048 + k * 1024); } while (0)
#define PG8_LDB(dst, b, h) do { _Pragma("unroll") for (int n = 0; n < 2; ++n) _Pragma("unroll") for (int k = 0; k < 2; ++k) dst[n][k] = *(const LAS bf16x8*)(lds + PG8_SB(b, h) + boff + n * 2048 + k * 1024); } while (0)
#define PG8_MMA(ai, bj, At, Bt) do { __builtin_amdgcn_s_setprio(1); _Pragma("unroll") for (int m = 0; m < 4; ++m) _Pragma("unroll") for (int n = 0; n < 2; ++n) { \
        if constexpr (F8) acc[ai][bj][m][n] = mma_f8(Bt[n][0], Bt[n][1], At[m][0], At[m][1], acc[ai][bj][m][n]); \
        else { _Pragma("unroll") for (int k = 0; k < 2; ++k) acc[ai][bj][m][n] = __builtin_amdgcn_mfma_f32_16x16x32_bf16(Bt[n][k], At[m][k], acc[ai][bj][m][n], 0, 0, 0); } } __builtin_amdgcn_s_setprio(0); } while (0)
#define PG8_BAR __builtin_amdgcn_s_barrier()
#define PG8_SCHED __builtin_amdgcn_sched_barrier(0)
#define PG8_AOFF(dst, unit) do { _Pragma("unroll") for (int _h = 0; _h < 2; ++_h) _Pragma("unroll") for (int _i = 0; _i < 2; ++_i) { \
        const int _r = (unit).pm * BM + _h * HALF + RA[_i]; const int _src = GATHER ? g.rowidx[_r] : _r; dst[_h][_i] = (unsigned)(_src * K + CA[_i]) * 2u; } } while (0)
    Unit cur, nxt; int ui = 0;
    if (!S.next(0, cur)) return;
    f32x4 acc[2][2][4][2];
#pragma unroll
    for (int a = 0; a < 2; ++a)
#pragma unroll
        for (int b = 0; b < 2; ++b)
#pragma unroll
            for (int m = 0; m < 4; ++m)
#pragma unroll
                for (int n = 0; n < 2; ++n) acc[a][b][m][n] = (f32x4){0.f, 0.f, 0.f, 0.f};
    bf16x8 At[4][2], B0[2][2], B1[2][2];
    unsigned cvA[2][2], nvA[2][2];
    PG8_AOFF(cvA, cur);
    const char* const gA = (const char*)g.A;
    const char* cB = (const char*)g.Bt + (size_t)cur.pb * tstep;
    PG8_STAGE(PG8_SB(0, 0), cB, voffB); PG8_STAGE(PG8_SA(0, 0), gA, cvA[0]); PG8_STAGE(PG8_SB(0, 1), cB + hstep, voffB); PG8_STAGE(PG8_SA(0, 1), gA, cvA[1]);
    if (wr == 1) PG8_BAR;
    WAIT_V(4); PG8_BAR;
    PG8_STAGE(PG8_SB(1, 0), cB + kstep, voffB); PG8_STAGE(PG8_SA(1, 0), gA + kstep, cvA[0]); PG8_STAGE(PG8_SB(1, 1), cB + hstep + kstep, voffB);
    WAIT_V(6); PG8_BAR;
    for (;;) {
        const bool has_next = S.next(ui + 1, nxt);
        if (has_next) { PG8_AOFF(nvA, nxt); } else {
#pragma unroll
            for (int h = 0; h < 2; ++h)
#pragma unroll
                for (int i = 0; i < 2; ++i) nvA[h][i] = cvA[h][i]; }
        const char* nB = has_next ? (const char*)g.Bt + (size_t)nxt.pb * tstep : cB;
        for (int t = 0; t < nt; t += 2) {
            const bool last = (t == nt - 2);
            const char* a1 = gA + (size_t)(t + 1) * kstep;
            const char* a2 = last ? gA : gA + (size_t)(t + 2) * kstep; const char* b2 = last ? nB : cB + (size_t)(t + 2) * kstep;
            const char* a3 = a2 + kstep; const char* b3 = b2 + kstep;
            unsigned xA0[2], xA1[2];
#pragma unroll
            for (int i = 0; i < 2; ++i) { xA0[i] = last ? nvA[0][i] : cvA[0][i]; xA1[i] = last ? nvA[1][i] : cvA[1][i]; }
            PG8_LDB(B0, 0, 0); PG8_SCHED; PG8_LDA(At, 0, 0); PG8_STAGE(PG8_SA(1, 1), a1, cvA[1]);
            WAIT_L(8); PG8_BAR; WAIT_L(0); PG8_MMA(0, 0, At, B0); PG8_BAR; PG8_SCHED;
            PG8_LDB(B1, 0, 1); PG8_STAGE(PG8_SB(0, 0), b2, voffB);
            PG8_BAR; WAIT_L(0); PG8_MMA(0, 1, At, B1); PG8_BAR;
            PG8_LDA(At, 0, 1); PG8_STAGE(PG8_SA(0, 0), a2, xA0);
            PG8_BAR; WAIT_L(0); PG8_MMA(1, 0, At, B0); PG8_BAR; PG8_SCHED;
            PG8_STAGE(PG8_SB(0, 1), b2 + hstep, voffB);
            WAIT_V(6); PG8_BAR; PG8_MMA(1, 1, At, B1); PG8_BAR;
            PG8_LDB(B0, 1, 0); PG8_SCHED; PG8_LDA(At, 1, 0); PG8_STAGE(PG8_SA(0, 1), a2, xA1);
            WAIT_L(8); PG8_BAR; WAIT_L(0); PG8_MMA(0, 0, At, B0); PG8_BAR; PG8_SCHED;
            PG8_LDB(B1, 1, 1); PG8_STAGE(PG8_SB(1, 0), b3, voffB);
            PG8_BAR; WAIT_L(0); PG8_MMA(0, 1, At, B1); PG8_BAR;
            PG8_LDA(At, 1, 1); PG8_STAGE(PG8_SA(1, 0), a3, xA0);
            PG8_BAR; WAIT_L(0); PG8_MMA(1, 0, At, B0); PG8_BAR; PG8_SCHED;
            PG8_STAGE(PG8_SB(1, 1), b3 + hstep, voffB);
            WAIT_V(6); PG8_BAR; PG8_MMA(1, 1, At, B1); PG8_BAR;
        }
#ifndef EMU
        if constexpr (F8) asm volatile("s_nop 15\n\ts_nop 15" ::: "memory");
#endif
        E(acc, cur, wr, wc, fr, fq);
        if (!has_next) break;
#pragma unroll
        for (int a = 0; a < 2; ++a)
#pragma unroll
            for (int b = 0; b < 2; ++b)
#pragma unroll
                for (int m = 0; m < 4; ++m)
#pragma unroll
                    for (int n = 0; n < 2; ++n) acc[a][b][m][n] = (f32x4){0.f, 0.f, 0.f, 0.f};
        cur = nxt; cB = nB; ++ui;
#pragma unroll
        for (int h = 0; h < 2; ++h)
#pragma unroll
            for (int i = 0; i < 2; ++i) cvA[h][i] = nvA[h][i];
    }
    WAIT_V(0);
    if (wr == 0) PG8_BAR;
    PG8_BAR;
#undef PG8_SA
#undef PG8_SB
#undef PG8_STAGE
#undef PG8_LDA
#undef PG8_LDB
#undef PG8_MMA
#undef PG8_BAR
#undef PG8_SCHED
#undef PG8_AOFF
}
}

struct Args { const float* in[37]; float* out; unsigned char* ws; int ph_lo, ph_hi; };
enum { I_X = 0, I_C, I_CTX, I_CCTX, I_WADA, I_BADA, I_N1G, I_N2G, I_WIN, I_GGW, I_GGB, I_GNG, I_RMU, I_RW0, I_RW2, I_RA0, I_RA2, I_RG2, I_RKK, I_RKA, I_RRK,
       I_RLG, I_RLB, I_SCW, I_SCB, I_SDTB, I_SALOG, I_SD, I_SNG, I_WOUT, I_ROUTW, I_ROUTB, I_WGU, I_BGU, I_WDN, I_BDN, I_FNG };

struct Tc { LAS unsigned char* lds; int tid, lane, wave, G, bid; };
__device__ __forceinline__ const float* inp(const Tc& t, int i) {
    const unsigned long long v = ((const LAS unsigned long long*)(t.lds + LDS_PTRS))[i];
    const unsigned lo = __builtin_amdgcn_readfirstlane((unsigned)v), hi = __builtin_amdgcn_readfirstlane((unsigned)(v >> 32));
    return (const float*)(((unsigned long long)hi << 32) | lo);
}

struct CvItem { const float* W; bf16_t* dst; int ldw, k0, n0, nv, K; };
__device__ __forceinline__ void cv_load(const CvItem& it, float (&ld)[32], int lane) {
    const int c = lane & 31; const float* wp = it.W + (size_t)(it.k0 + (lane >> 5)) * it.ldw + it.n0 + (c < it.nv ? c : 0);
#pragma unroll
    for (int i = 0; i < 32; ++i) ld[i] = wp[(size_t)(2 * i) * it.ldw];
}
__device__ __forceinline__ void cv_store(const CvItem& it, const float (&ld)[32], LAS float* scr, int lane) {
    { const int c = lane & 31;
#pragma unroll
      for (int i = 0; i < 32; ++i) scr[(2 * i + (lane >> 5)) * 33 + c] = (c < it.nv) ? ld[i] : 0.f; }
    WAVE_LDS_FENCE();
    const int c = lane & 7;
#pragma unroll
    for (int j = 0; j < 4; ++j) { const int n = (lane >> 3) + 8 * j; const LAS float* s = scr + (8 * c) * 33 + n;
        u32x4 o; o.x = pk2(s[0 * 33], s[1 * 33]); o.y = pk2(s[2 * 33], s[3 * 33]); o.z = pk2(s[4 * 33], s[5 * 33]); o.w = pk2(s[6 * 33], s[7 * 33]);
        *(u32x4*)(it.dst + (size_t)n * it.K + it.k0 + 8 * c) = o; }
    WAVE_LDS_FENCE();
}
__device__ __forceinline__ void cv_store8(const CvItem& it, const float (&ld)[32], LAS float* scr, int lane) {
    { const int c = lane & 31;
#pragma unroll
      for (int i = 0; i < 32; ++i) scr[(2 * i + (lane >> 5)) * 33 + c] = ld[i] * pg8::F8_WSCALE; }
    WAVE_LDS_FENCE();
    const int c = lane & 7; unsigned char* d8 = (unsigned char*)it.dst;
#pragma unroll
    for (int j = 0; j < 4; ++j) { const int n = (lane >> 3) + 8 * j; const LAS float* s = scr + (8 * c) * 33 + n;
        u32x2 o; o.x = pk4_fp8(s[0 * 33], s[1 * 33], s[2 * 33], s[3 * 33]); o.y = pk4_fp8(s[4 * 33], s[5 * 33], s[6 * 33], s[7 * 33]);
        *(u32x2*)(d8 + (size_t)n * it.K + it.k0 + 8 * c) = o; }
    WAVE_LDS_FENCE();
}
constexpr int CV_KB = D / 64, CV_I_IN = CV_KB * (NU / 32), CV_I_OUT = CV_KB * (D / 32), CV_I_GU = CV_KB * (2048 / 32), CV_I_DN = CV_KB * (D / 32);
constexpr int CV_MOE_ITEMS = NEXP * (CV_I_GU + CV_I_DN);
constexpr int CV_E_IN = CV_MOE_ITEMS / 4, CV_E_B = (CV_MOE_ITEMS * 2) / 5;
__device__ __forceinline__ CvItem cv_moe_item(const Args& a, int l, int it) {
    unsigned char* WGU = a.ws + WS_WGU; unsigned char* WDN = a.ws + WS_WD;
    const int e = it / (CV_I_GU + CV_I_DN); int r = it % (CV_I_GU + CV_I_DN); CvItem ci;
    if (r < CV_I_GU) { const int kb = r / 64, nb = r % 64, n0 = nb * 32; const int half = n0 >> 10, rem = n0 & 1023, pn = rem >> 7, jj = rem & 127;
        ci.W = a.in[I_WGU] + ((size_t)l * NEXP + e) * D * 2048; ci.ldw = 2048; ci.k0 = kb * 64; ci.n0 = n0; ci.nv = 32; ci.dst = (bf16_t*)(WGU + (((size_t)l * NEXP + e) * 2048 + pn * 256 + half * 128 + jj) * D); ci.K = D; }
    else { r -= CV_I_GU; const int kb = r / (D / 32), nb = r % (D / 32);
        ci.W = a.in[I_WDN] + ((size_t)l * NEXP + e) * DFF * D; ci.ldw = D; ci.k0 = kb * 64; ci.n0 = nb * 32; ci.nv = 32; ci.dst = (bf16_t*)(WDN + (((size_t)l * NEXP + e) * D + nb * 32) * DFF); ci.K = DFF; }
    return ci;
}
__device__ __forceinline__ CvItem cv_dense_item(const Args& a, int it) {
    bf16_t* WIN = (bf16_t*)(a.ws + WS_WIN); bf16_t* WOUT = (bf16_t*)(a.ws + WS_WOUT);
    const int l = it / (CV_I_IN + CV_I_OUT); int r = it % (CV_I_IN + CV_I_OUT); CvItem ci;
    if (r < CV_I_IN) { const int kb = r / (NU / 32), nb = r % (NU / 32), n0 = nb * 32; int nv = IN_COLS - n0; nv = nv < 0 ? 0 : (nv > 32 ? 32 : nv);
        ci.W = a.in[I_WIN] + (size_t)l * D * IN_COLS; ci.ldw = IN_COLS; ci.k0 = kb * 64; ci.n0 = n0; ci.nv = nv; ci.dst = WIN + ((size_t)l * NU + n0) * D; ci.K = D; }
    else { r -= CV_I_IN; const int kb = r / (D / 32), nb = r % (D / 32);
        ci.W = a.in[I_WOUT] + (size_t)l * D * D; ci.ldw = D; ci.k0 = kb * 64; ci.n0 = nb * 32; ci.nv = 32; ci.dst = WOUT + ((size_t)l * D + nb * 32) * D; ci.K = D; }
    return ci;
}
__device__ __forceinline__ void convert_moe(const Args& a, const Tc& t, int l, int i0, int i1, int gw, int ngw) {
    LAS float* scr = (LAS float*)(t.lds + t.wave * 16384);
    float ld[32], ln[32];
    if (i0 + gw < i1) { const CvItem c0 = cv_moe_item(a, l, i0 + gw); cv_load(c0, ld, t.lane); }
    for (int it = i0 + gw; it < i1; it += ngw) {
        const CvItem cur = cv_moe_item(a, l, it);
        const bool more = it + ngw < i1;
        if (more) { const CvItem nx = cv_moe_item(a, l, it + ngw); cv_load(nx, ln, t.lane); }
        cv_store8(cur, ld, scr, t.lane);
        if (more) {
#pragma unroll
            for (int i = 0; i < 32; ++i) ld[i] = ln[i]; }
    }
}
__device__ __forceinline__ void convert_in_slack(const Args& a, const Tc& t, int l, int i0, int i1, int nunits) {
    const int rem = nunits % t.G;
    if (t.bid >= rem) convert_moe(a, t, l, i0, i1, (t.bid - rem) * NWAVES + t.wave, (t.G - rem) * NWAVES);
}
__device__ __forceinline__ void phase_pro0(const Args& a, const Tc& t) {
    LAS float* scr = (LAS float*)(t.lds + t.wave * 16384);
    const int gw = t.bid * NWAVES + t.wave, NGW = t.G * NWAVES;
    { float ld[32];
      for (int it = gw; it < DEPTH * (CV_I_IN + CV_I_OUT); it += NGW) { const CvItem ci = cv_dense_item(a, it); cv_load(ci, ld, t.lane); cv_store(ci, ld, scr, t.lane); } }
    __syncthreads();
    LAS float* sc = (LAS float*)t.lds;
    LAS float* red = (LAS float*)(t.lds + 32768);
    for (int i = t.tid; i < NR * D; i += NTHREADS) { const int r = i / D, k = i % D; const float v = r < BATCH ? a.in[I_C][r * D + k] : a.in[I_CCTX][k]; sc[i] = siluf_(v); }
    __syncthreads();
    float* MODS = (float*)(a.ws + WS_MODS);
    const int jl = t.tid & 127, kq = t.tid >> 7;
    for (int cb = t.bid; cb < DEPTH * 48; cb += t.G) {
        const int l = cb / 48, j = (cb % 48) * 128 + jl;
        const float* w = a.in[I_WADA] + (size_t)l * D * 6144 + j;
        float acc[NR];
#pragma unroll
        for (int r = 0; r < NR; ++r) acc[r] = 0.f;
        for (int k = kq * 256; k < kq * 256 + 256; ++k) { const float wv = w[(size_t)k * 6144];
#pragma unroll
            for (int r = 0; r < NR; ++r) acc[r] += sc[r * D + k] * wv; }
#pragma unroll
        for (int r = 0; r < NR; ++r) red[(kq * NR + r) * 128 + jl] = acc[r];
        __syncthreads();
        if (kq == 0) {
            const float bb = a.in[I_BADA][(size_t)l * 6144 + j];
#pragma unroll
            for (int r = 0; r < NR; ++r) MODS[((size_t)l * NR + r) * 6144 + j] = red[(0 * NR + r) * 128 + jl] + red[(1 * NR + r) * 128 + jl] + red[(2 * NR + r) * 128 + jl] + red[(3 * NR + r) * 128 + jl] + bb;
        }
        __syncthreads();
    }
}

__device__ __forceinline__ int mod_row(int row) { return row < ML ? row / SEQ : BATCH; }
template <bool F8 = false>
__device__ __forceinline__ void norm_mod_store(const f32x4 (&v)[4], const float* g, const float* shift, const float* scale, bf16_t* hrow, int lane, f32x4 (&hout)[4]) {
    float ss = 0.f;
#pragma unroll
    for (int j = 0; j < 4; ++j) ss += (v[j][0] * v[j][0] + v[j][1] * v[j][1]) + (v[j][2] * v[j][2] + v[j][3] * v[j][3]);
    const float rstd = frsq(wave_sum(ss) * (1.0f / D) + 1e-6f);
#pragma unroll
    for (int j = 0; j < 4; ++j) { const int c = 4 * lane + 256 * j;
        const f32x4 gg = *(const f32x4*)(g + c), sh = *(const f32x4*)(shift + c), sc = *(const f32x4*)(scale + c);
        const f32x4 h = (v[j] * rstd * gg) * (sc + 1.0f) + sh; hout[j] = h;
        if constexpr (F8) { *(unsigned*)((unsigned char*)hrow + c) = pk4_fp8(h[0], h[1], h[2], h[3]); }
        else { u32x2 w; w.x = pk2(h[0], h[1]); w.y = pk2(h[2], h[3]); *(u32x2*)(hrow + c) = w; } }
}
__device__ __forceinline__ void phase_pro1(const Args& a, const Tc& t) {
    const int gw = t.bid * NWAVES + t.wave, NGW = t.G * NWAVES;
    bf16_t* X = (bf16_t*)(a.ws + WS_X); bf16_t* H = (bf16_t*)(a.ws + WS_H); const float* MODS = (const float*)(a.ws + WS_MODS);
    for (int row = gw; row < M; row += NGW) {
        const float* src = row < ML ? a.in[I_X] + (size_t)row * D : a.in[I_CTX] + (size_t)(row - ML) * D;
        f32x4 v[4], h[4];
#pragma unroll
        for (int j = 0; j < 4; ++j) { v[j] = *(const f32x4*)(src + 4 * t.lane + 256 * j); u32x2 w; w.x = pk2(v[j][0], v[j][1]); w.y = pk2(v[j][2], v[j][3]); *(u32x2*)(X + (size_t)row * D + 4 * t.lane + 256 * j) = w; }
        const float* md = MODS + (size_t)mod_row(row) * 6144;
        norm_mod_store(v, a.in[I_N1G], md, md + 1024, H + (size_t)row * D, t.lane, h);
    }
}

__device__ __forceinline__ float ld_or0(const float* p, const float* safe, bool ok) { const float v = *(ok ? p : safe); return ok ? v : 0.f; }
__device__ __forceinline__ float ld_or0(const bf16_t* p, const bf16_t* safe, bool ok) { const float v = ldbf(ok ? p : safe); return ok ? v : 0.f; }
__device__ __forceinline__ void seg_bounds(int row, int& lo, int& hi) {
    if (row < ML) { lo = row & ~63; hi = lo + 64; } else { lo = ML + ((row - ML) / CTX) * CTX; hi = lo + CTX; }
}
__device__ __forceinline__ void phase_prep(const Args& a, const Tc& t, int l) {
    const bf16_t* U = (const bf16_t*)(a.ws + WS_U);
    float* GG = (float*)(a.ws + WS_GG); bf16_t* RW7 = (bf16_t*)(a.ws + WS_RW7); bf16_t* SXBC = (bf16_t*)(a.ws + WS_SXBC); float* SDT = (float*)(a.ws + WS_SDT);
    const float* mu = a.in[I_RMU] + (size_t)l * 2 * 928;
    const float* w0 = a.in[I_RW0] + (size_t)l * 2 * 256; const float* w2 = a.in[I_RW2] + (size_t)l * 2 * 32 * 256;
    const float* a0 = a.in[I_RA0] + (size_t)l * 256; const float* a2 = a.in[I_RA2] + (size_t)l * 32 * 256;
    const float* rkk = a.in[I_RKK] + (size_t)l * 256; const float* rka = a.in[I_RKA] + (size_t)l * 256;
    const float* ggw = a.in[I_GGW] + (size_t)l * 2 * 16 * 128; const float* ggb = a.in[I_GGB] + (size_t)l * 2 * 128;
    const float* cw = a.in[I_SCW] + (size_t)l * 4 * 1024; const float* cb = a.in[I_SCB] + (size_t)l * 1024;
    const float* dtb = a.in[I_SDTB] + (size_t)l * 16;
    LAS float* LOW = (LAS float*)t.lds;
    LAS float* A2S = LOW + 16 * 128; LAS float* W2S = A2S + 32 * 256; LAS float* GWS = W2S + 64 * 256;
    for (int e = t.tid; e < 32 * 256 / 4; e += NTHREADS) *(LAS f32x4*)(A2S + 4 * e) = *(const f32x4*)(a2 + 4 * e);
    for (int e = t.tid; e < 64 * 256 / 4; e += NTHREADS) *(LAS f32x4*)(W2S + 4 * e) = *(const f32x4*)(w2 + 4 * e);
    for (int e = t.tid; e < 32 * 128 / 4; e += NTHREADS) *(LAS f32x4*)(GWS + 4 * e) = *(const f32x4*)(ggw + 4 * e);
    LDS_BARRIER();
    for (int tile = t.bid; tile < M / 16; tile += t.G) {
        const int r0 = tile * 16; int slo, shi; seg_bounds(r0, slo, shi);
        {
            const int tt = t.tid >> 5, r = t.tid & 31, row = r0 + tt;
            const bf16_t* up = U + (size_t)row * NU; const bool hp = row - 1 >= slo, hn = row + 1 < shi;
#pragma unroll
            for (int q = 0; q < 3; ++q) { const int col = U_RLWF + q * 32 + r, mi = col - U_RW;
                const float u = ldbf(up + col), pv = ld_or0(up + col - NU, up + col, hp), nv = ld_or0(up + col + NU, up + col, hn);
                const float s = u + mu[mi] * (pv - u) + mu[928 + mi] * (nv - u);
                LOW[tt * 128 + q * 32 + r] = q < 2 ? ftanh(s) : s; }
            LOW[tt * 128 + 96 + r] = ldbf(up + U_GLF + r);
        }
        LDS_BARRIER();
        {
            const int c = t.tid & 255, tt0 = (t.tid >> 8) * 8;
            float lu[10][3];
#pragma unroll
            for (int jj = 0; jj < 10; ++jj) { const int row = r0 + tt0 + jj - 1; const bool ok = row >= slo && row < shi; const bf16_t* up = U + (size_t)(ok ? row : r0) * NU;
                const float x0 = ldbf(up + U_RR + c), x1 = ldbf(up + U_RK + c), x2 = ldbf(up + U_RV + c); lu[jj][0] = ok ? x0 : 0.f; lu[jj][1] = ok ? x1 : 0.f; lu[jj][2] = ok ? x2 : 0.f; }
            float aa[8], af[8], ab[8];
#pragma unroll
            for (int j = 0; j < 8; ++j) { aa[j] = a0[c]; af[j] = w0[c]; ab[j] = w0[256 + c]; }
#pragma unroll 2
            for (int r4 = 0; r4 < 8; ++r4) { float wa[4], wf[4], wb[4];
#pragma unroll
                for (int q = 0; q < 4; ++q) { wa[q] = A2S[(4 * r4 + q) * 256 + c]; wf[q] = W2S[(4 * r4 + q) * 256 + c]; wb[q] = W2S[(32 + 4 * r4 + q) * 256 + c]; }
#pragma unroll
                for (int j = 0; j < 8; ++j) { const LAS float* lw = LOW + (tt0 + j) * 128;
                    const f32x4 la = *(const LAS f32x4*)(lw + 64 + 4 * r4), lf = *(const LAS f32x4*)(lw + 4 * r4), lb = *(const LAS f32x4*)(lw + 32 + 4 * r4);
#pragma unroll
                    for (int q = 0; q < 4; ++q) { aa[j] += la[q] * wa[q]; af[j] += lf[q] * wf[q]; ab[j] += lb[q] * wb[q]; } } }
            const float m0r = mu[c], m1r = mu[928 + c], m0k = mu[256 + c], m1k = mu[928 + 256 + c], m0v = mu[512 + c], m1v = mu[928 + 512 + c];
            const float kkg = rkk[c], kag = rka[c];
#pragma unroll
            for (int j = 0; j < 8; ++j) { const int row = r0 + tt0 + j;
                float u, pv, nv;
                u = lu[j + 1][0]; pv = lu[j][0]; nv = lu[j + 2][0]; const float rs = u + m0r * (pv - u) + m1r * (nv - u);
                u = lu[j + 1][1]; pv = lu[j][1]; nv = lu[j + 2][1]; const float ks = u + m0k * (pv - u) + m1k * (nv - u);
                u = lu[j + 1][2]; pv = lu[j][2]; nv = lu[j + 2][2]; const float vs = u + m0v * (pv - u) + m1v * (nv - u);
                const float av = sigmoidf_(aa[j]);
                const float wfv = fexp(-0.606531f * sigmoidf_(af[j])), wbv = fexp(-0.606531f * sigmoidf_(ab[j]));
                const float kr = ks * kkg; const float ssq = wave_sum(kr * kr); const float kk = kr * (frsq(ssq + 1e-12f));
                const float kf = ks * (1.0f + (av - 1.0f) * kag);
                const size_t o = (size_t)row * 256 + c, P = (size_t)M * 256;
                stbf(RW7 + o, rs); stbf(RW7 + P + o, kf); stbf(RW7 + 2 * P + o, vs); stbf(RW7 + 3 * P + o, kk); stbf(RW7 + 4 * P + o, kk * av); stbf(RW7 + 5 * P + o, wfv); stbf(RW7 + 6 * P + o, wbv); }
        }
        {
            const int j = t.tid & 127, dq = t.tid >> 7, dir = dq & 1, tt0 = (dq >> 1) * 8;
            float acc[8];
#pragma unroll
            for (int q = 0; q < 8; ++q) acc[q] = ggb[dir * 128 + j];
#pragma unroll
            for (int r4 = 0; r4 < 4; ++r4) { float w[4];
#pragma unroll
                for (int q2 = 0; q2 < 4; ++q2) w[q2] = GWS[(dir * 16 + 4 * r4 + q2) * 128 + j];
#pragma unroll
                for (int q = 0; q < 8; ++q) { const f32x4 lv = *(const LAS f32x4*)(LOW + (tt0 + q) * 128 + 96 + dir * 16 + 4 * r4);
                    acc[q] += (lv[0] * w[0] + lv[1] * w[1]) + (lv[2] * w[2] + lv[3] * w[3]); } }
#pragma unroll
            for (int q = 0; q < 8; ++q) GG[((size_t)dir * M + r0 + tt0 + q) * 128 + j] = logsigmoidf_(acc[q]) * (1.0f / 16.0f);
        }
        {
#pragma unroll
            for (int cc = 0; cc < 2; ++cc) { const int col = t.tid + cc * 512; const bf16_t* up = U + U_SXBC + col;
                const float c0 = cw[col], c1 = cw[1024 + col], c2 = cw[2048 + col], c3 = cw[3072 + col], bb = cb[col];
                const bf16_t* uc = up + (size_t)r0 * NU;
                float lc_[19];
#pragma unroll
                for (int q = 0; q < 19; ++q) lc_[q] = ld_or0(uc + (ptrdiff_t)(q - 2) * NU, uc, (r0 + q - 2 >= slo) && (r0 + q - 2 < shi));
                float um2 = lc_[0], um1 = lc_[1], u0 = lc_[2];
#pragma unroll
                for (int q = 0; q < 16; ++q) { const int row = r0 + q; const float up1 = lc_[q + 3];
                    const float y = c0 * um2 + c1 * um1 + c2 * u0 + c3 * up1 + bb;
                    stbf(SXBC + (size_t)row * 1024 + col, siluf_(y)); um2 = um1; um1 = u0; u0 = up1; } }
        }
        if (t.tid < 256) { const int tt = t.tid >> 4, j = t.tid & 15, row = r0 + tt; SDT[(size_t)row * 16 + j] = softplusf_(ldbf(U + (size_t)row * NU + U_SDT + j) + dtb[j]); }
        LDS_BARRIER();
    }
}

__device__ __forceinline__ int chain_row(int b, int dir, int s) {
    if (s < CTX) return ML + b * CTX + (dir ? CTX - 1 - s : s);
    const int tt = s - CTX; return b * SEQ + (dir ? SEQ - 1 - tt : tt);
}

__device__ __forceinline__ f32x4 mma16(f32x4 acc, const LAS bf16_t* A, int lda, const LAS bf16_t* Bt, int ldb, int K, int lane) {
    const int r = lane & 15, kq = (lane >> 4) * 8;
    for (int k0 = 0; k0 < K; k0 += 32) {
        const bf16x8 av = *(const LAS bf16x8*)(A + r * lda + k0 + kq), bv = *(const LAS bf16x8*)(Bt + r * ldb + k0 + kq);
        acc = __builtin_amdgcn_mfma_f32_16x16x32_bf16(av, bv, acc, 0, 0, 0);
    }
    return acc;
}
__device__ __forceinline__ float wave_incl_scan(float v, int lane) {
#pragma unroll
    for (int o = 1; o < 64; o <<= 1) { const float u = __shfl_up(v, o); if (lane >= o) v += u; }
    return v;
}
__device__ __forceinline__ int rc_row0(int b, int c) { return c < CTXC ? ML + b * CTX + 64 * c : b * SEQ + 64 * (c - CTXC); }
__device__ __forceinline__ int rc_chain_pos(int c, int dir) { return dir == 0 ? c : (c < CTXC ? CTXC - 1 - c : CTXC + (LATC - 1 - (c - CTXC))); }

constexpr int SSD_UNITS = BATCH * 2 * NRC;
__device__ __forceinline__ void ssd_a1_unit(const Args& a, const Tc& t, int l, int u) {
    const bf16_t* SXBC = (const bf16_t*)(a.ws + WS_SXBC); const float* SDT = (const float*)(a.ws + WS_SDT);
    bf16_t* SZ = (bf16_t*)(a.ws + WS_SZ); float* SDEC = (float*)(a.ws + WS_SDEC);
    const int c = u % NRC, g = (u / NRC) & 1, b = u / (2 * NRC), row0 = rc_row0(b, c);
    LAS bf16_t* BT = (LAS bf16_t*)t.lds;
    LAS bf16_t* XT = BT + 128 * 72 + t.wave * 64 * 72;
    for (int e = t.tid; e < 64 * 32; e += NTHREADS) { const int rho = e >> 5, n4 = (e & 31) * 4;
        const f32x4 v = ldbf4(SXBC + (size_t)(row0 + rho) * 1024 + 512 + g * 128 + n4);
#pragma unroll
        for (int q = 0; q < 4; ++q) BT[(n4 + q) * 72 + rho] = (bf16_t)f2bf(v[q]); }
    const int hh = t.wave & 3, dir = t.wave >> 2, h = 4 * g + hh, chain = (b * 8 + h) * 2 + dir, cc = rc_chain_pos(c, dir);
    const float a_neg = -fexp(a.in[I_SALOG][(size_t)l * 16 + dir * 8 + h]);
    const float dtv = SDT[(size_t)(row0 + t.lane) * 16 + dir * 8 + h], av = dtv * a_neg;
    const float pre = wave_incl_scan(av, t.lane), tot = __shfl(pre, 63);
    const float wgt = dir == 0 ? fexp(tot - pre) : fexp(pre - av);
    const float sc = dtv * wgt;
#pragma unroll
    for (int p4 = 0; p4 < 16; ++p4) { const f32x4 x = ldbf4(SXBC + (size_t)(row0 + t.lane) * 1024 + h * 64 + p4 * 4);
#pragma unroll
        for (int q = 0; q < 4; ++q) XT[(p4 * 4 + q) * 72 + t.lane] = (bf16_t)f2bf(x[q] * sc); }
    if (t.lane == 0) SDEC[(size_t)chain * NRC + cc] = fexp(tot);
    LDS_BARRIER();
    bf16_t* zb = SZ + ((size_t)chain * NRC + cc) * 64 * 128;
#pragma unroll 1
    for (int pt = 0; pt < 4; ++pt)
#pragma unroll 2
        for (int nt = 0; nt < 8; ++nt) { f32x4 acc = {0.f, 0.f, 0.f, 0.f};
            acc = mma16(acc, XT + pt * 16 * 72, 72, BT + nt * 16 * 72, 72, 64, t.lane);
#pragma unroll
            for (int r = 0; r < 4; ++r) zb[(size_t)(16 * pt + 4 * (t.lane >> 4) + r) * 128 + 16 * nt + (t.lane & 15)] = (bf16_t)f2bf(acc[r]); }
    LDS_BARRIER();
}
constexpr int CAR_DEP = 4;
__device__ __forceinline__ void ssd_b_carry(const Args& a, const Tc& t, int wg, int nwg) {
    const bf16_t* SZ = (const bf16_t*)(a.ws + WS_SZ); const float* SDEC = (const float*)(a.ws + WS_SDEC); bf16_t* SST = (bf16_t*)(a.ws + WS_SST);
    static_assert(NRC % 4 == 0, "carry unroll");
    constexpr int NG = NRC / 4;
    for (int idx = wg * NTHREADS + t.tid; idx < BATCH * 16 * 2048; idx += nwg * NTHREADS) {
        const int chain = idx >> 11, e4 = (idx & 2047) * 4;
        const bf16_t* zc = SZ + (size_t)chain * NRC * 8192 + e4; bf16_t* sc = SST + (size_t)chain * NRC * 8192 + e4; const float* dc = SDEC + (size_t)chain * NRC;
        f32x4 s = {0.f, 0.f, 0.f, 0.f};
        u32x2 z[CAR_DEP][4]; float d[CAR_DEP][4];
#pragma unroll
        for (int g = 0; g < CAR_DEP - 1 && g < NG; ++g)
#pragma unroll
            for (int q = 0; q < 4; ++q) { z[g][q] = *(const u32x2*)(zc + (size_t)(4 * g + q) * 8192); d[g][q] = dc[4 * g + q]; }
#pragma unroll
        for (int g = 0; g < NG; ++g) {
            if (g + CAR_DEP - 1 < NG) {
#pragma unroll
                for (int q = 0; q < 4; ++q) { z[(g + CAR_DEP - 1) % CAR_DEP][q] = *(const u32x2*)(zc + (size_t)(4 * (g + CAR_DEP - 1) + q) * 8192); d[(g + CAR_DEP - 1) % CAR_DEP][q] = dc[4 * (g + CAR_DEP - 1) + q]; } }
#pragma unroll
            for (int q = 0; q < 4; ++q) { u32x2 w; w.x = pk2(s[0], s[1]); w.y = pk2(s[2], s[3]); *(u32x2*)(sc + (size_t)(4 * g + q) * 8192) = w;
                const u32x2 zw = z[g % CAR_DEP][q]; s = s * d[g % CAR_DEP][q] + (f32x4){bf_lo(zw.x), bf_hi(zw.x), bf_lo(zw.y), bf_hi(zw.y)}; }
        }
    }
}
__device__ __forceinline__ void ssd_c_unit(const Args& a, const Tc& t, int l, int u) {
    const bf16_t* SXBC = (const bf16_t*)(a.ws + WS_SXBC); const float* SDT = (const float*)(a.ws + WS_SDT);
    const bf16_t* SST = (const bf16_t*)(a.ws + WS_SST); bf16_t* OS = (bf16_t*)(a.ws + WS_OS);
    const int c = u % NRC, g = (u / NRC) & 1, b = u / (2 * NRC), row0 = rc_row0(b, c);
    LAS bf16_t* CM = (LAS bf16_t*)t.lds;
    LAS bf16_t* BM = CM + 64 * 136;
    LAS bf16_t* GS = BM + 64 * 136;
    LAS bf16_t* XT = GS + 64 * 72 + t.wave * 64 * 72;
    LAS float* PRE = (LAS float*)(GS + 64 * 72 + 8 * 64 * 72) + t.wave * 128;
    for (int e = t.tid; e < 64 * 32; e += NTHREADS) { const int rho = e >> 5, n4 = (e & 31) * 4;
        const f32x4 bv = ldbf4(SXBC + (size_t)(row0 + rho) * 1024 + 512 + g * 128 + n4), cv = ldbf4(SXBC + (size_t)(row0 + rho) * 1024 + 768 + g * 128 + n4);
        u32x2 wb, wc; wb.x = pk2(bv[0], bv[1]); wb.y = pk2(bv[2], bv[3]); wc.x = pk2(cv[0], cv[1]); wc.y = pk2(cv[2], cv[3]);
        *(LAS u32x2*)(BM + rho * 136 + n4) = wb; *(LAS u32x2*)(CM + rho * 136 + n4) = wc; }
    const int hh = t.wave & 3, dir = t.wave >> 2, h = 4 * g + hh, chain = (b * 8 + h) * 2 + dir, cc = rc_chain_pos(c, dir);
    const bf16_t* sb = SST + ((size_t)chain * NRC + cc) * 8192;
    bf16x8 sf[4][4];
#pragma unroll
    for (int pt = 0; pt < 4; ++pt)
#pragma unroll
        for (int ks = 0; ks < 4; ++ks) sf[pt][ks] = *(const bf16x8*)(sb + (size_t)(16 * pt + (t.lane & 15)) * 128 + 32 * ks + 8 * (t.lane >> 4));
    const float a_neg = -fexp(a.in[I_SALOG][(size_t)l * 16 + dir * 8 + h]);
    const float dtv = SDT[(size_t)(row0 + t.lane) * 16 + dir * 8 + h], av = dtv * a_neg;
    const float pre = wave_incl_scan(av, t.lane), tot = __shfl(pre, 63);
    PRE[t.lane] = pre; PRE[64 + t.lane] = pre - av;
#pragma unroll
    for (int p4 = 0; p4 < 16; ++p4) { const f32x4 x = ldbf4(SXBC + (size_t)(row0 + t.lane) * 1024 + h * 64 + p4 * 4);
#pragma unroll
        for (int q = 0; q < 4; ++q) XT[(p4 * 4 + q) * 72 + t.lane] = (bf16_t)f2bf(x[q] * dtv); }
    LDS_BARRIER();
#pragma unroll
    for (int q = 0; q < 2; ++q) { const int ti = t.wave * 2 + q, it = ti >> 2, jt = ti & 3; f32x4 acc = {0.f, 0.f, 0.f, 0.f};
        acc = mma16(acc, CM + it * 16 * 136, 136, BM + jt * 16 * 136, 136, 128, t.lane);
#pragma unroll
        for (int r = 0; r < 4; ++r) GS[(16 * it + 4 * (t.lane >> 4) + r) * 72 + 16 * jt + (t.lane & 15)] = (bf16_t)f2bf(acc[r]); }
    LDS_BARRIER();
#pragma unroll 1
    for (int it = 0; it < 4; ++it) {
        f32x4 acc[4], acc2[4];
#pragma unroll
        for (int pt = 0; pt < 4; ++pt) { acc[pt] = (f32x4){0.f, 0.f, 0.f, 0.f}; acc2[pt] = (f32x4){0.f, 0.f, 0.f, 0.f}; }
        const int rho = 16 * it + (t.lane & 15);
        const float prer = PRE[rho], exr = PRE[64 + rho];
#pragma unroll
        for (int ks = 0; ks < 2; ++ks) {
            const int rp0 = 32 * ks + 8 * (t.lane >> 4);
            const bf16x8 g8 = *(const LAS bf16x8*)(GS + rho * 72 + rp0);
            bf16x8 af;
#pragma unroll
            for (int e = 0; e < 8; ++e) { const int rp = rp0 + e; const float gv = __uint_as_float(((unsigned)(unsigned short)g8[e]) << 16);
                float f;
                if (dir == 0) f = rp <= rho ? fexp(prer - PRE[rp]) : 0.f; else f = rp >= rho ? fexp(PRE[64 + rp] - exr) : 0.f;
                af[e] = (short)f2bf(gv * f); }
#pragma unroll
            for (int pt = 0; pt < 4; ++pt) { const bf16x8 bfr = *(const LAS bf16x8*)(XT + (16 * pt + (t.lane & 15)) * 72 + rp0); acc[pt] = __builtin_amdgcn_mfma_f32_16x16x32_bf16(af, bfr, acc[pt], 0, 0, 0); }
        }
#pragma unroll
        for (int ks = 0; ks < 4; ++ks) {
            const bf16x8 cf = *(const LAS bf16x8*)(CM + rho * 136 + 32 * ks + 8 * (t.lane >> 4));
#pragma unroll
            for (int pt = 0; pt < 4; ++pt) acc2[pt] = __builtin_amdgcn_mfma_f32_16x16x32_bf16(cf, sf[pt][ks], acc2[pt], 0, 0, 0);
        }
#pragma unroll
        for (int r = 0; r < 4; ++r) { const int ro = 16 * it + 4 * (t.lane >> 4) + r; const float f = dir == 0 ? fexp(PRE[ro]) : fexp(tot - PRE[64 + ro]);
#pragma unroll
            for (int pt = 0; pt < 4; ++pt) stbf(OS + ((size_t)dir * M + row0 + ro) * 512 + h * 64 + 16 * pt + (t.lane & 15), acc[pt][r] + f * acc2[pt][r]); }
    }
    LDS_BARRIER();
}


constexpr int RW_UNITS = BATCH * 8 * NCK, RW_PAIRS = RW_UNITS / 2, RWA_HALF = 57344;
static_assert(RW_UNITS % 2 == 0, "unit pairs");
__device__ __forceinline__ void rwkv_a_all(const Args& a, const Tc& t) {
    const bf16_t* RW7 = (const bf16_t*)(a.ws + WS_RW7);
    const size_t P7 = (size_t)M * 256;
    const int half = t.tid >> 8, ht = t.tid & 255, hw = t.wave & 3, hq = t.lane >> 4, lc = t.lane & 15;
    LAS unsigned char* hb = t.lds + half * RWA_HALF;
    LAS float* RAW = (LAS float*)hb;
    LAS float* RtF = RAW;
    LAS float* KhF = RAW + 1024;
    LAS float* AtF = RAW + 3 * 1024;
    LAS float* Uf = RAW + 6 * 1024;
    LAS float* Qkf = Uf + 256;
    LAS float* Nuf = Qkf + 256;
    LAS float* WTs = Nuf + 256;
    LAS bf16_t* BtN = (LAS bf16_t*)(WTs + 64);
    LAS bf16_t* KtN = BtN + 16 * 72; LAS bf16_t* AtN = KtN + 16 * 72; LAS bf16_t* RtN = AtN + 16 * 72;
    LAS bf16_t* KpT = BtN;
    LAS bf16_t* BhT = RtN + 16 * 72;
    LAS bf16_t* VT = BhT + 64 * 40; LAS bf16_t* ApS = VT + 64 * 40;
    LAS bf16_t* NpS = ApS + 64 * 40;
    LAS bf16_t* QbT = NpS + 16 * 40;
    f32x4 pf[6];
#define RWA_LOAD(pair) do { const int u_ = 2 * (pair) + half, ck_ = u_ % NCK, ch_ = u_ / NCK, dir_ = ch_ & 1, h_ = (ch_ >> 1) & 3, b_ = ch_ >> 3; \
        _Pragma("unroll") for (int q = 0; q < 6; ++q) { const int e = ht + 256 * q, vec = e >> 8, rem = e & 255, i = rem >> 4, c4 = rem & 15; \
            const int row = chain_row(b_, dir_, ck_ * RKT + i); const int vs = vec < 5 ? vec : 5 + dir_; \
            pf[q] = ldbf4(RW7 + (size_t)vs * P7 + (size_t)row * 256 + h_ * 64 + c4 * 4); } } while (0)
    if (t.bid < RW_PAIRS) RWA_LOAD(t.bid);
    for (int pair = t.bid; pair < RW_PAIRS; pair += t.G) {
        const int u = 2 * pair + half, ck = u % NCK, chain = u / NCK;
        unsigned char* rec = a.ws + WS_RK + ((size_t)chain * NCK + ck) * RK_BYTES;
#pragma unroll
        for (int q = 0; q < 6; ++q) *(LAS f32x4*)(RAW + (ht + 256 * q) * 4) = pf[q];
        for (int e = ht; e < 3 * 64 * 8; e += 256) { const int arr = e >> 9, rem = e & 511, r = rem >> 3, c2 = rem & 7; *(LAS unsigned*)(BhT + arr * 64 * 40 + r * 40 + 16 + 2 * c2) = 0u; }
        { const int arr = ht >> 7, rem = ht & 127, r = rem >> 3, c2 = rem & 7; *(LAS unsigned*)(NpS + arr * 16 * 40 + r * 40 + 16 + 2 * c2) = 0u; }
        LDS_BARRIER();
        if (pair + t.G < RW_PAIRS) RWA_LOAD(pair + t.G);
        { const int j = ht & 63, ig = ht >> 6; float wc = 1.f, wT = 1.f;
#pragma unroll
            for (int i = 0; i < 16; ++i) { const float wv = RAW[5 * 1024 + i * 64 + j]; wT *= wv; if (i < 4 * ig) wc *= wv; }
            if (ig == 0) WTs[j] = wT;
            float bh4[4], v4[4];
#pragma unroll
            for (int q = 0; q < 4; ++q) { const int i = 4 * ig + q; const float wp = wc; wc *= RAW[5 * 1024 + i * 64 + j]; const float iw = frcp(wc);
                const float at = RAW[3 * 1024 + i * 64 + j] * wp, rt = RAW[i * 64 + j] * wc, bt = RAW[4 * 1024 + i * 64 + j] * iw, kt = RAW[1024 + i * 64 + j] * iw;
                AtN[i * 72 + j] = (bf16_t)f2bf(at); RtN[i * 72 + j] = (bf16_t)f2bf(rt); BtN[i * 72 + j] = (bf16_t)f2bf(bt); KtN[i * 72 + j] = (bf16_t)f2bf(kt);
                bh4[q] = bt * wT; v4[q] = RAW[2 * 1024 + i * 64 + j];
                KhF[i * 64 + j] = kt * wT; RtF[i * 64 + j] = rt; AtF[i * 64 + j] = at; }
            { u32x2 wb, wv; wb.x = pk2(bh4[0], bh4[1]); wb.y = pk2(bh4[2], bh4[3]); wv.x = pk2(v4[0], v4[1]); wv.y = pk2(v4[2], v4[3]);
              *(LAS u32x2*)(BhT + j * 40 + 4 * ig) = wb; *(LAS u32x2*)(VT + j * 40 + 4 * ig) = wv; } }
        LDS_BARRIER();
        { f32x4 acc = {0.f, 0.f, 0.f, 0.f};
            acc = mma16(acc, (hw == 0 || hw == 3) ? BtN : KtN, 72, hw < 2 ? AtN : RtN, 72, 64, t.lane);
            f32x4 mv;
#pragma unroll
            for (int r = 0; r < 4; ++r) { const int s_ = 4 * hq + r, t_ = lc; const bool keep = hw < 2 ? (s_ < t_) : (s_ <= t_); mv[r] = keep ? acc[r] : 0.f; }
            if (hw == 0) *(LAS f32x4*)(Uf + lc * 16 + 4 * hq) = mv;
            else if (hw == 3) { u32x2 w; w.x = pk2(mv[0], mv[1]); w.y = pk2(mv[2], mv[3]); *(LAS u32x2*)(QbT + lc * 40 + 4 * hq) = w; }
            else {
#pragma unroll
                for (int r = 0; r < 4; ++r) { const int s_ = 4 * hq + r; if (hw == 1) Nuf[s_ * 16 + lc] = mv[r]; else Qkf[s_ * 16 + lc] = mv[r]; } } }
        LDS_BARRIER();
        if (ht < 80) { float x[16]; const bool isA = ht < 64; const int rr = isA ? ht : ht - 64;
#pragma unroll
            for (int tt = 0; tt < 16; ++tt) { float acc = isA ? AtF[tt * 64 + rr] : Nuf[rr * 16 + tt];
                f32x4 uc[4];
#pragma unroll
                for (int q = 0; q < 4; ++q) uc[q] = *(const LAS f32x4*)(Uf + tt * 16 + 4 * q);
#pragma unroll
                for (int s_ = 0; s_ < 16; ++s_) if (s_ < tt) acc -= x[s_] * uc[s_ >> 2][s_ & 3];
                x[tt] = acc; }
            u32x4 w0, w1; w0.x = pk2(x[0], x[1]); w0.y = pk2(x[2], x[3]); w0.z = pk2(x[4], x[5]); w0.w = pk2(x[6], x[7]); w1.x = pk2(x[8], x[9]); w1.y = pk2(x[10], x[11]); w1.z = pk2(x[12], x[13]); w1.w = pk2(x[14], x[15]);
            LAS bf16_t* xr = (isA ? ApS : NpS) + rr * 40; *(LAS u32x4*)xr = w0; *(LAS u32x4*)(xr + 8) = w1; }
        else if (ht >= 128) { for (int e = ht - 128; e < 64 * 8; e += 128) { const int r = e >> 3, c2 = e & 7; *(LAS unsigned*)(KpT + r * 40 + 16 + 2 * c2) = 0u; } }
        LDS_BARRIER();
        for (int ti = hw; ti < 25; ti += 4) {
            f32x4 acc = {0.f, 0.f, 0.f, 0.f};
            if (ti < 16) { const int jt = ti >> 2, jt2 = ti & 3;
                acc = mma16(acc, ApS + jt * 16 * 40, 40, BhT + jt2 * 16 * 40, 40, 32, t.lane);
                unsigned short o[4];
#pragma unroll
                for (int r = 0; r < 4; ++r) { const int j = 16 * jt + 4 * hq + r, j2 = 16 * jt2 + lc; const float dg = (j == j2) ? WTs[j] : 0.f; o[r] = (unsigned short)f2bf(dg - acc[r]); }
                u32x2 w; w.x = o[0] | ((unsigned)o[1] << 16); w.y = o[2] | ((unsigned)o[3] << 16);
                *(u32x2*)(rec + RK_PA + ((size_t)((jt2 * 2 + (jt >> 1)) * 64 + t.lane) * 8 + 4 * (jt & 1)) * 2) = w;
            } else if (ti < 20) { const int jt = ti - 16;
                acc = mma16(acc, ApS + jt * 16 * 40, 40, QbT, 40, 32, t.lane);
                unsigned short o[4];
                const f32x4 rt4 = *(const LAS f32x4*)(RtF + lc * 64 + 16 * jt + 4 * hq);
#pragma unroll
                for (int r = 0; r < 4; ++r) o[r] = (unsigned short)f2bf(rt4[r] - acc[r]);
                u32x2 w; w.x = o[0] | ((unsigned)o[1] << 16); w.y = o[2] | ((unsigned)o[3] << 16);
                *(u32x2*)(rec + RK_RA + ((size_t)(((jt >> 1) * 64 + t.lane) * 8 + 4 * (jt & 1))) * 2) = w;
            } else if (ti == 20) {
                acc = mma16(acc, NpS, 40, QbT, 40, 32, t.lane);
                unsigned short o[4];
#pragma unroll
                for (int r = 0; r < 4; ++r) o[r] = (unsigned short)f2bf(Qkf[(4 * hq + r) * 16 + lc] - acc[r]);
                u32x2 w; w.x = o[0] | ((unsigned)o[1] << 16); w.y = o[2] | ((unsigned)o[3] << 16);
                *(u32x2*)(rec + RK_QA + ((size_t)((lc + 16 * (hq >> 1)) * 8 + 4 * (hq & 1))) * 2) = w;
                u32x2 z; z.x = 0u; z.y = 0u; *(u32x2*)(rec + RK_QA + ((size_t)((32 + lc + 16 * (hq >> 1)) * 8 + 4 * (hq & 1))) * 2) = z;
            } else { const int jt2 = ti - 21;
                acc = mma16(acc, NpS, 40, BhT + jt2 * 16 * 40, 40, 32, t.lane);
                float kp[4];
#pragma unroll
                for (int r = 0; r < 4; ++r) { const int s_ = 4 * hq + r, j2 = 16 * jt2 + lc; kp[r] = KhF[s_ * 64 + j2] - acc[r]; }
                u32x2 w; w.x = pk2(kp[0], kp[1]); w.y = pk2(kp[2], kp[3]); *(LAS u32x2*)(KpT + (16 * jt2 + lc) * 40 + 4 * hq) = w;
            }
        }
        for (int e = ht; e < 4 * 64 * 4; e += 256) { const int it = e >> 8, rem = e & 255, ln = rem >> 2, e2 = (rem & 3) * 2, hp = ln >> 4, i2 = 16 * it + (ln & 15);
            unsigned w = 0u; if (hp < 2) { const int s0 = 8 * hp + e2; w = f2bf(RAW[2 * 1024 + s0 * 64 + i2]) | (f2bf(RAW[2 * 1024 + (s0 + 1) * 64 + i2]) << 16); }
            *(unsigned*)(rec + RK_VB + ((size_t)((it * 64 + ln) * 8 + e2)) * 2) = w; }
        LDS_BARRIER();
#pragma unroll
        for (int q = 0; q < 4; ++q) { const int ti = hw * 4 + q, rt = ti >> 2, it = ti & 3; f32x4 acc = {0.f, 0.f, 0.f, 0.f};
            acc = mma16(acc, KpT + rt * 16 * 40, 40, VT + it * 16 * 40, 40, 32, t.lane);
            u32x2 zw; zw.x = pk2(acc[0], acc[1]); zw.y = pk2(acc[2], acc[3]);
            *(u32x2*)(rec + RK_ZC + ((size_t)((rt * 4 + it) * 64 + t.lane)) * 8) = zw; }
        LDS_BARRIER();
    }
#undef RWA_LOAD
}
constexpr int RKB_TASKS = BATCH * 8 * 2, RKB_NS = 7, RKB_D = 5, RKB_SLOT = 17408;
__device__ __forceinline__ void rkb_piece(const unsigned char* rp, int p, int w0, int lane, LAS unsigned char* slot) {
    const unsigned char* src;
    if (p < 8) src = rp + RK_PA + (size_t)(p * 64 + lane) * 16; else if (p < 10) src = rp + RK_RA + (size_t)((p - 8) * 64 + lane) * 16; else if (p == 10) src = rp + RK_QA + (size_t)lane * 16;
    else if (p < 15) src = rp + RK_ZC + (size_t)(((p - 11) * 4 + w0 + (lane >> 5)) * 64) * 8 + (size_t)(lane & 31) * 16;
    else src = rp + RK_VB + (size_t)((w0 + (p - 15)) * 64 + lane) * 16;
    __builtin_amdgcn_global_load_lds((const unsigned*)src, (LAS unsigned*)(slot + p * 1024), 16, 0, 0);
}
__device__ __forceinline__ void rkb_issue(const unsigned char* rec, int ck, int w0, int lw, int lane, LAS unsigned char* ring) {
    const unsigned char* rp = rec + (size_t)ck * RK_BYTES; LAS unsigned char* slot = ring + (ck % RKB_NS) * RKB_SLOT;
#pragma unroll
    for (int q = 0; q < 4; ++q) rkb_piece(rp, 4 * lw + q, w0, lane, slot);
    if (lw == 0) rkb_piece(rp, 16, w0, lane, slot);
}
__device__ __forceinline__ void rwkv_b_task(const Args& a, const Tc& t, int task) {
    bf16_t* OR = (bf16_t*)(a.ws + WS_OR);
    const int hb = task & 1, chain = task >> 1, dir = chain & 1, h = (chain >> 1) & 3, b = chain >> 3, hq = t.lane >> 4, lc = t.lane & 15;
    const int w0 = 2 * hb, w = w0 + (t.wave & 1);
    const unsigned char* rec = a.ws + WS_RK + (size_t)chain * NCK * RK_BYTES;
    LAS unsigned char* ring = t.lds;
    const bool loader = (t.wave >= 2 && t.wave <= 5); const int lw = t.wave - 2;
    if (loader) {
#pragma unroll 1
        for (int ck = 0; ck < RKB_D; ++ck) rkb_issue(rec, ck, w0, lw, t.lane, ring);
    }
    f32x4 T[4];
#pragma unroll
    for (int rt = 0; rt < 4; ++rt) T[rt] = (f32x4){0.f, 0.f, 0.f, 0.f};
#pragma unroll 1
    for (int ck = 0; ck < NCK; ++ck) {
        if (loader) {
            if (ck + RKB_D <= NCK) { if (lw == 0) WAIT_V(20); else WAIT_V(16); } else WAIT_V(0);
        }
        __builtin_amdgcn_s_barrier();
        if (loader) { if (ck + RKB_D < NCK) rkb_issue(rec, ck + RKB_D, w0, lw, t.lane, ring); }
        else if (t.wave < 2) {
            const LAS unsigned char* slot = ring + (ck % RKB_NS) * RKB_SLOT;
            bf16x8 pa[4][2], ra[2], qa, vb; f32x4 zc[4]; u32x2 zraw[4];
#pragma unroll
            for (int rt = 0; rt < 4; ++rt) {
#pragma unroll
                for (int ks = 0; ks < 2; ++ks) pa[rt][ks] = *(const LAS bf16x8*)(slot + ((rt * 2 + ks) * 64 + t.lane) * 16);
                zraw[rt] = *(const LAS u32x2*)(slot + (11 + rt) * 1024 + t.wave * 512 + t.lane * 8); }
#pragma unroll
            for (int ks = 0; ks < 2; ++ks) ra[ks] = *(const LAS bf16x8*)(slot + ((8 + ks) * 64 + t.lane) * 16);
            qa = *(const LAS bf16x8*)(slot + (10 * 64 + t.lane) * 16); vb = *(const LAS bf16x8*)(slot + ((15 + t.wave) * 64 + t.lane) * 16);
            WAIT_L(0); __builtin_amdgcn_sched_barrier(0);
#pragma unroll
            for (int rt = 0; rt < 4; ++rt) { const u32x2 zw = zraw[rt]; zc[rt] = (f32x4){bf_lo(zw.x), bf_hi(zw.x), bf_lo(zw.y), bf_hi(zw.y)}; }
            bf16x8 bfr[2];
#pragma unroll
            for (int ks = 0; ks < 2; ++ks) { u32x4 wv; wv.x = pk2(T[2 * ks][0], T[2 * ks][1]); wv.y = pk2(T[2 * ks][2], T[2 * ks][3]); wv.z = pk2(T[2 * ks + 1][0], T[2 * ks + 1][1]); wv.w = pk2(T[2 * ks + 1][2], T[2 * ks + 1][3]);
                bfr[ks] = __builtin_bit_cast(bf16x8, wv); }
            f32x4 o = {0.f, 0.f, 0.f, 0.f};
            o = __builtin_amdgcn_mfma_f32_16x16x32_bf16(bfr[0], ra[0], o, 0, 0, 0);
            o = __builtin_amdgcn_mfma_f32_16x16x32_bf16(bfr[1], ra[1], o, 0, 0, 0);
            o = __builtin_amdgcn_mfma_f32_16x16x32_bf16(vb, qa, o, 0, 0, 0);
#pragma unroll
            for (int rt = 0; rt < 4; ++rt) { f32x4 n = __builtin_amdgcn_mfma_f32_16x16x32_bf16(pa[rt][0], bfr[0], zc[rt], 0, 0, 0); T[rt] = __builtin_amdgcn_mfma_f32_16x16x32_bf16(pa[rt][1], bfr[1], n, 0, 0, 0); }
            { const int row = chain_row(b, dir, ck * RKT + lc); u32x2 ow; ow.x = pk2(o[0], o[1]); ow.y = pk2(o[2], o[3]);
              *(u32x2*)(OR + ((size_t)dir * M + row) * 256 + h * 64 + 16 * w + 4 * hq) = ow; }
        }
    }
    __builtin_amdgcn_s_barrier();
}

constexpr int GLA_UNITS = BATCH * GNC;
__device__ __forceinline__ int gc_row0(int b, int c) { return c < GC_CTX ? ML + b * CTX + 32 * c : b * SEQ + 32 * (c - GC_CTX); }
__device__ __forceinline__ int gc_chain_pos(int c, int dir) { return dir == 0 ? c : (c < GC_CTX ? GC_CTX - 1 - c : GC_CTX + (GC_LAT - 1 - (c - GC_CTX))); }
__device__ __forceinline__ void gla_prefix(LAS float* PRE, int lane) {
    const int d = lane & 31, r0 = (lane >> 5) * 16; float run = 0.f;
#pragma unroll
    for (int i = 0; i < 16; ++i) { run += PRE[(r0 + i) * 33 + d]; PRE[(r0 + i) * 33 + d] = run; }
    WAVE_LDS_FENCE();
    if (lane >= 32) { const float add = PRE[15 * 33 + d];
#pragma unroll
        for (int i = 0; i < 16; ++i) PRE[(16 + i) * 33 + d] += add; }
    WAVE_LDS_FENCE();
}
__device__ __forceinline__ void gla_a1_unit(const Args& a, const Tc& t, int u) {
    const bf16_t* U = (const bf16_t*)(a.ws + WS_U); const float* GG = (const float*)(a.ws + WS_GG);
    float* GZ = (float*)(a.ws + WS_GZ); float* GDEC = (float*)(a.ws + WS_GDEC);
    const int c = u % GNC, b = u / GNC, row0 = gc_row0(b, c);
    const int h = t.wave & 3, dir = t.wave >> 2, chain = (b * 4 + h) * 2 + dir, cc = gc_chain_pos(c, dir);
    LAS float* PRE = (LAS float*)(t.lds + t.wave * 12288);
    LAS bf16_t* KT = (LAS bf16_t*)(PRE + 32 * 33 + 8);
    LAS bf16_t* VT = KT + 32 * 40;
    const int rho = t.lane & 31, hf = t.lane >> 5;
#pragma unroll
    for (int q = 0; q < 4; ++q) { const f32x4 g = *(const f32x4*)(GG + ((size_t)dir * M + row0 + rho) * 128 + h * 32 + hf * 16 + 4 * q);
#pragma unroll
        for (int e = 0; e < 4; ++e) PRE[rho * 33 + hf * 16 + 4 * q + e] = g[e]; }
    WAVE_LDS_FENCE();
    f32x4 graw[4];
#pragma unroll
    for (int q = 0; q < 4; ++q)
#pragma unroll
        for (int e = 0; e < 4; ++e) graw[q][e] = PRE[rho * 33 + hf * 16 + 4 * q + e];
    WAVE_LDS_FENCE();
    gla_prefix(PRE, t.lane);
#pragma unroll
    for (int q = 0; q < 4; ++q) { const f32x4 k = ldbf4(U + (size_t)(row0 + rho) * NU + U_GK + h * 32 + hf * 16 + 4 * q);
#pragma unroll
        for (int e = 0; e < 4; ++e) { const int d = hf * 16 + 4 * q + e; const float pre = PRE[rho * 33 + d], tot = PRE[31 * 33 + d];
            const float w = dir == 0 ? fexp(tot - pre) : fexp(pre - graw[q][e]);
            KT[d * 40 + rho] = (bf16_t)f2bf(k[e] * w); } }
#pragma unroll
    for (int q = 0; q < 8; ++q) { const f32x4 v = ldbf4(U + (size_t)(row0 + rho) * NU + U_GV + h * 64 + hf * 32 + 4 * q);
#pragma unroll
        for (int e = 0; e < 4; ++e) VT[(hf * 32 + 4 * q + e) * 40 + rho] = (bf16_t)f2bf(v[e]); }
    if (t.lane < 32) GDEC[((size_t)chain * GNC + cc) * 32 + t.lane] = fexp(PRE[31 * 33 + t.lane]);
    WAVE_LDS_FENCE();
    float* zb = GZ + ((size_t)chain * GNC + cc) * 2048;
#pragma unroll
    for (int vt = 0; vt < 4; ++vt)
#pragma unroll
        for (int dt = 0; dt < 2; ++dt) { f32x4 acc = {0.f, 0.f, 0.f, 0.f};
            acc = mma16(acc, VT + vt * 16 * 40, 40, KT + dt * 16 * 40, 40, 32, t.lane);
#pragma unroll
            for (int r = 0; r < 4; ++r) zb[(16 * vt + 4 * (t.lane >> 4) + r) * 32 + 16 * dt + (t.lane & 15)] = acc[r]; }
    WAVE_LDS_FENCE();
}
__device__ __forceinline__ void gla_b_carry(const Args& a, const Tc& t, int wg, int nwg) {
    const float* GZ = (const float*)(a.ws + WS_GZ); const float* GDEC = (const float*)(a.ws + WS_GDEC); bf16_t* GST = (bf16_t*)(a.ws + WS_GST);
    static_assert(GNC % 4 == 0, "carry unroll");
    constexpr int NG = GNC / 4, DEP = 3;
    for (int idx = (nwg - 1 - wg) * NTHREADS + t.tid; idx < BATCH * 8 * 512; idx += nwg * NTHREADS) {
        const int chain = idx >> 9, e4 = (idx & 511) * 4, d0 = e4 & 31;
        const float* zc = GZ + (size_t)chain * GNC * 2048 + e4; bf16_t* sc = GST + (size_t)chain * GNC * 2048 + e4; const float* dc = GDEC + (size_t)chain * GNC * 32 + d0;
        f32x4 s = {0.f, 0.f, 0.f, 0.f};
        f32x4 z[DEP][4], d[DEP][4];
#pragma unroll
        for (int g = 0; g < DEP - 1 && g < NG; ++g)
#pragma unroll
            for (int q = 0; q < 4; ++q) { z[g][q] = *(const f32x4*)(zc + (size_t)(4 * g + q) * 2048); d[g][q] = *(const f32x4*)(dc + (size_t)(4 * g + q) * 32); }
#pragma unroll
        for (int g = 0; g < NG; ++g) {
            if (g + DEP - 1 < NG) {
#pragma unroll
                for (int q = 0; q < 4; ++q) { z[(g + DEP - 1) % DEP][q] = *(const f32x4*)(zc + (size_t)(4 * (g + DEP - 1) + q) * 2048); d[(g + DEP - 1) % DEP][q] = *(const f32x4*)(dc + (size_t)(4 * (g + DEP - 1) + q) * 32); } }
#pragma unroll
            for (int q = 0; q < 4; ++q) { u32x2 w; w.x = pk2(s[0], s[1]); w.y = pk2(s[2], s[3]); *(u32x2*)(sc + (size_t)(4 * g + q) * 2048) = w; s = s * d[g % DEP][q] + z[g % DEP][q]; }
        }
    }
}
__device__ __forceinline__ void gla_c_unit(const Args& a, const Tc& t, int u) {
    const bf16_t* U = (const bf16_t*)(a.ws + WS_U); const float* GG = (const float*)(a.ws + WS_GG);
    const bf16_t* GST = (const bf16_t*)(a.ws + WS_GST); bf16_t* OG = (bf16_t*)(a.ws + WS_OG);
    const int c = u % GNC, b = u / GNC, row0 = gc_row0(b, c);
    const int h = t.wave & 3, dir = t.wave >> 2, chain = (b * 4 + h) * 2 + dir, cc = gc_chain_pos(c, dir);
    LAS float* PRE = (LAS float*)(t.lds + t.wave * 14592);
    LAS bf16_t* QN = (LAS bf16_t*)(PRE + 32 * 33 + 8);
    LAS bf16_t* KN = QN + 32 * 40;
    LAS bf16_t* VT = KN + 32 * 40;
    const int rho = t.lane & 31, hf = t.lane >> 5, hq = t.lane >> 4, lc = t.lane & 15;
#pragma unroll
    for (int q = 0; q < 4; ++q) { const f32x4 g = *(const f32x4*)(GG + ((size_t)dir * M + row0 + rho) * 128 + h * 32 + hf * 16 + 4 * q);
#pragma unroll
        for (int e = 0; e < 4; ++e) PRE[rho * 33 + hf * 16 + 4 * q + e] = g[e]; }
    WAVE_LDS_FENCE();
    f32x4 graw[4];
#pragma unroll
    for (int q = 0; q < 4; ++q)
#pragma unroll
        for (int e = 0; e < 4; ++e) graw[q][e] = PRE[rho * 33 + hf * 16 + 4 * q + e];
    WAVE_LDS_FENCE();
    gla_prefix(PRE, t.lane);
#pragma unroll
    for (int q = 0; q < 4; ++q) { const f32x4 qv = ldbf4(U + (size_t)(row0 + rho) * NU + U_GQ + h * 32 + hf * 16 + 4 * q), kv = ldbf4(U + (size_t)(row0 + rho) * NU + U_GK + h * 32 + hf * 16 + 4 * q);
#pragma unroll
        for (int e = 0; e < 4; ++e) { const int d = hf * 16 + 4 * q + e; const float pre = PRE[rho * 33 + d], tot = PRE[31 * 33 + d], ref = PRE[15 * 33 + d];
            const float ex = pre - graw[q][e], qs = qv[e] * 0.17677669529663687f;
            float fq, fk;
            if (dir == 0) { fq = fexp(pre - ref); fk = fexp(ref - pre); } else { fq = fexp(ref - ex); fk = fexp(ex - ref); }
            (void)tot;
            QN[rho * 40 + d] = (bf16_t)f2bf(qs * fq); KN[rho * 40 + d] = (bf16_t)f2bf(kv[e] * fk); } }
    bf16x8 q2f[2];
#pragma unroll
    for (int it = 0; it < 2; ++it) { const int ro = 16 * it + lc; const bf16_t* qp = U + (size_t)(row0 + ro) * NU + U_GQ + h * 32 + 8 * hq; const float* gp = GG + ((size_t)dir * M + row0 + ro) * 128 + h * 32 + 8 * hq;
        const f32x4 qa = ldbf4(qp), qb = ldbf4(qp + 4), ga = *(const f32x4*)gp, gb = *(const f32x4*)(gp + 4);
#pragma unroll
        for (int e = 0; e < 8; ++e) { const int d = 8 * hq + e; const float pre = PRE[ro * 33 + d], tot = PRE[31 * 33 + d]; const float qv = e < 4 ? qa[e & 3] : qb[e & 3], gv = e < 4 ? ga[e & 3] : gb[e & 3];
            const float f2 = dir == 0 ? fexp(pre) : fexp(tot - (pre - gv));
            q2f[it][e] = (short)f2bf(qv * 0.17677669529663687f * f2); } }
#pragma unroll
    for (int q = 0; q < 8; ++q) { const f32x4 v = ldbf4(U + (size_t)(row0 + rho) * NU + U_GV + h * 64 + hf * 32 + 4 * q);
#pragma unroll
        for (int e = 0; e < 4; ++e) VT[(hf * 32 + 4 * q + e) * 40 + rho] = (bf16_t)f2bf(v[e]); }
    WAVE_LDS_FENCE();
    f32x4 att[2][2];
#pragma unroll
    for (int it = 0; it < 2; ++it)
#pragma unroll
        for (int jt = 0; jt < 2; ++jt) { att[it][jt] = (f32x4){0.f, 0.f, 0.f, 0.f}; att[it][jt] = mma16(att[it][jt], QN + it * 16 * 40, 40, KN + jt * 16 * 40, 40, 32, t.lane); }
    WAVE_LDS_FENCE();
#pragma unroll
    for (int it = 0; it < 2; ++it)
#pragma unroll
        for (int jt = 0; jt < 2; ++jt)
#pragma unroll
            for (int r = 0; r < 4; ++r) { const int ro = 16 * it + 4 * hq + r, rp = 16 * jt + lc; const bool keep = dir == 0 ? (rp <= ro) : (rp >= ro);
                QN[ro * 40 + rp] = (bf16_t)f2bf(keep ? att[it][jt][r] : 0.f); }
    WAVE_LDS_FENCE();
    const bf16_t* sb = GST + ((size_t)chain * GNC + cc) * 2048;
#pragma unroll
    for (int it = 0; it < 2; ++it)
#pragma unroll
        for (int vt = 0; vt < 4; ++vt) { f32x4 acc = {0.f, 0.f, 0.f, 0.f};
            acc = mma16(acc, QN + it * 16 * 40, 40, VT + vt * 16 * 40, 40, 32, t.lane);
            const bf16x8 sf = *(const bf16x8*)(sb + (size_t)(16 * vt + lc) * 32 + 8 * hq);
            acc = __builtin_amdgcn_mfma_f32_16x16x32_bf16(q2f[it], sf, acc, 0, 0, 0);
#pragma unroll
            for (int r = 0; r < 4; ++r) stbf(OG + ((size_t)dir * M + row0 + 16 * it + 4 * hq + r) * 256 + h * 64 + 16 * vt + lc, acc[r]); }
    WAVE_LDS_FENCE();
}

__device__ __forceinline__ void phase_mixout(const Args& a, const Tc& t, int l, int Mtok) {
    const bf16_t* U = (const bf16_t*)(a.ws + WS_U); const bf16_t* RW7 = (const bf16_t*)(a.ws + WS_RW7); const bf16_t* SXBC = (const bf16_t*)(a.ws + WS_SXBC);
    const bf16_t* OG = (const bf16_t*)(a.ws + WS_OG); const bf16_t* OR = (const bf16_t*)(a.ws + WS_OR); const bf16_t* OS = (const bf16_t*)(a.ws + WS_OS);
    bf16_t* MIX = (bf16_t*)(a.ws + WS_MIX);
    const float* mu = a.in[I_RMU] + (size_t)l * 2 * 928; const float* g2 = a.in[I_RG2] + (size_t)l * 64 * 256;
    const float* gng = a.in[I_GNG] + (size_t)l * 256; const float* lng = a.in[I_RLG] + (size_t)l * 256; const float* lnb = a.in[I_RLB] + (size_t)l * 256;
    const float* rrk = a.in[I_RRK] + (size_t)l * 256; const float* sd = a.in[I_SD] + (size_t)l * 8; const float* sng = a.in[I_SNG] + (size_t)l * 512;
    LAS float* SG = (LAS float*)t.lds;
    LAS float* RED = (LAS float*)(t.lds + 4096);
    const size_t P = (size_t)M * 256;
    LAS float* G2S = (LAS float*)(t.lds + 8192);
    for (int e = t.tid; e < 64 * 256 / 4; e += NTHREADS) *(LAS f32x4*)(G2S + 4 * e) = *(const f32x4*)(g2 + 4 * e);
    LDS_BARRIER();
    for (int tile = t.bid; tile < Mtok / 16; tile += t.G) {
        const int r0 = tile * 16; int slo, shi; seg_bounds(r0, slo, shi);
        unsigned lgr[8][4], lsd[16][2];
        {   const int c = t.tid & 255, tt0 = (t.tid >> 8) * 8;
#pragma unroll
            for (int j = 0; j < 8; ++j) { const size_t row = (size_t)(r0 + tt0 + j);
                lgr[j][0] = (unsigned)OG[row * 256 + c] | ((unsigned)OG[P + row * 256 + c] << 16);
                lgr[j][1] = (unsigned)OR[row * 256 + c] | ((unsigned)OR[P + row * 256 + c] << 16);
                lgr[j][2] = (unsigned)U[row * NU + U_GOG + c] | ((unsigned)RW7[row * 256 + c] << 16);
                lgr[j][3] = (unsigned)RW7[P + row * 256 + c] | ((unsigned)RW7[2 * P + row * 256 + c] << 16); }
            const int cs = t.tid;
#pragma unroll
            for (int q = 0; q < 16; ++q) { const size_t row = (size_t)(r0 + q);
                lsd[q][0] = (unsigned)OS[row * 512 + cs] | ((unsigned)OS[(size_t)M * 512 + row * 512 + cs] << 16);
                lsd[q][1] = (unsigned)SXBC[row * 1024 + cs] | ((unsigned)U[row * NU + U_SZ + cs] << 16); } }
        {   const int tt = t.tid >> 5, r = t.tid & 31, row = r0 + tt; const bf16_t* up = U + (size_t)row * NU; const bool hp = row - 1 >= slo, hn = row + 1 < shi;
#pragma unroll
            for (int q = 0; q < 2; ++q) { const int col = U_RLGT + q * 32 + r, mi = col - U_RW; const float u = ldbf(up + col), pv = ld_or0(up + col - NU, up + col, hp), nv = ld_or0(up + col + NU, up + col, hn);
                SG[tt * 64 + q * 32 + r] = sigmoidf_(u + mu[mi] * (pv - u) + mu[928 + mi] * (nv - u)); } }
        LDS_BARRIER();
        {
            const int c = t.tid & 255, tt0 = (t.tid >> 8) * 8;
            float ag[8];
#pragma unroll
            for (int j = 0; j < 8; ++j) ag[j] = 0.f;
#pragma unroll 2
            for (int r4 = 0; r4 < 16; ++r4) { float w[4];
#pragma unroll
                for (int q = 0; q < 4; ++q) w[q] = G2S[(4 * r4 + q) * 256 + c];
#pragma unroll
                for (int j = 0; j < 8; ++j) { const f32x4 sv = *(const LAS f32x4*)(SG + (tt0 + j) * 64 + 4 * r4); ag[j] += (sv[0] * w[0] + sv[1] * w[1]) + (sv[2] * w[2] + sv[3] * w[3]); } }
            const float gn = gng[c], lg = lng[c], lb = lnb[c], rk = rrk[c];
#pragma unroll
            for (int j = 0; j < 8; ++j) { const int row = r0 + tt0 + j;
                const float og_ = bf_lo(lgr[j][0]) + bf_hi(lgr[j][0]);
                const float ms = wave_sum(og_ * og_) * (1.0f / 64.0f);
                const float o1 = og_ * (frsq(ms + 1e-6f)) * gn * siluf_(bf_lo(lgr[j][2]));
                const float orr = bf_lo(lgr[j][1]) + bf_hi(lgr[j][1]);
                const float mean = wave_sum(orr) * (1.0f / 64.0f); const float dd = orr - mean; const float var = wave_sum(dd * dd) * (1.0f / 64.0f);
                const float on = dd * (frsq(var + 64e-5f)) * lg + lb;
                const float bon = wave_sum(bf_hi(lgr[j][2]) * bf_lo(lgr[j][3]) * rk) * bf_hi(lgr[j][3]);
                const float o2 = (on + bon) * ag[j];
                MIX[(size_t)row * D + c] = (bf16_t)f2bf(o1); MIX[(size_t)row * D + 256 + c] = (bf16_t)f2bf(o2); }
        }
        {
            const int c = t.tid; const float dh = sd[c >> 6], ng = sng[c];
            float y[16];
#pragma unroll
            for (int q = 0; q < 16; ++q) {
                float v = bf_lo(lsd[q][0]) + bf_hi(lsd[q][0]) + dh * bf_lo(lsd[q][1]);
                v *= siluf_(bf_hi(lsd[q][1])); y[q] = v;
                const float ss = wave_sum(v * v); if (t.lane == 0) RED[q * 8 + t.wave] = ss; }
            LDS_BARRIER();
            const int gb = (t.wave >> 2) * 4;
#pragma unroll
            for (int q = 0; q < 16; ++q) { const float ms = (RED[q * 8 + gb] + RED[q * 8 + gb + 1] + RED[q * 8 + gb + 2] + RED[q * 8 + gb + 3]) * (1.0f / 256.0f);
                MIX[(size_t)(r0 + q) * D + 512 + c] = (bf16_t)f2bf(y[q] * (frsq(ms + 1e-6f)) * ng); }
        }
        LDS_BARRIER();
    }
}

static_assert(NEXP <= 32, "router lanes");
__device__ __forceinline__ unsigned long long router_key(float v, int e) { unsigned u = __float_as_uint(v); u = (u & 0x80000000u) ? ~u : (u | 0x80000000u); return ((unsigned long long)u << 32) | (unsigned)(31 - e); }
__device__ __forceinline__ float router_unkey(unsigned long long k) { unsigned u = (unsigned)(k >> 32); u = (u & 0x80000000u) ? (u & 0x7fffffffu) : ~u; return __uint_as_float(u); }
__device__ __forceinline__ void phase_router(const Args& a, const Tc& t, int l, int Mtok) {
    const bf16_t* X = (const bf16_t*)(a.ws + WS_X); bf16_t* H = (bf16_t*)(a.ws + WS_H); const float* MODS = (const float*)(a.ws + WS_MODS) + (size_t)l * NR * 6144;
    const float* rw = a.in[I_ROUTW] + (size_t)l * D * NEXP; const float* rb = a.in[I_ROUTB] + (size_t)l * NEXP;
    int* TOPI = (int*)(a.ws + WS_TOPI); float* TOPP = (float*)(a.ws + WS_TOPP);
    unsigned* CNT = (unsigned*)(a.ws + WS_CTL) + CW_CNT + l * 64;
    LAS int* hist = (LAS int*)(t.lds + LDS_MISC + 64);
    LAS float* HT = (LAS float*)t.lds;
    LAS float* PART = HT + 16 * 1028;
    if (t.tid < NEXP) hist[t.tid] = 0;
    __syncthreads();
    const int hq = t.lane >> 4, lc = t.lane & 15, e = t.lane & 31, rh = t.lane >> 5; const bool ev = e < NEXP;
    const float bias = ev ? rb[e] : 0.f;
    constexpr int NT = NEXP > 16 ? 2 : 1;
    float wreg[NT][32];
#pragma unroll
    for (int nt = 0; nt < NT; ++nt)
#pragma unroll
        for (int ks = 0; ks < 32; ++ks) { const int k = 128 * t.wave + 4 * ks + hq, col = 16 * nt + lc; wreg[nt][ks] = col < NEXP ? rw[(size_t)k * NEXP + col] : 0.f; }
    for (int tile = t.bid; tile < Mtok / 16; tile += t.G) {
        const int r0 = tile * 16;
#pragma unroll
        for (int rr = 0; rr < 2; ++rr) { const int lr = 2 * t.wave + rr, row = r0 + lr;
            f32x4 v[4], h[4];
#pragma unroll
            for (int j = 0; j < 4; ++j) v[j] = ldbf4(X + (size_t)row * D + 4 * t.lane + 256 * j);
            const float* md = MODS + (size_t)mod_row(row) * 6144;
            norm_mod_store<true>(v, a.in[I_N2G] + (size_t)l * D, md + 3 * 1024, md + 4 * 1024, (bf16_t*)((unsigned char*)H + (size_t)row * D), t.lane, h);
#pragma unroll
            for (int j = 0; j < 4; ++j) *(LAS f32x4*)(HT + lr * 1028 + 4 * t.lane + 256 * j) = h[j]; }
        LDS_BARRIER();
        f32x4 acc[NT];
#pragma unroll
        for (int nt = 0; nt < NT; ++nt) acc[nt] = (f32x4){0.f, 0.f, 0.f, 0.f};
#pragma unroll
        for (int ks = 0; ks < 32; ++ks) { const float av = HT[lc * 1028 + 128 * t.wave + 4 * ks + hq];
#pragma unroll
            for (int nt = 0; nt < NT; ++nt) acc[nt] = __builtin_amdgcn_mfma_f32_16x16x4f32(av, wreg[nt][ks], acc[nt], 0, 0, 0); }
#pragma unroll
        for (int nt = 0; nt < NT; ++nt)
#pragma unroll
            for (int r = 0; r < 4; ++r) PART[(t.wave * 16 + 4 * hq + r) * 33 + 16 * nt + lc] = acc[nt][r];
        LDS_BARRIER();
        {   const int lr = 2 * t.wave + rh, row = r0 + lr;
            float lg = bias;
#pragma unroll
            for (int w2 = 0; w2 < 8; ++w2) lg += PART[(w2 * 16 + lr) * 33 + (ev ? e : 0)];
            if (!ev) lg = -3.0e38f;
            unsigned long long key = router_key(lg, e);
            int ti[4]; float tv[4];
#pragma unroll
            for (int k = 0; k < 4; ++k) { unsigned long long m = key;
#pragma unroll
                for (int o = 1; o < 32; o <<= 1) { const unsigned long long other = __shfl_xor(m, o); m = other > m ? other : m; }
                ti[k] = 31 - (int)(unsigned)(m & 0xffffffffu); tv[k] = router_unkey(m);
                if (ti[k] == e) key = 0ull; }
            const float e0 = 1.0f, e1 = fexp(tv[1] - tv[0]), e2 = fexp(tv[2] - tv[0]), e3 = fexp(tv[3] - tv[0]); const float inv = frcp(e0 + e1 + e2 + e3);
            if (e == 0) {
                TOPI[row * 4 + 0] = ti[0]; TOPI[row * 4 + 1] = ti[1]; TOPI[row * 4 + 2] = ti[2]; TOPI[row * 4 + 3] = ti[3];
                TOPP[row * 4 + 0] = e0 * inv; TOPP[row * 4 + 1] = e1 * inv; TOPP[row * 4 + 2] = e2 * inv; TOPP[row * 4 + 3] = e3 * inv;
#pragma unroll
                for (int k = 0; k < 4; ++k) atomicAdd((int*)&hist[ti[k]], 1);
            } }
        LDS_BARRIER();
    }
    __syncthreads();
    if (t.tid < NEXP && hist[t.tid] != 0) atomicAdd(&CNT[t.tid], (unsigned)hist[t.tid]);
}

__device__ __forceinline__ int moe_offsets(const unsigned* CNT, LAS int* off, LAS int* cnt, int tid) {
    if (tid < NEXP) { int o = 0; for (int e = 0; e < tid; ++e) o += ((int)CNT[e] + 255) & ~255; off[tid] = o; cnt[tid] = (int)CNT[tid]; }
    __syncthreads();
    return (off[NEXP - 1] + ((cnt[NEXP - 1] + 255) & ~255)) >> 8;
}
__device__ __forceinline__ void phase_lists(const Args& a, const Tc& t, int l, int Mtok) {
    const int* TOPI = (const int*)(a.ws + WS_TOPI); const float* TOPP = (const float*)(a.ws + WS_TOPP);
    int* POS = (int*)(a.ws + WS_POS); int* ROWIDX = (int*)(a.ws + WS_ROWIDX); float* ROWGATE = (float*)(a.ws + WS_ROWGATE);
    unsigned* CNT = (unsigned*)(a.ws + WS_CTL) + CW_CNT + l * 64; unsigned* CUR = (unsigned*)(a.ws + WS_CTL) + CW_CUR + l * 64;
    LAS int* off = (LAS int*)(t.lds + LDS_MISC + 64); LAS int* cnt = off + 64; LAS int* hist = off + 128; LAS int* base = off + 192; LAS int* cur = off + 256;
    if (t.tid < NEXP) { hist[t.tid] = 0; cur[t.tid] = 0; }
    moe_offsets(CNT, off, cnt, t.tid);
    const int rpb = (Mtok + t.G - 1) / t.G, s0 = t.bid * rpb * 4; int s1 = (t.bid + 1) * rpb * 4; if (s1 > Mtok * 4) s1 = Mtok * 4;
    for (int s = s0 + t.tid; s < s1; s += NTHREADS) atomicAdd((int*)&hist[TOPI[s]], 1);
    __syncthreads();
    if (t.tid < NEXP) base[t.tid] = hist[t.tid] ? (int)atomicAdd(&CUR[t.tid], (unsigned)hist[t.tid]) : 0;
    __syncthreads();
    for (int s = s0 + t.tid; s < s1; s += NTHREADS) { const int e = TOPI[s]; const int p = off[e] + base[e] + atomicAdd((int*)&cur[e], 1);
        POS[s] = p; ROWIDX[p] = s >> 2; ROWGATE[p] = TOPP[s]; }
    for (int e = t.bid; e < NEXP; e += t.G) { const int lo = off[e] + cnt[e], hi = off[e] + ((cnt[e] + 255) & ~255);
        for (int p = lo + t.tid; p < hi; p += NTHREADS) { ROWIDX[p] = 0; ROWGATE[p] = 0.f; } }
    __syncthreads();
}
__device__ __forceinline__ int moe_tile_table(const Args& a, const Tc& t, int l) {
    unsigned* CNT = (unsigned*)(a.ws + WS_CTL) + CW_CNT + l * 64;
    LAS int* off = (LAS int*)(t.lds + LDS_MISC + 64); LAS int* cnt = off + 64; LAS int* tile_e = (LAS int*)(t.lds + LDS_TILE_E);
    const int ntiles = moe_offsets(CNT, off, cnt, t.tid);
    for (int tt = t.tid; tt < ntiles; tt += NTHREADS) { int e = 0;
        for (int q = 1; q < NEXP; ++q) if ((off[q] >> 8) <= tt) e = q;
        tile_e[tt] = e; }
    __syncthreads();
    return ntiles;
}

__device__ __forceinline__ void phase_combine(const Args& a, const Tc& t, int l, int Mtok) {
    const int gw = t.bid * NWAVES + t.wave, NGW = t.G * NWAVES;
    bf16_t* X = (bf16_t*)(a.ws + WS_X); bf16_t* H = (bf16_t*)(a.ws + WS_H); const bf16_t* Y = (const bf16_t*)(a.ws + WS_Y); const int* POS = (const int*)(a.ws + WS_POS);
    const float* MODS = (const float*)(a.ws + WS_MODS) + (size_t)l * NR * 6144;
    for (int rp = gw * 2; rp < Mtok; rp += NGW * 2) {
        int ps[2][4];
#pragma unroll
        for (int q = 0; q < 2; ++q) { const u32x4 pv = *(const u32x4*)(POS + (size_t)(rp + q) * 4); ps[q][0] = (int)pv.x; ps[q][1] = (int)pv.y; ps[q][2] = (int)pv.z; ps[q][3] = (int)pv.w; }
        u32x2 yv[2][4][4]; f32x4 xv[2][4];
#pragma unroll
        for (int q = 0; q < 2; ++q)
#pragma unroll
            for (int j = 0; j < 4; ++j) { const int c = 4 * t.lane + 256 * j; xv[q][j] = ldbf4(X + (size_t)(rp + q) * D + c);
#pragma unroll
                for (int k = 0; k < 4; ++k) yv[q][k][j] = *(const u32x2*)(Y + (size_t)ps[q][k] * D + c); }
#pragma unroll
        for (int q = 0; q < 2; ++q) { const int row = rp + q;
            const float* md = MODS + (size_t)mod_row(row) * 6144 + 5 * 1024;
            f32x4 v[4], h[4];
#pragma unroll
            for (int j = 0; j < 4; ++j) { const int c = 4 * t.lane + 256 * j;
                const u32x2 y0 = yv[q][0][j], y1 = yv[q][1][j], y2 = yv[q][2][j], y3 = yv[q][3][j];
                f32x4 s_; s_[0] = (bf_lo(y0.x) + bf_lo(y1.x)) + (bf_lo(y2.x) + bf_lo(y3.x)); s_[1] = (bf_hi(y0.x) + bf_hi(y1.x)) + (bf_hi(y2.x) + bf_hi(y3.x));
                s_[2] = (bf_lo(y0.y) + bf_lo(y1.y)) + (bf_lo(y2.y) + bf_lo(y3.y)); s_[3] = (bf_hi(y0.y) + bf_hi(y1.y)) + (bf_hi(y2.y) + bf_hi(y3.y));
                const f32x4 g = *(const f32x4*)(md + c);
                v[j] = xv[q][j] + g * s_; }
            if (l + 1 < DEPTH) {
#pragma unroll
                for (int j = 0; j < 4; ++j) { u32x2 w; w.x = pk2(v[j][0], v[j][1]); w.y = pk2(v[j][2], v[j][3]); *(u32x2*)(X + (size_t)row * D + 4 * t.lane + 256 * j) = w; }
                const float* md2 = MODS + (size_t)NR * 6144 + (size_t)mod_row(row) * 6144;
                norm_mod_store(v, a.in[I_N1G] + (size_t)(l + 1) * D, md2, md2 + 1024, H + (size_t)row * D, t.lane, h);
            } else {
                float ss = 0.f;
#pragma unroll
                for (int j = 0; j < 4; ++j) ss += (v[j][0] * v[j][0] + v[j][1] * v[j][1]) + (v[j][2] * v[j][2] + v[j][3] * v[j][3]);
                const float rstd = frsq(wave_sum(ss) * (1.0f / D) + 1e-6f);
#pragma unroll
                for (int j = 0; j < 4; ++j) { const int c = 4 * t.lane + 256 * j; const f32x4 g = *(const f32x4*)(a.in[I_FNG] + c); *(f32x4*)(a.out + (size_t)row * D + c) = v[j] * rstd * g; }
            } }
    }
}

#ifndef EMU
__device__ __forceinline__ void launder_ws(Args& al) {
    __attribute__((address_space(1))) unsigned char* p = (__attribute__((address_space(1))) unsigned char*)al.ws; asm volatile("" : "+s"(p)); al.ws = (unsigned char*)p; }
__device__ __forceinline__ void launder_tid(Tc& t) { int x = threadIdx.x; asm volatile("" : "+v"(x)); t.tid = x; t.lane = x & 63; t.wave = __builtin_amdgcn_readfirstlane(x >> 6); }
#endif
constexpr int PH_PER_LAYER = 12, N_PHASES = 2 + DEPTH * PH_PER_LAYER;
__global__ void __launch_bounds__(NTHREADS, 2) fwd(Args a) {
#ifdef EMU
    unsigned char* lds_raw = EMU_DYN_LDS();
#else
    extern __shared__ __attribute__((aligned(16))) unsigned char lds_raw[];
#endif
    Tc t; t.lds = (LAS unsigned char*)lds_raw; t.tid = threadIdx.x; t.lane = t.tid & 63; t.wave = __builtin_amdgcn_readfirstlane(t.tid >> 6); t.G = gridDim.x; t.bid = blockIdx.x;
    const int lo = a.ph_lo, hi = a.ph_hi;
    Args al = a;
    volatile LAS unsigned* misc = (volatile LAS unsigned*)(t.lds + LDS_MISC);
    if (t.tid < 16) misc[t.tid] = 0u;
    if (t.tid == 0) { LAS unsigned long long* tb = (LAS unsigned long long*)(t.lds + LDS_PTRS);
#pragma unroll
        for (int i = 0; i < 37; ++i) tb[i] = (unsigned long long)a.in[i]; }
    __syncthreads();
    XcdBarrier bar; bar.bar = (unsigned*)(a.ws + WS_CTL) + CW_BAR; bar.x = 0; bar.st = misc;
    if (hi - lo > 1) bar = xcd_barrier_post((unsigned*)(a.ws + WS_CTL) + CW_BAR, misc);
#ifdef EMU
#define LAUNDER_TID() ((void)0)
#else
#define LAUNDER_TID() launder_tid(t)
#endif
#if PROBE_SPIN >= 0 && !defined(EMU)
    unsigned long long pt_acc = 0ull, pt_t0 = 0ull;
#define PT_MATCH(k) ((PROBE_SPIN >= 100) ? ((k) == PROBE_SPIN - 100) : ((k) >= 2 && ((k) - 2) % PH_PER_LAYER == PROBE_SPIN))
#define PT_BEGIN(k) (PT_MATCH(k) ? (pt_t0 = wall_clock64(), true) : true)
#define PT_END(k) do { if (PT_MATCH(k)) pt_acc += wall_clock64() - pt_t0; } while (0)
#else
#define PT_BEGIN(k) true
#define PT_END(k) ((void)0)
#endif
#ifdef EMU
#define LAUNDER_WS() ((void)0)
#else
#define LAUNDER_WS() launder_ws(al)
#endif
#define IN_PH(k) (lo <= (k) && (k) < hi && (LAUNDER_TID(), LAUNDER_WS(), true) && PT_BEGIN(k))
#define REPS(bit) (((PROBE_DOUBLE >> (bit)) & 1) ? 2 : 1)
#ifdef EMU
#define SEAM(k) do { if ((k) + 1 < hi) xcd_barrier(bar); PT_END(k); } while (0)
#else
#define SEAM(k) do { if ((k) + 1 < hi) { XcdBarrier b2_ = bar; __attribute__((address_space(1))) unsigned* bp_ = (__attribute__((address_space(1))) unsigned*)b2_.bar; asm volatile("" : "+s"(bp_)); b2_.bar = (unsigned*)bp_; xcd_barrier(b2_); } PT_END(k); } while (0)
#endif
    if (IN_PH(0)) { for (int rep = 0; rep < REPS(15); ++rep) phase_pro0(al, t); SEAM(0); }
    if (IN_PH(1)) { phase_pro1(al, t); SEAM(1); }
    for (int l = 0; l < DEPTH; ++l) {
        const int pb = 2 + l * PH_PER_LAYER;
        const bool lastl = (l == DEPTH - 1);
        const int Mtok = lastl ? ML : M;
        const float* MODSL = (const float*)(al.ws + WS_MODS) + (size_t)l * NR * 6144;
        if (IN_PH(pb + 0)) {
            pg8::Gemm g{(const bf16_t*)(al.ws + WS_H), (const bf16_t*)(al.ws + WS_WIN) + (size_t)l * NU * D, D, nullptr};
            pg8::DenseSched S; S.o.init(M / 256, NU / 256, t.G, t.bid);
            pg8::EpiBf16 E{(bf16_t*)(al.ws + WS_U), NU};
            for (int rep = 0; rep < REPS(0); ++rep) pg8::gemm_phase<pg8::EpiBf16, pg8::DenseSched, false>(t.lds, t.tid, g, S, E);
            convert_in_slack(al, t, l, 0, CV_E_IN, (M / 256) * (NU / 256));
            SEAM(pb + 0);
        }
        if (IN_PH(pb + 1)) { for (int rep = 0; rep < REPS(1); ++rep) phase_prep(al, t, l); SEAM(pb + 1); }
        const bool a1_in_b = t.G >= 2 * RKB_TASKS;
        if (IN_PH(pb + 2)) {
            for (int rep = 0; rep < REPS(4); ++rep) rwkv_a_all(al, t);
            if (!a1_in_b) for (int u = t.bid; u < SSD_UNITS + GLA_UNITS; u += t.G) { if (u < SSD_UNITS) ssd_a1_unit(al, t, l, u); else gla_a1_unit(al, t, u - SSD_UNITS); }
            SEAM(pb + 2);
        }
        if (IN_PH(pb + 3)) {
            if (a1_in_b) {
                if (t.bid < RKB_TASKS) { for (int rep = 0; rep < REPS(5); ++rep) rwkv_b_task(al, t, t.bid); }
                else { const int wg = t.bid - RKB_TASKS, nwg = t.G - RKB_TASKS;
                    for (int u = wg; u < SSD_UNITS + GLA_UNITS; u += nwg) { if (u < SSD_UNITS) ssd_a1_unit(al, t, l, u); else gla_a1_unit(al, t, u - SSD_UNITS); }
                    sub_barrier((unsigned*)(al.ws + WS_CTL) + CW_SUB + l * 64, (unsigned)nwg);
                    ssd_b_carry(al, t, wg, nwg); gla_b_carry(al, t, wg, nwg);
                    __syncthreads(); convert_moe(al, t, l, CV_E_IN, lastl ? CV_MOE_ITEMS : CV_E_B, wg * NWAVES + t.wave, nwg * NWAVES); }
            } else {
                for (int task = t.bid; task < RKB_TASKS; task += t.G) rwkv_b_task(al, t, task);
                ssd_b_carry(al, t, t.bid, t.G); gla_b_carry(al, t, t.bid, t.G); __syncthreads(); convert_moe(al, t, l, CV_E_IN, lastl ? CV_MOE_ITEMS : CV_E_B, t.bid * NWAVES + t.wave, t.G * NWAVES);
            }
            SEAM(pb + 3);
        }
        if (IN_PH(pb + 4)) {
            for (int rep = 0; rep < REPS(6); ++rep) for (int u = t.bid; u < SSD_UNITS + GLA_UNITS; u += t.G) { if (u < SSD_UNITS) ssd_c_unit(al, t, l, u); else gla_c_unit(al, t, u - SSD_UNITS); }
            SEAM(pb + 4);
        }
        if (IN_PH(pb + 5)) { for (int rep = 0; rep < REPS(3); ++rep) phase_mixout(al, t, l, Mtok); SEAM(pb + 5); }
        if (IN_PH(pb + 6)) {
            pg8::Gemm g{(const bf16_t*)(al.ws + WS_MIX), (const bf16_t*)(al.ws + WS_WOUT) + (size_t)l * D * D, D, nullptr};
            pg8::DenseSched S; S.o.init(Mtok / 256, D / 256, t.G, t.bid);
            pg8::EpiResid E{(bf16_t*)(al.ws + WS_X), MODSL};
            pg8::gemm_phase<pg8::EpiResid, pg8::DenseSched, false>(t.lds, t.tid, g, S, E);
            if (!lastl) convert_in_slack(al, t, l, CV_E_B, CV_MOE_ITEMS, (Mtok / 256) * (D / 256));
            SEAM(pb + 6);
        }
        if (IN_PH(pb + 7)) { phase_router(al, t, l, Mtok); SEAM(pb + 7); }
        if (IN_PH(pb + 8)) { phase_lists(al, t, l, Mtok); SEAM(pb + 8); }
        if (IN_PH(pb + 9)) {
            const int ntiles = moe_tile_table(al, t, l);
            pg8::Gemm g{(const bf16_t*)(al.ws + WS_H), (const bf16_t*)(al.ws + WS_WGU + (size_t)l * NEXP * 2048 * D), D / 2, (const int*)(al.ws + WS_ROWIDX)};
            pg8::MoeSched S; S.o.init(ntiles, 8, t.G, t.bid); S.tile_e = (const LAS int*)(t.lds + LDS_TILE_E); S.nct = 8;
            pg8::EpiSwiglu E{al.ws + WS_ACT, al.in[I_BGU] + (size_t)l * NEXP * 2048};
            for (int rep = 0; rep < REPS(7); ++rep) pg8::gemm_phase<pg8::EpiSwiglu, pg8::MoeSched, true, true>(t.lds, t.tid, g, S, E);
            SEAM(pb + 9);
        }
        if (IN_PH(pb + 10)) {
            const int ntiles = moe_tile_table(al, t, l);
            pg8::Gemm g{(const bf16_t*)(al.ws + WS_ACT), (const bf16_t*)(al.ws + WS_WD + (size_t)l * NEXP * D * DFF), DFF / 2, nullptr};
            pg8::MoeSched S; S.o.init(ntiles, 4, t.G, t.bid); S.tile_e = (const LAS int*)(t.lds + LDS_TILE_E); S.nct = 4;
            pg8::EpiDown E{(bf16_t*)(al.ws + WS_Y), al.in[I_BDN] + (size_t)l * NEXP * D, (const float*)(al.ws + WS_ROWGATE)};
            for (int rep = 0; rep < REPS(8); ++rep) pg8::gemm_phase<pg8::EpiDown, pg8::MoeSched, false, true>(t.lds, t.tid, g, S, E);
            SEAM(pb + 10);
        }
        if (IN_PH(pb + 11)) { phase_combine(al, t, l, Mtok); SEAM(pb + 11); }
    }
#if PROBE_SPIN >= 0 && !defined(EMU)
    if (t.bid == 0) { const unsigned long long te = wall_clock64(); while (wall_clock64() - te < 4ull * pt_acc) __builtin_amdgcn_s_sleep(8); }
#endif
#undef IN_PH
#undef SEAM
}

}

extern "C" void kernel_launch(void* const* d_in, const int* in_sizes, int n_in, void* d_out, int out_size, void* d_ws, size_t ws_size, hipStream_t stream) {
    using namespace mk;
    static int grid = 0;
    if (grid == 0) {
        if (n_in != 37 || out_size != ML * D || ws_size < WS_END) { fprintf(stderr, "kernel_launch: unexpected shapes (n_in %d out %d ws %zu need %zu)\n", n_in, out_size, ws_size, (size_t)WS_END); grid = -1; return; }
#ifdef EMU
        { const char* e = getenv("EMU_GRID"); grid = e ? atoi(e) : 8; }
#else
        int dev = 0, cus = 0, per_cu = 0;
        if (hipGetDevice(&dev) != hipSuccess || hipDeviceGetAttribute(&cus, hipDeviceAttributeMultiprocessorCount, dev) != hipSuccess) { grid = -1; return; }
        if (hipFuncSetAttribute((const void*)fwd, hipFuncAttributeMaxDynamicSharedMemorySize, LDS_BYTES) != hipSuccess) { fprintf(stderr, "kernel_launch: hipFuncSetAttribute failed\n"); grid = -1; return; }
        if (hipOccupancyMaxActiveBlocksPerMultiprocessor(&per_cu, (const void*)fwd, NTHREADS, LDS_BYTES) != hipSuccess || per_cu < 1) fprintf(stderr, "kernel_launch: occupancy query reports %d\n", per_cu);
        (void)hipGetLastError();
        grid = cus;
#endif
    }
    if (grid < 0) return;
    (void)hipMemsetAsync((char*)d_ws + WS_CTL, 0, CTL_BYTES, stream);
    Args a{};
    for (int i = 0; i < 37; ++i) a.in[i] = (const float*)d_in[i];
    a.out = (float*)d_out; a.ws = (unsigned char*)d_ws;
#if N_LAUNCH_MODE == 1
    a.ph_lo = 0; a.ph_hi = N_PHASES;
    hipLaunchKernelGGL(fwd, dim3(grid), dim3(NTHREADS), LDS_BYTES, stream, a);
#else
    for (int p = 0; p < N_PHASES; ++p) { a.ph_lo = p; a.ph_hi = p + 1; hipLaunchKernelGGL(fwd, dim3(grid), dim3(NTHREADS), LDS_BYTES, stream, a); }
#endif
}
```

```cpp
#ifndef EMU
#include <hip/hip_runtime.h>
#endif
#include <cstdio>
#include <cstdint>
#include <cmath>

#ifndef CFG_BATCH
#define CFG_BATCH 4
#define CFG_SEQ 4096
#define CFG_CTX 256
#define CFG_DEPTH 4
#define CFG_NEXP 32
#endif
#ifndef PROBE_DOUBLE
#define PROBE_DOUBLE 0
#endif
#ifndef PROBE_SPIN
#define PROBE_SPIN (-1)
#endif
#ifndef N_LAUNCH_MODE
#define N_LAUNCH_MODE 1
#endif

namespace mk {
constexpr int BATCH = CFG_BATCH, SEQ = CFG_SEQ, CTX = CFG_CTX, DEPTH = CFG_DEPTH, NEXP = CFG_NEXP;
constexpr int D = 1024, ML = BATCH * SEQ, MC = BATCH * CTX, M = ML + MC, NR = BATCH + 1;
constexpr int IN_COLS = 3280, NU = 3328;
constexpr int TOPK = 4, DFF = 1024;
constexpr int MAXROWS = M * TOPK + NEXP * 256;
constexpr int NTHREADS = 512, NWAVES = 8;
constexpr int U_GQ = 0, U_GK = 128, U_GV = 256, U_GOG = 512, U_GLF = 768, U_GLB = 784;
constexpr int U_RW = 800, U_RR = 800, U_RK = 1056, U_RV = 1312, U_RLWF = 1568, U_RLWB = 1600, U_RLA = 1632, U_RLGT = 1664;
constexpr int U_SZ = 1728, U_SXBC = 2240, U_SDT = 3264;
static_assert(SEQ % 256 == 0 && CTX % 256 == 0 && M % 256 == 0, "row tiles");

constexpr size_t al256(size_t x) { return (x + 255) & ~(size_t)255; }
constexpr size_t WS_CTL = 0, CTL_BYTES = 1u << 20;
constexpr size_t WS_MODS = WS_CTL + CTL_BYTES;
constexpr size_t WS_X = WS_MODS + al256((size_t)DEPTH * NR * 6144 * 4);
constexpr size_t WS_H = WS_X + al256((size_t)M * D * 4);
constexpr size_t WS_U = WS_H + al256((size_t)M * D * 2);
constexpr size_t WS_GG = WS_U + al256((size_t)M * NU * 4);
constexpr size_t WS_RW7 = WS_GG + al256((size_t)2 * M * 128 * 4);
constexpr size_t WS_SXBC = WS_RW7 + al256((size_t)7 * M * 256 * 4);
constexpr size_t WS_SDT = WS_SXBC + al256((size_t)M * 1024 * 4);
constexpr size_t WS_OG = WS_SDT + al256((size_t)M * 16 * 4);
constexpr size_t WS_OR = WS_OG + al256((size_t)2 * M * 256 * 4);
constexpr size_t WS_OS = WS_OR + al256((size_t)2 * M * 256 * 4);
constexpr size_t WS_MIX = WS_OS + al256((size_t)2 * M * 512 * 4);
constexpr size_t WS_TOPI = WS_MIX + al256((size_t)M * D * 2);
constexpr size_t WS_TOPP = WS_TOPI + al256((size_t)M * 4 * 4);
constexpr size_t WS_POS = WS_TOPP + al256((size_t)M * 4 * 4);
constexpr size_t WS_ROWIDX = WS_POS + al256((size_t)M * 4 * 4);
constexpr size_t WS_ROWGATE = WS_ROWIDX + al256((size_t)MAXROWS * 4);
constexpr size_t WS_ACT = WS_ROWGATE + al256((size_t)MAXROWS * 4);
constexpr size_t WS_Y = WS_ACT + al256((size_t)MAXROWS * DFF * 2);
constexpr size_t WS_WIN = WS_Y + al256((size_t)MAXROWS * D * 2);
constexpr size_t WS_WOUT = WS_WIN + al256((size_t)DEPTH * NU * D * 2);
constexpr size_t WS_WGU = WS_WOUT + al256((size_t)DEPTH * D * D * 2);
constexpr size_t WS_WD = WS_WGU + al256((size_t)DEPTH * NEXP * 2048 * D * 2);
constexpr int CTXC = CTX / 64, LATC = SEQ / 64, NRC = CTXC + LATC;
constexpr size_t WS_SZ = WS_WD + al256((size_t)DEPTH * NEXP * D * DFF * 2);
constexpr size_t WS_SDEC = WS_SZ + al256((size_t)BATCH * 16 * NRC * 64 * 128 * 2);
constexpr size_t WS_SST = WS_SDEC + al256((size_t)BATCH * 16 * NRC * 4);
constexpr int RKT = 16, NCK = (CTX + SEQ) / RKT;
constexpr int RK_PA = 0, RK_RA = 8192, RK_QA = 10240, RK_VB = 11264, RK_ZC = 15360, RK_BYTES = 23552;
constexpr size_t WS_RK = WS_SST + al256((size_t)BATCH * 16 * NRC * 64 * 128 * 2);
constexpr int GC_CTX = CTX / 32, GC_LAT = SEQ / 32, GNC = GC_CTX + GC_LAT;
constexpr size_t WS_GZ = WS_RK + al256((size_t)BATCH * 8 * NCK * RK_BYTES);
constexpr size_t WS_GDEC = WS_GZ + al256((size_t)BATCH * 8 * GNC * 2048 * 4);
constexpr size_t WS_GST = WS_GDEC + al256((size_t)BATCH * 8 * GNC * 32 * 4);
constexpr size_t WS_END = WS_GST + al256((size_t)BATCH * 8 * GNC * 2048 * 2);
constexpr int CW_BAR = 4096;
constexpr int CW_CNT = 16384;
constexpr int CW_SUB = 32768;
constexpr int CW_CUR = 16384 + 64 * 8;
constexpr int LDS_STAGE = 131072;
constexpr int LDS_TILE_E = LDS_STAGE;
constexpr int LDS_MISC = LDS_STAGE + 2048;
constexpr int LDS_PTRS = LDS_MISC + 2048;
constexpr int LDS_BYTES = 147456;

#ifdef EMU
#define LAS
#define ASM_VM0() ((void)0)
#define ASM_LGKM0() ((void)0)
#define ASM_MEMFENCE() ((void)0)
#define WAIT_V(n) ((void)0)
#define WAIT_L(n) ((void)0)
#define WAVE_LDS_FENCE() emu_wave_sync()
#define LAUNDER_V(x) ((void)0)
#define LDS_BARRIER() emu_block_sync()
#else
#define LAS __attribute__((address_space(3)))
#define ASM_VM0() asm volatile("s_waitcnt vmcnt(0)" ::: "memory")
#define ASM_LGKM0() asm volatile("s_waitcnt lgkmcnt(0)" ::: "memory")
#define ASM_MEMFENCE() asm volatile("" ::: "memory")
#define WAIT_V(n) asm volatile("s_waitcnt vmcnt(" #n ")" ::: "memory")
#define WAIT_L(n) asm volatile("s_waitcnt lgkmcnt(" #n ")" ::: "memory")
#define LDS_BARRIER() do { asm volatile("s_waitcnt lgkmcnt(0)" ::: "memory"); __builtin_amdgcn_s_barrier(); asm volatile("" ::: "memory"); } while (0)
#define LAUNDER_V(x) asm volatile("" : "+v"(x))
#define WAVE_LDS_FENCE() do { asm volatile("s_waitcnt lgkmcnt(0)" ::: "memory"); } while (0)
#endif

typedef unsigned short bf16_t;
typedef short bf16x8 __attribute__((ext_vector_type(8)));
typedef float f32x4 __attribute__((ext_vector_type(4)));
typedef float f32x2 __attribute__((ext_vector_type(2)));
typedef unsigned u32x4 __attribute__((ext_vector_type(4)));
typedef unsigned u32x2 __attribute__((ext_vector_type(2)));

#ifdef EMU
__device__ __forceinline__ unsigned f2bf(float f) { unsigned u = __float_as_uint(f); return (u + 0x7fffu + ((u >> 16) & 1u)) >> 16; }
__device__ __forceinline__ unsigned pk2(float lo, float hi) { return f2bf(lo) | (f2bf(hi) << 16); }
#else
typedef __bf16 hw_bf16x2 __attribute__((ext_vector_type(2)));
__device__ __forceinline__ unsigned pk2(float lo, float hi) { const f32x2 v = {lo, hi}; return __builtin_bit_cast(unsigned, __builtin_convertvector(v, hw_bf16x2)); }
__device__ __forceinline__ unsigned f2bf(float f) { return pk2(f, f) & 0xffffu; }
#endif
typedef int i32x4 __attribute__((ext_vector_type(4)));
typedef int i32x8 __attribute__((ext_vector_type(8)));
#ifdef EMU
__device__ __forceinline__ unsigned f2e4m3(float f) {
    const unsigned sgn = (__float_as_uint(f) >> 24) & 0x80u; float a = fabsf(f); if (!(a < 448.f)) a = 448.f;
    if (a < 0.015625f) { const int q = (int)nearbyintf(a * 512.f); return sgn | (unsigned)q; }
    int e; const float m = frexpf(a, &e); int q = (int)nearbyintf(m * 16.f); int ee = e - 1;
    if (q == 16) { q = 8; ++ee; }
    return sgn | (unsigned)(((ee + 7) << 3) | (q - 8));
}
__device__ __forceinline__ unsigned pk4_fp8(float a, float b, float c, float d) { return f2e4m3(a) | (f2e4m3(b) << 8) | (f2e4m3(c) << 16) | (f2e4m3(d) << 24); }
#else
__device__ __forceinline__ unsigned pk4_fp8(float a, float b, float c, float d) {
    a = __builtin_amdgcn_fmed3f(a, -448.f, 448.f); b = __builtin_amdgcn_fmed3f(b, -448.f, 448.f); c = __builtin_amdgcn_fmed3f(c, -448.f, 448.f); d = __builtin_amdgcn_fmed3f(d, -448.f, 448.f);
    int w = __builtin_amdgcn_cvt_pk_fp8_f32(a, b, 0, false); w = __builtin_amdgcn_cvt_pk_fp8_f32(c, d, w, true); return (unsigned)w;
}
#endif
__device__ __forceinline__ float bf_lo(unsigned w) { return __uint_as_float(w << 16); }
__device__ __forceinline__ float bf_hi(unsigned w) { return __uint_as_float(w & 0xffff0000u); }
__device__ __forceinline__ float ldbf(const bf16_t* p) { return __uint_as_float(((unsigned)*p) << 16); }
__device__ __forceinline__ f32x4 ldbf4(const bf16_t* p) { const u32x2 w = *(const u32x2*)p; return (f32x4){bf_lo(w.x), bf_hi(w.x), bf_lo(w.y), bf_hi(w.y)}; }
__device__ __forceinline__ void stbf(bf16_t* p, float v) { *p = (bf16_t)f2bf(v); }
__device__ __forceinline__ float wave_sum(float v) {
#pragma unroll
    for (int o = 1; o < 64; o <<= 1) v += __shfl_xor(v, o);
    return v;
}
__device__ __forceinline__ float sum8(float v) { v += __shfl_xor(v, 1); v += __shfl_xor(v, 2); v += __shfl_xor(v, 4); return v; }
__device__ __forceinline__ float fexp(float x) { return __builtin_amdgcn_exp2f(x * 1.4426950408889634f); }
__device__ __forceinline__ float frcp(float x) { return __builtin_amdgcn_rcpf(x); }
__device__ __forceinline__ float frsq(float x) { return __builtin_amdgcn_rsqf(x); }
__device__ __forceinline__ float flog(float x) { return __builtin_amdgcn_logf(x) * 0.6931471805599453f; }
__device__ __forceinline__ float sigmoidf_(float x) { return frcp(1.0f + fexp(-x)); }
__device__ __forceinline__ float siluf_(float x) { return x * frcp(1.0f + fexp(-x)); }
__device__ __forceinline__ float ftanh(float x) { return 1.0f - 2.0f * frcp(fexp(2.0f * x) + 1.0f); }
__device__ __forceinline__ float softplusf_(float x) { return fmaxf(x, 0.f) + flog(1.0f + fexp(-fabsf(x))); }
__device__ __forceinline__ float logsigmoidf_(float x) { return -softplusf_(-x); }

#define XB_TMO      128
#define XB_XCNT(j)  (256  + 64 * (j))
#define XB_XSUB(j)  (1280 + 64 * (j))
#define XB_XGEN(j)  (2304 + 64 * (j))
#define XB_TOP      3328
#define XB_TOPGEN   3392
#define XCD_BAR_WORDS 3456
#ifdef EMU
#define XB_SPIN_CAP (0xffffffffu)
#else
#define XB_SPIN_CAP (1u << 22)
#endif
__device__ __forceinline__ unsigned xb_ld(unsigned* p)              { return __hip_atomic_load(p, __ATOMIC_RELAXED, __HIP_MEMORY_SCOPE_AGENT); }
__device__ __forceinline__ unsigned xb_add(unsigned* p, unsigned v) { return __hip_atomic_fetch_add(p, v, __ATOMIC_RELAXED, __HIP_MEMORY_SCOPE_AGENT); }
__device__ __forceinline__ unsigned xb_xcc_id() { return (unsigned)__builtin_amdgcn_s_getreg((3 << 11) | 20) & 0xFu; }
#define XB_SPIN(cond, bar) do { unsigned _sp = 0; while (cond) { __builtin_amdgcn_s_sleep(1); \
    if ((++_sp & 255u) == 0u) { if (xb_ld(&(bar)[XB_TMO])) break; if (_sp > XB_SPIN_CAP) { atomicAdd(&(bar)[XB_TMO], 1u); break; } } } } while (0)
struct XcdBarrier { unsigned* bar; unsigned x; volatile LAS unsigned* st; };
__device__ __forceinline__ XcdBarrier xcd_barrier_post(unsigned* bar, volatile LAS unsigned* st) {
    XcdBarrier b; b.bar = bar; b.x = xb_xcc_id(); b.st = st;
    if (threadIdx.x == 0) (void)xb_add(&bar[XB_XCNT(b.x)], 1u);
    return b;
}
__device__ __forceinline__ void xcd_barrier_complete(unsigned* bar, unsigned x, unsigned& nloc, unsigned& nx) {
    const unsigned G = gridDim.x * gridDim.y * gridDim.z;
    unsigned sum, cnt, mine, sp = 0u;
    for (;;) {
        sum = 0u; cnt = 0u; mine = 0u;
#pragma unroll
        for (unsigned j = 0; j < 16; ++j) { const unsigned c = xb_ld(&bar[XB_XCNT(j)]); sum += c; cnt += (c > 0u) ? 1u : 0u; mine = (j == x) ? c : mine; }
        if (sum == G) break;
        __builtin_amdgcn_s_sleep(1);
        if ((++sp & 255u) == 0u) { if (xb_ld(&bar[XB_TMO])) break; if (sp > XB_SPIN_CAP) { atomicAdd(&bar[XB_TMO], 1u); break; } }
    }
    nloc = mine > 0u ? mine : 1u; nx = cnt > 0u ? cnt : 1u;
}
__device__ __forceinline__ void xcd_barrier(const XcdBarrier& b) {
    ASM_VM0();
    __syncthreads();
    if (threadIdx.x == 0) {
        unsigned* bar = b.bar;
        __builtin_amdgcn_s_waitcnt(0);
        unsigned nloc = b.st[0], nx = b.st[1];
        if (nloc == 0u) { xcd_barrier_complete(bar, b.x, nloc, nx); b.st[0] = nloc; b.st[1] = nx; }
        const unsigned old = xb_add(&bar[XB_XSUB(b.x)], 1u);
        const unsigned gen = old / nloc;
        if (old + 1u == (gen + 1u) * nloc) {
            __builtin_amdgcn_fence(__ATOMIC_RELEASE, "agent");
            ASM_VM0();
            const unsigned og = xb_add(&bar[XB_TOP], 1u);
            const unsigned tg = og / nx;
            if (og + 1u == (tg + 1u) * nx) xb_add(&bar[XB_TOPGEN], 1u);
            else XB_SPIN(xb_ld(&bar[XB_TOPGEN]) == tg, bar);
            __builtin_amdgcn_fence(__ATOMIC_ACQUIRE, "agent");
            xb_add(&bar[XB_XGEN(b.x)], 1u);
            ASM_VM0();
        } else {
            XB_SPIN(xb_ld(&bar[XB_XGEN(b.x)]) == gen, bar);
            __builtin_amdgcn_fence(__ATOMIC_ACQUIRE, "agent");
            ASM_VM0();
        }
    }
    __syncthreads();
}

__device__ __forceinline__ void sub_arrive(unsigned* cnt) {
    ASM_VM0();
    __syncthreads();
    if (threadIdx.x == 0) { __builtin_amdgcn_fence(__ATOMIC_RELEASE, "agent"); ASM_VM0(); (void)xb_add(cnt, 1u); }
}
__device__ __forceinline__ void sub_wait(unsigned* cnt, unsigned n) {
    ASM_VM0();
    __syncthreads();
    if (threadIdx.x == 0) {
        unsigned sp = 0u;
        while (xb_ld(cnt) < n) { __builtin_amdgcn_s_sleep(1); if (++sp > XB_SPIN_CAP) break; }
        __builtin_amdgcn_fence(__ATOMIC_ACQUIRE, "agent");
        ASM_VM0();
    }
    __syncthreads();
}

namespace pg8 {
constexpr int BM = 256, BK = 64, HALF = 128, HTB = HALF * BK * 2, STAGE_BYTES = 8 * HTB, NXCD = 8, WGM = 8;
__host__ __device__ __forceinline__ int lds_byte(int r, int c) { const int st = (r >> 4) * 2 + (c >> 5), rr = r & 15, cc = c & 31, ob = rr * 64 + cc * 2; return st * 1024 + (ob ^ (((ob >> 9) & 1) << 5)); }
__host__ __device__ __forceinline__ void stage_rc(int b, int& R, int& C) { const int st = b / 1024, sb = b % 1024, swz = sb ^ (((sb >> 9) & 1) << 5); R = (st >> 1) * 16 + swz / 64; C = (st & 1) * 32 + (swz % 64) / 2; }
__host__ __device__ __forceinline__ int perm32(int rho) { const int n = rho >> 4, i = rho & 15; return 8 * (i >> 2) + 4 * n + (i & 3); }
struct Unit { int pm, pn, pb; };
struct Gemm { const bf16_t* A; const bf16_t* Bt; int K; const int* rowidx; };
struct Order {
    int nM, nN, nwg, G, c;
    __device__ __forceinline__ void init(int nM_, int nN_, int G_, int c_) { nM = nM_; nN = nN_; nwg = nM * nN; G = G_; c = c_; }
    __device__ __forceinline__ bool tile(int i, int& pm, int& pn) const {
        const long L = (long)i * G + c; if (L >= nwg) return false;
        int wgid = (int)L; { const int q = nwg / NXCD, r = nwg % NXCD, xcd = wgid % NXCD, off = wgid / NXCD; wgid = (xcd < r ? xcd * (q + 1) : r * (q + 1) + (xcd - r) * q) + off; }
        const int nig = WGM * nN, gid = wgid / nig, fm = gid * WGM, gsz = (nM - fm) < WGM ? (nM - fm) : WGM;
        pm = fm + ((wgid % nig) % gsz); pn = (wgid % nig) / gsz; return true;
    }
};
struct DenseSched { Order o; __device__ __forceinline__ bool next(int i, Unit& u) const { if (!o.tile(i, u.pm, u.pn)) return false; u.pb = u.pn; return true; } };
struct MoeSched { Order o; const LAS int* tile_e; int nct;
    __device__ __forceinline__ bool next(int i, Unit& u) const { if (!o.tile(i, u.pm, u.pn)) return false; u.pb = tile_e[u.pm] * nct + u.pn; return true; } };

__device__ __forceinline__ unsigned cvt_pk_bf16(float lo, float hi) {
#ifdef EMU
    return pk2(lo, hi);
#else
    return pk2(lo, hi);
#endif
}
struct EpiF32 {
    static constexpr bool PERM = false;
    float* C; int ldc;
    __device__ __forceinline__ void operator()(const f32x4 (&acc)[2][2][4][2], const Unit& u, int wr, int wc, int fr, int fq) const {
        const int row0 = u.pm * BM + wr * 64 + fr, col0 = u.pn * BM + wc * 32 + 4 * fq;
#pragma unroll
        for (int ai = 0; ai < 2; ++ai)
#pragma unroll
            for (int m = 0; m < 4; ++m) { float* rowp = C + (size_t)(row0 + ai * HALF + m * 16) * ldc + col0;
#pragma unroll
                for (int bj = 0; bj < 2; ++bj)
#pragma unroll
                    for (int n = 0; n < 2; ++n) *(f32x4*)(rowp + bj * HALF + n * 16) = acc[ai][bj][m][n]; }
    }
};
struct EpiBf16 {
    static constexpr bool PERM = true;
    bf16_t* C; int ldc;
    __device__ __forceinline__ void operator()(const f32x4 (&acc)[2][2][4][2], const Unit& u, int wr, int wc, int fr, int fq) const {
        const int row0 = u.pm * BM + wr * 64 + fr, col0 = u.pn * BM + wc * 32 + 8 * fq;
#pragma unroll
        for (int ai = 0; ai < 2; ++ai)
#pragma unroll
            for (int m = 0; m < 4; ++m) { bf16_t* rowp = C + (size_t)(row0 + ai * HALF + m * 16) * ldc + col0;
#pragma unroll
                for (int bj = 0; bj < 2; ++bj) { const f32x4 v0 = acc[ai][bj][m][0], v1 = acc[ai][bj][m][1];
                    u32x4 w; w.x = cvt_pk_bf16(v0[0], v0[1]); w.y = cvt_pk_bf16(v0[2], v0[3]); w.z = cvt_pk_bf16(v1[0], v1[1]); w.w = cvt_pk_bf16(v1[2], v1[3]);
                    *(u32x4*)(rowp + bj * HALF) = w; } }
    }
};
struct EpiResid {
    static constexpr bool PERM = true;
    bf16_t* X; const float* mods;
    __device__ __forceinline__ void operator()(const f32x4 (&acc)[2][2][4][2], const Unit& u, int wr, int wc, int fr, int fq) const {
        const int row0 = u.pm * BM + wr * 64 + fr, col0 = u.pn * BM + wc * 32 + 8 * fq;
        const int rbase = u.pm * BM; const int mrow = rbase < ML ? rbase / SEQ : BATCH;
        const float* g = mods + (size_t)mrow * 6144 + 2 * 1024 + col0;
        f32x4 gv[2][2];
#pragma unroll
        for (int bj = 0; bj < 2; ++bj)
#pragma unroll
            for (int n = 0; n < 2; ++n) gv[bj][n] = *(const f32x4*)(g + bj * HALF + 4 * n);
#pragma unroll
        for (int ai = 0; ai < 2; ++ai)
#pragma unroll
            for (int m = 0; m < 4; ++m) { bf16_t* rowp = X + (size_t)(row0 + ai * HALF + m * 16) * D + col0;
#pragma unroll
                for (int bj = 0; bj < 2; ++bj) { u32x4* p = (u32x4*)(rowp + bj * HALF); const u32x4 xo = *p;
                    const f32x4 v0 = (f32x4){bf_lo(xo.x), bf_hi(xo.x), bf_lo(xo.y), bf_hi(xo.y)} + gv[bj][0] * acc[ai][bj][m][0];
                    const f32x4 v1 = (f32x4){bf_lo(xo.z), bf_hi(xo.z), bf_lo(xo.w), bf_hi(xo.w)} + gv[bj][1] * acc[ai][bj][m][1];
                    u32x4 w; w.x = cvt_pk_bf16(v0[0], v0[1]); w.y = cvt_pk_bf16(v0[2], v0[3]); w.z = cvt_pk_bf16(v1[0], v1[1]); w.w = cvt_pk_bf16(v1[2], v1[3]);
                    *p = w; } }
    }
};
constexpr float F8_WSCALE = 64.0f, F8_ASCALE = 4.0f;
struct EpiSwiglu {
    static constexpr bool PERM = true;
    unsigned char* ACT; const float* bgu;
    __device__ __forceinline__ void operator()(const f32x4 (&acc)[2][2][4][2], const Unit& u, int wr, int wc, int fr, int fq) const {
        const int e = u.pb >> 3;
        const int row0 = u.pm * BM + wr * 64 + fr, j0 = u.pn * 128 + wc * 32 + 8 * fq;
        const float* bg = bgu + (size_t)e * 2048 + j0;
        f32x4 bgl[2], bln[2];
#pragma unroll
        for (int n = 0; n < 2; ++n) { bgl[n] = *(const f32x4*)(bg + 4 * n); bln[n] = *(const f32x4*)(bg + 1024 + 4 * n); }
#pragma unroll
        for (int ai = 0; ai < 2; ++ai)
#pragma unroll
            for (int m = 0; m < 4; ++m) { unsigned char* rowp = ACT + (size_t)(row0 + ai * HALF + m * 16) * DFF + j0;
                float o[8];
#pragma unroll
                for (int n = 0; n < 2; ++n)
#pragma unroll
                    for (int j = 0; j < 4; ++j) { float gl = acc[ai][0][m][n][j] * (1.0f / F8_WSCALE) + bgl[n][j], ln = acc[ai][1][m][n][j] * (1.0f / F8_WSCALE) + bln[n][j];
                        gl = fminf(gl, 7.0f); ln = fminf(fmaxf(ln, -7.0f), 7.0f);
                        o[n * 4 + j] = gl * __builtin_amdgcn_rcpf(1.0f + __builtin_amdgcn_exp2f(-1.702f * 1.4426950408889634f * gl)) * (ln * F8_ASCALE + F8_ASCALE); }
                u32x2 w; w.x = pk4_fp8(o[0], o[1], o[2], o[3]); w.y = pk4_fp8(o[4], o[5], o[6], o[7]);
                *(u32x2*)rowp = w; }
    }
};
struct EpiDown {
    static constexpr bool PERM = true;
    bf16_t* Y; const float* bd; const float* rowgate;
    __device__ __forceinline__ void operator()(const f32x4 (&acc)[2][2][4][2], const Unit& u, int wr, int wc, int fr, int fq) const {
        const int e = u.pb >> 2;
        const int row0 = u.pm * BM + wr * 64 + fr, col0 = u.pn * BM + wc * 32 + 8 * fq;
        const float* b = bd + (size_t)e * 1024 + col0;
        f32x4 bv[2][2];
#pragma unroll
        for (int bj = 0; bj < 2; ++bj)
#pragma unroll
            for (int n = 0; n < 2; ++n) bv[bj][n] = *(const f32x4*)(b + bj * HALF + 4 * n);
#pragma unroll
        for (int ai = 0; ai < 2; ++ai)
#pragma unroll
            for (int m = 0; m < 4; ++m) { const int row = row0 + ai * HALF + m * 16; const float gt = rowgate[row]; bf16_t* rowp = Y + (size_t)row * D + col0;
#pragma unroll
                for (int bj = 0; bj < 2; ++bj) { const f32x4 v0 = (acc[ai][bj][m][0] * (1.0f / (F8_WSCALE * F8_ASCALE)) + bv[bj][0]) * gt, v1 = (acc[ai][bj][m][1] * (1.0f / (F8_WSCALE * F8_ASCALE)) + bv[bj][1]) * gt;
                    u32x4 w; w.x = cvt_pk_bf16(v0[0], v0[1]); w.y = cvt_pk_bf16(v0[2], v0[3]); w.z = cvt_pk_bf16(v1[0], v1[1]); w.w = cvt_pk_bf16(v1[2], v1[3]);
                    *(u32x4*)(rowp + bj * HALF) = w; } }
    }
};

__device__ __forceinline__ f32x4 mma_f8(bf16x8 a0, bf16x8 a1, bf16x8 b0, bf16x8 b1, f32x4 c) {
#ifdef EMU
    return emu_mfma16_f8(a0, a1, b0, b1, c);
#else
    const i32x4 a0i = __builtin_bit_cast(i32x4, a0), a1i = __builtin_bit_cast(i32x4, a1), b0i = __builtin_bit_cast(i32x4, b0), b1i = __builtin_bit_cast(i32x4, b1);
    const i32x8 A = __builtin_shufflevector(a0i, a1i, 0, 1, 2, 3, 4, 5, 6, 7), B = __builtin_shufflevector(b0i, b1i, 0, 1, 2, 3, 4, 5, 6, 7);
    asm volatile("v_mfma_f32_16x16x128_f8f6f4 %0, %1, %2, %0" : "+v"(c) : "v"(A), "v"(B));
    return c;
#endif
}
template <class Epi, class Sched, bool GATHER, bool F8 = false>
__device__ __forceinline__ void gemm_phase(LAS unsigned char* lds, const int tid, const Gemm g, const Sched& S, const Epi& E) {
    const int wid = __builtin_amdgcn_readfirstlane(tid >> 6), lane = tid & 63, wr = wid >> 2, wc = wid & 3, fr = lane & 15, fq = lane >> 4;
    const int K = g.K, nt = K / BK;
    unsigned voffB[2]; int RA[2], CA[2];
#pragma unroll
    for (int i = 0; i < 2; ++i) { int R, C; stage_rc(tid * 16 + i * 8192, R, C); const int Rb = Epi::PERM ? ((R & ~31) + perm32(R & 31)) : R;
        RA[i] = R; CA[i] = C; voffB[i] = (unsigned)(Rb * K + C) * 2u; }
    const size_t kstep = (size_t)(BK * 2);
    const size_t hstep = (size_t)HALF * K * 2;
    const size_t tstep = 2 * hstep;
    const unsigned ldsw = (unsigned)wid * 1024u;
    const int aoff = lds_byte(wr * 64 + fr, fq * 8), boff = lds_byte(wc * 32 + fr, fq * 8);
#define PG8_SA(b, h) (((b) * 2 + (h)) * HTB)
#define PG8_SB(b, h) ((4 + (b) * 2 + (h)) * HTB)
#define PG8_STAGE(bufoff, gbase, voff) do { _Pragma("unroll") for (int _i = 0; _i < 2; ++_i) \
        __builtin_amdgcn_global_load_lds((const unsigned*)((const char*)(gbase) + (voff)[_i]), (LAS unsigned*)(lds + (bufoff) + ldsw + _i * 8192), 16, 0, 0); } while (0)
#define PG8_LDA(dst, b, h) do { _Pragma("unroll") for (int m = 0; m < 4; ++m) _Pragma("unroll") for (int k = 0; k < 2; ++k) dst[m][k] = *(const LAS bf16x8*)(lds + PG8_SA(b, h) + aoff + m * 2048 + k * 1024); } while (0)
#define PG8_LDB(dst, b, h) do { _Pragma("unroll") for (int n = 0; n < 2; ++n) _Pragma("unroll") for (int k = 0; k < 2; ++k) dst[n][k] = *(const LAS bf16x8*)(lds + PG8_SB(b, h) + boff + n * 2048 + k * 1024); } while (0)
#define PG8_MMA(ai, bj, At, Bt) do { __builtin_amdgcn_s_setprio(1); _Pragma("unroll") for (int m = 0; m < 4; ++m) _Pragma("unroll") for (int n = 0; n < 2; ++n) { \
        if constexpr (F8) acc[ai][bj][m][n] = mma_f8(Bt[n][0], Bt[n][1], At[m][0], At[m][1], acc[ai][bj][m][n]); \
        else { _Pragma("unroll") for (int k = 0; k < 2; ++k) acc[ai][bj][m][n] = __builtin_amdgcn_mfma_f32_16x16x32_bf16(Bt[n][k], At[m][k], acc[ai][bj][m][n], 0, 0, 0); } } __builtin_amdgcn_s_setprio(0); } while (0)
#define PG8_BAR __builtin_amdgcn_s_barrier()
#define PG8_SCHED __builtin_amdgcn_sched_barrier(0)
#define PG8_AOFF(dst, unit) do { _Pragma("unroll") for (int _h = 0; _h < 2; ++_h) _Pragma("unroll") for (int _i = 0; _i < 2; ++_i) { \
        const int _r = (unit).pm * BM + _h * HALF + RA[_i]; const int _src = GATHER ? g.rowidx[_r] : _r; dst[_h][_i] = (unsigned)(_src * K + CA[_i]) * 2u; } } while (0)
    Unit cur, nxt; int ui = 0;
    if (!S.next(0, cur)) return;
    f32x4 acc[2][2][4][2];
#pragma unroll
    for (int a = 0; a < 2; ++a)
#pragma unroll
        for (int b = 0; b < 2; ++b)
#pragma unroll
            for (int m = 0; m < 4; ++m)
#pragma unroll
                for (int n = 0; n < 2; ++n) acc[a][b][m][n] = (f32x4){0.f, 0.f, 0.f, 0.f};
    bf16x8 At[4][2], B0[2][2], B1[2][2];
    unsigned cvA[2][2], nvA[2][2];
    PG8_AOFF(cvA, cur);
    const char* const gA = (const char*)g.A;
    const char* cB = (const char*)g.Bt + (size_t)cur.pb * tstep;
    PG8_STAGE(PG8_SB(0, 0), cB, voffB); PG8_STAGE(PG8_SA(0, 0), gA, cvA[0]); PG8_STAGE(PG8_SB(0, 1), cB + hstep, voffB); PG8_STAGE(PG8_SA(0, 1), gA, cvA[1]);
    if (wr == 1) PG8_BAR;
    WAIT_V(4); PG8_BAR;
    PG8_STAGE(PG8_SB(1, 0), cB + kstep, voffB); PG8_STAGE(PG8_SA(1, 0), gA + kstep, cvA[0]); PG8_STAGE(PG8_SB(1, 1), cB + hstep + kstep, voffB);
    WAIT_V(6); PG8_BAR;
    for (;;) {
        const bool has_next = S.next(ui + 1, nxt);
        if (has_next) { PG8_AOFF(nvA, nxt); } else {
#pragma unroll
            for (int h = 0; h < 2; ++h)
#pragma unroll
                for (int i = 0; i < 2; ++i) nvA[h][i] = cvA[h][i]; }
        const char* nB = has_next ? (const char*)g.Bt + (size_t)nxt.pb * tstep : cB;
        for (int t = 0; t < nt; t += 2) {
            const bool last = (t == nt - 2);
            const char* a1 = gA + (size_t)(t + 1) * kstep;
            const char* a2 = last ? gA : gA + (size_t)(t + 2) * kstep; const char* b2 = last ? nB : cB + (size_t)(t + 2) * kstep;
            const char* a3 = a2 + kstep; const char* b3 = b2 + kstep;
            unsigned xA0[2], xA1[2];
#pragma unroll
            for (int i = 0; i < 2; ++i) { xA0[i] = last ? nvA[0][i] : cvA[0][i]; xA1[i] = last ? nvA[1][i] : cvA[1][i]; }
            PG8_LDB(B0, 0, 0); PG8_SCHED; PG8_LDA(At, 0, 0); PG8_STAGE(PG8_SA(1, 1), a1, cvA[1]);
            WAIT_L(8); PG8_BAR; WAIT_L(0); PG8_MMA(0, 0, At, B0); PG8_BAR; PG8_SCHED;
            PG8_LDB(B1, 0, 1); PG8_STAGE(PG8_SB(0, 0), b2, voffB);
            PG8_BAR; WAIT_L(0); PG8_MMA(0, 1, At, B1); PG8_BAR;
            PG8_LDA(At, 0, 1); PG8_STAGE(PG8_SA(0, 0), a2, xA0);
            PG8_BAR; WAIT_L(0); PG8_MMA(1, 0, At, B0); PG8_BAR; PG8_SCHED;
            PG8_STAGE(PG8_SB(0, 1), b2 + hstep, voffB);
            WAIT_V(6); PG8_BAR; PG8_MMA(1, 1, At, B1); PG8_BAR;
            PG8_LDB(B0, 1, 0); PG8_SCHED; PG8_LDA(At, 1, 0); PG8_STAGE(PG8_SA(0, 1), a2, xA1);
            WAIT_L(8); PG8_BAR; WAIT_L(0); PG8_MMA(0, 0, At, B0); PG8_BAR; PG8_SCHED;
            PG8_LDB(B1, 1, 1); PG8_STAGE(PG8_SB(1, 0), b3, voffB);
            PG8_BAR; WAIT_L(0); PG8_MMA(0, 1, At, B1); PG8_BAR;
            PG8_LDA(At, 1, 1); PG8_STAGE(PG8_SA(1, 0), a3, xA0);
            PG8_BAR; WAIT_L(0); PG8_MMA(1, 0, At, B0); PG8_BAR; PG8_SCHED;
            PG8_STAGE(PG8_SB(1, 1), b3 + hstep, voffB);
            WAIT_V(6); PG8_BAR; PG8_MMA(1, 1, At, B1); PG8_BAR;
        }
#ifndef EMU
        if constexpr (F8) asm volatile("s_nop 15\n\ts_nop 15" ::: "memory");
#endif
        E(acc, cur, wr, wc, fr, fq);
        if (!has_next) break;
#pragma unroll
        for (int a = 0; a < 2; ++a)
#pragma unroll
            for (int b = 0; b < 2; ++b)
#pragma unroll
                for (int m = 0; m < 4; ++m)
#pragma unroll
                    for (int n = 0; n < 2; ++n) acc[a][b][m][n] = (f32x4){0.f, 0.f, 0.f, 0.f};
        cur = nxt; cB = nB; ++ui;
#pragma unroll
        for (int h = 0; h < 2; ++h)
#pragma unroll
            for (int i = 0; i < 2; ++i) cvA[h][i] = nvA[h][i];
    }
    WAIT_V(0);
    if (wr == 0) PG8_BAR;
    PG8_BAR;
#undef PG8_SA
#undef PG8_SB
#undef PG8_STAGE
#undef PG8_LDA
#undef PG8_LDB
#undef PG8_MMA
#undef PG8_BAR
#undef PG8_SCHED
#undef PG8_AOFF
}
}

struct Args { const float* in[37]; float* out; unsigned char* ws; int ph_lo, ph_hi; };
enum { I_X = 0, I_C, I_CTX, I_CCTX, I_WADA, I_BADA, I_N1G, I_N2G, I_WIN, I_GGW, I_GGB, I_GNG, I_RMU, I_RW0, I_RW2, I_RA0, I_RA2, I_RG2, I_RKK, I_RKA, I_RRK,
       I_RLG, I_RLB, I_SCW, I_SCB, I_SDTB, I_SALOG, I_SD, I_SNG, I_WOUT, I_ROUTW, I_ROUTB, I_WGU, I_BGU, I_WDN, I_BDN, I_FNG };

struct Tc { LAS unsigned char* lds; int tid, lane, wave, G, bid; };
__device__ __forceinline__ const float* inp(const Tc& t, int i) {
    const unsigned long long v = ((const LAS unsigned long long*)(t.lds + LDS_PTRS))[i];
    const unsigned lo = __builtin_amdgcn_readfirstlane((unsigned)v), hi = __builtin_amdgcn_readfirstlane((unsigned)(v >> 32));
    return (const float*)(((unsigned long long)hi << 32) | lo);
}

struct CvItem { const float* W; bf16_t* dst; int ldw, k0, n0, nv, K; };
__device__ __forceinline__ void cv_load(const CvItem& it, float (&ld)[32], int lane) {
    const int c = lane & 31; const float* wp = it.W + (size_t)(it.k0 + (lane >> 5)) * it.ldw + it.n0 + (c < it.nv ? c : 0);
#pragma unroll
    for (int i = 0; i < 32; ++i) ld[i] = wp[(size_t)(2 * i) * it.ldw];
}
__device__ __forceinline__ void cv_store(const CvItem& it, const float (&ld)[32], LAS float* scr, int lane) {
    { const int c = lane & 31;
#pragma unroll
      for (int i = 0; i < 32; ++i) scr[(2 * i + (lane >> 5)) * 33 + c] = (c < it.nv) ? ld[i] : 0.f; }
    WAVE_LDS_FENCE();
    const int c = lane & 7;
#pragma unroll
    for (int j = 0; j < 4; ++j) { const int n = (lane >> 3) + 8 * j; const LAS float* s = scr + (8 * c) * 33 + n;
        u32x4 o; o.x = pk2(s[0 * 33], s[1 * 33]); o.y = pk2(s[2 * 33], s[3 * 33]); o.z = pk2(s[4 * 33], s[5 * 33]); o.w = pk2(s[6 * 33], s[7 * 33]);
        *(u32x4*)(it.dst + (size_t)n * it.K + it.k0 + 8 * c) = o; }
    WAVE_LDS_FENCE();
}
__device__ __forceinline__ void cv_store8(const CvItem& it, const float (&ld)[32], LAS float* scr, int lane) {
    { const int c = lane & 31;
#pragma unroll
      for (int i = 0; i < 32; ++i) scr[(2 * i + (lane >> 5)) * 33 + c] = ld[i] * pg8::F8_WSCALE; }
    WAVE_LDS_FENCE();
    const int c = lane & 7; unsigned char* d8 = (unsigned char*)it.dst;
#pragma unroll
    for (int j = 0; j < 4; ++j) { const int n = (lane >> 3) + 8 * j; const LAS float* s = scr + (8 * c) * 33 + n;
        u32x2 o; o.x = pk4_fp8(s[0 * 33], s[1 * 33], s[2 * 33], s[3 * 33]); o.y = pk4_fp8(s[4 * 33], s[5 * 33], s[6 * 33], s[7 * 33]);
        *(u32x2*)(d8 + (size_t)n * it.K + it.k0 + 8 * c) = o; }
    WAVE_LDS_FENCE();
}
constexpr int CV_KB = D / 64, CV_I_IN = CV_KB * (NU / 32), CV_I_OUT = CV_KB * (D / 32), CV_I_GU = CV_KB * (2048 / 32), CV_I_DN = CV_KB * (D / 32);
constexpr int CV_MOE_ITEMS = NEXP * (CV_I_GU + CV_I_DN);
constexpr int CV_E_IN = CV_MOE_ITEMS / 4, CV_E_B = (CV_MOE_ITEMS * 2) / 5;
__device__ __forceinline__ CvItem cv_moe_item(const Args& a, int l, int it) {
    unsigned char* WGU = a.ws + WS_WGU; unsigned char* WDN = a.ws + WS_WD;
    const int e = it / (CV_I_GU + CV_I_DN); int r = it % (CV_I_GU + CV_I_DN); CvItem ci;
    if (r < CV_I_GU) { const int kb = r / 64, nb = r % 64, n0 = nb * 32; const int half = n0 >> 10, rem = n0 & 1023, pn = rem >> 7, jj = rem & 127;
        ci.W = a.in[I_WGU] + ((size_t)l * NEXP + e) * D * 2048; ci.ldw = 2048; ci.k0 = kb * 64; ci.n0 = n0; ci.nv = 32; ci.dst = (bf16_t*)(WGU + (((size_t)l * NEXP + e) * 2048 + pn * 256 + half * 128 + jj) * D); ci.K = D; }
    else { r -= CV_I_GU; const int kb = r / (D / 32), nb = r % (D / 32);
        ci.W = a.in[I_WDN] + ((size_t)l * NEXP + e) * DFF * D; ci.ldw = D; ci.k0 = kb * 64; ci.n0 = nb * 32; ci.nv = 32; ci.dst = (bf16_t*)(WDN + (((size_t)l * NEXP + e) * D + nb * 32) * DFF); ci.K = DFF; }
    return ci;
}
__device__ __forceinline__ CvItem cv_dense_item(const Args& a, int it) {
    bf16_t* WIN = (bf16_t*)(a.ws + WS_WIN); bf16_t* WOUT = (bf16_t*)(a.ws + WS_WOUT);
    const int l = it / (CV_I_IN + CV_I_OUT); int r = it % (CV_I_IN + CV_I_OUT); CvItem ci;
    if (r < CV_I_IN) { const int kb = r / (NU / 32), nb = r % (NU / 32), n0 = nb * 32; int nv = IN_COLS - n0; nv = nv < 0 ? 0 : (nv > 32 ? 32 : nv);
        ci.W = a.in[I_WIN] + (size_t)l * D * IN_COLS; ci.ldw = IN_COLS; ci.k0 = kb * 64; ci.n0 = n0; ci.nv = nv; ci.dst = WIN + ((size_t)l * NU + n0) * D; ci.K = D; }
    else { r -= CV_I_IN; const int kb = r / (D / 32), nb = r % (D / 32);
        ci.W = a.in[I_WOUT] + (size_t)l * D * D; ci.ldw = D; ci.k0 = kb * 64; ci.n0 = nb * 32; ci.nv = 32; ci.dst = WOUT + ((size_t)l * D + nb * 32) * D; ci.K = D; }
    return ci;
}
__device__ __forceinline__ void convert_moe(const Args& a, const Tc& t, int l, int i0, int i1, int gw, int ngw) {
    LAS float* scr = (LAS float*)(t.lds + t.wave * 16384);
    float ld[32], ln[32];
    if (i0 + gw < i1) { const CvItem c0 = cv_moe_item(a, l, i0 + gw); cv_load(c0, ld, t.lane); }
    for (int it = i0 + gw; it < i1; it += ngw) {
        const CvItem cur = cv_moe_item(a, l, it);
        const bool more = it + ngw < i1;
        if (more) { const CvItem nx = cv_moe_item(a, l, it + ngw); cv_load(nx, ln, t.lane); }
        cv_store8(cur, ld, scr, t.lane);
        if (more) {
#pragma unroll
            for (int i = 0; i < 32; ++i) ld[i] = ln[i]; }
    }
}
__device__ __forceinline__ void convert_dense(const Args& a, const Tc& t, int l, int gw, int ngw) {
    LAS float* scr = (LAS float*)(t.lds + t.wave * 16384);
    float ld[32];
    for (int it = l * (CV_I_IN + CV_I_OUT) + gw; it < (l + 1) * (CV_I_IN + CV_I_OUT); it += ngw) { const CvItem ci = cv_dense_item(a, it); cv_load(ci, ld, t.lane); cv_store(ci, ld, scr, t.lane); }
}
__device__ __forceinline__ void convert_in_slack(const Args& a, const Tc& t, int l, int i0, int i1, int nunits) {
    const int rem = nunits % t.G;
    if (t.bid >= rem) convert_moe(a, t, l, i0, i1, (t.bid - rem) * NWAVES + t.wave, (t.G - rem) * NWAVES);
}
__device__ __forceinline__ void phase_pro0(const Args& a, const Tc& t) {
    LAS float* scr = (LAS float*)(t.lds + t.wave * 16384);
    const int gw = t.bid * NWAVES + t.wave, NGW = t.G * NWAVES;
    convert_dense(a, t, 0, gw, NGW);
    __syncthreads();
    LAS float* sc = (LAS float*)t.lds;
    LAS float* red = (LAS float*)(t.lds + 32768);
    for (int i = t.tid; i < NR * D; i += NTHREADS) { const int r = i / D, k = i % D; const float v = r < BATCH ? a.in[I_C][r * D + k] : a.in[I_CCTX][k]; sc[i] = siluf_(v); }
    __syncthreads();
    float* MODS = (float*)(a.ws + WS_MODS);
    const int jl = t.tid & 127, kq = t.tid >> 7;
    for (int cb = t.bid; cb < DEPTH * 48; cb += t.G) {
        const int l = cb / 48, j = (cb % 48) * 128 + jl;
        const float* w = a.in[I_WADA] + (size_t)l * D * 6144 + j;
        float acc[NR];
#pragma unroll
        for (int r = 0; r < NR; ++r) acc[r] = 0.f;
        for (int k = kq * 256; k < kq * 256 + 256; ++k) { const float wv = w[(size_t)k * 6144];
#pragma unroll
            for (int r = 0; r < NR; ++r) acc[r] += sc[r * D + k] * wv; }
#pragma unroll
        for (int r = 0; r < NR; ++r) red[(kq * NR + r) * 128 + jl] = acc[r];
        __syncthreads();
        if (kq == 0) {
            const float bb = a.in[I_BADA][(size_t)l * 6144 + j];
#pragma unroll
            for (int r = 0; r < NR; ++r) MODS[((size_t)l * NR + r) * 6144 + j] = red[(0 * NR + r) * 128 + jl] + red[(1 * NR + r) * 128 + jl] + red[(2 * NR + r) * 128 + jl] + red[(3 * NR + r) * 128 + jl] + bb;
        }
        __syncthreads();
    }
}

__device__ __forceinline__ int mod_row(int row) { return row < ML ? row / SEQ : BATCH; }
template <bool F8 = false>
__device__ __forceinline__ void norm_mod_store(const f32x4 (&v)[4], const float* g, const float* shift, const float* scale, bf16_t* hrow, int lane, f32x4 (&hout)[4]) {
    float ss = 0.f;
#pragma unroll
    for (int j = 0; j < 4; ++j) ss += (v[j][0] * v[j][0] + v[j][1] * v[j][1]) + (v[j][2] * v[j][2] + v[j][3] * v[j][3]);
    const float rstd = frsq(wave_sum(ss) * (1.0f / D) + 1e-6f);
#pragma unroll
    for (int j = 0; j < 4; ++j) { const int c = 4 * lane + 256 * j;
        const f32x4 gg = *(const f32x4*)(g + c), sh = *(const f32x4*)(shift + c), sc = *(const f32x4*)(scale + c);
        const f32x4 h = (v[j] * rstd * gg) * (sc + 1.0f) + sh; hout[j] = h;
        if constexpr (F8) { *(unsigned*)((unsigned char*)hrow + c) = pk4_fp8(h[0], h[1], h[2], h[3]); }
        else { u32x2 w; w.x = pk2(h[0], h[1]); w.y = pk2(h[2], h[3]); *(u32x2*)(hrow + c) = w; } }
}
__device__ __forceinline__ void phase_pro1(const Args& a, const Tc& t) {
    const int gw = t.bid * NWAVES + t.wave, NGW = t.G * NWAVES;
    bf16_t* X = (bf16_t*)(a.ws + WS_X); bf16_t* H = (bf16_t*)(a.ws + WS_H); const float* MODS = (const float*)(a.ws + WS_MODS);
    for (int row = gw; row < M; row += NGW) {
        const float* src = row < ML ? a.in[I_X] + (size_t)row * D : a.in[I_CTX] + (size_t)(row - ML) * D;
        f32x4 v[4], h[4];
#pragma unroll
        for (int j = 0; j < 4; ++j) { v[j] = *(const f32x4*)(src + 4 * t.lane + 256 * j); u32x2 w; w.x = pk2(v[j][0], v[j][1]); w.y = pk2(v[j][2], v[j][3]); *(u32x2*)(X + (size_t)row * D + 4 * t.lane + 256 * j) = w; }
        const float* md = MODS + (size_t)mod_row(row) * 6144;
        norm_mod_store(v, a.in[I_N1G], md, md + 1024, H + (size_t)row * D, t.lane, h);
    }
}

__device__ __forceinline__ float ld_or0(const float* p, const float* safe, bool ok) { const float v = *(ok ? p : safe); return ok ? v : 0.f; }
__device__ __forceinline__ float ld_or0(const bf16_t* p, const bf16_t* safe, bool ok) { const float v = ldbf(ok ? p : safe); return ok ? v : 0.f; }
__device__ __forceinline__ void seg_bounds(int row, int& lo, int& hi) {
    if (row < ML) { lo = row & ~63; hi = lo + 64; } else { lo = ML + ((row - ML) / CTX) * CTX; hi = lo + CTX; }
}
__device__ __forceinline__ void phase_prep(const Args& a, const Tc& t, int l) {
    const bf16_t* U = (const bf16_t*)(a.ws + WS_U);
    float* GG = (float*)(a.ws + WS_GG); bf16_t* RW7 = (bf16_t*)(a.ws + WS_RW7); bf16_t* SXBC = (bf16_t*)(a.ws + WS_SXBC); float* SDT = (float*)(a.ws + WS_SDT);
    const float* mu = a.in[I_RMU] + (size_t)l * 2 * 928;
    const float* w0 = a.in[I_RW0] + (size_t)l * 2 * 256; const float* w2 = a.in[I_RW2] + (size_t)l * 2 * 32 * 256;
    const float* a0 = a.in[I_RA0] + (size_t)l * 256; const float* a2 = a.in[I_RA2] + (size_t)l * 32 * 256;
    const float* rkk = a.in[I_RKK] + (size_t)l * 256; const float* rka = a.in[I_RKA] + (size_t)l * 256;
    const float* ggw = a.in[I_GGW] + (size_t)l * 2 * 16 * 128; const float* ggb = a.in[I_GGB] + (size_t)l * 2 * 128;
    const float* cw = a.in[I_SCW] + (size_t)l * 4 * 1024; const float* cb = a.in[I_SCB] + (size_t)l * 1024;
    const float* dtb = a.in[I_SDTB] + (size_t)l * 16;
    LAS float* LOW = (LAS float*)t.lds;
    LAS float* A2S = LOW + 16 * 128; LAS float* W2S = A2S + 32 * 256; LAS float* GWS = W2S + 64 * 256;
    for (int e = t.tid; e < 32 * 256 / 4; e += NTHREADS) *(LAS f32x4*)(A2S + 4 * e) = *(const f32x4*)(a2 + 4 * e);
    for (int e = t.tid; e < 64 * 256 / 4; e += NTHREADS) *(LAS f32x4*)(W2S + 4 * e) = *(const f32x4*)(w2 + 4 * e);
    for (int e = t.tid; e < 32 * 128 / 4; e += NTHREADS) *(LAS f32x4*)(GWS + 4 * e) = *(const f32x4*)(ggw + 4 * e);
    LDS_BARRIER();
    for (int tile = t.bid; tile < M / 16; tile += t.G) {
        const int r0 = tile * 16; int slo, shi; seg_bounds(r0, slo, shi);
        {
            const int tt = t.tid >> 5, r = t.tid & 31, row = r0 + tt;
            const bf16_t* up = U + (size_t)row * NU; const bool hp = row - 1 >= slo, hn = row + 1 < shi;
#pragma unroll
            for (int q = 0; q < 3; ++q) { const int col = U_RLWF + q * 32 + r, mi = col - U_RW;
                const float u = ldbf(up + col), pv = ld_or0(up + col - NU, up + col, hp), nv = ld_or0(up + col + NU, up + col, hn);
                const float s = u + mu[mi] * (pv - u) + mu[928 + mi] * (nv - u);
                LOW[tt * 128 + q * 32 + r] = q < 2 ? ftanh(s) : s; }
            LOW[tt * 128 + 96 + r] = ldbf(up + U_GLF + r);
        }
        LDS_BARRIER();
        {
            const int c = t.tid & 255, tt0 = (t.tid >> 8) * 8;
            float lu[10][3];
#pragma unroll
            for (int jj = 0; jj < 10; ++jj) { const int row = r0 + tt0 + jj - 1; const bool ok = row >= slo && row < shi; const bf16_t* up = U + (size_t)(ok ? row : r0) * NU;
                const float x0 = ldbf(up + U_RR + c), x1 = ldbf(up + U_RK + c), x2 = ldbf(up + U_RV + c); lu[jj][0] = ok ? x0 : 0.f; lu[jj][1] = ok ? x1 : 0.f; lu[jj][2] = ok ? x2 : 0.f; }
            float aa[8], af[8], ab[8];
#pragma unroll
            for (int j = 0; j < 8; ++j) { aa[j] = a0[c]; af[j] = w0[c]; ab[j] = w0[256 + c]; }
#pragma unroll 2
            for (int r4 = 0; r4 < 8; ++r4) { float wa[4], wf[4], wb[4];
#pragma unroll
                for (int q = 0; q < 4; ++q) { wa[q] = A2S[(4 * r4 + q) * 256 + c]; wf[q] = W2S[(4 * r4 + q) * 256 + c]; wb[q] = W2S[(32 + 4 * r4 + q) * 256 + c]; }
#pragma unroll
                for (int j = 0; j < 8; ++j) { const LAS float* lw = LOW + (tt0 + j) * 128;
                    const f32x4 la = *(const LAS f32x4*)(lw + 64 + 4 * r4), lf = *(const LAS f32x4*)(lw + 4 * r4), lb = *(const LAS f32x4*)(lw + 32 + 4 * r4);
#pragma unroll
                    for (int q = 0; q < 4; ++q) { aa[j] += la[q] * wa[q]; af[j] += lf[q] * wf[q]; ab[j] += lb[q] * wb[q]; } } }
            const float m0r = mu[c], m1r = mu[928 + c], m0k = mu[256 + c], m1k = mu[928 + 256 + c], m0v = mu[512 + c], m1v = mu[928 + 512 + c];
            const float kkg = rkk[c], kag = rka[c];
#pragma unroll
            for (int j = 0; j < 8; ++j) { const int row = r0 + tt0 + j;
                float u, pv, nv;
                u = lu[j + 1][0]; pv = lu[j][0]; nv = lu[j + 2][0]; const float rs = u + m0r * (pv - u) + m1r * (nv - u);
                u = lu[j + 1][1]; pv = lu[j][1]; nv = lu[j + 2][1]; const float ks = u + m0k * (pv - u) + m1k * (nv - u);
                u = lu[j + 1][2]; pv = lu[j][2]; nv = lu[j + 2][2]; const float vs = u + m0v * (pv - u) + m1v * (nv - u);
                const float av = sigmoidf_(aa[j]);
                const float wfv = fexp(-0.606531f * sigmoidf_(af[j])), wbv = fexp(-0.606531f * sigmoidf_(ab[j]));
                const float kr = ks * kkg; const float ssq = wave_sum(kr * kr); const float kk = kr * (frsq(ssq + 1e-12f));
                const float kf = ks * (1.0f + (av - 1.0f) * kag);
                const size_t o = (size_t)row * 256 + c, P = (size_t)M * 256;
                stbf(RW7 + o, rs); stbf(RW7 + P + o, kf); stbf(RW7 + 2 * P + o, vs); stbf(RW7 + 3 * P + o, kk); stbf(RW7 + 4 * P + o, kk * av); stbf(RW7 + 5 * P + o, wfv); stbf(RW7 + 6 * P + o, wbv); }
        }
        {
            const int j = t.tid & 127, dq = t.tid >> 7, dir = dq & 1, tt0 = (dq >> 1) * 8;
            float acc[8];
#pragma unroll
            for (int q = 0; q < 8; ++q) acc[q] = ggb[dir * 128 + j];
#pragma unroll
            for (int r4 = 0; r4 < 4; ++r4) { float w[4];
#pragma unroll
                for (int q2 = 0; q2 < 4; ++q2) w[q2] = GWS[(dir * 16 + 4 * r4 + q2) * 128 + j];
#pragma unroll
                for (int q = 0; q < 8; ++q) { const f32x4 lv = *(const LAS f32x4*)(LOW + (tt0 + q) * 128 + 96 + dir * 16 + 4 * r4);
                    acc[q] += (lv[0] * w[0] + lv[1] * w[1]) + (lv[2] * w[2] + lv[3] * w[3]); } }
#pragma unroll
            for (int q = 0; q < 8; ++q) GG[((size_t)dir * M + r0 + tt0 + q) * 128 + j] = logsigmoidf_(acc[q]) * (1.0f / 16.0f);
        }
        {
#pragma unroll
            for (int cc = 0; cc < 2; ++cc) { const int col = t.tid + cc * 512; const bf16_t* up = U + U_SXBC + col;
                const float c0 = cw[col], c1 = cw[1024 + col], c2 = cw[2048 + col], c3 = cw[3072 + col], bb = cb[col];
                const bf16_t* uc = up + (size_t)r0 * NU;
                float lc_[19];
#pragma unroll
                for (int q = 0; q < 19; ++q) lc_[q] = ld_or0(uc + (ptrdiff_t)(q - 2) * NU, uc, (r0 + q - 2 >= slo) && (r0 + q - 2 < shi));
                float um2 = lc_[0], um1 = lc_[1], u0 = lc_[2];
#pragma unroll
                for (int q = 0; q < 16; ++q) { const int row = r0 + q; const float up1 = lc_[q + 3];
                    const float y = c0 * um2 + c1 * um1 + c2 * u0 + c3 * up1 + bb;
                    stbf(SXBC + (size_t)row * 1024 + col, siluf_(y)); um2 = um1; um1 = u0; u0 = up1; } }
        }
        if (t.tid < 256) { const int tt = t.tid >> 4, j = t.tid & 15, row = r0 + tt; SDT[(size_t)row * 16 + j] = softplusf_(ldbf(U + (size_t)row * NU + U_SDT + j) + dtb[j]); }
        LDS_BARRIER();
    }
}

__device__ __forceinline__ int chain_row(int b, int dir, int s) {
    if (s < CTX) return ML + b * CTX + (dir ? CTX - 1 - s : s);
    const int tt = s - CTX; return b * SEQ + (dir ? SEQ - 1 - tt : tt);
}

__device__ __forceinline__ f32x4 mma16(f32x4 acc, const LAS bf16_t* A, int lda, const LAS bf16_t* Bt, int ldb, int K, int lane) {
    const int r = lane & 15, kq = (lane >> 4) * 8;
    for (int k0 = 0; k0 < K; k0 += 32) {
        const bf16x8 av = *(const LAS bf16x8*)(A + r * lda + k0 + kq), bv = *(const LAS bf16x8*)(Bt + r * ldb + k0 + kq);
        acc = __builtin_amdgcn_mfma_f32_16x16x32_bf16(av, bv, acc, 0, 0, 0);
    }
    return acc;
}
__device__ __forceinline__ float wave_incl_scan(float v, int lane) {
#pragma unroll
    for (int o = 1; o < 64; o <<= 1) { const float u = __shfl_up(v, o); if (lane >= o) v += u; }
    return v;
}
__device__ __forceinline__ int rc_row0(int b, int c) { return c < CTXC ? ML + b * CTX + 64 * c : b * SEQ + 64 * (c - CTXC); }
__device__ __forceinline__ int rc_chain_pos(int c, int dir) { return dir == 0 ? c : (c < CTXC ? CTXC - 1 - c : CTXC + (LATC - 1 - (c - CTXC))); }

constexpr int SSD_UNITS = BATCH * 2 * NRC;
__device__ __forceinline__ void ssd_a1_unit(const Args& a, const Tc& t, int l, int u) {
    const bf16_t* SXBC = (const bf16_t*)(a.ws + WS_SXBC); const float* SDT = (const float*)(a.ws + WS_SDT);
    bf16_t* SZ = (bf16_t*)(a.ws + WS_SZ); float* SDEC = (float*)(a.ws + WS_SDEC);
    const int c = u % NRC, g = (u / NRC) & 1, b = u / (2 * NRC), row0 = rc_row0(b, c);
    LAS bf16_t* BT = (LAS bf16_t*)t.lds;
    LAS bf16_t* XT = BT + 128 * 72 + t.wave * 64 * 72;
    for (int e = t.tid; e < 64 * 32; e += NTHREADS) { const int rho = e >> 5, n4 = (e & 31) * 4;
        const f32x4 v = ldbf4(SXBC + (size_t)(row0 + rho) * 1024 + 512 + g * 128 + n4);
#pragma unroll
        for (int q = 0; q < 4; ++q) BT[(n4 + q) * 72 + rho] = (bf16_t)f2bf(v[q]); }
    const int hh = t.wave & 3, dir = t.wave >> 2, h = 4 * g + hh, chain = (b * 8 + h) * 2 + dir, cc = rc_chain_pos(c, dir);
    const float a_neg = -fexp(a.in[I_SALOG][(size_t)l * 16 + dir * 8 + h]);
    const float dtv = SDT[(size_t)(row0 + t.lane) * 16 + dir * 8 + h], av = dtv * a_neg;
    const float pre = wave_incl_scan(av, t.lane), tot = __shfl(pre, 63);
    const float wgt = dir == 0 ? fexp(tot - pre) : fexp(pre - av);
    const float sc = dtv * wgt;
#pragma unroll
    for (int p4 = 0; p4 < 16; ++p4) { const f32x4 x = ldbf4(SXBC + (size_t)(row0 + t.lane) * 1024 + h * 64 + p4 * 4);
#pragma unroll
        for (int q = 0; q < 4; ++q) XT[(p4 * 4 + q) * 72 + t.lane] = (bf16_t)f2bf(x[q] * sc); }
    if (t.lane == 0) SDEC[(size_t)chain * NRC + cc] = fexp(tot);
    LDS_BARRIER();
    bf16_t* zb = SZ + ((size_t)chain * NRC + cc) * 64 * 128;
#pragma unroll 1
    for (int pt = 0; pt < 4; ++pt)
#pragma unroll 2
        for (int nt = 0; nt < 8; ++nt) { f32x4 acc = {0.f, 0.f, 0.f, 0.f};
            acc = mma16(acc, XT + pt * 16 * 72, 72, BT + nt * 16 * 72, 72, 64, t.lane);
#pragma unroll
            for (int r = 0; r < 4; ++r) zb[(size_t)(16 * pt + 4 * (t.lane >> 4) + r) * 128 + 16 * nt + (t.lane & 15)] = (bf16_t)f2bf(acc[r]); }
    LDS_BARRIER();
}
constexpr int CAR_DEP = 4;
__device__ __forceinline__ void ssd_b_carry(const Args& a, const Tc& t, int wg, int nwg) {
    const bf16_t* SZ = (const bf16_t*)(a.ws + WS_SZ); const float* SDEC = (const float*)(a.ws + WS_SDEC); bf16_t* SST = (bf16_t*)(a.ws + WS_SST);
    static_assert(NRC % 4 == 0, "carry unroll");
    constexpr int NG = NRC / 4;
    for (int idx = wg * NTHREADS + t.tid; idx < BATCH * 16 * 2048; idx += nwg * NTHREADS) {
        const int chain = idx >> 11, e4 = (idx & 2047) * 4;
        const bf16_t* zc = SZ + (size_t)chain * NRC * 8192 + e4; bf16_t* sc = SST + (size_t)chain * NRC * 8192 + e4; const float* dc = SDEC + (size_t)chain * NRC;
        f32x4 s = {0.f, 0.f, 0.f, 0.f};
        u32x2 z[CAR_DEP][4]; float d[CAR_DEP][4];
#pragma unroll
        for (int g = 0; g < CAR_DEP - 1 && g < NG; ++g)
#pragma unroll
            for (int q = 0; q < 4; ++q) { z[g][q] = *(const u32x2*)(zc + (size_t)(4 * g + q) * 8192); d[g][q] = dc[4 * g + q]; }
#pragma unroll
        for (int g = 0; g < NG; ++g) {
            if (g + CAR_DEP - 1 < NG) {
#pragma unroll
                for (int q = 0; q < 4; ++q) { z[(g + CAR_DEP - 1) % CAR_DEP][q] = *(const u32x2*)(zc + (size_t)(4 * (g + CAR_DEP - 1) + q) * 8192); d[(g + CAR_DEP - 1) % CAR_DEP][q] = dc[4 * (g + CAR_DEP - 1) + q]; } }
#pragma unroll
            for (int q = 0; q < 4; ++q) { u32x2 w; w.x = pk2(s[0], s[1]); w.y = pk2(s[2], s[3]); *(u32x2*)(sc + (size_t)(4 * g + q) * 8192) = w;
                const u32x2 zw = z[g % CAR_DEP][q]; s = s * d[g % CAR_DEP][q] + (f32x4){bf_lo(zw.x), bf_hi(zw.x), bf_lo(zw.y), bf_hi(zw.y)}; }
        }
    }
}
__device__ __forceinline__ void ssd_c_unit(const Args& a, const Tc& t, int l, int u) {
    const bf16_t* SXBC = (const bf16_t*)(a.ws + WS_SXBC); const float* SDT = (const float*)(a.ws + WS_SDT);
    const bf16_t* SST = (const bf16_t*)(a.ws + WS_SST); bf16_t* OS = (bf16_t*)(a.ws + WS_OS);
    const int c = u % NRC, g = (u / NRC) & 1, b = u / (2 * NRC), row0 = rc_row0(b, c);
    LAS bf16_t* CM = (LAS bf16_t*)t.lds;
    LAS bf16_t* BM = CM + 64 * 136;
    LAS bf16_t* GS = BM + 64 * 136;
    LAS bf16_t* XT = GS + 64 * 72 + t.wave * 64 * 72;
    LAS float* PRE = (LAS float*)(GS + 64 * 72 + 8 * 64 * 72) + t.wave * 128;
    for (int e = t.tid; e < 64 * 32; e += NTHREADS) { const int rho = e >> 5, n4 = (e & 31) * 4;
        const f32x4 bv = ldbf4(SXBC + (size_t)(row0 + rho) * 1024 + 512 + g * 128 + n4), cv = ldbf4(SXBC + (size_t)(row0 + rho) * 1024 + 768 + g * 128 + n4);
        u32x2 wb, wc; wb.x = pk2(bv[0], bv[1]); wb.y = pk2(bv[2], bv[3]); wc.x = pk2(cv[0], cv[1]); wc.y = pk2(cv[2], cv[3]);
        *(LAS u32x2*)(BM + rho * 136 + n4) = wb; *(LAS u32x2*)(CM + rho * 136 + n4) = wc; }
    const int hh = t.wave & 3, dir = t.wave >> 2, h = 4 * g + hh, chain = (b * 8 + h) * 2 + dir, cc = rc_chain_pos(c, dir);
    const bf16_t* sb = SST + ((size_t)chain * NRC + cc) * 8192;
    bf16x8 sf[4][4];
#pragma unroll
    for (int pt = 0; pt < 4; ++pt)
#pragma unroll
        for (int ks = 0; ks < 4; ++ks) sf[pt][ks] = *(const bf16x8*)(sb + (size_t)(16 * pt + (t.lane & 15)) * 128 + 32 * ks + 8 * (t.lane >> 4));
    const float a_neg = -fexp(a.in[I_SALOG][(size_t)l * 16 + dir * 8 + h]);
    const float dtv = SDT[(size_t)(row0 + t.lane) * 16 + dir * 8 + h], av = dtv * a_neg;
    const float pre = wave_incl_scan(av, t.lane), tot = __shfl(pre, 63);
    PRE[t.lane] = pre; PRE[64 + t.lane] = pre - av;
#pragma unroll
    for (int p4 = 0; p4 < 16; ++p4) { const f32x4 x = ldbf4(SXBC + (size_t)(row0 + t.lane) * 1024 + h * 64 + p4 * 4);
#pragma unroll
        for (int q = 0; q < 4; ++q) XT[(p4 * 4 + q) * 72 + t.lane] = (bf16_t)f2bf(x[q] * dtv); }
    LDS_BARRIER();
#pragma unroll
    for (int q = 0; q < 2; ++q) { const int ti = t.wave * 2 + q, it = ti >> 2, jt = ti & 3; f32x4 acc = {0.f, 0.f, 0.f, 0.f};
        acc = mma16(acc, CM + it * 16 * 136, 136, BM + jt * 16 * 136, 136, 128, t.lane);
#pragma unroll
        for (int r = 0; r < 4; ++r) GS[(16 * it + 4 * (t.lane >> 4) + r) * 72 + 16 * jt + (t.lane & 15)] = (bf16_t)f2bf(acc[r]); }
    LDS_BARRIER();
#pragma unroll 1
    for (int it = 0; it < 4; ++it) {
        f32x4 acc[4], acc2[4];
#pragma unroll
        for (int pt = 0; pt < 4; ++pt) { acc[pt] = (f32x4){0.f, 0.f, 0.f, 0.f}; acc2[pt] = (f32x4){0.f, 0.f, 0.f, 0.f}; }
        const int rho = 16 * it + (t.lane & 15);
        const float prer = PRE[rho], exr = PRE[64 + rho];
#pragma unroll
        for (int ks = 0; ks < 2; ++ks) {
            const int rp0 = 32 * ks + 8 * (t.lane >> 4);
            const bf16x8 g8 = *(const LAS bf16x8*)(GS + rho * 72 + rp0);
            bf16x8 af;
#pragma unroll
            for (int e = 0; e < 8; ++e) { const int rp = rp0 + e; const float gv = __uint_as_float(((unsigned)(unsigned short)g8[e]) << 16);
                float f;
                if (dir == 0) f = rp <= rho ? fexp(prer - PRE[rp]) : 0.f; else f = rp >= rho ? fexp(PRE[64 + rp] - exr) : 0.f;
                af[e] = (short)f2bf(gv * f); }
#pragma unroll
            for (int pt = 0; pt < 4; ++pt) { const bf16x8 bfr = *(const LAS bf16x8*)(XT + (16 * pt + (t.lane & 15)) * 72 + rp0); acc[pt] = __builtin_amdgcn_mfma_f32_16x16x32_bf16(af, bfr, acc[pt], 0, 0, 0); }
        }
#pragma unroll
        for (int ks = 0; ks < 4; ++ks) {
            const bf16x8 cf = *(const LAS bf16x8*)(CM + rho * 136 + 32 * ks + 8 * (t.lane >> 4));
#pragma unroll
            for (int pt = 0; pt < 4; ++pt) acc2[pt] = __builtin_amdgcn_mfma_f32_16x16x32_bf16(cf, sf[pt][ks], acc2[pt], 0, 0, 0);
        }
#pragma unroll
        for (int r = 0; r < 4; ++r) { const int ro = 16 * it + 4 * (t.lane >> 4) + r; const float f = dir == 0 ? fexp(PRE[ro]) : fexp(tot - PRE[64 + ro]);
#pragma unroll
            for (int pt = 0; pt < 4; ++pt) stbf(OS + ((size_t)dir * M + row0 + ro) * 512 + h * 64 + 16 * pt + (t.lane & 15), acc[pt][r] + f * acc2[pt][r]); }
    }
    LDS_BARRIER();
}


constexpr int RW_UNITS = BATCH * 8 * NCK, RW_PAIRS = RW_UNITS / 2, RWA_HALF = 57344;
static_assert(RW_UNITS % 2 == 0, "unit pairs");
__device__ __forceinline__ void rwkv_a_all(const Args& a, const Tc& t) {
    const bf16_t* RW7 = (const bf16_t*)(a.ws + WS_RW7);
    const size_t P7 = (size_t)M * 256;
    const int half = t.tid >> 8, ht = t.tid & 255, hw = t.wave & 3, hq = t.lane >> 4, lc = t.lane & 15;
    LAS unsigned char* hb = t.lds + half * RWA_HALF;
    LAS float* RAW = (LAS float*)hb;
    LAS float* RtF = RAW;
    LAS float* KhF = RAW + 1024;
    LAS float* AtF = RAW + 3 * 1024;
    LAS float* Uf = RAW + 6 * 1024;
    LAS float* Qkf = Uf + 256;
    LAS float* Nuf = Qkf + 256;
    LAS float* WTs = Nuf + 256;
    LAS bf16_t* BtN = (LAS bf16_t*)(WTs + 64);
    LAS bf16_t* KtN = BtN + 16 * 72; LAS bf16_t* AtN = KtN + 16 * 72; LAS bf16_t* RtN = AtN + 16 * 72;
    LAS bf16_t* KpT = BtN;
    LAS bf16_t* BhT = RtN + 16 * 72;
    LAS bf16_t* VT = BhT + 64 * 40; LAS bf16_t* ApS = VT + 64 * 40;
    LAS bf16_t* NpS = ApS + 64 * 40;
    LAS bf16_t* QbT = NpS + 16 * 40;
    f32x4 pf[6];
#define RWA_LOAD(pair) do { const int u_ = 2 * (pair) + half, ck_ = u_ % NCK, ch_ = u_ / NCK, dir_ = ch_ & 1, h_ = (ch_ >> 1) & 3, b_ = ch_ >> 3; \
        _Pragma("unroll") for (int q = 0; q < 6; ++q) { const int e = ht + 256 * q, vec = e >> 8, rem = e & 255, i = rem >> 4, c4 = rem & 15; \
            const int row = chain_row(b_, dir_, ck_ * RKT + i); const int vs = vec < 5 ? vec : 5 + dir_; \
            pf[q] = ldbf4(RW7 + (size_t)vs * P7 + (size_t)row * 256 + h_ * 64 + c4 * 4); } } while (0)
    if (t.bid < RW_PAIRS) RWA_LOAD(t.bid);
    for (int pair = t.bid; pair < RW_PAIRS; pair += t.G) {
        const int u = 2 * pair + half, ck = u % NCK, chain = u / NCK;
        unsigned char* rec = a.ws + WS_RK + ((size_t)chain * NCK + ck) * RK_BYTES;
#pragma unroll
        for (int q = 0; q < 6; ++q) *(LAS f32x4*)(RAW + (ht + 256 * q) * 4) = pf[q];
        for (int e = ht; e < 3 * 64 * 8; e += 256) { const int arr = e >> 9, rem = e & 511, r = rem >> 3, c2 = rem & 7; *(LAS unsigned*)(BhT + arr * 64 * 40 + r * 40 + 16 + 2 * c2) = 0u; }
        { const int arr = ht >> 7, rem = ht & 127, r = rem >> 3, c2 = rem & 7; *(LAS unsigned*)(NpS + arr * 16 * 40 + r * 40 + 16 + 2 * c2) = 0u; }
        LDS_BARRIER();
        if (pair + t.G < RW_PAIRS) RWA_LOAD(pair + t.G);
        { const int j = ht & 63, ig = ht >> 6; float wc = 1.f, wT = 1.f;
#pragma unroll
            for (int i = 0; i < 16; ++i) { const float wv = RAW[5 * 1024 + i * 64 + j]; wT *= wv; if (i < 4 * ig) wc *= wv; }
            if (ig == 0) WTs[j] = wT;
            float bh4[4], v4[4];
#pragma unroll
            for (int q = 0; q < 4; ++q) { const int i = 4 * ig + q; const float wp = wc; wc *= RAW[5 * 1024 + i * 64 + j]; const float iw = frcp(wc);
                const float at = RAW[3 * 1024 + i * 64 + j] * wp, rt = RAW[i * 64 + j] * wc, bt = RAW[4 * 1024 + i * 64 + j] * iw, kt = RAW[1024 + i * 64 + j] * iw;
                AtN[i * 72 + j] = (bf16_t)f2bf(at); RtN[i * 72 + j] = (bf16_t)f2bf(rt); BtN[i * 72 + j] = (bf16_t)f2bf(bt); KtN[i * 72 + j] = (bf16_t)f2bf(kt);
                bh4[q] = bt * wT; v4[q] = RAW[2 * 1024 + i * 64 + j];
                KhF[i * 64 + j] = kt * wT; RtF[i * 64 + j] = rt; AtF[i * 64 + j] = at; }
            { u32x2 wb, wv; wb.x = pk2(bh4[0], bh4[1]); wb.y = pk2(bh4[2], bh4[3]); wv.x = pk2(v4[0], v4[1]); wv.y = pk2(v4[2], v4[3]);
              *(LAS u32x2*)(BhT + j * 40 + 4 * ig) = wb; *(LAS u32x2*)(VT + j * 40 + 4 * ig) = wv; } }
        LDS_BARRIER();
        { f32x4 acc = {0.f, 0.f, 0.f, 0.f};
            acc = mma16(acc, (hw == 0 || hw == 3) ? BtN : KtN, 72, hw < 2 ? AtN : RtN, 72, 64, t.lane);
            f32x4 mv;
#pragma unroll
            for (int r = 0; r < 4; ++r) { const int s_ = 4 * hq + r, t_ = lc; const bool keep = hw < 2 ? (s_ < t_) : (s_ <= t_); mv[r] = keep ? acc[r] : 0.f; }
            if (hw == 0) *(LAS f32x4*)(Uf + lc * 16 + 4 * hq) = mv;
            else if (hw == 3) { u32x2 w; w.x = pk2(mv[0], mv[1]); w.y = pk2(mv[2], mv[3]); *(LAS u32x2*)(QbT + lc * 40 + 4 * hq) = w; }
            else {
#pragma unroll
                for (int r = 0; r < 4; ++r) { const int s_ = 4 * hq + r; if (hw == 1) Nuf[s_ * 16 + lc] = mv[r]; else Qkf[s_ * 16 + lc] = mv[r]; } } }
        LDS_BARRIER();
        if (ht < 80) { float x[16]; const bool isA = ht < 64; const int rr = isA ? ht : ht - 64;
#pragma unroll
            for (int tt = 0; tt < 16; ++tt) { float acc = isA ? AtF[tt * 64 + rr] : Nuf[rr * 16 + tt];
                f32x4 uc[4];
#pragma unroll
                for (int q = 0; q < 4; ++q) uc[q] = *(const LAS f32x4*)(Uf + tt * 16 + 4 * q);
#pragma unroll
                for (int s_ = 0; s_ < 16; ++s_) if (s_ < tt) acc -= x[s_] * uc[s_ >> 2][s_ & 3];
                x[tt] = acc; }
            u32x4 w0, w1; w0.x = pk2(x[0], x[1]); w0.y = pk2(x[2], x[3]); w0.z = pk2(x[4], x[5]); w0.w = pk2(x[6], x[7]); w1.x = pk2(x[8], x[9]); w1.y = pk2(x[10], x[11]); w1.z = pk2(x[12], x[13]); w1.w = pk2(x[14], x[15]);
            LAS bf16_t* xr = (isA ? ApS : NpS) + rr * 40; *(LAS u32x4*)xr = w0; *(LAS u32x4*)(xr + 8) = w1; }
        else if (ht >= 128) { for (int e = ht - 128; e < 64 * 8; e += 128) { const int r = e >> 3, c2 = e & 7; *(LAS unsigned*)(KpT + r * 40 + 16 + 2 * c2) = 0u; } }
        LDS_BARRIER();
        for (int ti = hw; ti < 25; ti += 4) {
            f32x4 acc = {0.f, 0.f, 0.f, 0.f};
            if (ti < 16) { const int jt = ti >> 2, jt2 = ti & 3;
                acc = mma16(acc, ApS + jt * 16 * 40, 40, BhT + jt2 * 16 * 40, 40, 32, t.lane);
                unsigned short o[4];
#pragma unroll
                for (int r = 0; r < 4; ++r) { const int j = 16 * jt + 4 * hq + r, j2 = 16 * jt2 + lc; const float dg = (j == j2) ? WTs[j] : 0.f; o[r] = (unsigned short)f2bf(dg - acc[r]); }
                u32x2 w; w.x = o[0] | ((unsigned)o[1] << 16); w.y = o[2] | ((unsigned)o[3] << 16);
                *(u32x2*)(rec + RK_PA + ((size_t)((jt2 * 2 + (jt >> 1)) * 64 + t.lane) * 8 + 4 * (jt & 1)) * 2) = w;
            } else if (ti < 20) { const int jt = ti - 16;
                acc = mma16(acc, ApS + jt * 16 * 40, 40, QbT, 40, 32, t.lane);
                unsigned short o[4];
                const f32x4 rt4 = *(const LAS f32x4*)(RtF + lc * 64 + 16 * jt + 4 * hq);
#pragma unroll
                for (int r = 0; r < 4; ++r) o[r] = (unsigned short)f2bf(rt4[r] - acc[r]);
                u32x2 w; w.x = o[0] | ((unsigned)o[1] << 16); w.y = o[2] | ((unsigned)o[3] << 16);
                *(u32x2*)(rec + RK_RA + ((size_t)(((jt >> 1) * 64 + t.lane) * 8 + 4 * (jt & 1))) * 2) = w;
            } else if (ti == 20) {
                acc = mma16(acc, NpS, 40, QbT, 40, 32, t.lane);
                unsigned short o[4];
#pragma unroll
                for (int r = 0; r < 4; ++r) o[r] = (unsigned short)f2bf(Qkf[(4 * hq + r) * 16 + lc] - acc[r]);
                u32x2 w; w.x = o[0] | ((unsigned)o[1] << 16); w.y = o[2] | ((unsigned)o[3] << 16);
                *(u32x2*)(rec + RK_QA + ((size_t)((lc + 16 * (hq >> 1)) * 8 + 4 * (hq & 1))) * 2) = w;
                u32x2 z; z.x = 0u; z.y = 0u; *(u32x2*)(rec + RK_QA + ((size_t)((32 + lc + 16 * (hq >> 1)) * 8 + 4 * (hq & 1))) * 2) = z;
            } else { const int jt2 = ti - 21;
                acc = mma16(acc, NpS, 40, BhT + jt2 * 16 * 40, 40, 32, t.lane);
                float kp[4];
#pragma unroll
                for (int r = 0; r < 4; ++r) { const int s_ = 4 * hq + r, j2 = 16 * jt2 + lc; kp[r] = KhF[s_ * 64 + j2] - acc[r]; }
                u32x2 w; w.x = pk2(kp[0], kp[1]); w.y = pk2(kp[2], kp[3]); *(LAS u32x2*)(KpT + (16 * jt2 + lc) * 40 + 4 * hq) = w;
            }
        }
        for (int e = ht; e < 4 * 64 * 4; e += 256) { const int it = e >> 8, rem = e & 255, ln = rem >> 2, e2 = (rem & 3) * 2, hp = ln >> 4, i2 = 16 * it + (ln & 15);
            unsigned w = 0u; if (hp < 2) { const int s0 = 8 * hp + e2; w = f2bf(RAW[2 * 1024 + s0 * 64 + i2]) | (f2bf(RAW[2 * 1024 + (s0 + 1) * 64 + i2]) << 16); }
            *(unsigned*)(rec + RK_VB + ((size_t)((it * 64 + ln) * 8 + e2)) * 2) = w; }
        LDS_BARRIER();
#pragma unroll
        for (int q = 0; q < 4; ++q) { const int ti = hw * 4 + q, rt = ti >> 2, it = ti & 3; f32x4 acc = {0.f, 0.f, 0.f, 0.f};
            acc = mma16(acc, KpT + rt * 16 * 40, 40, VT + it * 16 * 40, 40, 32, t.lane);
            u32x2 zw; zw.x = pk2(acc[0], acc[1]); zw.y = pk2(acc[2], acc[3]);
            *(u32x2*)(rec + RK_ZC + ((size_t)((rt * 4 + it) * 64 + t.lane)) * 8) = zw; }
        LDS_BARRIER();
    }
#undef RWA_LOAD
}
constexpr int RKB_TASKS = BATCH * 8 * 2, RKB_NS = 7, RKB_D = 5, RKB_SLOT = 17408;
__device__ __forceinline__ void rkb_piece(const unsigned char* rp, int p, int w0, int lane, LAS unsigned char* slot) {
    const unsigned char* src;
    if (p < 8) src = rp + RK_PA + (size_t)(p * 64 + lane) * 16; else if (p < 10) src = rp + RK_RA + (size_t)((p - 8) * 64 + lane) * 16; else if (p == 10) src = rp + RK_QA + (size_t)lane * 16;
    else if (p < 15) src = rp + RK_ZC + (size_t)(((p - 11) * 4 + w0 + (lane >> 5)) * 64) * 8 + (size_t)(lane & 31) * 16;
    else src = rp + RK_VB + (size_t)((w0 + (p - 15)) * 64 + lane) * 16;
    __builtin_amdgcn_global_load_lds((const unsigned*)src, (LAS unsigned*)(slot + p * 1024), 16, 0, 0);
}
__device__ __forceinline__ void rkb_issue(const unsigned char* rec, int ck, int w0, int lw, int lane, LAS unsigned char* ring) {
    const unsigned char* rp = rec + (size_t)ck * RK_BYTES; LAS unsigned char* slot = ring + (ck % RKB_NS) * RKB_SLOT;
#pragma unroll
    for (int q = 0; q < 4; ++q) rkb_piece(rp, 4 * lw + q, w0, lane, slot);
    if (lw == 0) rkb_piece(rp, 16, w0, lane, slot);
}
__device__ __forceinline__ void rwkv_b_task(const Args& a, const Tc& t, int task) {
    bf16_t* OR = (bf16_t*)(a.ws + WS_OR);
    const int hb = task & 1, chain = task >> 1, dir = chain & 1, h = (chain >> 1) & 3, b = chain >> 3, hq = t.lane >> 4, lc = t.lane & 15;
    const int w0 = 2 * hb, w = w0 + (t.wave & 1);
    const unsigned char* rec = a.ws + WS_RK + (size_t)chain * NCK * RK_BYTES;
    LAS unsigned char* ring = t.lds;
    const bool loader = (t.wave >= 2 && t.wave <= 5); const int lw = t.wave - 2;
    if (loader) {
#pragma unroll 1
        for (int ck = 0; ck < RKB_D; ++ck) rkb_issue(rec, ck, w0, lw, t.lane, ring);
    }
    f32x4 T[4];
#pragma unroll
    for (int rt = 0; rt < 4; ++rt) T[rt] = (f32x4){0.f, 0.f, 0.f, 0.f};
#pragma unroll 1
    for (int ck = 0; ck < NCK; ++ck) {
        if (loader) {
            if (ck + RKB_D <= NCK) { if (lw == 0) WAIT_V(20); else WAIT_V(16); } else WAIT_V(0);
        }
        __builtin_amdgcn_s_barrier();
        if (loader) { if (ck + RKB_D < NCK) rkb_issue(rec, ck + RKB_D, w0, lw, t.lane, ring); }
        else if (t.wave < 2) {
            const LAS unsigned char* slot = ring + (ck % RKB_NS) * RKB_SLOT;
            bf16x8 pa[4][2], ra[2], qa, vb; f32x4 zc[4]; u32x2 zraw[4];
#pragma unroll
            for (int rt = 0; rt < 4; ++rt) {
#pragma unroll
                for (int ks = 0; ks < 2; ++ks) pa[rt][ks] = *(const LAS bf16x8*)(slot + ((rt * 2 + ks) * 64 + t.lane) * 16);
                zraw[rt] = *(const LAS u32x2*)(slot + (11 + rt) * 1024 + t.wave * 512 + t.lane * 8); }
#pragma unroll
            for (int ks = 0; ks < 2; ++ks) ra[ks] = *(const LAS bf16x8*)(slot + ((8 + ks) * 64 + t.lane) * 16);
            qa = *(const LAS bf16x8*)(slot + (10 * 64 + t.lane) * 16); vb = *(const LAS bf16x8*)(slot + ((15 + t.wave) * 64 + t.lane) * 16);
            WAIT_L(0); __builtin_amdgcn_sched_barrier(0);
#pragma unroll
            for (int rt = 0; rt < 4; ++rt) { const u32x2 zw = zraw[rt]; zc[rt] = (f32x4){bf_lo(zw.x), bf_hi(zw.x), bf_lo(zw.y), bf_hi(zw.y)}; }
            bf16x8 bfr[2];
#pragma unroll
            for (int ks = 0; ks < 2; ++ks) { u32x4 wv; wv.x = pk2(T[2 * ks][0], T[2 * ks][1]); wv.y = pk2(T[2 * ks][2], T[2 * ks][3]); wv.z = pk2(T[2 * ks + 1][0], T[2 * ks + 1][1]); wv.w = pk2(T[2 * ks + 1][2], T[2 * ks + 1][3]);
                bfr[ks] = __builtin_bit_cast(bf16x8, wv); }
            f32x4 o = {0.f, 0.f, 0.f, 0.f};
            o = __builtin_amdgcn_mfma_f32_16x16x32_bf16(bfr[0], ra[0], o, 0, 0, 0);
            o = __builtin_amdgcn_mfma_f32_16x16x32_bf16(bfr[1], ra[1], o, 0, 0, 0);
            o = __builtin_amdgcn_mfma_f32_16x16x32_bf16(vb, qa, o, 0, 0, 0);
#pragma unroll
            for (int rt = 0; rt < 4; ++rt) { f32x4 n = __builtin_amdgcn_mfma_f32_16x16x32_bf16(pa[rt][0], bfr[0], zc[rt], 0, 0, 0); T[rt] = __builtin_amdgcn_mfma_f32_16x16x32_bf16(pa[rt][1], bfr[1], n, 0, 0, 0); }
            { const int row = chain_row(b, dir, ck * RKT + lc); u32x2 ow; ow.x = pk2(o[0], o[1]); ow.y = pk2(o[2], o[3]);
              *(u32x2*)(OR + ((size_t)dir * M + row) * 256 + h * 64 + 16 * w + 4 * hq) = ow; }
        }
    }
    __builtin_amdgcn_s_barrier();
}

constexpr int GLA_UNITS = BATCH * GNC;
__device__ __forceinline__ int gc_row0(int b, int c) { return c < GC_CTX ? ML + b * CTX + 32 * c : b * SEQ + 32 * (c - GC_CTX); }
__device__ __forceinline__ int gc_chain_pos(int c, int dir) { return dir == 0 ? c : (c < GC_CTX ? GC_CTX - 1 - c : GC_CTX + (GC_LAT - 1 - (c - GC_CTX))); }
__device__ __forceinline__ void gla_prefix(LAS float* PRE, int lane) {
    const int d = lane & 31, r0 = (lane >> 5) * 16; float run = 0.f;
#pragma unroll
    for (int i = 0; i < 16; ++i) { run += PRE[(r0 + i) * 33 + d]; PRE[(r0 + i) * 33 + d] = run; }
    WAVE_LDS_FENCE();
    if (lane >= 32) { const float add = PRE[15 * 33 + d];
#pragma unroll
        for (int i = 0; i < 16; ++i) PRE[(16 + i) * 33 + d] += add; }
    WAVE_LDS_FENCE();
}
__device__ __forceinline__ void gla_a1_unit(const Args& a, const Tc& t, int u) {
    const bf16_t* U = (const bf16_t*)(a.ws + WS_U); const float* GG = (const float*)(a.ws + WS_GG);
    float* GZ = (float*)(a.ws + WS_GZ); float* GDEC = (float*)(a.ws + WS_GDEC);
    const int c = u % GNC, b = u / GNC, row0 = gc_row0(b, c);
    const int h = t.wave & 3, dir = t.wave >> 2, chain = (b * 4 + h) * 2 + dir, cc = gc_chain_pos(c, dir);
    LAS float* PRE = (LAS float*)(t.lds + t.wave * 12288);
    LAS bf16_t* KT = (LAS bf16_t*)(PRE + 32 * 33 + 8);
    LAS bf16_t* VT = KT + 32 * 40;
    const int rho = t.lane & 31, hf = t.lane >> 5;
#pragma unroll
    for (int q = 0; q < 4; ++q) { const f32x4 g = *(const f32x4*)(GG + ((size_t)dir * M + row0 + rho) * 128 + h * 32 + hf * 16 + 4 * q);
#pragma unroll
        for (int e = 0; e < 4; ++e) PRE[rho * 33 + hf * 16 + 4 * q + e] = g[e]; }
    WAVE_LDS_FENCE();
    f32x4 graw[4];
#pragma unroll
    for (int q = 0; q < 4; ++q)
#pragma unroll
        for (int e = 0; e < 4; ++e) graw[q][e] = PRE[rho * 33 + hf * 16 + 4 * q + e];
    WAVE_LDS_FENCE();
    gla_prefix(PRE, t.lane);
#pragma unroll
    for (int q = 0; q < 4; ++q) { const f32x4 k = ldbf4(U + (size_t)(row0 + rho) * NU + U_GK + h * 32 + hf * 16 + 4 * q);
#pragma unroll
        for (int e = 0; e < 4; ++e) { const int d = hf * 16 + 4 * q + e; const float pre = PRE[rho * 33 + d], tot = PRE[31 * 33 + d];
            const float w = dir == 0 ? fexp(tot - pre) : fexp(pre - graw[q][e]);
            KT[d * 40 + rho] = (bf16_t)f2bf(k[e] * w); } }
#pragma unroll
    for (int q = 0; q < 8; ++q) { const f32x4 v = ldbf4(U + (size_t)(row0 + rho) * NU + U_GV + h * 64 + hf * 32 + 4 * q);
#pragma unroll
        for (int e = 0; e < 4; ++e) VT[(hf * 32 + 4 * q + e) * 40 + rho] = (bf16_t)f2bf(v[e]); }
    if (t.lane < 32) GDEC[((size_t)chain * GNC + cc) * 32 + t.lane] = fexp(PRE[31 * 33 + t.lane]);
    WAVE_LDS_FENCE();
    float* zb = GZ + ((size_t)chain * GNC + cc) * 2048;
#pragma unroll
    for (int vt = 0; vt < 4; ++vt)
#pragma unroll
        for (int dt = 0; dt < 2; ++dt) { f32x4 acc = {0.f, 0.f, 0.f, 0.f};
            acc = mma16(acc, VT + vt * 16 * 40, 40, KT + dt * 16 * 40, 40, 32, t.lane);
#pragma unroll
            for (int r = 0; r < 4; ++r) zb[(16 * vt + 4 * (t.lane >> 4) + r) * 32 + 16 * dt + (t.lane & 15)] = acc[r]; }
    WAVE_LDS_FENCE();
}
__device__ __forceinline__ void gla_b_carry(const Args& a, const Tc& t, int wg, int nwg) {
    const float* GZ = (const float*)(a.ws + WS_GZ); const float* GDEC = (const float*)(a.ws + WS_GDEC); bf16_t* GST = (bf16_t*)(a.ws + WS_GST);
    static_assert(GNC % 4 == 0, "carry unroll");
    constexpr int NG = GNC / 4, DEP = 3;
    for (int idx = (nwg - 1 - wg) * NTHREADS + t.tid; idx < BATCH * 8 * 512; idx += nwg * NTHREADS) {
        const int chain = idx >> 9, e4 = (idx & 511) * 4, d0 = e4 & 31;
        const float* zc = GZ + (size_t)chain * GNC * 2048 + e4; bf16_t* sc = GST + (size_t)chain * GNC * 2048 + e4; const float* dc = GDEC + (size_t)chain * GNC * 32 + d0;
        f32x4 s = {0.f, 0.f, 0.f, 0.f};
        f32x4 z[DEP][4], d[DEP][4];
#pragma unroll
        for (int g = 0; g < DEP - 1 && g < NG; ++g)
#pragma unroll
            for (int q = 0; q < 4; ++q) { z[g][q] = *(const f32x4*)(zc + (size_t)(4 * g + q) * 2048); d[g][q] = *(const f32x4*)(dc + (size_t)(4 * g + q) * 32); }
#pragma unroll
        for (int g = 0; g < NG; ++g) {
            if (g + DEP - 1 < NG) {
#pragma unroll
                for (int q = 0; q < 4; ++q) { z[(g + DEP - 1) % DEP][q] = *(const f32x4*)(zc + (size_t)(4 * (g + DEP - 1) + q) * 2048); d[(g + DEP - 1) % DEP][q] = *(const f32x4*)(dc + (size_t)(4 * (g + DEP - 1) + q) * 32); } }
#pragma unroll
            for (int q = 0; q < 4; ++q) { u32x2 w; w.x = pk2(s[0], s[1]); w.y = pk2(s[2], s[3]); *(u32x2*)(sc + (size_t)(4 * g + q) * 2048) = w; s = s * d[g % DEP][q] + z[g % DEP][q]; }
        }
    }
}
__device__ __forceinline__ void gla_c_unit(const Args& a, const Tc& t, int u) {
    const bf16_t* U = (const bf16_t*)(a.ws + WS_U); const float* GG = (const float*)(a.ws + WS_GG);
    const bf16_t* GST = (const bf16_t*)(a.ws + WS_GST); bf16_t* OG = (bf16_t*)(a.ws + WS_OG);
    const int c = u % GNC, b = u / GNC, row0 = gc_row0(b, c);
    const int h = t.wave & 3, dir = t.wave >> 2, chain = (b * 4 + h) * 2 + dir, cc = gc_chain_pos(c, dir);
    LAS float* PRE = (LAS float*)(t.lds + t.wave * 14592);
    LAS bf16_t* QN = (LAS bf16_t*)(PRE + 32 * 33 + 8);
    LAS bf16_t* KN = QN + 32 * 40;
    LAS bf16_t* VT = KN + 32 * 40;
    const int rho = t.lane & 31, hf = t.lane >> 5, hq = t.lane >> 4, lc = t.lane & 15;
#pragma unroll
    for (int q = 0; q < 4; ++q) { const f32x4 g = *(const f32x4*)(GG + ((size_t)dir * M + row0 + rho) * 128 + h * 32 + hf * 16 + 4 * q);
#pragma unroll
        for (int e = 0; e < 4; ++e) PRE[rho * 33 + hf * 16 + 4 * q + e] = g[e]; }
    WAVE_LDS_FENCE();
    f32x4 graw[4];
#pragma unroll
    for (int q = 0; q < 4; ++q)
#pragma unroll
        for (int e = 0; e < 4; ++e) graw[q][e] = PRE[rho * 33 + hf * 16 + 4 * q + e];
    WAVE_LDS_FENCE();
    gla_prefix(PRE, t.lane);
#pragma unroll
    for (int q = 0; q < 4; ++q) { const f32x4 qv = ldbf4(U + (size_t)(row0 + rho) * NU + U_GQ + h * 32 + hf * 16 + 4 * q), kv = ldbf4(U + (size_t)(row0 + rho) * NU + U_GK + h * 32 + hf * 16 + 4 * q);
#pragma unroll
        for (int e = 0; e < 4; ++e) { const int d = hf * 16 + 4 * q + e; const float pre = PRE[rho * 33 + d], tot = PRE[31 * 33 + d], ref = PRE[15 * 33 + d];
            const float ex = pre - graw[q][e], qs = qv[e] * 0.17677669529663687f;
            float fq, fk;
            if (dir == 0) { fq = fexp(pre - ref); fk = fexp(ref - pre); } else { fq = fexp(ref - ex); fk = fexp(ex - ref); }
            (void)tot;
            QN[rho * 40 + d] = (bf16_t)f2bf(qs * fq); KN[rho * 40 + d] = (bf16_t)f2bf(kv[e] * fk); } }
    bf16x8 q2f[2];
#pragma unroll
    for (int it = 0; it < 2; ++it) { const int ro = 16 * it + lc; const bf16_t* qp = U + (size_t)(row0 + ro) * NU + U_GQ + h * 32 + 8 * hq; const float* gp = GG + ((size_t)dir * M + row0 + ro) * 128 + h * 32 + 8 * hq;
        const f32x4 qa = ldbf4(qp), qb = ldbf4(qp + 4), ga = *(const f32x4*)gp, gb = *(const f32x4*)(gp + 4);
#pragma unroll
        for (int e = 0; e < 8; ++e) { const int d = 8 * hq + e; const float pre = PRE[ro * 33 + d], tot = PRE[31 * 33 + d]; const float qv = e < 4 ? qa[e & 3] : qb[e & 3], gv = e < 4 ? ga[e & 3] : gb[e & 3];
            const float f2 = dir == 0 ? fexp(pre) : fexp(tot - (pre - gv));
            q2f[it][e] = (short)f2bf(qv * 0.17677669529663687f * f2); } }
#pragma unroll
    for (int q = 0; q < 8; ++q) { const f32x4 v = ldbf4(U + (size_t)(row0 + rho) * NU + U_GV + h * 64 + hf * 32 + 4 * q);
#pragma unroll
        for (int e = 0; e < 4; ++e) VT[(hf * 32 + 4 * q + e) * 40 + rho] = (bf16_t)f2bf(v[e]); }
    WAVE_LDS_FENCE();
    f32x4 att[2][2];
#pragma unroll
    for (int it = 0; it < 2; ++it)
#pragma unroll
        for (int jt = 0; jt < 2; ++jt) { att[it][jt] = (f32x4){0.f, 0.f, 0.f, 0.f}; att[it][jt] = mma16(att[it][jt], QN + it * 16 * 40, 40, KN + jt * 16 * 40, 40, 32, t.lane); }
    WAVE_LDS_FENCE();
#pragma unroll
    for (int it = 0; it < 2; ++it)
#pragma unroll
        for (int jt = 0; jt < 2; ++jt)
#pragma unroll
            for (int r = 0; r < 4; ++r) { const int ro = 16 * it + 4 * hq + r, rp = 16 * jt + lc; const bool keep = dir == 0 ? (rp <= ro) : (rp >= ro);
                QN[ro * 40 + rp] = (bf16_t)f2bf(keep ? att[it][jt][r] : 0.f); }
    WAVE_LDS_FENCE();
    const bf16_t* sb = GST + ((size_t)chain * GNC + cc) * 2048;
#pragma unroll
    for (int it = 0; it < 2; ++it)
#pragma unroll
        for (int vt = 0; vt < 4; ++vt) { f32x4 acc = {0.f, 0.f, 0.f, 0.f};
            acc = mma16(acc, QN + it * 16 * 40, 40, VT + vt * 16 * 40, 40, 32, t.lane);
            const bf16x8 sf = *(const bf16x8*)(sb + (size_t)(16 * vt + lc) * 32 + 8 * hq);
            acc = __builtin_amdgcn_mfma_f32_16x16x32_bf16(q2f[it], sf, acc, 0, 0, 0);
#pragma unroll
            for (int r = 0; r < 4; ++r) stbf(OG + ((size_t)dir * M + row0 + 16 * it + 4 * hq + r) * 256 + h * 64 + 16 * vt + lc, acc[r]); }
    WAVE_LDS_FENCE();
}

__device__ __forceinline__ void phase_mixout(const Args& a, const Tc& t, int l, int Mtok) {
    const bf16_t* U = (const bf16_t*)(a.ws + WS_U); const bf16_t* RW7 = (const bf16_t*)(a.ws + WS_RW7); const bf16_t* SXBC = (const bf16_t*)(a.ws + WS_SXBC);
    const bf16_t* OG = (const bf16_t*)(a.ws + WS_OG); const bf16_t* OR = (const bf16_t*)(a.ws + WS_OR); const bf16_t* OS = (const bf16_t*)(a.ws + WS_OS);
    bf16_t* MIX = (bf16_t*)(a.ws + WS_MIX);
    const float* mu = a.in[I_RMU] + (size_t)l * 2 * 928; const float* g2 = a.in[I_RG2] + (size_t)l * 64 * 256;
    const float* gng = a.in[I_GNG] + (size_t)l * 256; const float* lng = a.in[I_RLG] + (size_t)l * 256; const float* lnb = a.in[I_RLB] + (size_t)l * 256;
    const float* rrk = a.in[I_RRK] + (size_t)l * 256; const float* sd = a.in[I_SD] + (size_t)l * 8; const float* sng = a.in[I_SNG] + (size_t)l * 512;
    LAS float* SG = (LAS float*)t.lds;
    LAS float* RED = (LAS float*)(t.lds + 4096);
    const size_t P = (size_t)M * 256;
    LAS float* G2S = (LAS float*)(t.lds + 8192);
    for (int e = t.tid; e < 64 * 256 / 4; e += NTHREADS) *(LAS f32x4*)(G2S + 4 * e) = *(const f32x4*)(g2 + 4 * e);
    LDS_BARRIER();
    for (int tile = t.bid; tile < Mtok / 16; tile += t.G) {
        const int r0 = tile * 16; int slo, shi; seg_bounds(r0, slo, shi);
        unsigned lgr[8][4], lsd[16][2];
        {   const int c = t.tid & 255, tt0 = (t.tid >> 8) * 8;
#pragma unroll
            for (int j = 0; j < 8; ++j) { const size_t row = (size_t)(r0 + tt0 + j);
                lgr[j][0] = (unsigned)OG[row * 256 + c] | ((unsigned)OG[P + row * 256 + c] << 16);
                lgr[j][1] = (unsigned)OR[row * 256 + c] | ((unsigned)OR[P + row * 256 + c] << 16);
                lgr[j][2] = (unsigned)U[row * NU + U_GOG + c] | ((unsigned)RW7[row * 256 + c] << 16);
                lgr[j][3] = (unsigned)RW7[P + row * 256 + c] | ((unsigned)RW7[2 * P + row * 256 + c] << 16); }
            const int cs = t.tid;
#pragma unroll
            for (int q = 0; q < 16; ++q) { const size_t row = (size_t)(r0 + q);
                lsd[q][0] = (unsigned)OS[row * 512 + cs] | ((unsigned)OS[(size_t)M * 512 + row * 512 + cs] << 16);
                lsd[q][1] = (unsigned)SXBC[row * 1024 + cs] | ((unsigned)U[row * NU + U_SZ + cs] << 16); } }
        {   const int tt = t.tid >> 5, r = t.tid & 31, row = r0 + tt; const bf16_t* up = U + (size_t)row * NU; const bool hp = row - 1 >= slo, hn = row + 1 < shi;
#pragma unroll
            for (int q = 0; q < 2; ++q) { const int col = U_RLGT + q * 32 + r, mi = col - U_RW; const float u = ldbf(up + col), pv = ld_or0(up + col - NU, up + col, hp), nv = ld_or0(up + col + NU, up + col, hn);
                SG[tt * 64 + q * 32 + r] = sigmoidf_(u + mu[mi] * (pv - u) + mu[928 + mi] * (nv - u)); } }
        LDS_BARRIER();
        {
            const int c = t.tid & 255, tt0 = (t.tid >> 8) * 8;
            float ag[8];
#pragma unroll
            for (int j = 0; j < 8; ++j) ag[j] = 0.f;
#pragma unroll 2
            for (int r4 = 0; r4 < 16; ++r4) { float w[4];
#pragma unroll
                for (int q = 0; q < 4; ++q) w[q] = G2S[(4 * r4 + q) * 256 + c];
#pragma unroll
                for (int j = 0; j < 8; ++j) { const f32x4 sv = *(const LAS f32x4*)(SG + (tt0 + j) * 64 + 4 * r4); ag[j] += (sv[0] * w[0] + sv[1] * w[1]) + (sv[2] * w[2] + sv[3] * w[3]); } }
            const float gn = gng[c], lg = lng[c], lb = lnb[c], rk = rrk[c];
#pragma unroll
            for (int j = 0; j < 8; ++j) { const int row = r0 + tt0 + j;
                const float og_ = bf_lo(lgr[j][0]) + bf_hi(lgr[j][0]);
                const float ms = wave_sum(og_ * og_) * (1.0f / 64.0f);
                const float o1 = og_ * (frsq(ms + 1e-6f)) * gn * siluf_(bf_lo(lgr[j][2]));
                const float orr = bf_lo(lgr[j][1]) + bf_hi(lgr[j][1]);
                const float mean = wave_sum(orr) * (1.0f / 64.0f); const float dd = orr - mean; const float var = wave_sum(dd * dd) * (1.0f / 64.0f);
                const float on = dd * (frsq(var + 64e-5f)) * lg + lb;
                const float bon = wave_sum(bf_hi(lgr[j][2]) * bf_lo(lgr[j][3]) * rk) * bf_hi(lgr[j][3]);
                const float o2 = (on + bon) * ag[j];
                MIX[(size_t)row * D + c] = (bf16_t)f2bf(o1); MIX[(size_t)row * D + 256 + c] = (bf16_t)f2bf(o2); }
        }
        {
            const int c = t.tid; const float dh = sd[c >> 6], ng = sng[c];
            float y[16];
#pragma unroll
            for (int q = 0; q < 16; ++q) {
                float v = bf_lo(lsd[q][0]) + bf_hi(lsd[q][0]) + dh * bf_lo(lsd[q][1]);
                v *= siluf_(bf_hi(lsd[q][1])); y[q] = v;
                const float ss = wave_sum(v * v); if (t.lane == 0) RED[q * 8 + t.wave] = ss; }
            LDS_BARRIER();
            const int gb = (t.wave >> 2) * 4;
#pragma unroll
            for (int q = 0; q < 16; ++q) { const float ms = (RED[q * 8 + gb] + RED[q * 8 + gb + 1] + RED[q * 8 + gb + 2] + RED[q * 8 + gb + 3]) * (1.0f / 256.0f);
                MIX[(size_t)(r0 + q) * D + 512 + c] = (bf16_t)f2bf(y[q] * (frsq(ms + 1e-6f)) * ng); }
        }
        LDS_BARRIER();
    }
}

static_assert(NEXP <= 32, "router lanes");
__device__ __forceinline__ unsigned long long router_key(float v, int e) { unsigned u = __float_as_uint(v); u = (u & 0x80000000u) ? ~u : (u | 0x80000000u); return ((unsigned long long)u << 32) | (unsigned)(31 - e); }
__device__ __forceinline__ float router_unkey(unsigned long long k) { unsigned u = (unsigned)(k >> 32); u = (u & 0x80000000u) ? (u & 0x7fffffffu) : ~u; return __uint_as_float(u); }
__device__ __forceinline__ void phase_router(const Args& a, const Tc& t, int l, int Mtok) {
    const bf16_t* X = (const bf16_t*)(a.ws + WS_X); bf16_t* H = (bf16_t*)(a.ws + WS_H); const float* MODS = (const float*)(a.ws + WS_MODS) + (size_t)l * NR * 6144;
    const float* rw = a.in[I_ROUTW] + (size_t)l * D * NEXP; const float* rb = a.in[I_ROUTB] + (size_t)l * NEXP;
    int* TOPI = (int*)(a.ws + WS_TOPI); float* TOPP = (float*)(a.ws + WS_TOPP);
    unsigned* CNT = (unsigned*)(a.ws + WS_CTL) + CW_CNT + l * 64;
    LAS int* hist = (LAS int*)(t.lds + LDS_MISC + 64);
    LAS float* HT = (LAS float*)t.lds;
    LAS float* PART = HT + 16 * 1028;
    if (t.tid < NEXP) hist[t.tid] = 0;
    __syncthreads();
    const int hq = t.lane >> 4, lc = t.lane & 15, e = t.lane & 31, rh = t.lane >> 5; const bool ev = e < NEXP;
    const float bias = ev ? rb[e] : 0.f;
    constexpr int NT = NEXP > 16 ? 2 : 1;
    float wreg[NT][32];
#pragma unroll
    for (int nt = 0; nt < NT; ++nt)
#pragma unroll
        for (int ks = 0; ks < 32; ++ks) { const int k = 128 * t.wave + 4 * ks + hq, col = 16 * nt + lc; wreg[nt][ks] = col < NEXP ? rw[(size_t)k * NEXP + col] : 0.f; }
    for (int tile = t.bid; tile < Mtok / 16; tile += t.G) {
        const int r0 = tile * 16;
#pragma unroll
        for (int rr = 0; rr < 2; ++rr) { const int lr = 2 * t.wave + rr, row = r0 + lr;
            f32x4 v[4], h[4];
#pragma unroll
            for (int j = 0; j < 4; ++j) v[j] = ldbf4(X + (size_t)row * D + 4 * t.lane + 256 * j);
            const float* md = MODS + (size_t)mod_row(row) * 6144;
            norm_mod_store<true>(v, a.in[I_N2G] + (size_t)l * D, md + 3 * 1024, md + 4 * 1024, (bf16_t*)((unsigned char*)H + (size_t)row * D), t.lane, h);
#pragma unroll
            for (int j = 0; j < 4; ++j) *(LAS f32x4*)(HT + lr * 1028 + 4 * t.lane + 256 * j) = h[j]; }
        LDS_BARRIER();
        f32x4 acc[NT];
#pragma unroll
        for (int nt = 0; nt < NT; ++nt) acc[nt] = (f32x4){0.f, 0.f, 0.f, 0.f};
#pragma unroll
        for (int ks = 0; ks < 32; ++ks) { const float av = HT[lc * 1028 + 128 * t.wave + 4 * ks + hq];
#pragma unroll
            for (int nt = 0; nt < NT; ++nt) acc[nt] = __builtin_amdgcn_mfma_f32_16x16x4f32(av, wreg[nt][ks], acc[nt], 0, 0, 0); }
#pragma unroll
        for (int nt = 0; nt < NT; ++nt)
#pragma unroll
            for (int r = 0; r < 4; ++r) PART[(t.wave * 16 + 4 * hq + r) * 33 + 16 * nt + lc] = acc[nt][r];
        LDS_BARRIER();
        {   const int lr = 2 * t.wave + rh, row = r0 + lr;
            float lg = bias;
#pragma unroll
            for (int w2 = 0; w2 < 8; ++w2) lg += PART[(w2 * 16 + lr) * 33 + (ev ? e : 0)];
            if (!ev) lg = -3.0e38f;
            unsigned long long key = router_key(lg, e);
            int ti[4]; float tv[4];
#pragma unroll
            for (int k = 0; k < 4; ++k) { unsigned long long m = key;
#pragma unroll
                for (int o = 1; o < 32; o <<= 1) { const unsigned long long other = __shfl_xor(m, o); m = other > m ? other : m; }
                ti[k] = 31 - (int)(unsigned)(m & 0xffffffffu); tv[k] = router_unkey(m);
                if (ti[k] == e) key = 0ull; }
            const float e0 = 1.0f, e1 = fexp(tv[1] - tv[0]), e2 = fexp(tv[2] - tv[0]), e3 = fexp(tv[3] - tv[0]); const float inv = frcp(e0 + e1 + e2 + e3);
            if (e == 0) {
                TOPI[row * 4 + 0] = ti[0]; TOPI[row * 4 + 1] = ti[1]; TOPI[row * 4 + 2] = ti[2]; TOPI[row * 4 + 3] = ti[3];
                TOPP[row * 4 + 0] = e0 * inv; TOPP[row * 4 + 1] = e1 * inv; TOPP[row * 4 + 2] = e2 * inv; TOPP[row * 4 + 3] = e3 * inv;
#pragma unroll
                for (int k = 0; k < 4; ++k) atomicAdd((int*)&hist[ti[k]], 1);
            } }
        LDS_BARRIER();
    }
    __syncthreads();
    if (t.tid < NEXP && hist[t.tid] != 0) atomicAdd(&CNT[t.tid], (unsigned)hist[t.tid]);
}

__device__ __forceinline__ int moe_offsets(const unsigned* CNT, LAS int* off, LAS int* cnt, int tid) {
    if (tid < NEXP) { int o = 0; for (int e = 0; e < tid; ++e) o += ((int)CNT[e] + 255) & ~255; off[tid] = o; cnt[tid] = (int)CNT[tid]; }
    __syncthreads();
    return (off[NEXP - 1] + ((cnt[NEXP - 1] + 255) & ~255)) >> 8;
}
__device__ __forceinline__ void phase_lists(const Args& a, const Tc& t, int l, int Mtok) {
    const int* TOPI = (const int*)(a.ws + WS_TOPI); const float* TOPP = (const float*)(a.ws + WS_TOPP);
    int* POS = (int*)(a.ws + WS_POS); int* ROWIDX = (int*)(a.ws + WS_ROWIDX); float* ROWGATE = (float*)(a.ws + WS_ROWGATE);
    unsigned* CNT = (unsigned*)(a.ws + WS_CTL) + CW_CNT + l * 64; unsigned* CUR = (unsigned*)(a.ws + WS_CTL) + CW_CUR + l * 64;
    LAS int* off = (LAS int*)(t.lds + LDS_MISC + 64); LAS int* cnt = off + 64; LAS int* hist = off + 128; LAS int* base = off + 192; LAS int* cur = off + 256;
    if (t.tid < NEXP) { hist[t.tid] = 0; cur[t.tid] = 0; }
    moe_offsets(CNT, off, cnt, t.tid);
    const int rpb = (Mtok + t.G - 1) / t.G, s0 = t.bid * rpb * 4; int s1 = (t.bid + 1) * rpb * 4; if (s1 > Mtok * 4) s1 = Mtok * 4;
    for (int s = s0 + t.tid; s < s1; s += NTHREADS) atomicAdd((int*)&hist[TOPI[s]], 1);
    __syncthreads();
    if (t.tid < NEXP) base[t.tid] = hist[t.tid] ? (int)atomicAdd(&CUR[t.tid], (unsigned)hist[t.tid]) : 0;
    __syncthreads();
    for (int s = s0 + t.tid; s < s1; s += NTHREADS) { const int e = TOPI[s]; const int p = off[e] + base[e] + atomicAdd((int*)&cur[e], 1);
        POS[s] = p; ROWIDX[p] = s >> 2; ROWGATE[p] = TOPP[s]; }
    for (int e = t.bid; e < NEXP; e += t.G) { const int lo = off[e] + cnt[e], hi = off[e] + ((cnt[e] + 255) & ~255);
        for (int p = lo + t.tid; p < hi; p += NTHREADS) { ROWIDX[p] = 0; ROWGATE[p] = 0.f; } }
    __syncthreads();
}
__device__ __forceinline__ int moe_tile_table(const Args& a, const Tc& t, int l) {
    unsigned* CNT = (unsigned*)(a.ws + WS_CTL) + CW_CNT + l * 64;
    LAS int* off = (LAS int*)(t.lds + LDS_MISC + 64); LAS int* cnt = off + 64; LAS int* tile_e = (LAS int*)(t.lds + LDS_TILE_E);
    const int ntiles = moe_offsets(CNT, off, cnt, t.tid);
    for (int tt = t.tid; tt < ntiles; tt += NTHREADS) { int e = 0;
        for (int q = 1; q < NEXP; ++q) if ((off[q] >> 8) <= tt) e = q;
        tile_e[tt] = e; }
    __syncthreads();
    return ntiles;
}

__device__ __forceinline__ void phase_combine(const Args& a, const Tc& t, int l, int Mtok) {
    const int gw = t.bid * NWAVES + t.wave, NGW = t.G * NWAVES;
    bf16_t* X = (bf16_t*)(a.ws + WS_X); bf16_t* H = (bf16_t*)(a.ws + WS_H); const bf16_t* Y = (const bf16_t*)(a.ws + WS_Y); const int* POS = (const int*)(a.ws + WS_POS);
    const float* MODS = (const float*)(a.ws + WS_MODS) + (size_t)l * NR * 6144;
    for (int rp = gw * 2; rp < Mtok; rp += NGW * 2) {
        int ps[2][4];
#pragma unroll
        for (int q = 0; q < 2; ++q) { const u32x4 pv = *(const u32x4*)(POS + (size_t)(rp + q) * 4); ps[q][0] = (int)pv.x; ps[q][1] = (int)pv.y; ps[q][2] = (int)pv.z; ps[q][3] = (int)pv.w; }
        u32x2 yv[2][4][4]; f32x4 xv[2][4];
#pragma unroll
        for (int q = 0; q < 2; ++q)
#pragma unroll
            for (int j = 0; j < 4; ++j) { const int c = 4 * t.lane + 256 * j; xv[q][j] = ldbf4(X + (size_t)(rp + q) * D + c);
#pragma unroll
                for (int k = 0; k < 4; ++k) yv[q][k][j] = *(const u32x2*)(Y + (size_t)ps[q][k] * D + c); }
#pragma unroll
        for (int q = 0; q < 2; ++q) { const int row = rp + q;
            const float* md = MODS + (size_t)mod_row(row) * 6144 + 5 * 1024;
            f32x4 v[4], h[4];
#pragma unroll
            for (int j = 0; j < 4; ++j) { const int c = 4 * t.lane + 256 * j;
                const u32x2 y0 = yv[q][0][j], y1 = yv[q][1][j], y2 = yv[q][2][j], y3 = yv[q][3][j];
                f32x4 s_; s_[0] = (bf_lo(y0.x) + bf_lo(y1.x)) + (bf_lo(y2.x) + bf_lo(y3.x)); s_[1] = (bf_hi(y0.x) + bf_hi(y1.x)) + (bf_hi(y2.x) + bf_hi(y3.x));
                s_[2] = (bf_lo(y0.y) + bf_lo(y1.y)) + (bf_lo(y2.y) + bf_lo(y3.y)); s_[3] = (bf_hi(y0.y) + bf_hi(y1.y)) + (bf_hi(y2.y) + bf_hi(y3.y));
                const f32x4 g = *(const f32x4*)(md + c);
                v[j] = xv[q][j] + g * s_; }
            if (l + 1 < DEPTH) {
#pragma unroll
                for (int j = 0; j < 4; ++j) { u32x2 w; w.x = pk2(v[j][0], v[j][1]); w.y = pk2(v[j][2], v[j][3]); *(u32x2*)(X + (size_t)row * D + 4 * t.lane + 256 * j) = w; }
                const float* md2 = MODS + (size_t)NR * 6144 + (size_t)mod_row(row) * 6144;
                norm_mod_store(v, a.in[I_N1G] + (size_t)(l + 1) * D, md2, md2 + 1024, H + (size_t)row * D, t.lane, h);
            } else {
                float ss = 0.f;
#pragma unroll
                for (int j = 0; j < 4; ++j) ss += (v[j][0] * v[j][0] + v[j][1] * v[j][1]) + (v[j][2] * v[j][2] + v[j][3] * v[j][3]);
                const float rstd = frsq(wave_sum(ss) * (1.0f / D) + 1e-6f);
#pragma unroll
                for (int j = 0; j < 4; ++j) { const int c = 4 * t.lane + 256 * j; const f32x4 g = *(const f32x4*)(a.in[I_FNG] + c); *(f32x4*)(a.out + (size_t)row * D + c) = v[j] * rstd * g; }
            } }
    }
}

#ifndef EMU
__device__ __forceinline__ void launder_ws(Args& al) {
    __attribute__((address_space(1))) unsigned char* p = (__attribute__((address_space(1))) unsigned char*)al.ws; asm volatile("" : "+s"(p)); al.ws = (unsigned char*)p; }
__device__ __forceinline__ void launder_tid(Tc& t) { int x = threadIdx.x; asm volatile("" : "+v"(x)); t.tid = x; t.lane = x & 63; t.wave = __builtin_amdgcn_readfirstlane(x >> 6); }
#endif
constexpr int PH_PER_LAYER = 12, N_PHASES = 2 + DEPTH * PH_PER_LAYER;
__global__ void __launch_bounds__(NTHREADS, 2) fwd(Args a) {
#ifdef EMU
    unsigned char* lds_raw = EMU_DYN_LDS();
#else
    extern __shared__ __attribute__((aligned(16))) unsigned char lds_raw[];
#endif
    Tc t; t.lds = (LAS unsigned char*)lds_raw; t.tid = threadIdx.x; t.lane = t.tid & 63; t.wave = __builtin_amdgcn_readfirstlane(t.tid >> 6); t.G = gridDim.x; t.bid = blockIdx.x;
    const int lo = a.ph_lo, hi = a.ph_hi;
    Args al = a;
    volatile LAS unsigned* misc = (volatile LAS unsigned*)(t.lds + LDS_MISC);
    if (t.tid < 16) misc[t.tid] = 0u;
    if (t.tid == 0) { LAS unsigned long long* tb = (LAS unsigned long long*)(t.lds + LDS_PTRS);
#pragma unroll
        for (int i = 0; i < 37; ++i) tb[i] = (unsigned long long)a.in[i]; }
    __syncthreads();
    XcdBarrier bar; bar.bar = (unsigned*)(a.ws + WS_CTL) + CW_BAR; bar.x = 0; bar.st = misc;
    if (hi - lo > 1) bar = xcd_barrier_post((unsigned*)(a.ws + WS_CTL) + CW_BAR, misc);
#ifdef EMU
#define LAUNDER_TID() ((void)0)
#else
#define LAUNDER_TID() launder_tid(t)
#endif
#if PROBE_SPIN >= 0 && !defined(EMU)
    unsigned long long pt_acc = 0ull, pt_t0 = 0ull;
#define PT_MATCH(k) ((PROBE_SPIN >= 100) ? ((k) == PROBE_SPIN - 100) : ((k) >= 2 && ((k) - 2) % PH_PER_LAYER == PROBE_SPIN))
#define PT_BEGIN(k) (PT_MATCH(k) ? (pt_t0 = wall_clock64(), true) : true)
#define PT_END(k) do { if (PT_MATCH(k)) pt_acc += wall_clock64() - pt_t0; } while (0)
#else
#define PT_BEGIN(k) true
#define PT_END(k) ((void)0)
#endif
#ifdef EMU
#define LAUNDER_WS() ((void)0)
#else
#define LAUNDER_WS() launder_ws(al)
#endif
#define IN_PH(k) (lo <= (k) && (k) < hi && (LAUNDER_TID(), LAUNDER_WS(), true) && PT_BEGIN(k))
#define REPS(bit) (((PROBE_DOUBLE >> (bit)) & 1) ? 2 : 1)
#ifdef EMU
#define SEAM(k) do { if ((k) + 1 < hi) xcd_barrier(bar); PT_END(k); } while (0)
#else
#define SEAM(k) do { if ((k) + 1 < hi) { XcdBarrier b2_ = bar; __attribute__((address_space(1))) unsigned* bp_ = (__attribute__((address_space(1))) unsigned*)b2_.bar; asm volatile("" : "+s"(bp_)); b2_.bar = (unsigned*)bp_; xcd_barrier(b2_); } PT_END(k); } while (0)
#endif
    if (IN_PH(0)) { for (int rep = 0; rep < REPS(15); ++rep) phase_pro0(al, t); SEAM(0); }
    if (IN_PH(1)) { phase_pro1(al, t); SEAM(1); }
    for (int l = 0; l < DEPTH; ++l) {
        const int pb = 2 + l * PH_PER_LAYER;
        const bool lastl = (l == DEPTH - 1);
        const int Mtok = lastl ? ML : M;
        const float* MODSL = (const float*)(al.ws + WS_MODS) + (size_t)l * NR * 6144;
        if (IN_PH(pb + 0)) {
            pg8::Gemm g{(const bf16_t*)(al.ws + WS_H), (const bf16_t*)(al.ws + WS_WIN) + (size_t)l * NU * D, D, nullptr};
            pg8::DenseSched S; S.o.init(M / 256, NU / 256, t.G, t.bid);
            pg8::EpiBf16 E{(bf16_t*)(al.ws + WS_U), NU};
            for (int rep = 0; rep < REPS(0); ++rep) pg8::gemm_phase<pg8::EpiBf16, pg8::DenseSched, false>(t.lds, t.tid, g, S, E);
            convert_in_slack(al, t, l, 0, CV_E_IN, (M / 256) * (NU / 256));
            SEAM(pb + 0);
        }
        if (IN_PH(pb + 1)) { for (int rep = 0; rep < REPS(1); ++rep) phase_prep(al, t, l); SEAM(pb + 1); }
        const bool a1_in_b = t.G >= 2 * RKB_TASKS;
        if (IN_PH(pb + 2)) {
            for (int rep = 0; rep < REPS(4); ++rep) rwkv_a_all(al, t);
            if (!a1_in_b) for (int u = t.bid; u < SSD_UNITS + GLA_UNITS; u += t.G) { if (u < SSD_UNITS) ssd_a1_unit(al, t, l, u); else gla_a1_unit(al, t, u - SSD_UNITS); }
            SEAM(pb + 2);
        }
        if (IN_PH(pb + 3)) {
            if (a1_in_b) {
                if (t.bid < RKB_TASKS) { for (int rep = 0; rep < REPS(5); ++rep) rwkv_b_task(al, t, t.bid); }
                else { const int wg = t.bid - RKB_TASKS, nwg = t.G - RKB_TASKS;
                    for (int u = wg; u < SSD_UNITS + GLA_UNITS; u += nwg) { if (u < SSD_UNITS) ssd_a1_unit(al, t, l, u); else gla_a1_unit(al, t, u - SSD_UNITS); }
                    unsigned* sub = (unsigned*)(al.ws + WS_CTL) + CW_SUB + l * 64;
                    sub_arrive(sub);
                    convert_moe(al, t, l, CV_E_IN, lastl ? CV_MOE_ITEMS : CV_E_B, wg * NWAVES + t.wave, nwg * NWAVES);
                    if (!lastl) convert_dense(al, t, l + 1, wg * NWAVES + t.wave, nwg * NWAVES);
                    sub_wait(sub, (unsigned)nwg);
                    ssd_b_carry(al, t, wg, nwg); gla_b_carry(al, t, wg, nwg); }
            } else {
                for (int task = t.bid; task < RKB_TASKS; task += t.G) rwkv_b_task(al, t, task);
                ssd_b_carry(al, t, t.bid, t.G); gla_b_carry(al, t, t.bid, t.G); __syncthreads(); convert_moe(al, t, l, CV_E_IN, lastl ? CV_MOE_ITEMS : CV_E_B, t.bid * NWAVES + t.wave, t.G * NWAVES); if (!lastl) convert_dense(al, t, l + 1, t.bid * NWAVES + t.wave, t.G * NWAVES);
            }
            SEAM(pb + 3);
        }
        if (IN_PH(pb + 4)) {
            for (int rep = 0; rep < REPS(6); ++rep) for (int u = t.bid; u < SSD_UNITS + GLA_UNITS; u += t.G) { if (u < SSD_UNITS) ssd_c_unit(al, t, l, u); else gla_c_unit(al, t, u - SSD_UNITS); }
            SEAM(pb + 4);
        }
        if (IN_PH(pb + 5)) { for (int rep = 0; rep < REPS(3); ++rep) phase_mixout(al, t, l, Mtok); SEAM(pb + 5); }
        if (IN_PH(pb + 6)) {
            pg8::Gemm g{(const bf16_t*)(al.ws + WS_MIX), (const bf16_t*)(al.ws + WS_WOUT) + (size_t)l * D * D, D, nullptr};
            pg8::DenseSched S; S.o.init(Mtok / 256, D / 256, t.G, t.bid);
            pg8::EpiResid E{(bf16_t*)(al.ws + WS_X), MODSL};
            pg8::gemm_phase<pg8::EpiResid, pg8::DenseSched, false>(t.lds, t.tid, g, S, E);
            if (!lastl) convert_in_slack(al, t, l, CV_E_B, CV_MOE_ITEMS, (Mtok / 256) * (D / 256));
            SEAM(pb + 6);
        }
        if (IN_PH(pb + 7)) { phase_router(al, t, l, Mtok); SEAM(pb + 7); }
        if (IN_PH(pb + 8)) { phase_lists(al, t, l, Mtok); SEAM(pb + 8); }
        if (IN_PH(pb + 9)) {
            const int ntiles = moe_tile_table(al, t, l);
            pg8::Gemm g{(const bf16_t*)(al.ws + WS_H), (const bf16_t*)(al.ws + WS_WGU + (size_t)l * NEXP * 2048 * D), D / 2, (const int*)(al.ws + WS_ROWIDX)};
            pg8::MoeSched S; S.o.init(ntiles, 8, t.G, t.bid); S.tile_e = (const LAS int*)(t.lds + LDS_TILE_E); S.nct = 8;
            pg8::EpiSwiglu E{al.ws + WS_ACT, al.in[I_BGU] + (size_t)l * NEXP * 2048};
            for (int rep = 0; rep < REPS(7); ++rep) pg8::gemm_phase<pg8::EpiSwiglu, pg8::MoeSched, true, true>(t.lds, t.tid, g, S, E);
            SEAM(pb + 9);
        }
        if (IN_PH(pb + 10)) {
            const int ntiles = moe_tile_table(al, t, l);
            pg8::Gemm g{(const bf16_t*)(al.ws + WS_ACT), (const bf16_t*)(al.ws + WS_WD + (size_t)l * NEXP * D * DFF), DFF / 2, nullptr};
            pg8::MoeSched S; S.o.init(ntiles, 4, t.G, t.bid); S.tile_e = (const LAS int*)(t.lds + LDS_TILE_E); S.nct = 4;
            pg8::EpiDown E{(bf16_t*)(al.ws + WS_Y), al.in[I_BDN] + (size_t)l * NEXP * D, (const float*)(al.ws + WS_ROWGATE)};
            for (int rep = 0; rep < REPS(8); ++rep) pg8::gemm_phase<pg8::EpiDown, pg8::MoeSched, false, true>(t.lds, t.tid, g, S, E);
            SEAM(pb + 10);
        }
        if (IN_PH(pb + 11)) { phase_combine(al, t, l, Mtok); SEAM(pb + 11); }
    }
#if PROBE_SPIN >= 0 && !defined(EMU)
    if (t.bid == 0) { const unsigned long long te = wall_clock64(); while (wall_clock64() - te < 4ull * pt_acc) __builtin_amdgcn_s_sleep(8); }
#endif
#undef IN_PH
#undef SEAM
}

}

extern "C" void kernel_launch(void* const* d_in, const int* in_sizes, int n_in, void* d_out, int out_size, void* d_ws, size_t ws_size, hipStream_t stream) {
    using namespace mk;
    static int grid = 0;
    if (grid == 0) {
        if (n_in != 37 || out_size != ML * D || ws_size < WS_END) { fprintf(stderr, "kernel_launch: unexpected shapes (n_in %d out %d ws %zu need %zu)\n", n_in, out_size, ws_size, (size_t)WS_END); grid = -1; return; }
#ifdef EMU
        { const char* e = getenv("EMU_GRID"); grid = e ? atoi(e) : 8; }
#else
        int dev = 0, cus = 0, per_cu = 0;
        if (hipGetDevice(&dev) != hipSuccess || hipDeviceGetAttribute(&cus, hipDeviceAttributeMultiprocessorCount, dev) != hipSuccess) { grid = -1; return; }
        if (hipFuncSetAttribute((const void*)fwd, hipFuncAttributeMaxDynamicSharedMemorySize, LDS_BYTES) != hipSuccess) { fprintf(stderr, "kernel_launch: hipFuncSetAttribute failed\n"); grid = -1; return; }
        if (hipOccupancyMaxActiveBlocksPerMultiprocessor(&per_cu, (const void*)fwd, NTHREADS, LDS_BYTES) != hipSuccess || per_cu < 1) fprintf(stderr, "kernel_launch: occupancy query reports %d\n", per_cu);
        (void)hipGetLastError();
        grid = cus;
#endif
    }
    if (grid < 0) return;
    (void)hipMemsetAsync((char*)d_ws + WS_CTL, 0, CTL_BYTES, stream);
    Args a{};
    for (int i = 0; i < 37; ++i) a.in[i] = (const float*)d_in[i];
    a.out = (float*)d_out; a.ws = (unsigned char*)d_ws;
#if N_LAUNCH_MODE == 1
    a.ph_lo = 0; a.ph_hi = N_PHASES;
    hipLaunchKernelGGL(fwd, dim3(grid), dim3(NTHREADS), LDS_BYTES, stream, a);
#else
    for (int p = 0; p < N_PHASES; ++p) { a.ph_lo = p; a.ph_hi = p + 1; hipLaunchKernelGGL(fwd, dim3(grid), dim3(NTHREADS), LDS_BYTES, stream, a); }
#endif
}
```
